# Optimizing an MI355X kernel written in HIP

```python
import jax, jax.numpy as jnp
from jax import lax
import numpy as np

D_MODEL = 1024
BATCH = 8
SEQ = 4096
DEPTH = 2

GRID_W = 64
CTX_LEN = 256
HG_DIM = 128
HG_WIDTH = D_MODEL // 2
HG_HEADS = HG_WIDTH // HG_DIM
MLP_WIDTH = D_MODEL - HG_WIDTH
MLP_HEADS = 4
MLP_DIM = MLP_WIDTH // MLP_HEADS
MLP_CHUNK = 128
SCAN_CHUNK = 32
MIX_WIDTH = HG_WIDTH + MLP_WIDTH
PROJ_WIDTH = 5 * HG_WIDTH + 2 * MLP_WIDTH
D_FF = 2816
CONV_W = 3
EPS = 1e-6

kernel_name = "hybrid_hgrn2_gmlp_dit_prefix"


def rmsnorm(x, gain):
    xf = x.astype(jnp.float32)
    y = xf * lax.rsqrt(jnp.mean(xf * xf, axis=-1, keepdims=True) + EPS)
    return (y * gain.astype(jnp.float32)).astype(x.dtype)


def layernorm(x, gain, bias):
    xf = x.astype(jnp.float32)
    mu = jnp.mean(xf, axis=-1, keepdims=True)
    var = jnp.mean(jnp.square(xf - mu), axis=-1, keepdims=True)
    y = (xf - mu) * lax.rsqrt(var + EPS) * gain.astype(jnp.float32) + bias.astype(jnp.float32)
    return y.astype(x.dtype)


def modulate(h, shift, scale):
    return h * (1.0 + scale) + shift


def split_heads(a, n_heads):
    b, t, w = a.shape
    return a.reshape(b, t, n_heads, w // n_heads).transpose(0, 2, 1, 3)


def merge_heads(a):
    b, h, t, d = a.shape
    return a.transpose(0, 2, 1, 3).reshape(b, t, h * d)


def flip_t(a):
    return jnp.flip(a, axis=2)


def lower_bounds(logits):
    cum = jnp.cumsum(jax.nn.softmax(logits.astype(jnp.float32), axis=0), axis=0)
    return cum - cum[0:1]


def forget_gate(f_logit, lb, first):
    f = f_logit.astype(jnp.float32)
    if first:
        return jax.nn.log_sigmoid(f), jax.nn.sigmoid(-f)
    gate = lb + (1.0 - lb) * jax.nn.sigmoid(f)
    return jnp.log(gate), 1.0 - gate


def hgrn2_gates(p, lb_f, lb_b, first):
    w = HG_WIDTH
    logf_f, k_f = forget_gate(p[..., :w], lb_f, first)
    logf_b, k_b = forget_gate(p[..., w:2 * w], lb_b, first)
    v = p[..., 2 * w:3 * w].astype(jnp.float32)
    return tuple(split_heads(a, HG_HEADS) for a in (logf_f, k_f, logf_b, k_b, v))


def advance_state(h, k, v, b):
    b_last = b[:, :, -1:, :]
    return (jnp.exp(b_last)[:, :, 0, :, None] * h
            + jnp.einsum('bhsk,bhsv->bhkv', k * jnp.exp(b_last - b), v))


def chunk_gla(q, k, v, log_f, h0):
    b_, h_, t, _ = q.shape
    n = t // SCAN_CHUNK

    def to_chunks(a):
        return jnp.moveaxis(a.reshape(b_, h_, n, SCAN_CHUNK, a.shape[-1]), 2, 0)

    mask = jnp.tril(jnp.ones((SCAN_CHUNK, SCAN_CHUNK), dtype=bool))[:, :, None]

    def step(h, blk):
        qc, kc, vc, gc = blk
        b = jnp.cumsum(gc, axis=2)
        o_inter = jnp.einsum('bhtk,bhkv->bhtv', qc * jnp.exp(b), h)
        diff = b[:, :, :, None, :] - b[:, :, None, :, :]
        decay = jnp.where(mask, jnp.exp(jnp.where(mask, diff, 0.0)), 0.0)
        scores = jnp.einsum('bhtk,bhsk,bhtsk->bhts', qc, kc, decay)
        o = o_inter + jnp.einsum('bhts,bhsv->bhtv', scores, vc)
        return advance_state(h, kc, vc, b), o

    h_end, o = lax.scan(step, h0, (to_chunks(q), to_chunks(k), to_chunks(v), to_chunks(log_f)))
    o = jnp.moveaxis(o, 0, 2).reshape(b_, h_, t, v.shape[-1])
    return o, h_end


def chunk_sgu(u, v, ln_g, ln_b, w_s, b_s):
    bsz, t, _ = u.shape
    n = t // MLP_CHUNK
    u = jax.nn.gelu(u, approximate=False).reshape(bsz, n, MLP_CHUNK, MLP_HEADS, MLP_DIM)
    v = jax.nn.gelu(v, approximate=False).reshape(bsz, n, MLP_CHUNK, MLP_HEADS, MLP_DIM)
    v = layernorm(v, ln_g.reshape(MLP_HEADS, MLP_DIM), ln_b.reshape(MLP_HEADS, MLP_DIM))
    z = jnp.einsum('hpq,bnqhc->bnphc', w_s.astype(v.dtype), v) + jnp.transpose(b_s)[None, None, :, :, None]
    return (u * z).reshape(bsz, t, MLP_WIDTH)


def token_mixers(p, lb_f, lb_b, first, h0_f, h0_b, hg_gain, sgu_g, sgu_b, w_s, b_s):
    w = HG_WIDTH
    logf_f, k_f, logf_b, k_b, v = hgrn2_gates(p, lb_f, lb_b, first)
    q = split_heads(jax.nn.silu(p[..., 3 * w:4 * w].astype(jnp.float32)), HG_HEADS) * (HG_DIM ** -0.5)
    o_f, h_f = chunk_gla(q, k_f, v, logf_f, h0_f)
    o_b, h_b = chunk_gla(flip_t(q), flip_t(k_b), flip_t(v), flip_t(logf_b), h0_b)
    o = rmsnorm(o_f + flip_t(o_b), hg_gain.reshape(HG_HEADS, 1, HG_DIM))
    o_hg = merge_heads(o).astype(p.dtype) * jax.nn.silu(p[..., 4 * w:5 * w])
    o_mlp = chunk_sgu(p[..., 5 * w:5 * w + MLP_WIDTH], p[..., 5 * w + MLP_WIDTH:], sgu_g, sgu_b, w_s, b_s)
    return jnp.concatenate([o_hg, o_mlp], axis=-1), h_f, h_b


def conv_ffn(h, w_up, taps, conv_b, w_down, rows):
    a, g = jnp.split(h @ w_up, 2, axis=-1)
    bsz, t, f = g.shape
    if rows is None:
        g2, tp = g.reshape(bsz, 1, t, f), taps[1:2]
    else:
        g2, tp = g.reshape(bsz, rows, GRID_W, f), taps
    gc = lax.conv_general_dilated(g2, tp[:, :, None, :].astype(g.dtype), (1, 1), 'SAME',
                                  dimension_numbers=('NHWC', 'HWIO', 'NHWC'), feature_group_count=f)
    gc = gc.reshape(bsz, t, f) + conv_b
    return (a * jax.nn.gelu(gc, approximate=False)) @ w_down


def setup_inputs(seed: int = 0) -> dict:
    key = jax.random.key(seed)
    ks = jax.random.split(key, 22)
    nrm = jax.random.normal
    L, D, F = DEPTH, D_MODEL, D_FF
    return {
        "x": nrm(ks[0], (BATCH, SEQ, D), jnp.float32),
        "c": nrm(ks[1], (BATCH, D), jnp.float32),
        "ctx": nrm(ks[2], (BATCH, CTX_LEN, D), jnp.float32),
        "c_ctx": nrm(ks[3], (D,), jnp.float32),
        "w_ada": nrm(ks[4], (L, D, 6 * D), jnp.float32) * (0.5 * D ** -0.5),
        "b_ada": nrm(ks[5], (L, 6 * D), jnp.float32) * 0.02,
        "norm_mix": 1.0 + 0.1 * nrm(ks[6], (L, D), jnp.float32),
        "norm_ffn": 1.0 + 0.1 * nrm(ks[7], (L, D), jnp.float32),
        "w_in": nrm(ks[8], (L, D, PROJ_WIDTH), jnp.float32) * D ** -0.5,
        "lb_logits_fwd": nrm(ks[9], (L, HG_WIDTH), jnp.float32),
        "lb_logits_bwd": nrm(ks[10], (L, HG_WIDTH), jnp.float32),
        "hg_norm": 1.0 + 0.1 * nrm(ks[11], (L, HG_WIDTH), jnp.float32),
        "sgu_norm_g": 1.0 + 0.1 * nrm(ks[12], (L, MLP_WIDTH), jnp.float32),
        "sgu_norm_b": 0.02 * nrm(ks[13], (L, MLP_WIDTH), jnp.float32),
        "w_spatial": nrm(ks[14], (L, MLP_HEADS, MLP_CHUNK, MLP_CHUNK), jnp.float32) * MLP_CHUNK ** -0.5,
        "b_spatial": 1.0 + 0.1 * nrm(ks[15], (L, MLP_HEADS, MLP_CHUNK), jnp.float32),
        "w_out": nrm(ks[16], (L, MIX_WIDTH, D), jnp.float32) * MIX_WIDTH ** -0.5,
        "w_up": nrm(ks[17], (L, D, 2 * F), jnp.float32) * D ** -0.5,
        "conv_w": nrm(ks[18], (L, CONV_W, CONV_W, F), jnp.float32) / CONV_W,
        "conv_b": 0.02 * nrm(ks[19], (L, F), jnp.float32),
        "w_down": nrm(ks[20], (L, F, D), jnp.float32) * F ** -0.5,
        "norm_final": 1.0 + 0.1 * nrm(ks[21], (D,), jnp.float32),
    }


def reference(x, c, ctx, c_ctx, w_ada, b_ada, norm_mix, norm_ffn, w_in, lb_logits_fwd, lb_logits_bwd,
              hg_norm, sgu_norm_g, sgu_norm_b, w_spatial, b_spatial, w_out, w_up, conv_w, conv_b, w_down,
              norm_final):
    w = HG_WIDTH
    rows = x.shape[1] // GRID_W
    bsz = x.shape[0]
    lb_f_all = lower_bounds(lb_logits_fwd)
    lb_b_all = lower_bounds(lb_logits_bwd)
    ada = jnp.einsum('bd,lde->lbe', jax.nn.silu(c), w_ada) + b_ada[:, None, :]
    ada_c = jnp.einsum('d,lde->le', jax.nn.silu(c_ctx), w_ada) + b_ada
    h0 = jnp.zeros((bsz, HG_HEADS, HG_DIM, HG_DIM), jnp.float32)
    xc = ctx
    for l in range(DEPTH):
        first, last = l == 0, l == DEPTH - 1
        sh1, sc1, g1, sh2, sc2, g2 = (m[:, None, :] for m in jnp.split(ada[l], 6, axis=-1))
        csh1, csc1, cg1, csh2, csc2, cg2 = jnp.split(ada_c[l], 6, axis=-1)
        lb_f, lb_b = lb_f_all[l], lb_b_all[l]
        mix_args = (hg_norm[l], sgu_norm_g[l], sgu_norm_b[l], w_spatial[l], b_spatial[l])

        hc = modulate(rmsnorm(xc, norm_mix[l]), csh1, csc1)
        if last:
            logf_f, k_f, logf_b, k_b, vc = hgrn2_gates(hc @ w_in[l][:, :3 * w], lb_f, lb_b, first)
            hf_c = advance_state(h0, k_f, vc, jnp.cumsum(logf_f, axis=2))
            hb_c = advance_state(h0, flip_t(k_b), flip_t(vc), jnp.cumsum(flip_t(logf_b), axis=2))
        else:
            oc, hf_c, hb_c = token_mixers(hc @ w_in[l], lb_f, lb_b, first, h0, h0, *mix_args)

        h = modulate(rmsnorm(x, norm_mix[l]), sh1, sc1)
        o, _, _ = token_mixers(h @ w_in[l], lb_f, lb_b, first, hf_c, hb_c, *mix_args)
        x = x + g1 * (o @ w_out[l])
        h2 = modulate(rmsnorm(x, norm_ffn[l]), sh2, sc2)
        x = x + g2 * conv_ffn(h2, w_up[l], conv_w[l], conv_b[l], w_down[l], rows)

        if not last:
            xc = xc + cg1 * (oc @ w_out[l])
            hc2 = modulate(rmsnorm(xc, norm_ffn[l]), csh2, csc2)
            xc = xc + cg2 * conv_ffn(hc2, w_up[l], conv_w[l], conv_b[l], w_down[l], None)
    return rmsnorm(x, norm_final)
```

```cpp
#include <hip/hip_runtime.h>
#include <hip/hip_cooperative_groups.h>
#include <cstdio>
namespace cg = cooperative_groups;

#define LAS __attribute__((address_space(3)))
typedef unsigned short bf16_t;
typedef short bf16x8 __attribute__((ext_vector_type(8)));
typedef float f32x4 __attribute__((ext_vector_type(4)));
typedef float f32x2 __attribute__((ext_vector_type(2)));
typedef unsigned u32x4 __attribute__((ext_vector_type(4)));
typedef unsigned u32x2 __attribute__((ext_vector_type(2)));
typedef __bf16 bf2_t __attribute__((ext_vector_type(2)));

constexpr int D = 1024, NB = 8, SEQ = 4096, DEPTH = 2, CTXL = 256;
constexpr int NLAT = NB * SEQ;
constexpr int NCTX = NB * CTXL;
constexpr int NROW = NLAT + NCTX;
constexpr int PW = 3584, FF = 2816, UPW = 2 * FF;
constexpr float EPS = 1e-6f;

constexpr size_t WS_WIN = 0;
constexpr size_t WS_WOUT = WS_WIN + (size_t)DEPTH * PW * D * 2;
constexpr size_t WS_WUP = WS_WOUT + (size_t)DEPTH * D * D * 2;
constexpr size_t WS_WDOWN = WS_WUP + (size_t)DEPTH * UPW * D * 2;
constexpr size_t WS_WSP = WS_WDOWN + (size_t)DEPTH * D * FF * 2;
constexpr size_t WS_ADA = WS_WSP + (size_t)DEPTH * 4 * 128 * 128 * 2;
constexpr size_t WS_LB = WS_ADA + (size_t)DEPTH * 9 * 6144 * 4;
constexpr size_t WS_XC = WS_LB + 2 * 512 * 4;
constexpr size_t WS_H = WS_XC + (size_t)NCTX * D * 4;
constexpr size_t WS_BIG = WS_H + (size_t)NROW * D * 2;
constexpr size_t WS_OFB = WS_BIG + (size_t)NROW * PW * 2;
constexpr size_t WS_END = WS_BIG + (size_t)NROW * UPW * 2;

struct Params {
    const float* in[22];
    float* out;
    unsigned char* ws;
};

__device__ __forceinline__ unsigned pk_bf16(float a, float b) { f32x2 v = {a, b}; bf2_t r = __builtin_convertvector(v, bf2_t); return __builtin_bit_cast(unsigned, r); }
__device__ __forceinline__ float bf_lo(unsigned u) { return __uint_as_float(u << 16); }
__device__ __forceinline__ float bf_hi(unsigned u) { return __uint_as_float(u & 0xffff0000u); }
__device__ __forceinline__ float bf1(bf16_t u) { return __uint_as_float(((unsigned)u) << 16); }
__device__ __forceinline__ bf16_t to_bf1(float a) { return (bf16_t)(pk_bf16(a, 0.f) & 0xffffu); }
__device__ __forceinline__ float fast_rcp(float x) { return __builtin_amdgcn_rcpf(x); }
__device__ __forceinline__ float gelu_f(float v) {
    const float av = fabsf(v), t = fast_rcp(av * 0.2316418882f + 1.0f);
    float q = t * 0.5307027145f + (-0.7265760135f); q = q * t + 0.7107068705f; q = q * t + (-0.142248368f); q = q * t + 0.127414796f; q = q * t;
    const float e = __builtin_amdgcn_exp2f((v * v) * (-0.72134752044f));
    const float m = v * (q * e);
    return v < 0.f ? m : v - m;
}
__device__ __forceinline__ int opaque_tid() { int t = threadIdx.x; asm volatile("" : "+v"(t)); return t; }
__device__ __forceinline__ float silu_f(float x) { return x * fast_rcp(1.0f + __expf(-x)); }

namespace pg8 {
constexpr int BM = 256, BK = 64, HALF = 128, HTB = HALF * BK * 2, STAGE_BYTES = 8 * HTB, NXCD = 8, WGM = 8;
__host__ __device__ __forceinline__ int lds_byte(int r, int c) { const int st = (r >> 4) * 2 + (c >> 5), rr = r & 15, cc = c & 31, ob = rr * 64 + cc * 2; return st * 1024 + (ob ^ (((ob >> 9) & 1) << 5)); }
__host__ __device__ __forceinline__ void stage_rc(int b, int& R, int& C) { const int st = b / 1024, sb = b % 1024, swz = sb ^ (((sb >> 9) & 1) << 5); R = (st >> 1) * 16 + swz / 64; C = (st & 1) * 32 + (swz % 64) / 2; }
__host__ __device__ __forceinline__ int perm32(int rho) { const int n = rho >> 4, i = rho & 15; return 8 * (i >> 2) + 4 * n + (i & 3); }
struct Unit { int pm, pn; };
struct Gemm { const bf16_t* A; const bf16_t* Bt; int M, N, K; };
struct StaticOrder {
    int nM, nN, nwg, G, c;
    __device__ void init(int M, int N, int G_, int c_) { nM = M / BM; nN = N / BM; nwg = nM * nN; G = G_; c = c_; }
    __device__ bool next(int i, Unit& u) const {
        const long L = (long)i * G + c; if (L >= nwg) return false;
        int wgid = (int)L; { const int q = nwg / NXCD, r = nwg % NXCD, xcd = wgid % NXCD, off = wgid / NXCD; wgid = (xcd < r ? xcd * (q + 1) : r * (q + 1) + (xcd - r) * q) + off; }
        const int nig = WGM * nN, gid = wgid / nig, fm = gid * WGM, gsz = (nM - fm) < WGM ? (nM - fm) : WGM;
        u.pm = fm + ((wgid % nig) % gsz); u.pn = (wgid % nig) / gsz; return true;
    }
    __device__ __forceinline__ void a_ready(const Unit&) const {}
    __device__ __forceinline__ void done(const Unit&) const {}
};
struct EpiBf16 {
    static constexpr bool PERM = true;
    bf16_t* O; int ldc; int split_cols; size_t split_stride;
    __device__ __forceinline__ void operator()(const f32x4 (&acc)[2][2][4][2], const Unit& u, int wr, int wc, int fr, int fq) const {
        const int row0 = u.pm * BM + wr * 64 + fr; int colt = u.pn * BM; bf16_t* base = O;
        if (split_cols) { const int t = colt / split_cols; base += (size_t)t * split_stride; colt -= t * split_cols; }
        const int col0 = colt + wc * 32 + 8 * fq;
#pragma unroll
        for (int ai = 0; ai < 2; ++ai)
#pragma unroll
            for (int m = 0; m < 4; ++m) { bf16_t* rowp = base + (size_t)(row0 + ai * HALF + m * 16) * ldc + col0;
#pragma unroll
                for (int bj = 0; bj < 2; ++bj) { const f32x4 v0 = acc[ai][bj][m][0], v1 = acc[ai][bj][m][1];
                    u32x4 w; w.x = pk_bf16(v0[0], v0[1]); w.y = pk_bf16(v0[2], v0[3]); w.z = pk_bf16(v1[0], v1[1]); w.w = pk_bf16(v1[2], v1[3]);
                    *(u32x4*)(rowp + bj * HALF) = w; } }
    }
};
struct EpiRes {
    static constexpr bool PERM = false;
    const float* resL; float* outL; const float* resC; float* outC; const float* gate;
    __device__ __forceinline__ void operator()(const f32x4 (&acc)[2][2][4][2], const Unit& u, int wr, int wc, int fr, int fq) const {
        const float* res; float* out; const float* g; int rowb;
        if (u.pm < NLAT / BM) { res = resL; out = outL; g = gate + (size_t)(u.pm >> 4) * 6144; rowb = u.pm * BM; }
        else { res = resC; out = outC; g = gate + (size_t)8 * 6144; rowb = u.pm * BM - NLAT; }
        const int row0 = rowb + wr * 64 + fr, col0 = u.pn * BM + wc * 32 + 4 * fq;
        f32x4 gv[2][2];
#pragma unroll
        for (int bj = 0; bj < 2; ++bj)
#pragma unroll
            for (int n = 0; n < 2; ++n) gv[bj][n] = *(const f32x4*)(g + col0 + bj * HALF + n * 16);
#pragma unroll
        for (int ai = 0; ai < 2; ++ai)
#pragma unroll
            for (int m = 0; m < 4; ++m) { const size_t ro = (size_t)(row0 + ai * HALF + m * 16) * D + col0;
#pragma unroll
                for (int bj = 0; bj < 2; ++bj)
#pragma unroll
                    for (int n = 0; n < 2; ++n) { const f32x4 r = *(const f32x4*)(res + ro + bj * HALF + n * 16);
                        *(f32x4*)(out + ro + bj * HALF + n * 16) = r + gv[bj][n] * acc[ai][bj][m][n]; } }
    }
};

template <class Epi, class Sched>
__device__ __forceinline__ void gemm_phase(LAS unsigned char* lds, const Gemm g, const Sched& S, const Epi& E) {
    const int tid = opaque_tid(), wid = __builtin_amdgcn_readfirstlane(tid >> 6), lane = tid & 63, wr = wid >> 2, wc = wid & 3, fr = lane & 15, fq = lane >> 4;
    const int K = g.K, nt = K / BK;
    unsigned voffA[2], voffB[2];
#pragma unroll
    for (int i = 0; i < 2; ++i) { int R, C; stage_rc(tid * 16 + i * 8192, R, C); const int Rb = Epi::PERM ? ((R & ~31) + perm32(R & 31)) : R;
        voffA[i] = (unsigned)(R * K + C) * 2u; voffB[i] = (unsigned)(Rb * K + C) * 2u; }
    const size_t kstep = (size_t)(BK * 2);
    const size_t hstep = (size_t)HALF * K * 2;
    const size_t tstep = 2 * hstep;
    const unsigned ldsw = (unsigned)wid * 1024u;
    const int aoff = lds_byte(wr * 64 + fr, fq * 8), boff = lds_byte(wc * 32 + fr, fq * 8);
#define PG8_SA(b, h) (((b) * 2 + (h)) * HTB)
#define PG8_SB(b, h) ((4 + (b) * 2 + (h)) * HTB)
#define PG8_STAGE(bufoff, gbase, voff) do { _Pragma("unroll") for (int _i = 0; _i < 2; ++_i) \
        __builtin_amdgcn_global_load_lds((const unsigned*)((const char*)(gbase) + (voff)[_i]), (LAS unsigned*)(lds + (bufoff) + ldsw + _i * 8192), 16, 0, 0); } while (0)
#define PG8_LDA(dst, b, h) do { _Pragma("unroll") for (int m = 0; m < 4; ++m) _Pragma("unroll") for (int k = 0; k < 2; ++k) dst[m][k] = *(const LAS bf16x8*)(lds + PG8_SA(b, h) + aoff + m * 2048 + k * 1024); } while (0)
#define PG8_LDB(dst, b, h) do { _Pragma("unroll") for (int n = 0; n < 2; ++n) _Pragma("unroll") for (int k = 0; k < 2; ++k) dst[n][k] = *(const LAS bf16x8*)(lds + PG8_SB(b, h) + boff + n * 2048 + k * 1024); } while (0)
#define PG8_MMA(ai, bj, At, Bt) do { __builtin_amdgcn_s_setprio(1); _Pragma("unroll") for (int m = 0; m < 4; ++m) _Pragma("unroll") for (int n = 0; n < 2; ++n) _Pragma("unroll") for (int k = 0; k < 2; ++k) \
        acc[ai][bj][m][n] = __builtin_amdgcn_mfma_f32_16x16x32_bf16(Bt[n][k], At[m][k], acc[ai][bj][m][n], 0, 0, 0); __builtin_amdgcn_s_setprio(0); } while (0)
#define PG8_WAIT_V(n) asm volatile("s_waitcnt vmcnt(" #n ")" ::: "memory")
#define PG8_WAIT_L(n) asm volatile("s_waitcnt lgkmcnt(" #n ")" ::: "memory")
#define PG8_BAR __builtin_amdgcn_s_barrier()
#define PG8_SCHED __builtin_amdgcn_sched_barrier(0)
    Unit cur, nxt; int ui = 0;
    if (!S.next(0, cur)) return;
    f32x4 acc[2][2][4][2];
#pragma unroll
    for (int a = 0; a < 2; ++a)
#pragma unroll
        for (int b = 0; b < 2; ++b)
#pragma unroll
            for (int m = 0; m < 4; ++m)
#pragma unroll
                for (int n = 0; n < 2; ++n) acc[a][b][m][n] = (f32x4){0.f, 0.f, 0.f, 0.f};
    bf16x8 At[4][2], B0[2][2], B1[2][2];
    const char* cA = (const char*)g.A + (size_t)cur.pm * tstep; const char* cB = (const char*)g.Bt + (size_t)cur.pn * tstep;
    S.a_ready(cur);
    PG8_STAGE(PG8_SB(0, 0), cB, voffB); PG8_STAGE(PG8_SA(0, 0), cA, voffA); PG8_STAGE(PG8_SB(0, 1), cB + hstep, voffB); PG8_STAGE(PG8_SA(0, 1), cA + hstep, voffA);
    if (wr == 1) PG8_BAR;
    PG8_WAIT_V(4); PG8_BAR;
    PG8_STAGE(PG8_SB(1, 0), cB + kstep, voffB); PG8_STAGE(PG8_SA(1, 0), cA + kstep, voffA); PG8_STAGE(PG8_SB(1, 1), cB + hstep + kstep, voffB);
    PG8_WAIT_V(6); PG8_BAR;
    for (;;) {
        const bool has_next = S.next(ui + 1, nxt);
        const char* nA = has_next ? (const char*)g.A + (size_t)nxt.pm * tstep : cA; const char* nB = has_next ? (const char*)g.Bt + (size_t)nxt.pn * tstep : cB;
        for (int t = 0; t < nt; t += 2) {
            const bool last = (t == nt - 2);
            const char* a1 = cA + (size_t)(t + 1) * kstep;
            const char* a2 = last ? nA : cA + (size_t)(t + 2) * kstep; const char* b2 = last ? nB : cB + (size_t)(t + 2) * kstep;
            const char* a3 = a2 + kstep; const char* b3 = b2 + kstep;
            if (last && has_next) S.a_ready(nxt);
            PG8_LDB(B0, 0, 0); PG8_SCHED; PG8_LDA(At, 0, 0); PG8_STAGE(PG8_SA(1, 1), a1 + hstep, voffA);
            PG8_WAIT_L(8); PG8_BAR; PG8_WAIT_L(0); PG8_MMA(0, 0, At, B0); PG8_BAR; PG8_SCHED;
            PG8_LDB(B1, 0, 1); PG8_STAGE(PG8_SB(0, 0), b2, voffB);
            PG8_BAR; PG8_WAIT_L(0); PG8_MMA(0, 1, At, B1); PG8_BAR;
            PG8_LDA(At, 0, 1); PG8_STAGE(PG8_SA(0, 0), a2, voffA);
            PG8_BAR; PG8_WAIT_L(0); PG8_MMA(1, 0, At, B0); PG8_BAR; PG8_SCHED;
            PG8_STAGE(PG8_SB(0, 1), b2 + hstep, voffB);
            PG8_WAIT_V(6); PG8_BAR; PG8_MMA(1, 1, At, B1); PG8_BAR;
            PG8_LDB(B0, 1, 0); PG8_SCHED; PG8_LDA(At, 1, 0); PG8_STAGE(PG8_SA(0, 1), a2 + hstep, voffA);
            PG8_WAIT_L(8); PG8_BAR; PG8_WAIT_L(0); PG8_MMA(0, 0, At, B0); PG8_BAR; PG8_SCHED;
            PG8_LDB(B1, 1, 1); PG8_STAGE(PG8_SB(1, 0), b3, voffB);
            PG8_BAR; PG8_WAIT_L(0); PG8_MMA(0, 1, At, B1); PG8_BAR;
            PG8_LDA(At, 1, 1); PG8_STAGE(PG8_SA(1, 0), a3, voffA);
            PG8_BAR; PG8_WAIT_L(0); PG8_MMA(1, 0, At, B0); PG8_BAR; PG8_SCHED;
            PG8_STAGE(PG8_SB(1, 1), b3 + hstep, voffB);
            PG8_WAIT_V(6); PG8_BAR; PG8_MMA(1, 1, At, B1); PG8_BAR;
        }
        E(acc, cur, wr, wc, fr, fq); S.done(cur);
        if (!has_next) break;
#pragma unroll
        for (int a = 0; a < 2; ++a)
#pragma unroll
            for (int b = 0; b < 2; ++b)
#pragma unroll
                for (int m = 0; m < 4; ++m)
#pragma unroll
                    for (int n = 0; n < 2; ++n) acc[a][b][m][n] = (f32x4){0.f, 0.f, 0.f, 0.f};
        cur = nxt; cA = nA; cB = nB; ++ui;
    }
    PG8_WAIT_V(0);
    if (wr == 0) PG8_BAR;
    PG8_BAR;
#undef PG8_SA
#undef PG8_SB
#undef PG8_STAGE
#undef PG8_LDA
#undef PG8_LDB
#undef PG8_MMA
#undef PG8_WAIT_V
#undef PG8_WAIT_L
#undef PG8_BAR
#undef PG8_SCHED
}
}

__device__ void phase_prep(const Params& p, LAS unsigned char* lds) {
    const int tid = opaque_tid();
    constexpr int NT_L = 896 + 256 + 1408 + 704;
    constexpr int J_ADA = 192, J_TR = J_ADA + 2 * NT_L, J_WSP = J_TR + 32, J_LB = J_WSP + 1;
    for (int job = blockIdx.x; job < J_LB; job += gridDim.x) {
        if (job < J_ADA) {
            LAS float* s = (LAS float*)lds;
            LAS float* red = (LAS float*)(lds + 9 * 1024 * 4);
            for (int i = tid; i < 9 * 1024; i += 512) { const int r = i >> 10, d = i & 1023; const float v = r < 8 ? p.in[1][r * 1024 + d] : p.in[3][d]; s[i] = silu_f(v); }
            __syncthreads();
            const int l = job / 96, e0 = (job % 96) * 64, col = tid & 63, dg = tid >> 6;
            const float* w = p.in[4] + ((size_t)l * 1024 + dg * 128) * 6144 + e0 + col;
            float acc[9];
#pragma unroll
            for (int r = 0; r < 9; ++r) acc[r] = 0.f;
            for (int dd = 0; dd < 128; ++dd) { const float wv = w[(size_t)dd * 6144];
#pragma unroll
                for (int r = 0; r < 9; ++r) acc[r] += s[r * 1024 + dg * 128 + dd] * wv; }
#pragma unroll
            for (int r = 0; r < 9; ++r) red[(dg * 9 + r) * 64 + col] = acc[r];
            __syncthreads();
            for (int i = tid; i < 9 * 64; i += 512) { const int r = i >> 6, c = i & 63; float a = 0.f;
#pragma unroll
                for (int g = 0; g < 8; ++g) a += red[(g * 9 + r) * 64 + c];
                ((float*)(p.ws + WS_ADA))[((size_t)l * 9 + r) * 6144 + e0 + c] = a + p.in[5][l * 6144 + e0 + c]; }
            __syncthreads();
        } else if (job < J_TR) {
            const int j = job - J_ADA, l = j / NT_L; int r = j % NT_L;
            const float* src; bf16_t* dst; int K, N;
            if (r < 896) { src = p.in[8] + (size_t)l * D * PW; dst = (bf16_t*)(p.ws + WS_WIN) + (size_t)l * PW * D; K = D; N = PW; }
            else if (r < 1152) { r -= 896; src = p.in[16] + (size_t)l * D * D; dst = (bf16_t*)(p.ws + WS_WOUT) + (size_t)l * D * D; K = D; N = D; }
            else if (r < 2560) { r -= 1152; src = p.in[17] + (size_t)l * D * UPW; dst = (bf16_t*)(p.ws + WS_WUP) + (size_t)l * UPW * D; K = D; N = UPW; }
            else { r -= 2560; src = p.in[20] + (size_t)l * FF * D; dst = (bf16_t*)(p.ws + WS_WDOWN) + (size_t)l * D * FF; K = FF; N = D; }
            const int ntn = N >> 6, kt = r / ntn, nt = r % ntn;
            LAS float* tile = (LAS float*)lds;
            { const int kk = tid >> 3, n8 = (tid & 7) * 8; const float* sp = src + (size_t)(kt * 64 + kk) * N + nt * 64 + n8;
              const f32x4 a = *(const f32x4*)sp, b = *(const f32x4*)(sp + 4);
              LAS float* tp = tile + kk * 65 + n8; tp[0] = a[0]; tp[1] = a[1]; tp[2] = a[2]; tp[3] = a[3]; tp[4] = b[0]; tp[5] = b[1]; tp[6] = b[2]; tp[7] = b[3]; }
            __syncthreads();
            { const int nn = tid >> 3, k8 = (tid & 7) * 8; float v[8];
#pragma unroll
              for (int i = 0; i < 8; ++i) v[i] = tile[(k8 + i) * 65 + nn];
              u32x4 w; w.x = pk_bf16(v[0], v[1]); w.y = pk_bf16(v[2], v[3]); w.z = pk_bf16(v[4], v[5]); w.w = pk_bf16(v[6], v[7]);
              *(u32x4*)(dst + (size_t)(nt * 64 + nn) * K + kt * 64 + k8) = w; }
            __syncthreads();
        } else if (job < J_WSP) {
            const int j = job - J_TR; const size_t i0 = (size_t)j * 4096 + tid * 8;
            const f32x4 a = *(const f32x4*)(p.in[14] + i0), b = *(const f32x4*)(p.in[14] + i0 + 4);
            u32x4 w; w.x = pk_bf16(a[0], a[1]); w.y = pk_bf16(a[2], a[3]); w.z = pk_bf16(b[0], b[1]); w.w = pk_bf16(b[2], b[3]);
            *(u32x4*)((bf16_t*)(p.ws + WS_WSP) + i0) = w;
        } else {
            for (int i = tid; i < 1024; i += 512) { const int dir = i >> 9, c = i & 511; const float* lg = dir ? p.in[10] : p.in[9];
                const float l0 = lg[c], l1 = lg[512 + c]; ((float*)(p.ws + WS_LB))[i] = 1.0f / (1.0f + expf(l0 - l1)); }
        }
    }
}

__device__ void phase_norm(const float* xl, const float* xc, const float* gain, const float* ada_l, int shift_idx, int nrows, bf16_t* H) {
    const int tid_ = opaque_tid(); const int wave = tid_ >> 6, lane = tid_ & 63;
    for (int row = blockIdx.x * 8 + wave; row < nrows; row += gridDim.x * 8) {
        const float* src; const float* mod;
        if (row < NLAT) { src = xl + (size_t)row * D; mod = ada_l + (size_t)(row >> 12) * 6144; } else { src = xc + (size_t)(row - NLAT) * D; mod = ada_l + (size_t)8 * 6144; }
        f32x4 v[4]; float ss = 0.f;
#pragma unroll
        for (int j = 0; j < 4; ++j) { v[j] = *(const f32x4*)(src + j * 256 + lane * 4); ss += v[j][0] * v[j][0] + v[j][1] * v[j][1] + v[j][2] * v[j][2] + v[j][3] * v[j][3]; }
#pragma unroll
        for (int o = 32; o > 0; o >>= 1) ss += __shfl_xor(ss, o);
        const float rs = rsqrtf(ss * (1.0f / D) + EPS);
#pragma unroll
        for (int j = 0; j < 4; ++j) { const int d = j * 256 + lane * 4;
            const f32x4 g = *(const f32x4*)(gain + d), sh = *(const f32x4*)(mod + shift_idx * 1024 + d), sc = *(const f32x4*)(mod + (shift_idx + 1) * 1024 + d);
            f32x4 y = v[j] * rs * g; y = y * (sc + 1.0f) + sh;
            u32x2 w; w.x = pk_bf16(y[0], y[1]); w.y = pk_bf16(y[2], y[3]);
            *(u32x2*)(H + (size_t)row * D + d) = w; }
    }
}
__device__ void phase_final(float* x, const float* gain) {
    const int tid_ = opaque_tid(); const int wave = tid_ >> 6, lane = tid_ & 63;
    for (int row = blockIdx.x * 8 + wave; row < NLAT; row += gridDim.x * 8) {
        float* src = x + (size_t)row * D;
        f32x4 v[4]; float ss = 0.f;
#pragma unroll
        for (int j = 0; j < 4; ++j) { v[j] = *(const f32x4*)(src + j * 256 + lane * 4); ss += v[j][0] * v[j][0] + v[j][1] * v[j][1] + v[j][2] * v[j][2] + v[j][3] * v[j][3]; }
#pragma unroll
        for (int o = 32; o > 0; o >>= 1) ss += __shfl_xor(ss, o);
        const float rs = rsqrtf(ss * (1.0f / D) + EPS);
#pragma unroll
        for (int j = 0; j < 4; ++j) { const int d = j * 256 + lane * 4; const f32x4 g = *(const f32x4*)(gain + d); *(f32x4*)(src + d) = v[j] * rs * g; }
    }
}

constexpr int QS_ST = 136, KT_ST = 40;
constexpr int SC_QS = 0, SC_KH = SC_QS + 32 * QS_ST * 2, SC_KT = SC_KH + 32 * QS_ST * 2, SC_VT = SC_KT + 128 * KT_ST * 2, SC_DS = SC_VT + 128 * KT_ST * 2, SC_BUF = SC_DS + 512;
constexpr int SC_AW = 2 * SC_BUF;

__device__ void scan_chain(const Params& p, int l, int chain, LAS unsigned char* lds) {
    const int tid = opaque_tid(), w = tid >> 6, lane = tid & 63;
    const int dir = chain & 1, h = (chain >> 1) & 3, b = chain >> 3;
    const int tau = lane & 31, kh = lane >> 5, k0 = 16 * w + 8 * kh, l15 = lane & 15, q4 = lane >> 4;
    const bf16_t* P = (const bf16_t*)(p.ws + WS_BIG);
    bf16_t* OFB = (bf16_t*)(p.ws + WS_OFB) + (size_t)dir * NROW * 512;
    const int fcol = dir * 512 + h * 128 + k0, vcol = 1024 + h * 128 + k0, qcol = 1536 + h * 128 + k0;
    const bool first = (l == 0);
    float lbv[8];
#pragma unroll
    for (int j = 0; j < 8; ++j) lbv[j] = first ? 0.f : ((const float*)(p.ws + WS_LB))[dir * 512 + h * 128 + k0 + j];
    constexpr int NCH = 8 + 128;
    auto rowof = [&](int ci, int t) -> int {
        if (ci < 8) { int tt = 32 * ci + t; if (dir) tt = 255 - tt; return NLAT + b * 256 + tt; }
        int tt = 32 * (ci - 8) + t; if (dir) tt = 4095 - tt; return b * 4096 + tt; };
    LAS bf16_t* Aw = (LAS bf16_t*)(lds + SC_AW) + w * 32 * KT_ST;
    for (int i = lane; i < 32 * KT_ST / 2; i += 64) ((LAS unsigned*)Aw)[i] = 0u;
    u32x4 rf, rq, rv, nf, nq, nv;
    f32x4 S[8];
#pragma unroll
    for (int j = 0; j < 8; ++j) S[j] = (f32x4){0.f, 0.f, 0.f, 0.f};

    auto load_raw = [&](int ci, u32x4& f, u32x4& q, u32x4& v) {
        const bf16_t* rp = P + (size_t)rowof(ci, tau) * PW;
        f = *(const u32x4*)(rp + fcol); q = *(const u32x4*)(rp + qcol); v = *(const u32x4*)(rp + vcol); };
    auto prep = [&](int buf, const u32x4& f, const u32x4& q, const u32x4& v) {
        LAS unsigned char* base = lds + buf * SC_BUF;
        LAS bf16_t* Qs = (LAS bf16_t*)(base + SC_QS); LAS bf16_t* Kh = (LAS bf16_t*)(base + SC_KH);
        LAS bf16_t* Kt = (LAS bf16_t*)(base + SC_KT); LAS bf16_t* Vt = (LAS bf16_t*)(base + SC_VT); LAS float* dS = (LAS float*)(base + SC_DS);
        float lg[8], kk[8];
#pragma unroll
        for (int j = 0; j < 8; ++j) {
            const unsigned fw = f[j >> 1]; const float x = (j & 1) ? bf_hi(fw) : bf_lo(fw);
            const float e = __expf(-fabsf(x)), r = fast_rcp(1.0f + e);
            if (first) { lg[j] = fminf(x, 0.f) - __logf(1.0f + e); kk[j] = x >= 0.f ? e * r : r; }
            else { const float sg = x >= 0.f ? r : e * r; const float gate = lbv[j] + (1.0f - lbv[j]) * sg; lg[j] = __logf(gate); kk[j] = 1.0f - gate; }
        }
#pragma unroll
        for (int off = 1; off < 32; off <<= 1) {
#pragma unroll
            for (int j = 0; j < 8; ++j) { const float t = __shfl_up(lg[j], off, 32); if (tau >= off) lg[j] += t; }
        }
        float qt[8], kh_[8], kt_[8];
#pragma unroll
        for (int j = 0; j < 8; ++j) {
            const float bl = fmaxf(__shfl(lg[j], 31, 32), -80.f), bc = fmaxf(lg[j], -80.f);
            const unsigned qw = q[j >> 1]; const float qx = (j & 1) ? bf_hi(qw) : bf_lo(qw);
            const float qv = silu_f(qx) * 0.08838834764831845f;
            qt[j] = qv * __expf(bc); kh_[j] = kk[j] * __expf(-bc); kt_[j] = kk[j] * __expf(bl - bc);
            if (tau == 31) dS[k0 + j] = __expf(bl);
        }
        u32x4 wq, wk; wq.x = pk_bf16(qt[0], qt[1]); wq.y = pk_bf16(qt[2], qt[3]); wq.z = pk_bf16(qt[4], qt[5]); wq.w = pk_bf16(qt[6], qt[7]);
        wk.x = pk_bf16(kh_[0], kh_[1]); wk.y = pk_bf16(kh_[2], kh_[3]); wk.z = pk_bf16(kh_[4], kh_[5]); wk.w = pk_bf16(kh_[6], kh_[7]);
        *(LAS u32x4*)(Qs + tau * QS_ST + k0) = wq; *(LAS u32x4*)(Kh + tau * QS_ST + k0) = wk;
#pragma unroll
        for (int j = 0; j < 8; ++j) { Kt[(k0 + j) * KT_ST + tau] = to_bf1(kt_[j]); const unsigned vw = v[j >> 1]; Vt[(k0 + j) * KT_ST + tau] = (bf16_t)((j & 1) ? (vw >> 16) : (vw & 0xffffu)); }
    };

    load_raw(0, rf, rq, rv);
    prep(0, rf, rq, rv);
    load_raw(1, rf, rq, rv);
    __syncthreads();
    for (int ci = 0; ci < NCH; ++ci) {
        if (ci + 2 < NCH) load_raw(ci + 2, nf, nq, nv);
        if (ci + 1 < NCH) prep((ci + 1) & 1, rf, rq, rv);
        {
            LAS unsigned char* base = lds + (ci & 1) * SC_BUF;
            LAS bf16_t* Qs = (LAS bf16_t*)(base + SC_QS); LAS bf16_t* Kh = (LAS bf16_t*)(base + SC_KH);
            LAS bf16_t* Kt = (LAS bf16_t*)(base + SC_KT); LAS bf16_t* Vt = (LAS bf16_t*)(base + SC_VT); LAS float* dS = (LAS float*)(base + SC_DS);
            f32x4 o[2]; o[0] = (f32x4){0.f, 0.f, 0.f, 0.f}; o[1] = o[0];
#pragma unroll
            for (int kb = 0; kb < 4; ++kb) {
                u32x4 sb; sb.x = pk_bf16(S[2 * kb][0], S[2 * kb][1]); sb.y = pk_bf16(S[2 * kb][2], S[2 * kb][3]); sb.z = pk_bf16(S[2 * kb + 1][0], S[2 * kb + 1][1]); sb.w = pk_bf16(S[2 * kb + 1][2], S[2 * kb + 1][3]);
                const bf16x8 bfr = __builtin_bit_cast(bf16x8, sb);
#pragma unroll
                for (int mt = 0; mt < 2; ++mt) {
                    const LAS bf16_t* qp = Qs + (16 * mt + l15) * QS_ST + 32 * kb + 4 * q4;
                    const u32x2 lo = *(const LAS u32x2*)qp, hi = *(const LAS u32x2*)(qp + 16);
                    u32x4 av; av.x = lo.x; av.y = lo.y; av.z = hi.x; av.w = hi.y;
                    o[mt] = __builtin_amdgcn_mfma_f32_16x16x32_bf16(__builtin_bit_cast(bf16x8, av), bfr, o[mt], 0, 0, 0);
                }
            }
            f32x4 a00 = (f32x4){0.f, 0.f, 0.f, 0.f}, a10 = a00, a11 = a00;
#pragma unroll
            for (int kb = 0; kb < 4; ++kb) {
                const bf16x8 qn0 = *(const LAS bf16x8*)(Qs + l15 * QS_ST + 32 * kb + 8 * q4), qn1 = *(const LAS bf16x8*)(Qs + (16 + l15) * QS_ST + 32 * kb + 8 * q4);
                const bf16x8 kh0 = *(const LAS bf16x8*)(Kh + l15 * QS_ST + 32 * kb + 8 * q4), kh1 = *(const LAS bf16x8*)(Kh + (16 + l15) * QS_ST + 32 * kb + 8 * q4);
                a00 = __builtin_amdgcn_mfma_f32_16x16x32_bf16(qn0, kh0, a00, 0, 0, 0);
                a10 = __builtin_amdgcn_mfma_f32_16x16x32_bf16(qn1, kh0, a10, 0, 0, 0);
                a11 = __builtin_amdgcn_mfma_f32_16x16x32_bf16(qn1, kh1, a11, 0, 0, 0);
            }
#pragma unroll
            for (int i = 0; i < 4; ++i) { const int t = 4 * q4 + i; const bool keep = l15 <= t;
                Aw[t * KT_ST + l15] = to_bf1(keep ? a00[i] : 0.f);
                Aw[(16 + t) * KT_ST + l15] = to_bf1(a10[i]);
                Aw[(16 + t) * KT_ST + 16 + l15] = to_bf1(keep ? a11[i] : 0.f); }
            asm volatile("s_waitcnt lgkmcnt(0)" ::: "memory");
            const bf16x8 af0 = *(const LAS bf16x8*)(Aw + l15 * KT_ST + 8 * q4), af1 = *(const LAS bf16x8*)(Aw + (16 + l15) * KT_ST + 8 * q4);
            const bf16x8 vf = *(const LAS bf16x8*)(Vt + (16 * w + l15) * KT_ST + 8 * q4);
            o[0] = __builtin_amdgcn_mfma_f32_16x16x32_bf16(af0, vf, o[0], 0, 0, 0);
            o[1] = __builtin_amdgcn_mfma_f32_16x16x32_bf16(af1, vf, o[1], 0, 0, 0);
#pragma unroll
            for (int j = 0; j < 8; ++j) {
                const f32x4 dv = *(const LAS f32x4*)(dS + 16 * j + 4 * q4);
                const bf16x8 kf = *(const LAS bf16x8*)(Kt + (16 * j + l15) * KT_ST + 8 * q4);
                S[j] = __builtin_amdgcn_mfma_f32_16x16x32_bf16(kf, vf, S[j] * dv, 0, 0, 0);
            }
            if (first || ci >= 8) {
#pragma unroll
                for (int mt = 0; mt < 2; ++mt)
#pragma unroll
                    for (int i = 0; i < 4; ++i) { const int row = rowof(ci, 16 * mt + 4 * q4 + i);
                        OFB[(size_t)row * 512 + h * 128 + 16 * w + l15] = to_bf1(o[mt][i]); }
            }
        }
        __syncthreads();
        rf = nf; rq = nq; rv = nv;
    }
}

constexpr int SG_ST = 136;
__device__ void sgu_tile(const Params& p, int l, int tile, LAS unsigned char* lds) {
    const int tid = opaque_tid(), w = tid >> 6, lane = tid & 63, l15 = lane & 15, q4 = lane >> 4;
    const int h = tile & 3, rowbase = (tile >> 2) * 128;
    const bf16_t* P = (const bf16_t*)(p.ws + WS_BIG);
    bf16_t* O = (bf16_t*)(p.ws + WS_H);
    LAS bf16_t* Vt = (LAS bf16_t*)lds;
    {
        const int q = tid >> 2, cgp = tid & 3;
        const bf16_t* vp = P + (size_t)(rowbase + q) * PW + 3072 + 128 * h + 32 * cgp;
        float g[32];
#pragma unroll
        for (int i = 0; i < 4; ++i) { const u32x4 r = *(const u32x4*)(vp + 8 * i);
#pragma unroll
            for (int j = 0; j < 4; ++j) { g[8 * i + 2 * j] = gelu_f(bf_lo(r[j])); g[8 * i + 2 * j + 1] = gelu_f(bf_hi(r[j])); } }
        float s = 0.f;
#pragma unroll
        for (int i = 0; i < 32; ++i) s += g[i];
        s += __shfl_xor(s, 1); s += __shfl_xor(s, 2);
        const float mu = s * (1.0f / 128.f);
        float vs = 0.f;
#pragma unroll
        for (int i = 0; i < 32; ++i) { const float d = g[i] - mu; vs += d * d; }
        vs += __shfl_xor(vs, 1); vs += __shfl_xor(vs, 2);
        const float rstd = rsqrtf(vs * (1.0f / 128.f) + EPS);
        const float* lng = p.in[12] + l * 512 + h * 128 + 32 * cgp; const float* lnb = p.in[13] + l * 512 + h * 128 + 32 * cgp;
#pragma unroll
        for (int i = 0; i < 32; ++i) { const float y = (g[i] - mu) * rstd * lng[i] + lnb[i]; Vt[(32 * cgp + i) * SG_ST + q] = to_bf1(y); }
    }
    __syncthreads();
    {
        const int prow = 16 * w + l15;
        const bf16_t* wsp = (const bf16_t*)(p.ws + WS_WSP) + ((size_t)(l * 4 + h) * 128 + prow) * 128 + 8 * q4;
        bf16x8 wf[4];
#pragma unroll
        for (int kb = 0; kb < 4; ++kb) wf[kb] = *(const bf16x8*)(wsp + 32 * kb);
        const float bs = p.in[15][(l * 4 + h) * 128 + prow];
        const bf16_t* up = P + (size_t)(rowbase + prow) * PW + 2560 + 128 * h + 4 * q4;
        bf16_t* op = O + (size_t)(rowbase + prow) * D + 512 + 128 * h + 4 * q4;
#pragma unroll
        for (int mt = 0; mt < 8; ++mt) {
            f32x4 acc = (f32x4){0.f, 0.f, 0.f, 0.f};
#pragma unroll
            for (int kb = 0; kb < 4; ++kb) { const bf16x8 af = *(const LAS bf16x8*)(Vt + (16 * mt + l15) * SG_ST + 32 * kb + 8 * q4);
                acc = __builtin_amdgcn_mfma_f32_16x16x32_bf16(af, wf[kb], acc, 0, 0, 0); }
            const u32x2 uu = *(const u32x2*)(up + 16 * mt);
            const float u0 = gelu_f(bf_lo(uu.x)), u1 = gelu_f(bf_hi(uu.x)), u2 = gelu_f(bf_lo(uu.y)), u3 = gelu_f(bf_hi(uu.y));
            u32x2 wv; wv.x = pk_bf16(u0 * (acc[0] + bs), u1 * (acc[1] + bs)); wv.y = pk_bf16(u2 * (acc[2] + bs), u3 * (acc[3] + bs));
            *(u32x2*)(op + 16 * mt) = wv;
        }
    }
    __syncthreads();
}

__device__ void phase_mixer(const Params& p, int l, LAS unsigned char* lds) {
    const int G = gridDim.x, bid = blockIdx.x;
    const int ntile = (l == 0) ? (NROW / 128) * 4 : (NLAT / 128) * 4;
    if (G > 64) {
        if (bid < 64) scan_chain(p, l, bid, lds);
        else for (int t = bid - 64; t < ntile; t += G - 64) sgu_tile(p, l, t, lds);
    } else {
        for (int c = bid; c < 64; c += G) { scan_chain(p, l, c, lds); __syncthreads(); }
        for (int t = bid; t < ntile; t += G) sgu_tile(p, l, t, lds);
    }
}

__device__ void phase_combine(const Params& p, int l, int nrows) {
    const int tid_ = opaque_tid(); const int wave = tid_ >> 6, lane = tid_ & 63, hd = lane >> 4, v0 = (lane & 15) * 8;
    const bf16_t* P = (const bf16_t*)(p.ws + WS_BIG);
    const bf16_t* OF = (const bf16_t*)(p.ws + WS_OFB); const bf16_t* OB = OF + (size_t)NROW * 512;
    bf16_t* O = (bf16_t*)(p.ws + WS_H);
    const float* gn = p.in[11] + l * 512 + hd * 128 + v0;
    const f32x4 g0 = *(const f32x4*)gn, g1 = *(const f32x4*)(gn + 4);
    for (int row = blockIdx.x * 8 + wave; row < nrows; row += gridDim.x * 8) {
        const u32x4 a = *(const u32x4*)(OF + (size_t)row * 512 + hd * 128 + v0), bq = *(const u32x4*)(OB + (size_t)row * 512 + hd * 128 + v0);
        const u32x4 gg = *(const u32x4*)(P + (size_t)row * PW + 2048 + hd * 128 + v0);
        float s[8]; float ss = 0.f;
#pragma unroll
        for (int j = 0; j < 4; ++j) { s[2 * j] = bf_lo(a[j]) + bf_lo(bq[j]); s[2 * j + 1] = bf_hi(a[j]) + bf_hi(bq[j]); ss += s[2 * j] * s[2 * j] + s[2 * j + 1] * s[2 * j + 1]; }
#pragma unroll
        for (int o = 8; o > 0; o >>= 1) ss += __shfl_xor(ss, o);
        const float rs = rsqrtf(ss * (1.0f / 128.f) + EPS);
        float y[8];
#pragma unroll
        for (int j = 0; j < 4; ++j) { y[2 * j] = s[2 * j] * rs * (j < 2 ? g0[2 * j] : g1[2 * j - 4]) * silu_f(bf_lo(gg[j])); y[2 * j + 1] = s[2 * j + 1] * rs * (j < 2 ? g0[2 * j + 1] : g1[2 * j - 3]) * silu_f(bf_hi(gg[j])); }
        u32x4 wv; wv.x = pk_bf16(y[0], y[1]); wv.y = pk_bf16(y[2], y[3]); wv.z = pk_bf16(y[4], y[5]); wv.w = pk_bf16(y[6], y[7]);
        *(u32x4*)(O + (size_t)row * D + hd * 128 + v0) = wv;
    }
}

__device__ void phase_conv(const Params& p, int l, int nrows) {
    bf16_t* Aup = (bf16_t*)(p.ws + WS_BIG); const bf16_t* Gup = Aup + (size_t)NROW * FF;
    const float* cw = p.in[18] + (size_t)l * 9 * FF; const float* cb = p.in[19] + (size_t)l * FF;
    const long total = (long)nrows * 352;
    const int tid_ = opaque_tid();
    for (long id = (long)blockIdx.x * 512 + tid_; id < total; id += (long)gridDim.x * 512) {
        const int tok = (int)(id / 352), f0 = (int)(id % 352) * 8;
        float acc[8];
        { const f32x4 b0 = *(const f32x4*)(cb + f0), b1 = *(const f32x4*)(cb + f0 + 4); acc[0] = b0[0]; acc[1] = b0[1]; acc[2] = b0[2]; acc[3] = b0[3]; acc[4] = b1[0]; acc[5] = b1[1]; acc[6] = b1[2]; acc[7] = b1[3]; }
        if (tok < NLAT) {
            const int t = tok & 4095, r = t >> 6, c = t & 63;
#pragma unroll
            for (int dr = -1; dr <= 1; ++dr) {
                if ((unsigned)(r + dr) > 63u) continue;
#pragma unroll
                for (int dc = -1; dc <= 1; ++dc) {
                    if ((unsigned)(c + dc) > 63u) continue;
                    const u32x4 gv = *(const u32x4*)(Gup + (size_t)(tok + dr * 64 + dc) * FF + f0);
                    const float* tp = cw + ((dr + 1) * 3 + (dc + 1)) * FF + f0; const f32x4 t0 = *(const f32x4*)tp, t1 = *(const f32x4*)(tp + 4);
                    acc[0] += bf_lo(gv.x) * t0[0]; acc[1] += bf_hi(gv.x) * t0[1]; acc[2] += bf_lo(gv.y) * t0[2]; acc[3] += bf_hi(gv.y) * t0[3];
                    acc[4] += bf_lo(gv.z) * t1[0]; acc[5] += bf_hi(gv.z) * t1[1]; acc[6] += bf_lo(gv.w) * t1[2]; acc[7] += bf_hi(gv.w) * t1[3];
                }
            }
        } else {
            const int t = (tok - NLAT) & 255;
#pragma unroll
            for (int dc = -1; dc <= 1; ++dc) {
                if ((unsigned)(t + dc) > 255u) continue;
                const u32x4 gv = *(const u32x4*)(Gup + (size_t)(tok + dc) * FF + f0);
                const float* tp = cw + (3 + (dc + 1)) * FF + f0; const f32x4 t0 = *(const f32x4*)tp, t1 = *(const f32x4*)(tp + 4);
                acc[0] += bf_lo(gv.x) * t0[0]; acc[1] += bf_hi(gv.x) * t0[1]; acc[2] += bf_lo(gv.y) * t0[2]; acc[3] += bf_hi(gv.y) * t0[3];
                acc[4] += bf_lo(gv.z) * t1[0]; acc[5] += bf_hi(gv.z) * t1[1]; acc[6] += bf_lo(gv.w) * t1[2]; acc[7] += bf_hi(gv.w) * t1[3];
            }
        }
        bf16_t* ap = Aup + (size_t)tok * FF + f0;
        const u32x4 av = *(const u32x4*)ap;
        u32x4 wv;
        wv.x = pk_bf16(bf_lo(av.x) * gelu_f(acc[0]), bf_hi(av.x) * gelu_f(acc[1])); wv.y = pk_bf16(bf_lo(av.y) * gelu_f(acc[2]), bf_hi(av.y) * gelu_f(acc[3]));
        wv.z = pk_bf16(bf_lo(av.z) * gelu_f(acc[4]), bf_hi(av.z) * gelu_f(acc[5])); wv.w = pk_bf16(bf_lo(av.w) * gelu_f(acc[6]), bf_hi(av.w) * gelu_f(acc[7]));
        *(u32x4*)ap = wv;
    }
}

__global__ void __launch_bounds__(512, 2) fwd_megakernel(Params p) {
    extern __shared__ __attribute__((aligned(16))) unsigned char shm[];
    LAS unsigned char* lds = (LAS unsigned char*)shm;
    cg::grid_group grid = cg::this_grid();
    const int G = gridDim.x, bid = blockIdx.x;
    float* XC = (float*)(p.ws + WS_XC);
    bf16_t* H = (bf16_t*)(p.ws + WS_H);
    bf16_t* BIG = (bf16_t*)(p.ws + WS_BIG);
    const float* ADA = (const float*)(p.ws + WS_ADA);

    phase_prep(p, lds);
    grid.sync();
    for (int l = 0; l < DEPTH; ++l) {
        const bool last = (l == DEPTH - 1);
        const float* ada_l = ADA + (size_t)l * 9 * 6144;
        const float* xl = (l == 0) ? p.in[0] : p.out;
        const float* xc = (l == 0) ? p.in[2] : XC;
        const int Mfull = last ? NLAT : NROW;
        phase_norm(xl, xc, p.in[6] + l * D, ada_l, 0, NROW, H);
        grid.sync();
        { pg8::StaticOrder S; S.init(NROW, PW, G, bid);
          pg8::EpiBf16 E{BIG, PW, 0, 0};
          pg8::gemm_phase(lds, pg8::Gemm{H, (const bf16_t*)(p.ws + WS_WIN) + (size_t)l * PW * D, NROW, PW, D}, S, E); }
        grid.sync();
        phase_mixer(p, l, lds);
        grid.sync();
        phase_combine(p, l, Mfull);
        grid.sync();
        { pg8::StaticOrder S; S.init(Mfull, D, G, bid);
          pg8::EpiRes E{xl, p.out, xc, XC, ada_l + 2 * 1024};
          pg8::gemm_phase(lds, pg8::Gemm{H, (const bf16_t*)(p.ws + WS_WOUT) + (size_t)l * D * D, Mfull, D, D}, S, E); }
        grid.sync();
        phase_norm(p.out, XC, p.in[7] + l * D, ada_l, 3, Mfull, H);
        grid.sync();
        { pg8::StaticOrder S; S.init(Mfull, UPW, G, bid);
          pg8::EpiBf16 E{BIG, FF, FF, (size_t)NROW * FF};
          pg8::gemm_phase(lds, pg8::Gemm{H, (const bf16_t*)(p.ws + WS_WUP) + (size_t)l * UPW * D, Mfull, UPW, D}, S, E); }
        grid.sync();
        phase_conv(p, l, Mfull);
        grid.sync();
        { pg8::StaticOrder S; S.init(Mfull, D, G, bid);
          pg8::EpiRes E{p.out, p.out, XC, XC, ada_l + 5 * 1024};
          pg8::gemm_phase(lds, pg8::Gemm{BIG, (const bf16_t*)(p.ws + WS_WDOWN) + (size_t)l * D * FF, Mfull, D, FF}, S, E); }
        grid.sync();
    }
    phase_final(p.out, p.in[21]);
}

extern "C" void kernel_launch(void* const* d_in, const int* in_sizes, int n_in, void* d_out, int out_size, void* d_ws, size_t ws_size, hipStream_t stream) {
    constexpr int LDS_BYTES = 131072;
    static int grid_blocks = 0;
    if (!grid_blocks) {
        int dev = 0, cus = 0, per_cu = 0;
        (void)hipGetDevice(&dev);
        (void)hipDeviceGetAttribute(&cus, hipDeviceAttributeMultiprocessorCount, dev);
        (void)hipFuncSetAttribute((const void*)fwd_megakernel, hipFuncAttributeMaxDynamicSharedMemorySize, LDS_BYTES);
        (void)hipOccupancyMaxActiveBlocksPerMultiprocessor(&per_cu, (const void*)fwd_megakernel, 512, LDS_BYTES);
        if (per_cu < 1) per_cu = 1;
        grid_blocks = cus * per_cu;
        if (ws_size < WS_END) fprintf(stderr, "workspace too small: %zu < %zu\n", ws_size, (size_t)WS_END);
    }
    Params p{};
    for (int i = 0; i < 22; ++i) p.in[i] = (const float*)d_in[i];
    p.out = (float*)d_out; p.ws = (unsigned char*)d_ws;
    void* args[] = {&p};
    hipError_t e = hipLaunchCooperativeKernel((const void*)fwd_megakernel, dim3(grid_blocks), dim3(512), args, LDS_BYTES, stream);
    if (e != hipSuccess) fprintf(stderr, "cooperative launch failed: %s (grid %d)\n", hipGetErrorString(e), grid_blocks);
}
```

```cpp
#include <hip/hip_runtime.h>
#include <hip/hip_cooperative_groups.h>
#include <cstdio>
namespace cg = cooperative_groups;

#define LAS __attribute__((address_space(3)))
typedef unsigned short bf16_t;
typedef short bf16x8 __attribute__((ext_vector_type(8)));
typedef float f32x4 __attribute__((ext_vector_type(4)));
typedef float f32x2 __attribute__((ext_vector_type(2)));
typedef unsigned u32x4 __attribute__((ext_vector_type(4)));
typedef unsigned u32x2 __attribute__((ext_vector_type(2)));
typedef __bf16 bf2_t __attribute__((ext_vector_type(2)));

constexpr int D = 1024, NB = 8, SEQ = 4096, DEPTH = 2, CTXL = 256;
constexpr int NLAT = NB * SEQ;
constexpr int NCTX = NB * CTXL;
constexpr int NROW = NLAT + NCTX;
constexpr int PW = 3584, FF = 2816, UPW = 2 * FF;
constexpr float EPS = 1e-6f;

constexpr size_t WS_WIN = 0;
constexpr size_t WS_WOUT = WS_WIN + (size_t)DEPTH * PW * D * 2;
constexpr size_t WS_WUP = WS_WOUT + (size_t)DEPTH * D * D * 2;
constexpr size_t WS_WDOWN = WS_WUP + (size_t)DEPTH * UPW * D * 2;
constexpr size_t WS_WSP = WS_WDOWN + (size_t)DEPTH * D * FF * 2;
constexpr size_t WS_ADA = WS_WSP + (size_t)DEPTH * 4 * 128 * 128 * 2;
constexpr size_t WS_LB = WS_ADA + (size_t)DEPTH * 9 * 6144 * 4;
constexpr size_t WS_XC = WS_LB + 2 * 512 * 4;
constexpr size_t WS_H = WS_XC + (size_t)NCTX * D * 4;
constexpr size_t WS_BIG = WS_H + (size_t)NROW * D * 2;
constexpr size_t WS_OFB = WS_BIG + (size_t)NROW * PW * 2;
constexpr size_t WS_QB = WS_OFB + 2 * (size_t)NROW * 512 * 2;
constexpr size_t WS_DS = WS_BIG + (size_t)NROW * UPW * 2;
constexpr size_t WS_END = WS_DS + (size_t)64 * 136 * 128 * 4;

struct Params {
    const float* in[22];
    float* out;
    unsigned char* ws;
};

__device__ __forceinline__ unsigned pk_bf16(float a, float b) { f32x2 v = {a, b}; bf2_t r = __builtin_convertvector(v, bf2_t); return __builtin_bit_cast(unsigned, r); }
__device__ __forceinline__ float bf_lo(unsigned u) { return __uint_as_float(u << 16); }
__device__ __forceinline__ float bf_hi(unsigned u) { return __uint_as_float(u & 0xffff0000u); }
__device__ __forceinline__ float bf1(bf16_t u) { return __uint_as_float(((unsigned)u) << 16); }
__device__ __forceinline__ bf16_t to_bf1(float a) { return (bf16_t)(pk_bf16(a, 0.f) & 0xffffu); }
__device__ __forceinline__ float fast_rcp(float x) { return __builtin_amdgcn_rcpf(x); }
__device__ __forceinline__ float gelu_f(float v) {
    const float av = fabsf(v), t = fast_rcp(av * 0.2316418882f + 1.0f);
    float q = t * 0.5307027145f + (-0.7265760135f); q = q * t + 0.7107068705f; q = q * t + (-0.142248368f); q = q * t + 0.127414796f; q = q * t;
    const float e = __builtin_amdgcn_exp2f((v * v) * (-0.72134752044f));
    const float m = v * (q * e);
    return v < 0.f ? m : v - m;
}
__device__ __forceinline__ int opaque_tid() { int t = threadIdx.x; asm volatile("" : "+v"(t)); return t; }
__device__ __forceinline__ float silu_f(float x) { return x * fast_rcp(1.0f + __expf(-x)); }

namespace pg8 {
constexpr int BM = 256, BK = 64, HALF = 128, HTB = HALF * BK * 2, STAGE_BYTES = 8 * HTB, NXCD = 8, WGM = 8;
__host__ __device__ __forceinline__ int lds_byte(int r, int c) { const int st = (r >> 4) * 2 + (c >> 5), rr = r & 15, cc = c & 31, ob = rr * 64 + cc * 2; return st * 1024 + (ob ^ (((ob >> 9) & 1) << 5)); }
__host__ __device__ __forceinline__ void stage_rc(int b, int& R, int& C) { const int st = b / 1024, sb = b % 1024, swz = sb ^ (((sb >> 9) & 1) << 5); R = (st >> 1) * 16 + swz / 64; C = (st & 1) * 32 + (swz % 64) / 2; }
__host__ __device__ __forceinline__ int perm32(int rho) { const int n = rho >> 4, i = rho & 15; return 8 * (i >> 2) + 4 * n + (i & 3); }
struct Unit { int pm, pn; };
struct Gemm { const bf16_t* A; const bf16_t* Bt; int M, N, K; };
struct StaticOrder {
    int nM, nN, nwg, G, c;
    __device__ void init(int M, int N, int G_, int c_) { nM = M / BM; nN = N / BM; nwg = nM * nN; G = G_; c = c_; }
    __device__ bool next(int i, Unit& u) const {
        const long L = (long)i * G + c; if (L >= nwg) return false;
        int wgid = (int)L; { const int q = nwg / NXCD, r = nwg % NXCD, xcd = wgid % NXCD, off = wgid / NXCD; wgid = (xcd < r ? xcd * (q + 1) : r * (q + 1) + (xcd - r) * q) + off; }
        const int nig = WGM * nN, gid = wgid / nig, fm = gid * WGM, gsz = (nM - fm) < WGM ? (nM - fm) : WGM;
        u.pm = fm + ((wgid % nig) % gsz); u.pn = (wgid % nig) / gsz; return true;
    }
    __device__ __forceinline__ void a_ready(const Unit&) const {}
    __device__ __forceinline__ void done(const Unit&) const {}
};
struct EpiBf16 {
    static constexpr bool PERM = true;
    bf16_t* O; int ldc; int split_cols; size_t split_stride;
    __device__ __forceinline__ void operator()(const f32x4 (&acc)[2][2][4][2], const Unit& u, int wr, int wc, int fr, int fq) const {
        const int row0 = u.pm * BM + wr * 64 + fr; int colt = u.pn * BM; bf16_t* base = O;
        if (split_cols) { const int t = colt / split_cols; base += (size_t)t * split_stride; colt -= t * split_cols; }
        const int col0 = colt + wc * 32 + 8 * fq;
#pragma unroll
        for (int ai = 0; ai < 2; ++ai)
#pragma unroll
            for (int m = 0; m < 4; ++m) { bf16_t* rowp = base + (size_t)(row0 + ai * HALF + m * 16) * ldc + col0;
#pragma unroll
                for (int bj = 0; bj < 2; ++bj) { const f32x4 v0 = acc[ai][bj][m][0], v1 = acc[ai][bj][m][1];
                    u32x4 w; w.x = pk_bf16(v0[0], v0[1]); w.y = pk_bf16(v0[2], v0[3]); w.z = pk_bf16(v1[0], v1[1]); w.w = pk_bf16(v1[2], v1[3]);
                    *(u32x4*)(rowp + bj * HALF) = w; } }
    }
};
struct EpiRes {
    static constexpr bool PERM = false;
    const float* resL; float* outL; const float* resC; float* outC; const float* gate;
    __device__ __forceinline__ void operator()(const f32x4 (&acc)[2][2][4][2], const Unit& u, int wr, int wc, int fr, int fq) const {
        const float* res; float* out; const float* g; int rowb;
        if (u.pm < NLAT / BM) { res = resL; out = outL; g = gate + (size_t)(u.pm >> 4) * 6144; rowb = u.pm * BM; }
        else { res = resC; out = outC; g = gate + (size_t)8 * 6144; rowb = u.pm * BM - NLAT; }
        const int row0 = rowb + wr * 64 + fr, col0 = u.pn * BM + wc * 32 + 4 * fq;
        f32x4 gv[2][2];
#pragma unroll
        for (int bj = 0; bj < 2; ++bj)
#pragma unroll
            for (int n = 0; n < 2; ++n) gv[bj][n] = *(const f32x4*)(g + col0 + bj * HALF + n * 16);
#pragma unroll
        for (int ai = 0; ai < 2; ++ai)
#pragma unroll
            for (int m = 0; m < 4; ++m) { const size_t ro = (size_t)(row0 + ai * HALF + m * 16) * D + col0;
#pragma unroll
                for (int bj = 0; bj < 2; ++bj)
#pragma unroll
                    for (int n = 0; n < 2; ++n) { const f32x4 r = *(const f32x4*)(res + ro + bj * HALF + n * 16);
                        *(f32x4*)(out + ro + bj * HALF + n * 16) = r + gv[bj][n] * acc[ai][bj][m][n]; } }
    }
};

template <class Epi, class Sched>
__device__ __forceinline__ void gemm_phase(LAS unsigned char* lds, const Gemm g, const Sched& S, const Epi& E) {
    const int tid = opaque_tid(), wid = __builtin_amdgcn_readfirstlane(tid >> 6), lane = tid & 63, wr = wid >> 2, wc = wid & 3, fr = lane & 15, fq = lane >> 4;
    const int K = g.K, nt = K / BK;
    unsigned voffA[2], voffB[2];
#pragma unroll
    for (int i = 0; i < 2; ++i) { int R, C; stage_rc(tid * 16 + i * 8192, R, C); const int Rb = Epi::PERM ? ((R & ~31) + perm32(R & 31)) : R;
        voffA[i] = (unsigned)(R * K + C) * 2u; voffB[i] = (unsigned)(Rb * K + C) * 2u; }
    const size_t kstep = (size_t)(BK * 2);
    const size_t hstep = (size_t)HALF * K * 2;
    const size_t tstep = 2 * hstep;
    const unsigned ldsw = (unsigned)wid * 1024u;
    const int aoff = lds_byte(wr * 64 + fr, fq * 8), boff = lds_byte(wc * 32 + fr, fq * 8);
#define PG8_SA(b, h) (((b) * 2 + (h)) * HTB)
#define PG8_SB(b, h) ((4 + (b) * 2 + (h)) * HTB)
#define PG8_STAGE(bufoff, gbase, voff) do { _Pragma("unroll") for (int _i = 0; _i < 2; ++_i) \
        __builtin_amdgcn_global_load_lds((const unsigned*)((const char*)(gbase) + (voff)[_i]), (LAS unsigned*)(lds + (bufoff) + ldsw + _i * 8192), 16, 0, 0); } while (0)
#define PG8_LDA(dst, b, h) do { _Pragma("unroll") for (int m = 0; m < 4; ++m) _Pragma("unroll") for (int k = 0; k < 2; ++k) dst[m][k] = *(const LAS bf16x8*)(lds + PG8_SA(b, h) + aoff + m * 2048 + k * 1024); } while (0)
#define PG8_LDB(dst, b, h) do { _Pragma("unroll") for (int n = 0; n < 2; ++n) _Pragma("unroll") for (int k = 0; k < 2; ++k) dst[n][k] = *(const LAS bf16x8*)(lds + PG8_SB(b, h) + boff + n * 2048 + k * 1024); } while (0)
#define PG8_MMA(ai, bj, At, Bt) do { __builtin_amdgcn_s_setprio(1); _Pragma("unroll") for (int m = 0; m < 4; ++m) _Pragma("unroll") for (int n = 0; n < 2; ++n) _Pragma("unroll") for (int k = 0; k < 2; ++k) \
        acc[ai][bj][m][n] = __builtin_amdgcn_mfma_f32_16x16x32_bf16(Bt[n][k], At[m][k], acc[ai][bj][m][n], 0, 0, 0); __builtin_amdgcn_s_setprio(0); } while (0)
#define PG8_WAIT_V(n) asm volatile("s_waitcnt vmcnt(" #n ")" ::: "memory")
#define PG8_WAIT_L(n) asm volatile("s_waitcnt lgkmcnt(" #n ")" ::: "memory")
#define PG8_BAR __builtin_amdgcn_s_barrier()
#define PG8_SCHED __builtin_amdgcn_sched_barrier(0)
    Unit cur, nxt; int ui = 0;
    if (!S.next(0, cur)) return;
    f32x4 acc[2][2][4][2];
#pragma unroll
    for (int a = 0; a < 2; ++a)
#pragma unroll
        for (int b = 0; b < 2; ++b)
#pragma unroll
            for (int m = 0; m < 4; ++m)
#pragma unroll
                for (int n = 0; n < 2; ++n) acc[a][b][m][n] = (f32x4){0.f, 0.f, 0.f, 0.f};
    bf16x8 At[4][2], B0[2][2], B1[2][2];
    const char* cA = (const char*)g.A + (size_t)cur.pm * tstep; const char* cB = (const char*)g.Bt + (size_t)cur.pn * tstep;
    S.a_ready(cur);
    PG8_STAGE(PG8_SB(0, 0), cB, voffB); PG8_STAGE(PG8_SA(0, 0), cA, voffA); PG8_STAGE(PG8_SB(0, 1), cB + hstep, voffB); PG8_STAGE(PG8_SA(0, 1), cA + hstep, voffA);
    if (wr == 1) PG8_BAR;
    PG8_WAIT_V(4); PG8_BAR;
    PG8_STAGE(PG8_SB(1, 0), cB + kstep, voffB); PG8_STAGE(PG8_SA(1, 0), cA + kstep, voffA); PG8_STAGE(PG8_SB(1, 1), cB + hstep + kstep, voffB);
    PG8_WAIT_V(6); PG8_BAR;
    for (;;) {
        const bool has_next = S.next(ui + 1, nxt);
        const char* nA = has_next ? (const char*)g.A + (size_t)nxt.pm * tstep : cA; const char* nB = has_next ? (const char*)g.Bt + (size_t)nxt.pn * tstep : cB;
        for (int t = 0; t < nt; t += 2) {
            const bool last = (t == nt - 2);
            const char* a1 = cA + (size_t)(t + 1) * kstep;
            const char* a2 = last ? nA : cA + (size_t)(t + 2) * kstep; const char* b2 = last ? nB : cB + (size_t)(t + 2) * kstep;
            const char* a3 = a2 + kstep; const char* b3 = b2 + kstep;
            if (last && has_next) S.a_ready(nxt);
            PG8_LDB(B0, 0, 0); PG8_SCHED; PG8_LDA(At, 0, 0); PG8_STAGE(PG8_SA(1, 1), a1 + hstep, voffA);
            PG8_WAIT_L(8); PG8_BAR; PG8_WAIT_L(0); PG8_MMA(0, 0, At, B0); PG8_BAR; PG8_SCHED;
            PG8_LDB(B1, 0, 1); PG8_STAGE(PG8_SB(0, 0), b2, voffB);
            PG8_BAR; PG8_WAIT_L(0); PG8_MMA(0, 1, At, B1); PG8_BAR;
            PG8_LDA(At, 0, 1); PG8_STAGE(PG8_SA(0, 0), a2, voffA);
            PG8_BAR; PG8_WAIT_L(0); PG8_MMA(1, 0, At, B0); PG8_BAR; PG8_SCHED;
            PG8_STAGE(PG8_SB(0, 1), b2 + hstep, voffB);
            PG8_WAIT_V(6); PG8_BAR; PG8_MMA(1, 1, At, B1); PG8_BAR;
            PG8_LDB(B0, 1, 0); PG8_SCHED; PG8_LDA(At, 1, 0); PG8_STAGE(PG8_SA(0, 1), a2 + hstep, voffA);
            PG8_WAIT_L(8); PG8_BAR; PG8_WAIT_L(0); PG8_MMA(0, 0, At, B0); PG8_BAR; PG8_SCHED;
            PG8_LDB(B1, 1, 1); PG8_STAGE(PG8_SB(1, 0), b3, voffB);
            PG8_BAR; PG8_WAIT_L(0); PG8_MMA(0, 1, At, B1); PG8_BAR;
            PG8_LDA(At, 1, 1); PG8_STAGE(PG8_SA(1, 0), a3, voffA);
            PG8_BAR; PG8_WAIT_L(0); PG8_MMA(1, 0, At, B0); PG8_BAR; PG8_SCHED;
            PG8_STAGE(PG8_SB(1, 1), b3 + hstep, voffB);
            PG8_WAIT_V(6); PG8_BAR; PG8_MMA(1, 1, At, B1); PG8_BAR;
        }
        E(acc, cur, wr, wc, fr, fq); S.done(cur);
        if (!has_next) break;
#pragma unroll
        for (int a = 0; a < 2; ++a)
#pragma unroll
            for (int b = 0; b < 2; ++b)
#pragma unroll
                for (int m = 0; m < 4; ++m)
#pragma unroll
                    for (int n = 0; n < 2; ++n) acc[a][b][m][n] = (f32x4){0.f, 0.f, 0.f, 0.f};
        cur = nxt; cA = nA; cB = nB; ++ui;
    }
    PG8_WAIT_V(0);
    if (wr == 0) PG8_BAR;
    PG8_BAR;
#undef PG8_SA
#undef PG8_SB
#undef PG8_STAGE
#undef PG8_LDA
#undef PG8_LDB
#undef PG8_MMA
#undef PG8_WAIT_V
#undef PG8_WAIT_L
#undef PG8_BAR
#undef PG8_SCHED
}
}

__device__ void phase_prep(const Params& p, LAS unsigned char* lds) {
    const int tid = opaque_tid();
    constexpr int NT_L = 896 + 256 + 1408 + 704;
    constexpr int J_ADA = 192, J_TR = J_ADA + 2 * NT_L, J_WSP = J_TR + 32, J_LB = J_WSP + 1;
    for (int job = blockIdx.x; job < J_LB; job += gridDim.x) {
        if (job < J_ADA) {
            LAS float* s = (LAS float*)lds;
            LAS float* red = (LAS float*)(lds + 9 * 1024 * 4);
            for (int i = tid; i < 9 * 1024; i += 512) { const int r = i >> 10, d = i & 1023; const float v = r < 8 ? p.in[1][r * 1024 + d] : p.in[3][d]; s[i] = silu_f(v); }
            __syncthreads();
            const int l = job / 96, e0 = (job % 96) * 64, col = tid & 63, dg = tid >> 6;
            const float* w = p.in[4] + ((size_t)l * 1024 + dg * 128) * 6144 + e0 + col;
            float acc[9];
#pragma unroll
            for (int r = 0; r < 9; ++r) acc[r] = 0.f;
            for (int dd = 0; dd < 128; ++dd) { const float wv = w[(size_t)dd * 6144];
#pragma unroll
                for (int r = 0; r < 9; ++r) acc[r] += s[r * 1024 + dg * 128 + dd] * wv; }
#pragma unroll
            for (int r = 0; r < 9; ++r) red[(dg * 9 + r) * 64 + col] = acc[r];
            __syncthreads();
            for (int i = tid; i < 9 * 64; i += 512) { const int r = i >> 6, c = i & 63; float a = 0.f;
#pragma unroll
                for (int g = 0; g < 8; ++g) a += red[(g * 9 + r) * 64 + c];
                ((float*)(p.ws + WS_ADA))[((size_t)l * 9 + r) * 6144 + e0 + c] = a + p.in[5][l * 6144 + e0 + c]; }
            __syncthreads();
        } else if (job < J_TR) {
            const int j = job - J_ADA, l = j / NT_L; int r = j % NT_L;
            const float* src; bf16_t* dst; int K, N;
            if (r < 896) { src = p.in[8] + (size_t)l * D * PW; dst = (bf16_t*)(p.ws + WS_WIN) + (size_t)l * PW * D; K = D; N = PW; }
            else if (r < 1152) { r -= 896; src = p.in[16] + (size_t)l * D * D; dst = (bf16_t*)(p.ws + WS_WOUT) + (size_t)l * D * D; K = D; N = D; }
            else if (r < 2560) { r -= 1152; src = p.in[17] + (size_t)l * D * UPW; dst = (bf16_t*)(p.ws + WS_WUP) + (size_t)l * UPW * D; K = D; N = UPW; }
            else { r -= 2560; src = p.in[20] + (size_t)l * FF * D; dst = (bf16_t*)(p.ws + WS_WDOWN) + (size_t)l * D * FF; K = FF; N = D; }
            const int ntn = N >> 6, kt = r / ntn, nt = r % ntn;
            LAS float* tile = (LAS float*)lds;
            { const int kk = tid >> 3, n8 = (tid & 7) * 8; const float* sp = src + (size_t)(kt * 64 + kk) * N + nt * 64 + n8;
              const f32x4 a = *(const f32x4*)sp, b = *(const f32x4*)(sp + 4);
              LAS float* tp = tile + kk * 65 + n8; tp[0] = a[0]; tp[1] = a[1]; tp[2] = a[2]; tp[3] = a[3]; tp[4] = b[0]; tp[5] = b[1]; tp[6] = b[2]; tp[7] = b[3]; }
            __syncthreads();
            { const int nn = tid >> 3, k8 = (tid & 7) * 8; float v[8];
#pragma unroll
              for (int i = 0; i < 8; ++i) v[i] = tile[(k8 + i) * 65 + nn];
              u32x4 w; w.x = pk_bf16(v[0], v[1]); w.y = pk_bf16(v[2], v[3]); w.z = pk_bf16(v[4], v[5]); w.w = pk_bf16(v[6], v[7]);
              *(u32x4*)(dst + (size_t)(nt * 64 + nn) * K + kt * 64 + k8) = w; }
            __syncthreads();
        } else if (job < J_WSP) {
            const int j = job - J_TR; const size_t i0 = (size_t)j * 4096 + tid * 8;
            const f32x4 a = *(const f32x4*)(p.in[14] + i0), b = *(const f32x4*)(p.in[14] + i0 + 4);
            u32x4 w; w.x = pk_bf16(a[0], a[1]); w.y = pk_bf16(a[2], a[3]); w.z = pk_bf16(b[0], b[1]); w.w = pk_bf16(b[2], b[3]);
            *(u32x4*)((bf16_t*)(p.ws + WS_WSP) + i0) = w;
        } else {
            for (int i = tid; i < 1024; i += 512) { const int dir = i >> 9, c = i & 511; const float* lg = dir ? p.in[10] : p.in[9];
                const float l0 = lg[c], l1 = lg[512 + c]; ((float*)(p.ws + WS_LB))[i] = 1.0f / (1.0f + expf(l0 - l1)); }
        }
    }
}

__device__ void phase_norm(const float* xl, const float* xc, const float* gain, const float* ada_l, int shift_idx, int nrows, bf16_t* H) {
    const int tid_ = opaque_tid(); const int wave = tid_ >> 6, lane = tid_ & 63;
    for (int row = blockIdx.x * 8 + wave; row < nrows; row += gridDim.x * 8) {
        const float* src; const float* mod;
        if (row < NLAT) { src = xl + (size_t)row * D; mod = ada_l + (size_t)(row >> 12) * 6144; } else { src = xc + (size_t)(row - NLAT) * D; mod = ada_l + (size_t)8 * 6144; }
        f32x4 v[4]; float ss = 0.f;
#pragma unroll
        for (int j = 0; j < 4; ++j) { v[j] = *(const f32x4*)(src + j * 256 + lane * 4); ss += v[j][0] * v[j][0] + v[j][1] * v[j][1] + v[j][2] * v[j][2] + v[j][3] * v[j][3]; }
#pragma unroll
        for (int o = 32; o > 0; o >>= 1) ss += __shfl_xor(ss, o);
        const float rs = rsqrtf(ss * (1.0f / D) + EPS);
#pragma unroll
        for (int j = 0; j < 4; ++j) { const int d = j * 256 + lane * 4;
            const f32x4 g = *(const f32x4*)(gain + d), sh = *(const f32x4*)(mod + shift_idx * 1024 + d), sc = *(const f32x4*)(mod + (shift_idx + 1) * 1024 + d);
            f32x4 y = v[j] * rs * g; y = y * (sc + 1.0f) + sh;
            u32x2 w; w.x = pk_bf16(y[0], y[1]); w.y = pk_bf16(y[2], y[3]);
            *(u32x2*)(H + (size_t)row * D + d) = w; }
    }
}
__device__ void phase_final(float* x, const float* gain) {
    const int tid_ = opaque_tid(); const int wave = tid_ >> 6, lane = tid_ & 63;
    for (int row = blockIdx.x * 8 + wave; row < NLAT; row += gridDim.x * 8) {
        float* src = x + (size_t)row * D;
        f32x4 v[4]; float ss = 0.f;
#pragma unroll
        for (int j = 0; j < 4; ++j) { v[j] = *(const f32x4*)(src + j * 256 + lane * 4); ss += v[j][0] * v[j][0] + v[j][1] * v[j][1] + v[j][2] * v[j][2] + v[j][3] * v[j][3]; }
#pragma unroll
        for (int o = 32; o > 0; o >>= 1) ss += __shfl_xor(ss, o);
        const float rs = rsqrtf(ss * (1.0f / D) + EPS);
#pragma unroll
        for (int j = 0; j < 4; ++j) { const int d = j * 256 + lane * 4; const f32x4 g = *(const f32x4*)(gain + d); *(f32x4*)(src + d) = v[j] * rs * g; }
    }
}

constexpr int QS_ST = 136, KT_ST = 40;
constexpr int P1_QS = 0, P1_KH = P1_QS + 32 * QS_ST * 2, P1_VT = P1_KH + 32 * QS_ST * 2, P1_KT = P1_VT + 128 * KT_ST * 2, P1_AW = P1_KT + 128 * KT_ST * 2;
constexpr int NCH = 8 + 128;

template <int CTRL, int RMASK> __device__ __forceinline__ float dpp_mul(float x) {
    const int t = __builtin_amdgcn_update_dpp(0x3f800000, __builtin_bit_cast(int, x), CTRL, RMASK, 0xf, false);
    return x * __builtin_bit_cast(float, t);
}
__device__ __forceinline__ float cumprod32(float x) {
    x = dpp_mul<0x111, 0xf>(x); x = dpp_mul<0x112, 0xf>(x); x = dpp_mul<0x114, 0xf>(x); x = dpp_mul<0x118, 0xf>(x);
    x = dpp_mul<0x142, 0xa>(x);
    return x;
}

__device__ void prep_item(const Params& p, int l, int item, LAS unsigned char* lds) {
    const int tid = opaque_tid(), w = tid >> 6, lane = tid & 63;
    const int tau = lane & 31, kh = lane >> 5, k0 = 16 * w + 8 * kh, l15 = lane & 15, q4 = lane >> 4;
    const int ci = item % NCH, bh = item / NCH, h = bh & 3, b = bh >> 2;
    const int R0 = ci < 8 ? NLAT + b * 256 + 32 * ci : b * 4096 + 32 * (ci - 8);
    bf16_t* P = (bf16_t*)(p.ws + WS_BIG);
    const bool first = (l == 0);
    const bool want_out = first || ci >= 8;
    LAS bf16_t* Qs = (LAS bf16_t*)(lds + P1_QS); LAS bf16_t* Kh = (LAS bf16_t*)(lds + P1_KH);
    LAS bf16_t* Vt = (LAS bf16_t*)(lds + P1_VT); LAS bf16_t* Kt = (LAS bf16_t*)(lds + P1_KT);
    LAS bf16_t* Aw = (LAS bf16_t*)(lds + P1_AW) + w * 32 * KT_ST;
    for (int i = lane; i < 32 * KT_ST / 2; i += 64) ((LAS unsigned*)Aw)[i] = 0u;
    u32x4 rf0, rq0, rv0, rf1, rq1, rv1;
    { const bf16_t* rp = P + (size_t)(R0 + tau) * PW; rf0 = *(const u32x4*)(rp + h * 128 + k0); rq0 = *(const u32x4*)(rp + 1536 + h * 128 + k0); rv0 = *(const u32x4*)(rp + 1024 + h * 128 + k0); }
    { const bf16_t* rp = P + (size_t)(R0 + 31 - tau) * PW; rf1 = *(const u32x4*)(rp + 512 + h * 128 + k0); rq1 = *(const u32x4*)(rp + 1536 + h * 128 + k0); rv1 = *(const u32x4*)(rp + 1024 + h * 128 + k0); }
    asm volatile("s_waitcnt vmcnt(0)" ::: "memory");
    __syncthreads();
    auto one_dir = [&](const int dir, const u32x4& f, const u32x4& q, const u32x4& v) {
        const int tokl = dir ? 31 - tau : tau;
        const float* lbp = (const float*)(p.ws + WS_LB) + dir * 512 + h * 128 + k0;
        float E[8], kk[8];
#pragma unroll
        for (int j = 0; j < 8; ++j) {
            const unsigned fw = f[j >> 1]; const float x = (j & 1) ? bf_hi(fw) : bf_lo(fw);
            const float e = __expf(-fabsf(x)), r = fast_rcp(1.0f + e);
            const float sp = x >= 0.f ? r : e * r, sn = x >= 0.f ? e * r : r;
            if (first) { E[j] = sp; kk[j] = sn; }
            else { const float lb = lbp[j]; const float gate = lb + (1.0f - lb) * sp; E[j] = gate; kk[j] = 1.0f - gate; }
        }
        float qt[8], kh_[8], kt_[8];
#pragma unroll
        for (int j = 0; j < 8; ++j) {
            const float Ej = fmaxf(cumprod32(E[j]), 1e-35f);
            const float T0 = __builtin_bit_cast(float, __builtin_amdgcn_readlane(__builtin_bit_cast(int, Ej), 31)), T1 = __builtin_bit_cast(float, __builtin_amdgcn_readlane(__builtin_bit_cast(int, Ej), 63));
            const float T = kh ? T1 : T0;
            const unsigned qw = q[j >> 1]; const float qx = (j & 1) ? bf_hi(qw) : bf_lo(qw);
            qt[j] = silu_f(qx) * 0.08838834764831845f * Ej;
            kh_[j] = kk[j] * fast_rcp(Ej); kt_[j] = kh_[j] * T;
            if (tau == 31) ((float*)(p.ws + WS_DS))[((size_t)((b * 4 + h) * 2 + dir) * NCH + ci) * 128 + k0 + j] = T;
        }
        u32x4 wq, wk; wq.x = pk_bf16(qt[0], qt[1]); wq.y = pk_bf16(qt[2], qt[3]); wq.z = pk_bf16(qt[4], qt[5]); wq.w = pk_bf16(qt[6], qt[7]);
        wk.x = pk_bf16(kh_[0], kh_[1]); wk.y = pk_bf16(kh_[2], kh_[3]); wk.z = pk_bf16(kh_[4], kh_[5]); wk.w = pk_bf16(kh_[6], kh_[7]);
        *(LAS u32x4*)(Qs + tau * QS_ST + k0) = wq; *(LAS u32x4*)(Kh + tau * QS_ST + k0) = wk;
        if (dir == 0) *(u32x4*)(P + (size_t)(R0 + tokl) * PW + 1536 + h * 128 + k0) = wq;
        else *(u32x4*)((bf16_t*)(p.ws + WS_QB) + (size_t)(R0 + tokl) * 512 + h * 128 + k0) = wq;
#pragma unroll
        for (int j = 0; j < 8; ++j) { Kt[(k0 + j) * KT_ST + tokl] = to_bf1(kt_[j]); const unsigned vw = v[j >> 1]; Vt[(k0 + j) * KT_ST + tau] = (bf16_t)((j & 1) ? (vw >> 16) : (vw & 0xffffu)); }
        __syncthreads();
        if (want_out) {
            f32x4 a00 = (f32x4){0.f, 0.f, 0.f, 0.f}, a10 = a00, a11 = a00;
#pragma unroll
            for (int kb = 0; kb < 4; ++kb) {
                const bf16x8 qn0 = *(const LAS bf16x8*)(Qs + l15 * QS_ST + 32 * kb + 8 * q4), qn1 = *(const LAS bf16x8*)(Qs + (16 + l15) * QS_ST + 32 * kb + 8 * q4);
                const bf16x8 kh0 = *(const LAS bf16x8*)(Kh + l15 * QS_ST + 32 * kb + 8 * q4), kh1 = *(const LAS bf16x8*)(Kh + (16 + l15) * QS_ST + 32 * kb + 8 * q4);
                a00 = __builtin_amdgcn_mfma_f32_16x16x32_bf16(qn0, kh0, a00, 0, 0, 0);
                a10 = __builtin_amdgcn_mfma_f32_16x16x32_bf16(qn1, kh0, a10, 0, 0, 0);
                a11 = __builtin_amdgcn_mfma_f32_16x16x32_bf16(qn1, kh1, a11, 0, 0, 0);
            }
#pragma unroll
            for (int i = 0; i < 4; ++i) { const int t = 4 * q4 + i; const bool keep = l15 <= t;
                Aw[t * KT_ST + l15] = to_bf1(keep ? a00[i] : 0.f);
                Aw[(16 + t) * KT_ST + l15] = to_bf1(a10[i]);
                Aw[(16 + t) * KT_ST + 16 + l15] = to_bf1(keep ? a11[i] : 0.f); }
            asm volatile("s_waitcnt lgkmcnt(0)" ::: "memory");
            const bf16x8 vf = *(const LAS bf16x8*)(Vt + (16 * w + l15) * KT_ST + 8 * q4);
            bf16_t* OFB = (bf16_t*)(p.ws + WS_OFB) + (size_t)dir * NROW * 512;
#pragma unroll
            for (int mt = 0; mt < 2; ++mt) {
                const bf16x8 af = *(const LAS bf16x8*)(Aw + (16 * mt + l15) * KT_ST + 8 * q4);
                const f32x4 o = __builtin_amdgcn_mfma_f32_16x16x32_bf16(vf, af, (f32x4){0.f, 0.f, 0.f, 0.f}, 0, 0, 0);
                const int tl = 16 * mt + l15, tok = dir ? 31 - tl : tl;
                u32x2 wv; wv.x = pk_bf16(o[0], o[1]); wv.y = pk_bf16(o[2], o[3]);
                *(u32x2*)(OFB + (size_t)(R0 + tok) * 512 + h * 128 + 16 * w + 4 * q4) = wv;
            }
        }
        { const int k = tid >> 2, part = tid & 3;
          const u32x4 kv = *(const LAS u32x4*)(Kt + k * KT_ST + 8 * part);
          bf16_t* dst = P + (size_t)(R0 + (k >> 2)) * PW + h * 128 + (k & 3) * 32 + part * 8;
          *(u32x4*)(dst + dir * 512) = kv;
          if (dir == 0) { const u32x4 vv = *(const LAS u32x4*)(Vt + k * KT_ST + 8 * part); *(u32x4*)(dst + 1024) = vv; } }
        __syncthreads();
    };
    one_dir(0, rf0, rq0, rv0);
    one_dir(1, rf1, rq1, rv1);
}

constexpr int SC_QS = 0, SC_KT = SC_QS + 32 * QS_ST * 2, SC_VT = SC_KT + 128 * KT_ST * 2, SC_DS = SC_VT + 128 * KT_ST * 2, SC_BUF = SC_DS + 512;
__device__ void scan_chain(const Params& p, int l, int chain, LAS unsigned char* lds) {
    const int tid = opaque_tid(), w = tid >> 6, lane = tid & 63, l15 = lane & 15, q4 = lane >> 4;
    const int dir = chain & 1, h = (chain >> 1) & 3, b = chain >> 3;
    const bf16_t* P = (const bf16_t*)(p.ws + WS_BIG);
    bf16_t* OFB = (bf16_t*)(p.ws + WS_OFB) + (size_t)dir * NROW * 512;
    const float* DS = (const float*)(p.ws + WS_DS) + (size_t)chain * NCH * 128;
    const bool first = (l == 0);
    auto chunk_of = [&](int s) -> int { return dir ? (s < 8 ? 7 - s : 143 - s) : s; };
    auto row0_of = [&](int c) -> int { return c < 8 ? NLAT + b * 256 + 32 * c : b * 4096 + 32 * (c - 8); };
    const int qrow = tid >> 4, qseg = tid & 15, kk_ = tid >> 2, kpart = tid & 3;
    u32x4 rq, rk, rv, nq, nk, nv; f32x4 rd, nd; u32x2 oi[2], noi[2];
    rd = nd = (f32x4){0.f, 0.f, 0.f, 0.f};
    auto load_raw = [&](int s, u32x4& q, u32x4& k, u32x4& v, f32x4& d, u32x2 (&o)[2]) {
        const int c = chunk_of(s), R0 = row0_of(c);
        if (dir == 0) q = *(const u32x4*)(P + (size_t)(R0 + qrow) * PW + 1536 + h * 128 + qseg * 8);
        else q = *(const u32x4*)((const bf16_t*)(p.ws + WS_QB) + (size_t)(R0 + qrow) * 512 + h * 128 + qseg * 8);
        const bf16_t* kp = P + (size_t)(R0 + (kk_ >> 2)) * PW + h * 128 + (kk_ & 3) * 32 + kpart * 8;
        k = *(const u32x4*)(kp + dir * 512); v = *(const u32x4*)(kp + 1024);
        if (tid < 32) d = *(const f32x4*)(DS + (size_t)c * 128 + tid * 4);
#pragma unroll
        for (int mt = 0; mt < 2; ++mt) { const int tok = 16 * mt + l15;
            o[mt] = *(const u32x2*)(OFB + (size_t)(R0 + tok) * 512 + h * 128 + 16 * w + 4 * q4); }
    };
    auto stage = [&](int buf, const u32x4& q, const u32x4& k, const u32x4& v, const f32x4& d) {
        LAS unsigned char* base = lds + buf * SC_BUF;
        *(LAS u32x4*)((LAS bf16_t*)(base + SC_QS) + qrow * QS_ST + qseg * 8) = q;
        *(LAS u32x4*)((LAS bf16_t*)(base + SC_KT) + kk_ * KT_ST + kpart * 8) = k;
        *(LAS u32x4*)((LAS bf16_t*)(base + SC_VT) + kk_ * KT_ST + kpart * 8) = v;
        if (tid < 32) *(LAS f32x4*)((LAS float*)(base + SC_DS) + tid * 4) = d;
    };
    f32x4 S[8];
#pragma unroll
    for (int j = 0; j < 8; ++j) S[j] = (f32x4){0.f, 0.f, 0.f, 0.f};
    load_raw(0, rq, rk, rv, rd, oi);
    stage(0, rq, rk, rv, rd);
    load_raw(1, rq, rk, rv, rd, noi);
    __syncthreads();
    for (int s = 0; s < NCH; ++s) {
        u32x2 n2oi[2]; n2oi[0] = n2oi[1] = (u32x2){0u, 0u};
        if (s + 2 < NCH) load_raw(s + 2, nq, nk, nv, nd, n2oi);
        if (s + 1 < NCH) stage((s + 1) & 1, rq, rk, rv, rd);
        {
            LAS unsigned char* base = lds + (s & 1) * SC_BUF;
            LAS bf16_t* Qs = (LAS bf16_t*)(base + SC_QS); LAS bf16_t* Kt = (LAS bf16_t*)(base + SC_KT); LAS bf16_t* Vt = (LAS bf16_t*)(base + SC_VT); LAS float* dS = (LAS float*)(base + SC_DS);
            f32x4 o[2]; o[0] = (f32x4){0.f, 0.f, 0.f, 0.f}; o[1] = o[0];
#pragma unroll
            for (int kb = 0; kb < 4; ++kb) {
                u32x4 sb; sb.x = pk_bf16(S[2 * kb][0], S[2 * kb][1]); sb.y = pk_bf16(S[2 * kb][2], S[2 * kb][3]); sb.z = pk_bf16(S[2 * kb + 1][0], S[2 * kb + 1][1]); sb.w = pk_bf16(S[2 * kb + 1][2], S[2 * kb + 1][3]);
                const bf16x8 sfr = __builtin_bit_cast(bf16x8, sb);
#pragma unroll
                for (int mt = 0; mt < 2; ++mt) {
                    const LAS bf16_t* qp = Qs + (16 * mt + l15) * QS_ST + 32 * kb + 4 * q4;
                    const u32x2 lo = *(const LAS u32x2*)qp, hi = *(const LAS u32x2*)(qp + 16);
                    u32x4 av; av.x = lo.x; av.y = lo.y; av.z = hi.x; av.w = hi.y;
                    o[mt] = __builtin_amdgcn_mfma_f32_16x16x32_bf16(sfr, __builtin_bit_cast(bf16x8, av), o[mt], 0, 0, 0);
                }
            }
            const bf16x8 vf = *(const LAS bf16x8*)(Vt + (16 * w + l15) * KT_ST + 8 * q4);
#pragma unroll
            for (int j = 0; j < 8; ++j) {
                const f32x4 dv = *(const LAS f32x4*)(dS + 16 * j + 4 * q4);
                const bf16x8 kf = *(const LAS bf16x8*)(Kt + (16 * j + l15) * KT_ST + 8 * q4);
                S[j] = __builtin_amdgcn_mfma_f32_16x16x32_bf16(kf, vf, S[j] * dv, 0, 0, 0);
            }
            const int c = chunk_of(s);
            if (first || c >= 8) {
                const int R0 = row0_of(c);
#pragma unroll
                for (int mt = 0; mt < 2; ++mt) { const int tok = 16 * mt + l15;
                    u32x2 wv; wv.x = pk_bf16(o[mt][0] + bf_lo(oi[mt].x), o[mt][1] + bf_hi(oi[mt].x)); wv.y = pk_bf16(o[mt][2] + bf_lo(oi[mt].y), o[mt][3] + bf_hi(oi[mt].y));
                    *(u32x2*)(OFB + (size_t)(R0 + tok) * 512 + h * 128 + 16 * w + 4 * q4) = wv; }
            }
        }
        __syncthreads();
        rq = nq; rk = nk; rv = nv; rd = nd; oi[0] = noi[0]; oi[1] = noi[1]; noi[0] = n2oi[0]; noi[1] = n2oi[1];
    }
}

constexpr int SG_ST = 136;
__device__ void sgu_tile(const Params& p, int l, int tile, LAS unsigned char* lds) {
    const int tid = opaque_tid(), w = tid >> 6, lane = tid & 63, l15 = lane & 15, q4 = lane >> 4;
    const int h = tile & 3, rowbase = (tile >> 2) * 128;
    const bf16_t* P = (const bf16_t*)(p.ws + WS_BIG);
    bf16_t* O = (bf16_t*)(p.ws + WS_H);
    LAS bf16_t* Vt = (LAS bf16_t*)lds;
    {
        const int q = tid >> 2, cgp = tid & 3;
        const bf16_t* vp = P + (size_t)(rowbase + q) * PW + 3072 + 128 * h + 32 * cgp;
        float g[32];
#pragma unroll
        for (int i = 0; i < 4; ++i) { const u32x4 r = *(const u32x4*)(vp + 8 * i);
#pragma unroll
            for (int j = 0; j < 4; ++j) { g[8 * i + 2 * j] = gelu_f(bf_lo(r[j])); g[8 * i + 2 * j + 1] = gelu_f(bf_hi(r[j])); } }
        float s = 0.f;
#pragma unroll
        for (int i = 0; i < 32; ++i) s += g[i];
        s += __shfl_xor(s, 1); s += __shfl_xor(s, 2);
        const float mu = s * (1.0f / 128.f);
        float vs = 0.f;
#pragma unroll
        for (int i = 0; i < 32; ++i) { const float d = g[i] - mu; vs += d * d; }
        vs += __shfl_xor(vs, 1); vs += __shfl_xor(vs, 2);
        const float rstd = rsqrtf(vs * (1.0f / 128.f) + EPS);
        const float* lng = p.in[12] + l * 512 + h * 128 + 32 * cgp; const float* lnb = p.in[13] + l * 512 + h * 128 + 32 * cgp;
#pragma unroll
        for (int i = 0; i < 32; ++i) { const float y = (g[i] - mu) * rstd * lng[i] + lnb[i]; Vt[(32 * cgp + i) * SG_ST + q] = to_bf1(y); }
    }
    __syncthreads();
    {
        const int prow = 16 * w + l15;
        const bf16_t* wsp = (const bf16_t*)(p.ws + WS_WSP) + ((size_t)(l * 4 + h) * 128 + prow) * 128 + 8 * q4;
        bf16x8 wf[4];
#pragma unroll
        for (int kb = 0; kb < 4; ++kb) wf[kb] = *(const bf16x8*)(wsp + 32 * kb);
        const float bs = p.in[15][(l * 4 + h) * 128 + prow];
        const bf16_t* up = P + (size_t)(rowbase + prow) * PW + 2560 + 128 * h + 4 * q4;
        bf16_t* op = O + (size_t)(rowbase + prow) * D + 512 + 128 * h + 4 * q4;
#pragma unroll
        for (int mt = 0; mt < 8; ++mt) {
            f32x4 acc = (f32x4){0.f, 0.f, 0.f, 0.f};
#pragma unroll
            for (int kb = 0; kb < 4; ++kb) { const bf16x8 af = *(const LAS bf16x8*)(Vt + (16 * mt + l15) * SG_ST + 32 * kb + 8 * q4);
                acc = __builtin_amdgcn_mfma_f32_16x16x32_bf16(af, wf[kb], acc, 0, 0, 0); }
            const u32x2 uu = *(const u32x2*)(up + 16 * mt);
            const float u0 = gelu_f(bf_lo(uu.x)), u1 = gelu_f(bf_hi(uu.x)), u2 = gelu_f(bf_lo(uu.y)), u3 = gelu_f(bf_hi(uu.y));
            u32x2 wv; wv.x = pk_bf16(u0 * (acc[0] + bs), u1 * (acc[1] + bs)); wv.y = pk_bf16(u2 * (acc[2] + bs), u3 * (acc[3] + bs));
            *(u32x2*)(op + 16 * mt) = wv;
        }
    }
    __syncthreads();
}

__device__ void phase_mixer(const Params& p, int l, LAS unsigned char* lds) {
    const int G = gridDim.x, bid = blockIdx.x;
    const int ntile = (l == 0) ? (NROW / 128) * 4 : (NLAT / 128) * 4;
    if (G > 64) {
        if (bid < 64) scan_chain(p, l, bid, lds);
        else for (int t = bid - 64; t < ntile; t += G - 64) sgu_tile(p, l, t, lds);
    } else {
        for (int c = bid; c < 64; c += G) { scan_chain(p, l, c, lds); __syncthreads(); }
        for (int t = bid; t < ntile; t += G) sgu_tile(p, l, t, lds);
    }
}

__device__ void phase_combine(const Params& p, int l, int nrows) {
    const int tid_ = opaque_tid(); const int wave = tid_ >> 6, lane = tid_ & 63, hd = lane >> 4, v0 = (lane & 15) * 8;
    const bf16_t* P = (const bf16_t*)(p.ws + WS_BIG);
    const bf16_t* OF = (const bf16_t*)(p.ws + WS_OFB); const bf16_t* OB = OF + (size_t)NROW * 512;
    bf16_t* O = (bf16_t*)(p.ws + WS_H);
    const float* gn = p.in[11] + l * 512 + hd * 128 + v0;
    const f32x4 g0 = *(const f32x4*)gn, g1 = *(const f32x4*)(gn + 4);
    for (int row = blockIdx.x * 8 + wave; row < nrows; row += gridDim.x * 8) {
        const u32x4 a = *(const u32x4*)(OF + (size_t)row * 512 + hd * 128 + v0), bq = *(const u32x4*)(OB + (size_t)row * 512 + hd * 128 + v0);
        const u32x4 gg = *(const u32x4*)(P + (size_t)row * PW + 2048 + hd * 128 + v0);
        float s[8]; float ss = 0.f;
#pragma unroll
        for (int j = 0; j < 4; ++j) { s[2 * j] = bf_lo(a[j]) + bf_lo(bq[j]); s[2 * j + 1] = bf_hi(a[j]) + bf_hi(bq[j]); ss += s[2 * j] * s[2 * j] + s[2 * j + 1] * s[2 * j + 1]; }
#pragma unroll
        for (int o = 8; o > 0; o >>= 1) ss += __shfl_xor(ss, o);
        const float rs = rsqrtf(ss * (1.0f / 128.f) + EPS);
        float y[8];
#pragma unroll
        for (int j = 0; j < 4; ++j) { y[2 * j] = s[2 * j] * rs * (j < 2 ? g0[2 * j] : g1[2 * j - 4]) * silu_f(bf_lo(gg[j])); y[2 * j + 1] = s[2 * j + 1] * rs * (j < 2 ? g0[2 * j + 1] : g1[2 * j - 3]) * silu_f(bf_hi(gg[j])); }
        u32x4 wv; wv.x = pk_bf16(y[0], y[1]); wv.y = pk_bf16(y[2], y[3]); wv.z = pk_bf16(y[4], y[5]); wv.w = pk_bf16(y[6], y[7]);
        *(u32x4*)(O + (size_t)row * D + hd * 128 + v0) = wv;
    }
}

__device__ void phase_conv(const Params& p, int l, int nrows) {
    bf16_t* Aup = (bf16_t*)(p.ws + WS_BIG); const bf16_t* Gup = Aup + (size_t)NROW * FF;
    const float* cw = p.in[18] + (size_t)l * 9 * FF; const float* cb = p.in[19] + (size_t)l * FF;
    const int tid_ = opaque_tid();
    const long total = (long)(nrows / 16) * 352;
    for (long id = (long)blockIdx.x * 512 + tid_; id < total; id += (long)gridDim.x * 512) {
        const int seg = (int)(id / 352), f0 = (int)(id % 352) * 8;
        const int tok0 = seg * 16;
        int c0, W; bool up, dn;
        if (tok0 < NLAT) { const int t = tok0 & 4095, r = t >> 6; c0 = t & 63; W = 64; up = r > 0; dn = r < 63; }
        else { c0 = (tok0 - NLAT) & 255; W = 256; up = false; dn = false; }
        float tp[9][8]; float bias[8];
#pragma unroll
        for (int k = 0; k < 9; ++k) { const f32x4 t0 = *(const f32x4*)(cw + k * FF + f0), t1 = *(const f32x4*)(cw + k * FF + f0 + 4);
            tp[k][0] = t0[0]; tp[k][1] = t0[1]; tp[k][2] = t0[2]; tp[k][3] = t0[3]; tp[k][4] = t1[0]; tp[k][5] = t1[1]; tp[k][6] = t1[2]; tp[k][7] = t1[3]; }
        { const f32x4 b0 = *(const f32x4*)(cb + f0), b1 = *(const f32x4*)(cb + f0 + 4); bias[0] = b0[0]; bias[1] = b0[1]; bias[2] = b0[2]; bias[3] = b0[3]; bias[4] = b1[0]; bias[5] = b1[1]; bias[6] = b1[2]; bias[7] = b1[3]; }
        const u32x4 zero = (u32x4){0u, 0u, 0u, 0u};
        const bf16_t* gp = Gup + (size_t)tok0 * FF + f0;
        u32x4 L[3], M[3], R[3];
        { const bool v = c0 > 0;
          L[0] = (v && up) ? *(const u32x4*)(gp - (size_t)65 * FF) : zero; L[1] = v ? *(const u32x4*)(gp - (size_t)FF) : zero; L[2] = (v && dn) ? *(const u32x4*)(gp + (size_t)63 * FF) : zero; }
        M[0] = up ? *(const u32x4*)(gp - (size_t)64 * FF) : zero; M[1] = *(const u32x4*)gp; M[2] = dn ? *(const u32x4*)(gp + (size_t)64 * FF) : zero;
#pragma unroll 4
        for (int i = 0; i < 16; ++i) {
            const bf16_t* np = gp + (size_t)(i + 1) * FF;
            const bool v = (c0 + i + 1) < W;
            R[0] = (v && up) ? *(const u32x4*)(np - (size_t)64 * FF) : zero; R[1] = v ? *(const u32x4*)np : zero; R[2] = (v && dn) ? *(const u32x4*)(np + (size_t)64 * FF) : zero;
            float acc[8];
#pragma unroll
            for (int j = 0; j < 8; ++j) acc[j] = bias[j];
#pragma unroll
            for (int rr = 0; rr < 3; ++rr) {
#pragma unroll
                for (int j = 0; j < 4; ++j) {
                    acc[2 * j] += bf_lo(L[rr][j]) * tp[rr * 3 + 0][2 * j] + bf_lo(M[rr][j]) * tp[rr * 3 + 1][2 * j] + bf_lo(R[rr][j]) * tp[rr * 3 + 2][2 * j];
                    acc[2 * j + 1] += bf_hi(L[rr][j]) * tp[rr * 3 + 0][2 * j + 1] + bf_hi(M[rr][j]) * tp[rr * 3 + 1][2 * j + 1] + bf_hi(R[rr][j]) * tp[rr * 3 + 2][2 * j + 1];
                }
            }
            bf16_t* ap = Aup + (size_t)(tok0 + i) * FF + f0;
            const u32x4 av = *(const u32x4*)ap;
            u32x4 wv;
#pragma unroll
            for (int j = 0; j < 4; ++j) wv[j] = pk_bf16(bf_lo(av[j]) * gelu_f(acc[2 * j]), bf_hi(av[j]) * gelu_f(acc[2 * j + 1]));
            *(u32x4*)ap = wv;
#pragma unroll
            for (int rr = 0; rr < 3; ++rr) { L[rr] = M[rr]; M[rr] = R[rr]; }
        }
    }
}

__global__ void __launch_bounds__(512, 2) fwd_megakernel(Params p) {
    extern __shared__ __attribute__((aligned(16))) unsigned char shm[];
    LAS unsigned char* lds = (LAS unsigned char*)shm;
    cg::grid_group grid = cg::this_grid();
    const int G = gridDim.x, bid = blockIdx.x;
    float* XC = (float*)(p.ws + WS_XC);
    bf16_t* H = (bf16_t*)(p.ws + WS_H);
    bf16_t* BIG = (bf16_t*)(p.ws + WS_BIG);
    const float* ADA = (const float*)(p.ws + WS_ADA);

    phase_prep(p, lds);
    grid.sync();
    for (int l = 0; l < DEPTH; ++l) {
        const bool last = (l == DEPTH - 1);
        const float* ada_l = ADA + (size_t)l * 9 * 6144;
        const float* xl = (l == 0) ? p.in[0] : p.out;
        const float* xc = (l == 0) ? p.in[2] : XC;
        const int Mfull = last ? NLAT : NROW;
        phase_norm(xl, xc, p.in[6] + l * D, ada_l, 0, NROW, H);
        grid.sync();
        { pg8::StaticOrder S; S.init(NROW, PW, G, bid);
          pg8::EpiBf16 E{BIG, PW, 0, 0};
          pg8::gemm_phase(lds, pg8::Gemm{H, (const bf16_t*)(p.ws + WS_WIN) + (size_t)l * PW * D, NROW, PW, D}, S, E); }
        grid.sync();
        for (int it = bid; it < 32 * NCH; it += G) prep_item(p, l, it, lds);
        grid.sync();
        phase_mixer(p, l, lds);
        grid.sync();
        phase_combine(p, l, Mfull);
        grid.sync();
        { pg8::StaticOrder S; S.init(Mfull, D, G, bid);
          pg8::EpiRes E{xl, p.out, xc, XC, ada_l + 2 * 1024};
          pg8::gemm_phase(lds, pg8::Gemm{H, (const bf16_t*)(p.ws + WS_WOUT) + (size_t)l * D * D, Mfull, D, D}, S, E); }
        grid.sync();
        phase_norm(p.out, XC, p.in[7] + l * D, ada_l, 3, Mfull, H);
        grid.sync();
        { pg8::StaticOrder S; S.init(Mfull, UPW, G, bid);
          pg8::EpiBf16 E{BIG, FF, FF, (size_t)NROW * FF};
          pg8::gemm_phase(lds, pg8::Gemm{H, (const bf16_t*)(p.ws + WS_WUP) + (size_t)l * UPW * D, Mfull, UPW, D}, S, E); }
        grid.sync();
        phase_conv(p, l, Mfull);
        grid.sync();
        { pg8::StaticOrder S; S.init(Mfull, D, G, bid);
          pg8::EpiRes E{p.out, p.out, XC, XC, ada_l + 5 * 1024};
          pg8::gemm_phase(lds, pg8::Gemm{BIG, (const bf16_t*)(p.ws + WS_WDOWN) + (size_t)l * D * FF, Mfull, D, FF}, S, E); }
        grid.sync();
    }
    phase_final(p.out, p.in[21]);
}

extern "C" void kernel_launch(void* const* d_in, const int* in_sizes, int n_in, void* d_out, int out_size, void* d_ws, size_t ws_size, hipStream_t stream) {
    constexpr int LDS_BYTES = 131072;
    static int grid_blocks = 0;
    if (!grid_blocks) {
        int dev = 0, cus = 0, per_cu = 0;
        (void)hipGetDevice(&dev);
        (void)hipDeviceGetAttribute(&cus, hipDeviceAttributeMultiprocessorCount, dev);
        (void)hipFuncSetAttribute((const void*)fwd_megakernel, hipFuncAttributeMaxDynamicSharedMemorySize, LDS_BYTES);
        (void)hipOccupancyMaxActiveBlocksPerMultiprocessor(&per_cu, (const void*)fwd_megakernel, 512, LDS_BYTES);
        if (per_cu < 1) per_cu = 1;
        grid_blocks = cus * per_cu;
        if (ws_size < WS_END) fprintf(stderr, "workspace too small: %zu < %zu\n", ws_size, (size_t)WS_END);
    }
    Params p{};
    for (int i = 0; i < 22; ++i) p.in[i] = (const float*)d_in[i];
    p.out = (float*)d_out; p.ws = (unsigned char*)d_ws;
    void* args[] = {&p};
    hipError_t e = hipLaunchCooperativeKernel((const void*)fwd_megakernel, dim3(grid_blocks), dim3(512), args, LDS_BYTES, stream);
    if (e != hipSuccess) fprintf(stderr, "cooperative launch failed: %s (grid %d)\n", hipGetErrorString(e), grid_blocks);
}
```

```cpp
#include <hip/hip_runtime.h>
#include <hip/hip_cooperative_groups.h>
#include <cstdio>
namespace cg = cooperative_groups;

#define LAS __attribute__((address_space(3)))
typedef unsigned short bf16_t;
typedef short bf16x8 __attribute__((ext_vector_type(8)));
typedef float f32x4 __attribute__((ext_vector_type(4)));
typedef float f32x2 __attribute__((ext_vector_type(2)));
typedef unsigned u32x4 __attribute__((ext_vector_type(4)));
typedef unsigned u32x2 __attribute__((ext_vector_type(2)));
typedef __bf16 bf2_t __attribute__((ext_vector_type(2)));

constexpr int D = 1024, NB = 8, SEQ = 4096, DEPTH = 2, CTXL = 256;
constexpr int NLAT = NB * SEQ;
constexpr int NCTX = NB * CTXL;
constexpr int NROW = NLAT + NCTX;
constexpr int PW = 3584, FF = 2816, UPW = 2 * FF;
constexpr float EPS = 1e-6f;

constexpr size_t WS_WIN = 0;
constexpr size_t WS_WOUT = WS_WIN + (size_t)DEPTH * PW * D * 2;
constexpr size_t WS_WUP = WS_WOUT + (size_t)DEPTH * D * D * 2;
constexpr size_t WS_WDOWN = WS_WUP + (size_t)DEPTH * UPW * D * 2;
constexpr size_t WS_WSP = WS_WDOWN + (size_t)DEPTH * D * FF * 2;
constexpr size_t WS_ADA = WS_WSP + (size_t)DEPTH * 4 * 128 * 128 * 2;
constexpr size_t WS_LB = WS_ADA + (size_t)DEPTH * 9 * 6144 * 4;
constexpr size_t WS_XC = WS_LB + 2 * 512 * 4;
constexpr size_t WS_H = WS_XC + (size_t)NCTX * D * 4;
constexpr size_t WS_BIG = WS_H + (size_t)NROW * D * 2;
constexpr size_t WS_OFB = WS_BIG + (size_t)NROW * PW * 2;
constexpr size_t WS_QB = WS_OFB + 2 * (size_t)NROW * 512 * 2;
constexpr size_t WS_DS = WS_BIG + (size_t)NROW * UPW * 2;
constexpr size_t WS_BAR = WS_DS + (size_t)64 * 136 * 128 * 4;
constexpr size_t WS_END = WS_BAR + 16384;

struct Params {
    const float* in[22];
    float* out;
    unsigned char* ws;
};

__device__ __forceinline__ unsigned pk_bf16(float a, float b) { f32x2 v = {a, b}; bf2_t r = __builtin_convertvector(v, bf2_t); return __builtin_bit_cast(unsigned, r); }
__device__ __forceinline__ float bf_lo(unsigned u) { return __uint_as_float(u << 16); }
__device__ __forceinline__ float bf_hi(unsigned u) { return __uint_as_float(u & 0xffff0000u); }
__device__ __forceinline__ float bf1(bf16_t u) { return __uint_as_float(((unsigned)u) << 16); }
__device__ __forceinline__ bf16_t to_bf1(float a) { return (bf16_t)(pk_bf16(a, 0.f) & 0xffffu); }
__device__ __forceinline__ float fast_rcp(float x) { return __builtin_amdgcn_rcpf(x); }
__device__ __forceinline__ float gelu_f(float v) {
    const float av = fabsf(v), t = fast_rcp(av * 0.2316418882f + 1.0f);
    float q = t * 0.5307027145f + (-0.7265760135f); q = q * t + 0.7107068705f; q = q * t + (-0.142248368f); q = q * t + 0.127414796f; q = q * t;
    const float e = __builtin_amdgcn_exp2f((v * v) * (-0.72134752044f));
    const float m = v * (q * e);
    return v < 0.f ? m : v - m;
}
__device__ __forceinline__ int opaque_tid() { int t = threadIdx.x; asm volatile("" : "+v"(t)); return t; }
__device__ __forceinline__ float silu_f(float x) { return x * fast_rcp(1.0f + __expf(-x)); }

namespace pg8 {
constexpr int BM = 256, BK = 64, HALF = 128, HTB = HALF * BK * 2, STAGE_BYTES = 8 * HTB, NXCD = 8, WGM = 8;
__host__ __device__ __forceinline__ int lds_byte(int r, int c) { const int st = (r >> 4) * 2 + (c >> 5), rr = r & 15, cc = c & 31, ob = rr * 64 + cc * 2; return st * 1024 + (ob ^ (((ob >> 9) & 1) << 5)); }
__host__ __device__ __forceinline__ void stage_rc(int b, int& R, int& C) { const int st = b / 1024, sb = b % 1024, swz = sb ^ (((sb >> 9) & 1) << 5); R = (st >> 1) * 16 + swz / 64; C = (st & 1) * 32 + (swz % 64) / 2; }
__host__ __device__ __forceinline__ int perm32(int rho) { const int n = rho >> 4, i = rho & 15; return 8 * (i >> 2) + 4 * n + (i & 3); }
struct Unit { int pm, pn; };
struct Gemm { const bf16_t* A; const bf16_t* Bt; int M, N, K; };
struct StaticOrder {
    int nM, nN, nwg, G, c;
    __device__ void init(int M, int N, int G_, int c_) { nM = M / BM; nN = N / BM; nwg = nM * nN; G = G_; c = c_; }
    __device__ bool next(int i, Unit& u) const {
        const long L = (long)i * G + c; if (L >= nwg) return false;
        int wgid = (int)L; { const int q = nwg / NXCD, r = nwg % NXCD, xcd = wgid % NXCD, off = wgid / NXCD; wgid = (xcd < r ? xcd * (q + 1) : r * (q + 1) + (xcd - r) * q) + off; }
        const int nig = WGM * nN, gid = wgid / nig, fm = gid * WGM, gsz = (nM - fm) < WGM ? (nM - fm) : WGM;
        u.pm = fm + ((wgid % nig) % gsz); u.pn = (wgid % nig) / gsz; return true;
    }
    __device__ __forceinline__ void a_ready(const Unit&) const {}
    __device__ __forceinline__ void done(const Unit&) const {}
};
struct EpiBf16 {
    static constexpr bool PERM = true;
    bf16_t* O; int ldc; int split_cols; size_t split_stride;
    __device__ __forceinline__ void operator()(const f32x4 (&acc)[2][2][4][2], const Unit& u, int wr, int wc, int fr, int fq) const {
        const int row0 = u.pm * BM + wr * 64 + fr; int colt = u.pn * BM; bf16_t* base = O;
        if (split_cols) { const int t = colt / split_cols; base += (size_t)t * split_stride; colt -= t * split_cols; }
        const int col0 = colt + wc * 32 + 8 * fq;
#pragma unroll
        for (int ai = 0; ai < 2; ++ai)
#pragma unroll
            for (int m = 0; m < 4; ++m) { bf16_t* rowp = base + (size_t)(row0 + ai * HALF + m * 16) * ldc + col0;
#pragma unroll
                for (int bj = 0; bj < 2; ++bj) { const f32x4 v0 = acc[ai][bj][m][0], v1 = acc[ai][bj][m][1];
                    u32x4 w; w.x = pk_bf16(v0[0], v0[1]); w.y = pk_bf16(v0[2], v0[3]); w.z = pk_bf16(v1[0], v1[1]); w.w = pk_bf16(v1[2], v1[3]);
                    *(u32x4*)(rowp + bj * HALF) = w; } }
    }
};
struct EpiRes {
    static constexpr bool PERM = false;
    const float* resL; float* outL; const float* resC; float* outC; const float* gate;
    __device__ __forceinline__ void operator()(const f32x4 (&acc)[2][2][4][2], const Unit& u, int wr, int wc, int fr, int fq) const {
        const float* res; float* out; const float* g; int rowb;
        if (u.pm < NLAT / BM) { res = resL; out = outL; g = gate + (size_t)(u.pm >> 4) * 6144; rowb = u.pm * BM; }
        else { res = resC; out = outC; g = gate + (size_t)8 * 6144; rowb = u.pm * BM - NLAT; }
        const int row0 = rowb + wr * 64 + fr, col0 = u.pn * BM + wc * 32 + 4 * fq;
        f32x4 gv[2][2];
#pragma unroll
        for (int bj = 0; bj < 2; ++bj)
#pragma unroll
            for (int n = 0; n < 2; ++n) gv[bj][n] = *(const f32x4*)(g + col0 + bj * HALF + n * 16);
#pragma unroll
        for (int ai = 0; ai < 2; ++ai)
#pragma unroll
            for (int m = 0; m < 4; ++m) { const size_t ro = (size_t)(row0 + ai * HALF + m * 16) * D + col0;
#pragma unroll
                for (int bj = 0; bj < 2; ++bj)
#pragma unroll
                    for (int n = 0; n < 2; ++n) { const f32x4 r = *(const f32x4*)(res + ro + bj * HALF + n * 16);
                        *(f32x4*)(out + ro + bj * HALF + n * 16) = r + gv[bj][n] * acc[ai][bj][m][n]; } }
    }
};

template <class Epi, class Sched>
__device__ __forceinline__ void gemm_phase(LAS unsigned char* lds, const Gemm g, const Sched& S, const Epi& E) {
    const int tid = opaque_tid(), wid = __builtin_amdgcn_readfirstlane(tid >> 6), lane = tid & 63, wr = wid >> 2, wc = wid & 3, fr = lane & 15, fq = lane >> 4;
    const int K = g.K, nt = K / BK;
    unsigned voffA[2], voffB[2];
#pragma unroll
    for (int i = 0; i < 2; ++i) { int R, C; stage_rc(tid * 16 + i * 8192, R, C); const int Rb = Epi::PERM ? ((R & ~31) + perm32(R & 31)) : R;
        voffA[i] = (unsigned)(R * K + C) * 2u; voffB[i] = (unsigned)(Rb * K + C) * 2u; }
    const size_t kstep = (size_t)(BK * 2);
    const size_t hstep = (size_t)HALF * K * 2;
    const size_t tstep = 2 * hstep;
    const unsigned ldsw = (unsigned)wid * 1024u;
    const int aoff = lds_byte(wr * 64 + fr, fq * 8), boff = lds_byte(wc * 32 + fr, fq * 8);
#define PG8_SA(b, h) (((b) * 2 + (h)) * HTB)
#define PG8_SB(b, h) ((4 + (b) * 2 + (h)) * HTB)
#define PG8_STAGE(bufoff, gbase, voff) do { _Pragma("unroll") for (int _i = 0; _i < 2; ++_i) \
        __builtin_amdgcn_global_load_lds((const unsigned*)((const char*)(gbase) + (voff)[_i]), (LAS unsigned*)(lds + (bufoff) + ldsw + _i * 8192), 16, 0, 0); } while (0)
#define PG8_LDA(dst, b, h) do { _Pragma("unroll") for (int m = 0; m < 4; ++m) _Pragma("unroll") for (int k = 0; k < 2; ++k) dst[m][k] = *(const LAS bf16x8*)(lds + PG8_SA(b, h) + aoff + m * 2048 + k * 1024); } while (0)
#define PG8_LDB(dst, b, h) do { _Pragma("unroll") for (int n = 0; n < 2; ++n) _Pragma("unroll") for (int k = 0; k < 2; ++k) dst[n][k] = *(const LAS bf16x8*)(lds + PG8_SB(b, h) + boff + n * 2048 + k * 1024); } while (0)
#define PG8_MMA(ai, bj, At, Bt) do { __builtin_amdgcn_s_setprio(1); _Pragma("unroll") for (int m = 0; m < 4; ++m) _Pragma("unroll") for (int n = 0; n < 2; ++n) _Pragma("unroll") for (int k = 0; k < 2; ++k) \
        acc[ai][bj][m][n] = __builtin_amdgcn_mfma_f32_16x16x32_bf16(Bt[n][k], At[m][k], acc[ai][bj][m][n], 0, 0, 0); __builtin_amdgcn_s_setprio(0); } while (0)
#define PG8_WAIT_V(n) asm volatile("s_waitcnt vmcnt(" #n ")" ::: "memory")
#define PG8_WAIT_L(n) asm volatile("s_waitcnt lgkmcnt(" #n ")" ::: "memory")
#define PG8_BAR __builtin_amdgcn_s_barrier()
#define PG8_SCHED __builtin_amdgcn_sched_barrier(0)
    Unit cur, nxt; int ui = 0;
    if (!S.next(0, cur)) return;
    f32x4 acc[2][2][4][2];
#pragma unroll
    for (int a = 0; a < 2; ++a)
#pragma unroll
        for (int b = 0; b < 2; ++b)
#pragma unroll
            for (int m = 0; m < 4; ++m)
#pragma unroll
                for (int n = 0; n < 2; ++n) acc[a][b][m][n] = (f32x4){0.f, 0.f, 0.f, 0.f};
    bf16x8 At[4][2], B0[2][2], B1[2][2];
    const char* cA = (const char*)g.A + (size_t)cur.pm * tstep; const char* cB = (const char*)g.Bt + (size_t)cur.pn * tstep;
    S.a_ready(cur);
    PG8_STAGE(PG8_SB(0, 0), cB, voffB); PG8_STAGE(PG8_SA(0, 0), cA, voffA); PG8_STAGE(PG8_SB(0, 1), cB + hstep, voffB); PG8_STAGE(PG8_SA(0, 1), cA + hstep, voffA);
    if (wr == 1) PG8_BAR;
    PG8_WAIT_V(4); PG8_BAR;
    PG8_STAGE(PG8_SB(1, 0), cB + kstep, voffB); PG8_STAGE(PG8_SA(1, 0), cA + kstep, voffA); PG8_STAGE(PG8_SB(1, 1), cB + hstep + kstep, voffB);
    PG8_WAIT_V(6); PG8_BAR;
    for (;;) {
        const bool has_next = S.next(ui + 1, nxt);
        const char* nA = has_next ? (const char*)g.A + (size_t)nxt.pm * tstep : cA; const char* nB = has_next ? (const char*)g.Bt + (size_t)nxt.pn * tstep : cB;
        for (int t = 0; t < nt; t += 2) {
            const bool last = (t == nt - 2);
            const char* a1 = cA + (size_t)(t + 1) * kstep;
            const char* a2 = last ? nA : cA + (size_t)(t + 2) * kstep; const char* b2 = last ? nB : cB + (size_t)(t + 2) * kstep;
            const char* a3 = a2 + kstep; const char* b3 = b2 + kstep;
            if (last && has_next) S.a_ready(nxt);
            PG8_LDB(B0, 0, 0); PG8_SCHED; PG8_LDA(At, 0, 0); PG8_STAGE(PG8_SA(1, 1), a1 + hstep, voffA);
            PG8_WAIT_L(8); PG8_BAR; PG8_WAIT_L(0); PG8_MMA(0, 0, At, B0); PG8_BAR; PG8_SCHED;
            PG8_LDB(B1, 0, 1); PG8_STAGE(PG8_SB(0, 0), b2, voffB);
            PG8_BAR; PG8_WAIT_L(0); PG8_MMA(0, 1, At, B1); PG8_BAR;
            PG8_LDA(At, 0, 1); PG8_STAGE(PG8_SA(0, 0), a2, voffA);
            PG8_BAR; PG8_WAIT_L(0); PG8_MMA(1, 0, At, B0); PG8_BAR; PG8_SCHED;
            PG8_STAGE(PG8_SB(0, 1), b2 + hstep, voffB);
            PG8_WAIT_V(6); PG8_BAR; PG8_MMA(1, 1, At, B1); PG8_BAR;
            PG8_LDB(B0, 1, 0); PG8_SCHED; PG8_LDA(At, 1, 0); PG8_STAGE(PG8_SA(0, 1), a2 + hstep, voffA);
            PG8_WAIT_L(8); PG8_BAR; PG8_WAIT_L(0); PG8_MMA(0, 0, At, B0); PG8_BAR; PG8_SCHED;
            PG8_LDB(B1, 1, 1); PG8_STAGE(PG8_SB(1, 0), b3, voffB);
            PG8_BAR; PG8_WAIT_L(0); PG8_MMA(0, 1, At, B1); PG8_BAR;
            PG8_LDA(At, 1, 1); PG8_STAGE(PG8_SA(1, 0), a3, voffA);
            PG8_BAR; PG8_WAIT_L(0); PG8_MMA(1, 0, At, B0); PG8_BAR; PG8_SCHED;
            PG8_STAGE(PG8_SB(1, 1), b3 + hstep, voffB);
            PG8_WAIT_V(6); PG8_BAR; PG8_MMA(1, 1, At, B1); PG8_BAR;
        }
        E(acc, cur, wr, wc, fr, fq); S.done(cur);
        if (!has_next) break;
#pragma unroll
        for (int a = 0; a < 2; ++a)
#pragma unroll
            for (int b = 0; b < 2; ++b)
#pragma unroll
                for (int m = 0; m < 4; ++m)
#pragma unroll
                    for (int n = 0; n < 2; ++n) acc[a][b][m][n] = (f32x4){0.f, 0.f, 0.f, 0.f};
        cur = nxt; cA = nA; cB = nB; ++ui;
    }
    PG8_WAIT_V(0);
    if (wr == 0) PG8_BAR;
    PG8_BAR;
#undef PG8_SA
#undef PG8_SB
#undef PG8_STAGE
#undef PG8_LDA
#undef PG8_LDB
#undef PG8_MMA
#undef PG8_WAIT_V
#undef PG8_WAIT_L
#undef PG8_BAR
#undef PG8_SCHED
}
}

__device__ void phase_prep(const Params& p, LAS unsigned char* lds) {
    const int tid = opaque_tid();
    constexpr int NT_L = 896 + 256 + 1408 + 704;
    constexpr int J_ADA = 192, J_TR = J_ADA + 2 * NT_L, J_WSP = J_TR + 32, J_LB = J_WSP + 1;
    for (int job = blockIdx.x; job < J_LB; job += gridDim.x) {
        if (job < J_ADA) {
            LAS float* s = (LAS float*)lds;
            LAS float* red = (LAS float*)(lds + 9 * 1024 * 4);
            for (int i = tid; i < 9 * 1024; i += 512) { const int r = i >> 10, d = i & 1023; const float v = r < 8 ? p.in[1][r * 1024 + d] : p.in[3][d]; s[i] = silu_f(v); }
            __syncthreads();
            const int l = job / 96, e0 = (job % 96) * 64, col = tid & 63, dg = tid >> 6;
            const float* w = p.in[4] + ((size_t)l * 1024 + dg * 128) * 6144 + e0 + col;
            float acc[9];
#pragma unroll
            for (int r = 0; r < 9; ++r) acc[r] = 0.f;
            for (int dd = 0; dd < 128; ++dd) { const float wv = w[(size_t)dd * 6144];
#pragma unroll
                for (int r = 0; r < 9; ++r) acc[r] += s[r * 1024 + dg * 128 + dd] * wv; }
#pragma unroll
            for (int r = 0; r < 9; ++r) red[(dg * 9 + r) * 64 + col] = acc[r];
            __syncthreads();
            for (int i = tid; i < 9 * 64; i += 512) { const int r = i >> 6, c = i & 63; float a = 0.f;
#pragma unroll
                for (int g = 0; g < 8; ++g) a += red[(g * 9 + r) * 64 + c];
                ((float*)(p.ws + WS_ADA))[((size_t)l * 9 + r) * 6144 + e0 + c] = a + p.in[5][l * 6144 + e0 + c]; }
            __syncthreads();
        } else if (job < J_TR) {
            const int j = job - J_ADA, l = j / NT_L; int r = j % NT_L;
            const float* src; bf16_t* dst; int K, N;
            if (r < 896) { src = p.in[8] + (size_t)l * D * PW; dst = (bf16_t*)(p.ws + WS_WIN) + (size_t)l * PW * D; K = D; N = PW; }
            else if (r < 1152) { r -= 896; src = p.in[16] + (size_t)l * D * D; dst = (bf16_t*)(p.ws + WS_WOUT) + (size_t)l * D * D; K = D; N = D; }
            else if (r < 2560) { r -= 1152; src = p.in[17] + (size_t)l * D * UPW; dst = (bf16_t*)(p.ws + WS_WUP) + (size_t)l * UPW * D; K = D; N = UPW; }
            else { r -= 2560; src = p.in[20] + (size_t)l * FF * D; dst = (bf16_t*)(p.ws + WS_WDOWN) + (size_t)l * D * FF; K = FF; N = D; }
            const int ntn = N >> 6, kt = r / ntn, nt = r % ntn;
            LAS float* tile = (LAS float*)lds;
            { const int kk = tid >> 3, n8 = (tid & 7) * 8; const float* sp = src + (size_t)(kt * 64 + kk) * N + nt * 64 + n8;
              const f32x4 a = *(const f32x4*)sp, b = *(const f32x4*)(sp + 4);
              LAS float* tp = tile + kk * 65 + n8; tp[0] = a[0]; tp[1] = a[1]; tp[2] = a[2]; tp[3] = a[3]; tp[4] = b[0]; tp[5] = b[1]; tp[6] = b[2]; tp[7] = b[3]; }
            __syncthreads();
            { const int nn = tid >> 3, k8 = (tid & 7) * 8; float v[8];
#pragma unroll
              for (int i = 0; i < 8; ++i) v[i] = tile[(k8 + i) * 65 + nn];
              u32x4 w; w.x = pk_bf16(v[0], v[1]); w.y = pk_bf16(v[2], v[3]); w.z = pk_bf16(v[4], v[5]); w.w = pk_bf16(v[6], v[7]);
              *(u32x4*)(dst + (size_t)(nt * 64 + nn) * K + kt * 64 + k8) = w; }
            __syncthreads();
        } else if (job < J_WSP) {
            const int j = job - J_TR; const size_t i0 = (size_t)j * 4096 + tid * 8;
            const f32x4 a = *(const f32x4*)(p.in[14] + i0), b = *(const f32x4*)(p.in[14] + i0 + 4);
            u32x4 w; w.x = pk_bf16(a[0], a[1]); w.y = pk_bf16(a[2], a[3]); w.z = pk_bf16(b[0], b[1]); w.w = pk_bf16(b[2], b[3]);
            *(u32x4*)((bf16_t*)(p.ws + WS_WSP) + i0) = w;
        } else {
            for (int i = tid; i < 1024; i += 512) { const int dir = i >> 9, c = i & 511; const float* lg = dir ? p.in[10] : p.in[9];
                const float l0 = lg[c], l1 = lg[512 + c]; ((float*)(p.ws + WS_LB))[i] = 1.0f / (1.0f + expf(l0 - l1)); }
        }
    }
}

__device__ void phase_norm(const float* xl, const float* xc, const float* gain, const float* ada_l, int shift_idx, int nrows, bf16_t* H) {
    const int tid_ = opaque_tid(); const int wave = tid_ >> 6, lane = tid_ & 63;
    for (int row = (blockIdx.x * 8 + wave) * 2; row < nrows; row += gridDim.x * 16) {
        const float* src[2]; const float* mod[2];
#pragma unroll
        for (int u = 0; u < 2; ++u) { const int r = row + u;
            if (r < NLAT) { src[u] = xl + (size_t)r * D; mod[u] = ada_l + (size_t)(r >> 12) * 6144; } else { src[u] = xc + (size_t)(r - NLAT) * D; mod[u] = ada_l + (size_t)8 * 6144; } }
        f32x4 v[2][4];
#pragma unroll
        for (int u = 0; u < 2; ++u)
#pragma unroll
            for (int j = 0; j < 4; ++j) v[u][j] = *(const f32x4*)(src[u] + j * 256 + lane * 4);
#pragma unroll
        for (int u = 0; u < 2; ++u) {
            float ss = 0.f;
#pragma unroll
            for (int j = 0; j < 4; ++j) ss += v[u][j][0] * v[u][j][0] + v[u][j][1] * v[u][j][1] + v[u][j][2] * v[u][j][2] + v[u][j][3] * v[u][j][3];
#pragma unroll
            for (int o = 32; o > 0; o >>= 1) ss += __shfl_xor(ss, o);
            const float rs = rsqrtf(ss * (1.0f / D) + EPS);
#pragma unroll
            for (int j = 0; j < 4; ++j) { const int d = j * 256 + lane * 4;
                const f32x4 g = *(const f32x4*)(gain + d), sh = *(const f32x4*)(mod[u] + shift_idx * 1024 + d), sc = *(const f32x4*)(mod[u] + (shift_idx + 1) * 1024 + d);
                f32x4 y = v[u][j] * rs * g; y = y * (sc + 1.0f) + sh;
                u32x2 wv; wv.x = pk_bf16(y[0], y[1]); wv.y = pk_bf16(y[2], y[3]);
                *(u32x2*)(H + (size_t)(row + u) * D + d) = wv; }
        }
    }
}
__device__ void phase_final(float* x, const float* gain) {
    const int tid_ = opaque_tid(); const int wave = tid_ >> 6, lane = tid_ & 63;
    for (int row = (blockIdx.x * 8 + wave) * 2; row < NLAT; row += gridDim.x * 16) {
        f32x4 v[2][4];
#pragma unroll
        for (int u = 0; u < 2; ++u)
#pragma unroll
            for (int j = 0; j < 4; ++j) v[u][j] = *(const f32x4*)(x + (size_t)(row + u) * D + j * 256 + lane * 4);
#pragma unroll
        for (int u = 0; u < 2; ++u) {
            float ss = 0.f;
#pragma unroll
            for (int j = 0; j < 4; ++j) ss += v[u][j][0] * v[u][j][0] + v[u][j][1] * v[u][j][1] + v[u][j][2] * v[u][j][2] + v[u][j][3] * v[u][j][3];
#pragma unroll
            for (int o = 32; o > 0; o >>= 1) ss += __shfl_xor(ss, o);
            const float rs = rsqrtf(ss * (1.0f / D) + EPS);
#pragma unroll
            for (int j = 0; j < 4; ++j) { const int d = j * 256 + lane * 4; const f32x4 g = *(const f32x4*)(gain + d); *(f32x4*)(x + (size_t)(row + u) * D + d) = v[u][j] * rs * g; }
        }
    }
}

constexpr int QS_ST = 136, KT_ST = 40;
constexpr int P1_QS = 0, P1_KH = P1_QS + 32 * QS_ST * 2, P1_VT = P1_KH + 32 * QS_ST * 2, P1_KT = P1_VT + 128 * KT_ST * 2, P1_AW = P1_KT + 128 * KT_ST * 2;
constexpr int NCH = 8 + 128;

template <int CTRL, int RMASK> __device__ __forceinline__ float dpp_mul(float x) {
    const int t = __builtin_amdgcn_update_dpp(0x3f800000, __builtin_bit_cast(int, x), CTRL, RMASK, 0xf, false);
    return x * __builtin_bit_cast(float, t);
}
__device__ __forceinline__ float cumprod32(float x) {
    x = dpp_mul<0x111, 0xf>(x); x = dpp_mul<0x112, 0xf>(x); x = dpp_mul<0x114, 0xf>(x); x = dpp_mul<0x118, 0xf>(x);
    x = dpp_mul<0x142, 0xa>(x);
    return x;
}

__device__ void prep_item(const Params& p, int l, int item, LAS unsigned char* lds) {
    const int tid = opaque_tid(), w = tid >> 6, lane = tid & 63;
    const int tau = lane & 31, kh = lane >> 5, k0 = 16 * w + 8 * kh, l15 = lane & 15, q4 = lane >> 4;
    const int ci = item % NCH, bh = item / NCH, h = bh & 3, b = bh >> 2;
    const int R0 = ci < 8 ? NLAT + b * 256 + 32 * ci : b * 4096 + 32 * (ci - 8);
    bf16_t* P = (bf16_t*)(p.ws + WS_BIG);
    const bool first = (l == 0);
    const bool want_out = first || ci >= 8;
    LAS bf16_t* Qs = (LAS bf16_t*)(lds + P1_QS); LAS bf16_t* Kh = (LAS bf16_t*)(lds + P1_KH);
    LAS bf16_t* Vt = (LAS bf16_t*)(lds + P1_VT); LAS bf16_t* Kt = (LAS bf16_t*)(lds + P1_KT);
    LAS bf16_t* Aw = (LAS bf16_t*)(lds + P1_AW) + w * 32 * KT_ST;
    for (int i = lane; i < 32 * KT_ST / 2; i += 64) ((LAS unsigned*)Aw)[i] = 0u;
    u32x4 rf0, rq0, rv0, rf1, rq1, rv1;
    { const bf16_t* rp = P + (size_t)(R0 + tau) * PW; rf0 = *(const u32x4*)(rp + h * 128 + k0); rq0 = *(const u32x4*)(rp + 1536 + h * 128 + k0); rv0 = *(const u32x4*)(rp + 1024 + h * 128 + k0); }
    { const bf16_t* rp = P + (size_t)(R0 + 31 - tau) * PW; rf1 = *(const u32x4*)(rp + 512 + h * 128 + k0); rq1 = *(const u32x4*)(rp + 1536 + h * 128 + k0); rv1 = *(const u32x4*)(rp + 1024 + h * 128 + k0); }
    asm volatile("s_waitcnt vmcnt(0)" ::: "memory");
    __syncthreads();
    auto one_dir = [&](const int dir, const u32x4& f, const u32x4& q, const u32x4& v) {
        const int tokl = dir ? 31 - tau : tau;
        const float* lbp = (const float*)(p.ws + WS_LB) + dir * 512 + h * 128 + k0;
        float E[8], kk[8];
#pragma unroll
        for (int j = 0; j < 8; ++j) {
            const unsigned fw = f[j >> 1]; const float x = (j & 1) ? bf_hi(fw) : bf_lo(fw);
            const float e = __expf(-fabsf(x)), r = fast_rcp(1.0f + e);
            const float sp = x >= 0.f ? r : e * r, sn = x >= 0.f ? e * r : r;
            if (first) { E[j] = sp; kk[j] = sn; }
            else { const float lb = lbp[j]; const float gate = lb + (1.0f - lb) * sp; E[j] = gate; kk[j] = 1.0f - gate; }
        }
        float qt[8], kh_[8], kt_[8];
#pragma unroll
        for (int j = 0; j < 8; ++j) {
            const float Ej = fmaxf(cumprod32(E[j]), 1e-35f);
            const float T0 = __builtin_bit_cast(float, __builtin_amdgcn_readlane(__builtin_bit_cast(int, Ej), 31)), T1 = __builtin_bit_cast(float, __builtin_amdgcn_readlane(__builtin_bit_cast(int, Ej), 63));
            const float T = kh ? T1 : T0;
            const unsigned qw = q[j >> 1]; const float qx = (j & 1) ? bf_hi(qw) : bf_lo(qw);
            qt[j] = silu_f(qx) * 0.08838834764831845f * Ej;
            kh_[j] = kk[j] * fast_rcp(Ej); kt_[j] = kh_[j] * T;
            if (tau == 31) ((float*)(p.ws + WS_DS))[((size_t)((b * 4 + h) * 2 + dir) * NCH + ci) * 128 + k0 + j] = T;
        }
        u32x4 wq, wk; wq.x = pk_bf16(qt[0], qt[1]); wq.y = pk_bf16(qt[2], qt[3]); wq.z = pk_bf16(qt[4], qt[5]); wq.w = pk_bf16(qt[6], qt[7]);
        wk.x = pk_bf16(kh_[0], kh_[1]); wk.y = pk_bf16(kh_[2], kh_[3]); wk.z = pk_bf16(kh_[4], kh_[5]); wk.w = pk_bf16(kh_[6], kh_[7]);
        *(LAS u32x4*)(Qs + tau * QS_ST + k0) = wq; *(LAS u32x4*)(Kh + tau * QS_ST + k0) = wk;
        if (dir == 0) *(u32x4*)(P + (size_t)(R0 + tokl) * PW + 1536 + h * 128 + k0) = wq;
        else *(u32x4*)((bf16_t*)(p.ws + WS_QB) + (size_t)(R0 + tokl) * 512 + h * 128 + k0) = wq;
#pragma unroll
        for (int j = 0; j < 8; ++j) { Kt[(k0 + j) * KT_ST + tokl] = to_bf1(kt_[j]); const unsigned vw = v[j >> 1]; Vt[(k0 + j) * KT_ST + tau] = (bf16_t)((j & 1) ? (vw >> 16) : (vw & 0xffffu)); }
        __syncthreads();
        if (want_out) {
            f32x4 a00 = (f32x4){0.f, 0.f, 0.f, 0.f}, a10 = a00, a11 = a00;
#pragma unroll
            for (int kb = 0; kb < 4; ++kb) {
                const bf16x8 qn0 = *(const LAS bf16x8*)(Qs + l15 * QS_ST + 32 * kb + 8 * q4), qn1 = *(const LAS bf16x8*)(Qs + (16 + l15) * QS_ST + 32 * kb + 8 * q4);
                const bf16x8 kh0 = *(const LAS bf16x8*)(Kh + l15 * QS_ST + 32 * kb + 8 * q4), kh1 = *(const LAS bf16x8*)(Kh + (16 + l15) * QS_ST + 32 * kb + 8 * q4);
                a00 = __builtin_amdgcn_mfma_f32_16x16x32_bf16(qn0, kh0, a00, 0, 0, 0);
                a10 = __builtin_amdgcn_mfma_f32_16x16x32_bf16(qn1, kh0, a10, 0, 0, 0);
                a11 = __builtin_amdgcn_mfma_f32_16x16x32_bf16(qn1, kh1, a11, 0, 0, 0);
            }
#pragma unroll
            for (int i = 0; i < 4; ++i) { const int t = 4 * q4 + i; const bool keep = l15 <= t;
                Aw[t * KT_ST + l15] = to_bf1(keep ? a00[i] : 0.f);
                Aw[(16 + t) * KT_ST + l15] = to_bf1(a10[i]);
                Aw[(16 + t) * KT_ST + 16 + l15] = to_bf1(keep ? a11[i] : 0.f); }
            asm volatile("s_waitcnt lgkmcnt(0)" ::: "memory");
            const bf16x8 vf = *(const LAS bf16x8*)(Vt + (16 * w + l15) * KT_ST + 8 * q4);
            bf16_t* OFB = (bf16_t*)(p.ws + WS_OFB) + (size_t)dir * NROW * 512;
#pragma unroll
            for (int mt = 0; mt < 2; ++mt) {
                const bf16x8 af = *(const LAS bf16x8*)(Aw + (16 * mt + l15) * KT_ST + 8 * q4);
                const f32x4 o = __builtin_amdgcn_mfma_f32_16x16x32_bf16(vf, af, (f32x4){0.f, 0.f, 0.f, 0.f}, 0, 0, 0);
                const int tl = 16 * mt + l15, tok = dir ? 31 - tl : tl;
                u32x2 wv; wv.x = pk_bf16(o[0], o[1]); wv.y = pk_bf16(o[2], o[3]);
                *(u32x2*)(OFB + (size_t)(R0 + tok) * 512 + h * 128 + 16 * w + 4 * q4) = wv;
            }
        }
        { const int k = tid >> 2, part = tid & 3;
          const u32x4 kv = *(const LAS u32x4*)(Kt + k * KT_ST + 8 * part);
          bf16_t* dst = P + (size_t)(R0 + (k >> 2)) * PW + h * 128 + (k & 3) * 32 + part * 8;
          *(u32x4*)(dst + dir * 512) = kv;
          if (dir == 0) { const u32x4 vv = *(const LAS u32x4*)(Vt + k * KT_ST + 8 * part); *(u32x4*)(dst + 1024) = vv; } }
        __syncthreads();
    };
    one_dir(0, rf0, rq0, rv0);
    one_dir(1, rf1, rq1, rv1);
}

constexpr int SC_QS = 0, SC_KT = SC_QS + 32 * QS_ST * 2, SC_VT = SC_KT + 128 * KT_ST * 2, SC_DS = SC_VT + 128 * KT_ST * 2, SC_BUF = SC_DS + 512;
struct RawSet { u32x4 q, k, v; f32x4 d; u32x2 o0, o1; };
__device__ void scan_chain(const Params& p, int l, int chain, LAS unsigned char* lds) {
    const int tid = opaque_tid(), w = tid >> 6, lane = tid & 63, l15 = lane & 15, q4 = lane >> 4;
    const int dir = chain & 1, h = (chain >> 1) & 3, b = chain >> 3;
    const bf16_t* P = (const bf16_t*)(p.ws + WS_BIG);
    bf16_t* OFB = (bf16_t*)(p.ws + WS_OFB) + (size_t)dir * NROW * 512;
    const float* DS = (const float*)(p.ws + WS_DS) + (size_t)chain * NCH * 128;
    const bool first = (l == 0);
    auto chunk_of = [&](int s) -> int { return dir ? (s < 8 ? 7 - s : 143 - s) : s; };
    auto row0_of = [&](int c) -> int { return c < 8 ? NLAT + b * 256 + 32 * c : b * 4096 + 32 * (c - 8); };
    const int qrow = tid >> 4, qseg = tid & 15, kk_ = tid >> 2, kpart = tid & 3;
    const bf16_t* qbase = dir ? (const bf16_t*)(p.ws + WS_QB) + h * 128 + qseg * 8 : P + 1536 + h * 128 + qseg * 8;
    const int qpitch = dir ? 512 : PW;
    const int dlane = tid & 31;
    auto load_raw = [&](int s, RawSet& r) {
        const int c = chunk_of(s), R0 = row0_of(c);
        r.q = *(const u32x4*)(qbase + (size_t)(R0 + qrow) * qpitch);
        const bf16_t* kp = P + (size_t)(R0 + (kk_ >> 2)) * PW + h * 128 + (kk_ & 3) * 32 + kpart * 8;
        r.k = *(const u32x4*)(kp + dir * 512); r.v = *(const u32x4*)(kp + 1024);
        r.d = *(const f32x4*)(DS + (size_t)c * 128 + dlane * 4);
        const bf16_t* op = OFB + (size_t)(R0 + l15) * 512 + h * 128 + 16 * w + 4 * q4;
        r.o0 = *(const u32x2*)op; r.o1 = *(const u32x2*)(op + 16 * 512);
    };
    auto stage = [&](int buf, const RawSet& r) {
        LAS unsigned char* base = lds + buf * SC_BUF;
        *(LAS u32x4*)((LAS bf16_t*)(base + SC_QS) + qrow * QS_ST + qseg * 8) = r.q;
        *(LAS u32x4*)((LAS bf16_t*)(base + SC_KT) + kk_ * KT_ST + kpart * 8) = r.k;
        *(LAS u32x4*)((LAS bf16_t*)(base + SC_VT) + kk_ * KT_ST + kpart * 8) = r.v;
        *(LAS f32x4*)((LAS float*)(base + SC_DS) + dlane * 4) = r.d;
    };
    f32x4 S[8];
#pragma unroll
    for (int j = 0; j < 8; ++j) S[j] = (f32x4){0.f, 0.f, 0.f, 0.f};
    auto compute = [&](int s, const u32x2 oi0, const u32x2 oi1) {
        LAS unsigned char* base = lds + (s & 1) * SC_BUF;
        LAS bf16_t* Qs = (LAS bf16_t*)(base + SC_QS); LAS bf16_t* Kt = (LAS bf16_t*)(base + SC_KT); LAS bf16_t* Vt = (LAS bf16_t*)(base + SC_VT); LAS float* dS = (LAS float*)(base + SC_DS);
        bf16x8 qf[4][2], kf[8]; f32x4 dv[8];
#pragma unroll
        for (int kb = 0; kb < 4; ++kb)
#pragma unroll
            for (int mt = 0; mt < 2; ++mt) {
                const LAS bf16_t* qp = Qs + (16 * mt + l15) * QS_ST + 32 * kb + 4 * q4;
                const u32x2 lo = *(const LAS u32x2*)qp, hi = *(const LAS u32x2*)(qp + 16);
                u32x4 av; av.x = lo.x; av.y = lo.y; av.z = hi.x; av.w = hi.y; qf[kb][mt] = __builtin_bit_cast(bf16x8, av);
            }
        const bf16x8 vf = *(const LAS bf16x8*)(Vt + (16 * w + l15) * KT_ST + 8 * q4);
#pragma unroll
        for (int j = 0; j < 8; ++j) { dv[j] = *(const LAS f32x4*)(dS + 16 * j + 4 * q4); kf[j] = *(const LAS bf16x8*)(Kt + (16 * j + l15) * KT_ST + 8 * q4); }
        __builtin_amdgcn_sched_barrier(0);
        f32x4 o[2]; o[0] = (f32x4){0.f, 0.f, 0.f, 0.f}; o[1] = o[0];
#pragma unroll
        for (int kb = 0; kb < 4; ++kb) {
            u32x4 sb; sb.x = pk_bf16(S[2 * kb][0], S[2 * kb][1]); sb.y = pk_bf16(S[2 * kb][2], S[2 * kb][3]); sb.z = pk_bf16(S[2 * kb + 1][0], S[2 * kb + 1][1]); sb.w = pk_bf16(S[2 * kb + 1][2], S[2 * kb + 1][3]);
            const bf16x8 sfr = __builtin_bit_cast(bf16x8, sb);
            o[0] = __builtin_amdgcn_mfma_f32_16x16x32_bf16(sfr, qf[kb][0], o[0], 0, 0, 0);
            o[1] = __builtin_amdgcn_mfma_f32_16x16x32_bf16(sfr, qf[kb][1], o[1], 0, 0, 0);
        }
#pragma unroll
        for (int j = 0; j < 8; ++j) S[j] = __builtin_amdgcn_mfma_f32_16x16x32_bf16(kf[j], vf, S[j] * dv[j], 0, 0, 0);
        const int c = chunk_of(s);
        bf16_t* op = OFB + (size_t)(row0_of(c) + l15) * 512 + h * 128 + 16 * w + 4 * q4;
        u32x2 w0, w1;
        w0.x = pk_bf16(o[0][0] + bf_lo(oi0.x), o[0][1] + bf_hi(oi0.x)); w0.y = pk_bf16(o[0][2] + bf_lo(oi0.y), o[0][3] + bf_hi(oi0.y));
        w1.x = pk_bf16(o[1][0] + bf_lo(oi1.x), o[1][1] + bf_hi(oi1.x)); w1.y = pk_bf16(o[1][2] + bf_lo(oi1.y), o[1][3] + bf_hi(oi1.y));
        *(u32x2*)op = w0; *(u32x2*)(op + 16 * 512) = w1;
    };
    RawSet r0, r1, r2, r3;
    load_raw(0, r0); load_raw(1, r1); load_raw(2, r2); load_raw(3, r3);
    stage(0, r0);
    __syncthreads();
#define SC_STEP(S_, CUR, NXT) do { const int s_ = (S_); const u32x2 oi0 = CUR.o0, oi1 = CUR.o1; \
        load_raw(s_ + 4 < NCH ? s_ + 4 : NCH - 1, CUR); \
        stage((s_ + 1) & 1, NXT); \
        compute(s_, oi0, oi1); __syncthreads(); } while (0)
    for (int s = 0; s < NCH; s += 4) {
        SC_STEP(s, r0, r1); SC_STEP(s + 1, r1, r2); SC_STEP(s + 2, r2, r3); SC_STEP(s + 3, r3, r0);
    }
#undef SC_STEP
}

constexpr int SG_ST = 136;
__device__ void sgu_tile(const Params& p, int l, int tile, LAS unsigned char* lds) {
    const int tid = opaque_tid(), w = tid >> 6, lane = tid & 63, l15 = lane & 15, q4 = lane >> 4;
    const int h = tile & 3, rowbase = (tile >> 2) * 128;
    const bf16_t* P = (const bf16_t*)(p.ws + WS_BIG);
    bf16_t* O = (bf16_t*)(p.ws + WS_H);
    LAS bf16_t* Vt = (LAS bf16_t*)lds;
    {
        const int q = tid >> 2, cgp = tid & 3;
        const bf16_t* vp = P + (size_t)(rowbase + q) * PW + 3072 + 128 * h + 32 * cgp;
        float g[32];
#pragma unroll
        for (int i = 0; i < 4; ++i) { const u32x4 r = *(const u32x4*)(vp + 8 * i);
#pragma unroll
            for (int j = 0; j < 4; ++j) { g[8 * i + 2 * j] = gelu_f(bf_lo(r[j])); g[8 * i + 2 * j + 1] = gelu_f(bf_hi(r[j])); } }
        float s = 0.f;
#pragma unroll
        for (int i = 0; i < 32; ++i) s += g[i];
        s += __shfl_xor(s, 1); s += __shfl_xor(s, 2);
        const float mu = s * (1.0f / 128.f);
        float vs = 0.f;
#pragma unroll
        for (int i = 0; i < 32; ++i) { const float d = g[i] - mu; vs += d * d; }
        vs += __shfl_xor(vs, 1); vs += __shfl_xor(vs, 2);
        const float rstd = rsqrtf(vs * (1.0f / 128.f) + EPS);
        const float* lng = p.in[12] + l * 512 + h * 128 + 32 * cgp; const float* lnb = p.in[13] + l * 512 + h * 128 + 32 * cgp;
#pragma unroll
        for (int i = 0; i < 32; ++i) { const float y = (g[i] - mu) * rstd * lng[i] + lnb[i]; Vt[(32 * cgp + i) * SG_ST + q] = to_bf1(y); }
    }
    __syncthreads();
    {
        const int prow = 16 * w + l15;
        const bf16_t* wsp = (const bf16_t*)(p.ws + WS_WSP) + ((size_t)(l * 4 + h) * 128 + prow) * 128 + 8 * q4;
        bf16x8 wf[4];
#pragma unroll
        for (int kb = 0; kb < 4; ++kb) wf[kb] = *(const bf16x8*)(wsp + 32 * kb);
        const float bs = p.in[15][(l * 4 + h) * 128 + prow];
        const bf16_t* up = P + (size_t)(rowbase + prow) * PW + 2560 + 128 * h + 4 * q4;
        bf16_t* op = O + (size_t)(rowbase + prow) * D + 512 + 128 * h + 4 * q4;
#pragma unroll
        for (int mt = 0; mt < 8; ++mt) {
            f32x4 acc = (f32x4){0.f, 0.f, 0.f, 0.f};
#pragma unroll
            for (int kb = 0; kb < 4; ++kb) { const bf16x8 af = *(const LAS bf16x8*)(Vt + (16 * mt + l15) * SG_ST + 32 * kb + 8 * q4);
                acc = __builtin_amdgcn_mfma_f32_16x16x32_bf16(af, wf[kb], acc, 0, 0, 0); }
            const u32x2 uu = *(const u32x2*)(up + 16 * mt);
            const float u0 = gelu_f(bf_lo(uu.x)), u1 = gelu_f(bf_hi(uu.x)), u2 = gelu_f(bf_lo(uu.y)), u3 = gelu_f(bf_hi(uu.y));
            u32x2 wv; wv.x = pk_bf16(u0 * (acc[0] + bs), u1 * (acc[1] + bs)); wv.y = pk_bf16(u2 * (acc[2] + bs), u3 * (acc[3] + bs));
            *(u32x2*)(op + 16 * mt) = wv;
        }
    }
    __syncthreads();
}

__device__ void phase_mixer(const Params& p, int l, LAS unsigned char* lds) {
    const int G = gridDim.x, bid = blockIdx.x;
    const int ntile = (l == 0) ? (NROW / 128) * 4 : (NLAT / 128) * 4;
    if (G > 64) {
        if (bid < 64) scan_chain(p, l, bid, lds);
        else for (int t = bid - 64; t < ntile; t += G - 64) sgu_tile(p, l, t, lds);
    } else {
        for (int c = bid; c < 64; c += G) { scan_chain(p, l, c, lds); __syncthreads(); }
        for (int t = bid; t < ntile; t += G) sgu_tile(p, l, t, lds);
    }
}

__device__ void phase_combine(const Params& p, int l, int nrows) {
    const int tid_ = opaque_tid(); const int wave = tid_ >> 6, lane = tid_ & 63, hd = lane >> 4, v0 = (lane & 15) * 8;
    const bf16_t* P = (const bf16_t*)(p.ws + WS_BIG);
    const bf16_t* OF = (const bf16_t*)(p.ws + WS_OFB); const bf16_t* OB = OF + (size_t)NROW * 512;
    bf16_t* O = (bf16_t*)(p.ws + WS_H);
    const float* gn = p.in[11] + l * 512 + hd * 128 + v0;
    const f32x4 g0 = *(const f32x4*)gn, g1 = *(const f32x4*)(gn + 4);
    for (int row = blockIdx.x * 8 + wave; row < nrows; row += gridDim.x * 8) {
        const u32x4 a = *(const u32x4*)(OF + (size_t)row * 512 + hd * 128 + v0), bq = *(const u32x4*)(OB + (size_t)row * 512 + hd * 128 + v0);
        const u32x4 gg = *(const u32x4*)(P + (size_t)row * PW + 2048 + hd * 128 + v0);
        float s[8]; float ss = 0.f;
#pragma unroll
        for (int j = 0; j < 4; ++j) { s[2 * j] = bf_lo(a[j]) + bf_lo(bq[j]); s[2 * j + 1] = bf_hi(a[j]) + bf_hi(bq[j]); ss += s[2 * j] * s[2 * j] + s[2 * j + 1] * s[2 * j + 1]; }
#pragma unroll
        for (int o = 8; o > 0; o >>= 1) ss += __shfl_xor(ss, o);
        const float rs = rsqrtf(ss * (1.0f / 128.f) + EPS);
        float y[8];
#pragma unroll
        for (int j = 0; j < 4; ++j) { y[2 * j] = s[2 * j] * rs * (j < 2 ? g0[2 * j] : g1[2 * j - 4]) * silu_f(bf_lo(gg[j])); y[2 * j + 1] = s[2 * j + 1] * rs * (j < 2 ? g0[2 * j + 1] : g1[2 * j - 3]) * silu_f(bf_hi(gg[j])); }
        u32x4 wv; wv.x = pk_bf16(y[0], y[1]); wv.y = pk_bf16(y[2], y[3]); wv.z = pk_bf16(y[4], y[5]); wv.w = pk_bf16(y[6], y[7]);
        *(u32x4*)(O + (size_t)row * D + hd * 128 + v0) = wv;
    }
}

__device__ void phase_conv(const Params& p, int l, int nrows) {
    bf16_t* Aup = (bf16_t*)(p.ws + WS_BIG); const bf16_t* Gup = Aup + (size_t)NROW * FF;
    const float* cw = p.in[18] + (size_t)l * 9 * FF; const float* cb = p.in[19] + (size_t)l * FF;
    const int tid_ = opaque_tid();
    const long total = (long)(nrows / 16) * 352;
    for (long id = (long)blockIdx.x * 512 + tid_; id < total; id += (long)gridDim.x * 512) {
        const int seg = (int)(id / 352), f0 = (int)(id % 352) * 8;
        const int tok0 = seg * 16;
        int c0, W; bool up, dn;
        if (tok0 < NLAT) { const int t = tok0 & 4095, r = t >> 6; c0 = t & 63; W = 64; up = r > 0; dn = r < 63; }
        else { c0 = (tok0 - NLAT) & 255; W = 256; up = false; dn = false; }
        float tp[9][8]; float bias[8];
#pragma unroll
        for (int k = 0; k < 9; ++k) { const f32x4 t0 = *(const f32x4*)(cw + k * FF + f0), t1 = *(const f32x4*)(cw + k * FF + f0 + 4);
            tp[k][0] = t0[0]; tp[k][1] = t0[1]; tp[k][2] = t0[2]; tp[k][3] = t0[3]; tp[k][4] = t1[0]; tp[k][5] = t1[1]; tp[k][6] = t1[2]; tp[k][7] = t1[3]; }
        { const f32x4 b0 = *(const f32x4*)(cb + f0), b1 = *(const f32x4*)(cb + f0 + 4); bias[0] = b0[0]; bias[1] = b0[1]; bias[2] = b0[2]; bias[3] = b0[3]; bias[4] = b1[0]; bias[5] = b1[1]; bias[6] = b1[2]; bias[7] = b1[3]; }
        const u32x4 zero = (u32x4){0u, 0u, 0u, 0u};
        const bf16_t* gp = Gup + (size_t)tok0 * FF + f0;
        u32x4 L[3], M[3], R[3];
        { const bool v = c0 > 0;
          L[0] = (v && up) ? *(const u32x4*)(gp - (size_t)65 * FF) : zero; L[1] = v ? *(const u32x4*)(gp - (size_t)FF) : zero; L[2] = (v && dn) ? *(const u32x4*)(gp + (size_t)63 * FF) : zero; }
        M[0] = up ? *(const u32x4*)(gp - (size_t)64 * FF) : zero; M[1] = *(const u32x4*)gp; M[2] = dn ? *(const u32x4*)(gp + (size_t)64 * FF) : zero;
#pragma unroll 4
        for (int i = 0; i < 16; ++i) {
            const bf16_t* np = gp + (size_t)(i + 1) * FF;
            const bool v = (c0 + i + 1) < W;
            R[0] = (v && up) ? *(const u32x4*)(np - (size_t)64 * FF) : zero; R[1] = v ? *(const u32x4*)np : zero; R[2] = (v && dn) ? *(const u32x4*)(np + (size_t)64 * FF) : zero;
            float acc[8];
#pragma unroll
            for (int j = 0; j < 8; ++j) acc[j] = bias[j];
#pragma unroll
            for (int rr = 0; rr < 3; ++rr) {
#pragma unroll
                for (int j = 0; j < 4; ++j) {
                    acc[2 * j] += bf_lo(L[rr][j]) * tp[rr * 3 + 0][2 * j] + bf_lo(M[rr][j]) * tp[rr * 3 + 1][2 * j] + bf_lo(R[rr][j]) * tp[rr * 3 + 2][2 * j];
                    acc[2 * j + 1] += bf_hi(L[rr][j]) * tp[rr * 3 + 0][2 * j + 1] + bf_hi(M[rr][j]) * tp[rr * 3 + 1][2 * j + 1] + bf_hi(R[rr][j]) * tp[rr * 3 + 2][2 * j + 1];
                }
            }
            bf16_t* ap = Aup + (size_t)(tok0 + i) * FF + f0;
            const u32x4 av = *(const u32x4*)ap;
            u32x4 wv;
#pragma unroll
            for (int j = 0; j < 4; ++j) wv[j] = pk_bf16(bf_lo(av[j]) * gelu_f(acc[2 * j]), bf_hi(av[j]) * gelu_f(acc[2 * j + 1]));
            *(u32x4*)ap = wv;
#pragma unroll
            for (int rr = 0; rr < 3; ++rr) { L[rr] = M[rr]; M[rr] = R[rr]; }
        }
    }
}

#define XB_TMO      128
#define XB_XCNT(j)  (256  + 64 * (j))
#define XB_XSUB(j)  (1280 + 64 * (j))
#define XB_XGEN(j)  (2304 + 64 * (j))
#define XB_TOP      3328
#define XB_TOPGEN   3392
#define XCD_BAR_WORDS 3456
#define XB_SPIN_CAP (1u << 20)
__device__ __forceinline__ unsigned xb_ld(unsigned* p)              { return __hip_atomic_load(p, __ATOMIC_RELAXED, __HIP_MEMORY_SCOPE_AGENT); }
__device__ __forceinline__ unsigned xb_add(unsigned* p, unsigned v) { return __hip_atomic_fetch_add(p, v, __ATOMIC_RELAXED, __HIP_MEMORY_SCOPE_AGENT); }
__device__ __forceinline__ unsigned xb_xcc_id() { return (unsigned)__builtin_amdgcn_s_getreg((3 << 11) | 20) & 0xFu; }
#define XB_SPIN(cond, bar) do { unsigned _sp = 0; while (cond) { __builtin_amdgcn_s_sleep(1); \
    if ((++_sp & 255u) == 0u) { if (xb_ld(&(bar)[XB_TMO])) break; if (_sp > XB_SPIN_CAP) { atomicAdd(&(bar)[XB_TMO], 1u); break; } } } } while (0)
struct XcdBarrier { unsigned* bar; unsigned x; volatile LAS unsigned* st; };
__device__ __forceinline__ XcdBarrier xcd_barrier_post(unsigned* bar, volatile LAS unsigned* st) {
    XcdBarrier b; b.bar = bar; b.x = xb_xcc_id(); b.st = st;
    if (threadIdx.x == 0) (void)xb_add(&bar[XB_XCNT(b.x)], 1u);
    return b;
}
__device__ __forceinline__ void xcd_barrier_complete(unsigned* bar, unsigned x, unsigned& nloc, unsigned& nx) {
    const unsigned G = gridDim.x * gridDim.y * gridDim.z;
    unsigned sum, cnt, mine, sp = 0u;
    for (;;) {
        sum = 0u; cnt = 0u; mine = 0u;
#pragma unroll
        for (unsigned j = 0; j < 16; ++j) { const unsigned c = xb_ld(&bar[XB_XCNT(j)]); sum += c; cnt += (c > 0u) ? 1u : 0u; mine = (j == x) ? c : mine; }
        if (sum == G) break;
        __builtin_amdgcn_s_sleep(1);
        if ((++sp & 255u) == 0u) { if (xb_ld(&bar[XB_TMO])) break; if (sp > XB_SPIN_CAP) { atomicAdd(&bar[XB_TMO], 1u); break; } }
    }
    nloc = mine > 0u ? mine : 1u; nx = cnt > 0u ? cnt : 1u;
}
__device__ __forceinline__ void xcd_barrier(const XcdBarrier& b) {
    asm volatile("s_waitcnt vmcnt(0)" ::: "memory");
    __syncthreads();
    if (threadIdx.x == 0) {
        unsigned* bar = b.bar;
        __builtin_amdgcn_s_waitcnt(0);
        unsigned nloc = b.st[0], nx = b.st[1];
        if (nloc == 0u) { xcd_barrier_complete(bar, b.x, nloc, nx); b.st[0] = nloc; b.st[1] = nx; }
        const unsigned old = xb_add(&bar[XB_XSUB(b.x)], 1u);
        const unsigned gen = old / nloc;
        if (old + 1u == (gen + 1u) * nloc) {
            __builtin_amdgcn_fence(__ATOMIC_RELEASE, "agent");
            asm volatile("s_waitcnt vmcnt(0)" ::: "memory");
            const unsigned og = xb_add(&bar[XB_TOP], 1u);
            const unsigned tg = og / nx;
            if (og + 1u == (tg + 1u) * nx) xb_add(&bar[XB_TOPGEN], 1u);
            else XB_SPIN(xb_ld(&bar[XB_TOPGEN]) == tg, bar);
            __builtin_amdgcn_fence(__ATOMIC_ACQUIRE, "agent");
            xb_add(&bar[XB_XGEN(b.x)], 1u);
            asm volatile("s_waitcnt vmcnt(0)" ::: "memory");
        } else {
            XB_SPIN(xb_ld(&bar[XB_XGEN(b.x)]) == gen, bar);
            __builtin_amdgcn_fence(__ATOMIC_ACQUIRE, "agent");
            asm volatile("s_waitcnt vmcnt(0)" ::: "memory");
        }
    }
    __syncthreads();
}

__global__ void __launch_bounds__(512, 2) fwd_megakernel(Params p) {
    extern __shared__ __attribute__((aligned(16))) unsigned char shm[];
    LAS unsigned char* lds = (LAS unsigned char*)shm;
    cg::grid_group grid = cg::this_grid();
    __shared__ uint4 xb_words;
    if (threadIdx.x == 0) xb_words = make_uint4(0u, 0u, 0u, 0u);
    __syncthreads();
    const XcdBarrier xb = xcd_barrier_post((unsigned*)(p.ws + WS_BAR), (volatile LAS unsigned*)&xb_words);
    const int G = gridDim.x, bid = blockIdx.x;
    float* XC = (float*)(p.ws + WS_XC);
    bf16_t* H = (bf16_t*)(p.ws + WS_H);
    bf16_t* BIG = (bf16_t*)(p.ws + WS_BIG);
    const float* ADA = (const float*)(p.ws + WS_ADA);

    phase_prep(p, lds);
    grid.sync();
    for (int l = 0; l < DEPTH; ++l) {
        const bool last = (l == DEPTH - 1);
        const float* ada_l = ADA + (size_t)l * 9 * 6144;
        const float* xl = (l == 0) ? p.in[0] : p.out;
        const float* xc = (l == 0) ? p.in[2] : XC;
        const int Mfull = last ? NLAT : NROW;
        phase_norm(xl, xc, p.in[6] + l * D, ada_l, 0, NROW, H);
        xcd_barrier(xb);
        { pg8::StaticOrder S; S.init(NROW, PW, G, bid);
          pg8::EpiBf16 E{BIG, PW, 0, 0};
          pg8::gemm_phase(lds, pg8::Gemm{H, (const bf16_t*)(p.ws + WS_WIN) + (size_t)l * PW * D, NROW, PW, D}, S, E); }
        xcd_barrier(xb);
        for (int it = bid; it < 32 * NCH; it += G) prep_item(p, l, it, lds);
        xcd_barrier(xb);
        phase_mixer(p, l, lds);
        xcd_barrier(xb);
        phase_combine(p, l, Mfull);
        xcd_barrier(xb);
        { pg8::StaticOrder S; S.init(Mfull, D, G, bid);
          pg8::EpiRes E{xl, p.out, xc, XC, ada_l + 2 * 1024};
          pg8::gemm_phase(lds, pg8::Gemm{H, (const bf16_t*)(p.ws + WS_WOUT) + (size_t)l * D * D, Mfull, D, D}, S, E); }
        xcd_barrier(xb);
        phase_norm(p.out, XC, p.in[7] + l * D, ada_l, 3, Mfull, H);
        xcd_barrier(xb);
        { pg8::StaticOrder S; S.init(Mfull, UPW, G, bid);
          pg8::EpiBf16 E{BIG, FF, FF, (size_t)NROW * FF};
          pg8::gemm_phase(lds, pg8::Gemm{H, (const bf16_t*)(p.ws + WS_WUP) + (size_t)l * UPW * D, Mfull, UPW, D}, S, E); }
        xcd_barrier(xb);
        phase_conv(p, l, Mfull);
        xcd_barrier(xb);
        { pg8::StaticOrder S; S.init(Mfull, D, G, bid);
          pg8::EpiRes E{p.out, p.out, XC, XC, ada_l + 5 * 1024};
          pg8::gemm_phase(lds, pg8::Gemm{BIG, (const bf16_t*)(p.ws + WS_WDOWN) + (size_t)l * D * FF, Mfull, D, FF}, S, E); }
        xcd_barrier(xb);
    }
    phase_final(p.out, p.in[21]);
}

extern "C" void kernel_launch(void* const* d_in, const int* in_sizes, int n_in, void* d_out, int out_size, void* d_ws, size_t ws_size, hipStream_t stream) {
    constexpr int LDS_BYTES = 131072;
    static int grid_blocks = 0;
    if (!grid_blocks) {
        int dev = 0, cus = 0, per_cu = 0;
        (void)hipGetDevice(&dev);
        (void)hipDeviceGetAttribute(&cus, hipDeviceAttributeMultiprocessorCount, dev);
        (void)hipFuncSetAttribute((const void*)fwd_megakernel, hipFuncAttributeMaxDynamicSharedMemorySize, LDS_BYTES);
        (void)hipOccupancyMaxActiveBlocksPerMultiprocessor(&per_cu, (const void*)fwd_megakernel, 512, LDS_BYTES);
        if (per_cu < 1) per_cu = 1;
        grid_blocks = cus * per_cu;
        if (ws_size < WS_END) fprintf(stderr, "workspace too small: %zu < %zu\n", ws_size, (size_t)WS_END);
    }
    Params p{};
    for (int i = 0; i < 22; ++i) p.in[i] = (const float*)d_in[i];
    p.out = (float*)d_out; p.ws = (unsigned char*)d_ws;
    (void)hipMemsetAsync((unsigned char*)d_ws + WS_BAR, 0, XCD_BAR_WORDS * 4, stream);
    void* args[] = {&p};
    hipError_t e = hipLaunchCooperativeKernel((const void*)fwd_megakernel, dim3(grid_blocks), dim3(512), args, LDS_BYTES, stream);
    if (e != hipSuccess) fprintf(stderr, "cooperative launch failed: %s (grid %d)\n", hipGetErrorString(e), grid_blocks);
}
```

```cpp
#include <hip/hip_runtime.h>
#include <hip/hip_cooperative_groups.h>
#include <cstdio>
namespace cg = cooperative_groups;

#define LAS __attribute__((address_space(3)))
typedef unsigned short bf16_t;
typedef short bf16x8 __attribute__((ext_vector_type(8)));
typedef float f32x4 __attribute__((ext_vector_type(4)));
typedef float f32x2 __attribute__((ext_vector_type(2)));
typedef unsigned u32x4 __attribute__((ext_vector_type(4)));
typedef unsigned u32x2 __attribute__((ext_vector_type(2)));
typedef __bf16 bf2_t __attribute__((ext_vector_type(2)));

constexpr int D = 1024, NB = 8, SEQ = 4096, DEPTH = 2, CTXL = 256;
constexpr int NLAT = NB * SEQ;
constexpr int NCTX = NB * CTXL;
constexpr int NROW = NLAT + NCTX;
constexpr int PW = 3584, FF = 2816, UPW = 2 * FF;
constexpr float EPS = 1e-6f;

constexpr size_t WS_WIN = 0;
constexpr size_t WS_WOUT = WS_WIN + (size_t)DEPTH * PW * D * 2;
constexpr size_t WS_WUP = WS_WOUT + (size_t)DEPTH * D * D * 2;
constexpr size_t WS_WDOWN = WS_WUP + (size_t)DEPTH * UPW * D * 2;
constexpr size_t WS_WSP = WS_WDOWN + (size_t)DEPTH * D * FF * 2;
constexpr size_t WS_ADA = WS_WSP + (size_t)DEPTH * 4 * 128 * 128 * 2;
constexpr size_t WS_LB = WS_ADA + (size_t)DEPTH * 9 * 6144 * 4;
constexpr size_t WS_XC = WS_LB + 2 * 512 * 4;
constexpr size_t WS_H = WS_XC + (size_t)NCTX * D * 4;
constexpr size_t WS_BIG = WS_H + (size_t)NROW * D * 2;
constexpr size_t WS_OFB = WS_BIG + (size_t)NROW * PW * 2;
constexpr size_t WS_QB = WS_OFB + 2 * (size_t)NROW * 512 * 2;
constexpr size_t WS_DS = WS_BIG + (size_t)NROW * UPW * 2;
constexpr size_t WS_BAR = WS_DS + (size_t)64 * 136 * 128 * 4;
constexpr size_t WS_END = WS_BAR + 16384;

struct Params {
    const float* in[22];
    float* out;
    unsigned char* ws;
};

__device__ __forceinline__ unsigned pk_bf16(float a, float b) { f32x2 v = {a, b}; bf2_t r = __builtin_convertvector(v, bf2_t); return __builtin_bit_cast(unsigned, r); }
__device__ __forceinline__ float bf_lo(unsigned u) { return __uint_as_float(u << 16); }
__device__ __forceinline__ float bf_hi(unsigned u) { return __uint_as_float(u & 0xffff0000u); }
__device__ __forceinline__ float bf1(bf16_t u) { return __uint_as_float(((unsigned)u) << 16); }
__device__ __forceinline__ bf16_t to_bf1(float a) { return (bf16_t)(pk_bf16(a, 0.f) & 0xffffu); }
__device__ __forceinline__ float fast_rcp(float x) { return __builtin_amdgcn_rcpf(x); }
__device__ __forceinline__ float gelu_f(float v) {
    const float av = fabsf(v), t = fast_rcp(av * 0.2316418882f + 1.0f);
    float q = t * 0.5307027145f + (-0.7265760135f); q = q * t + 0.7107068705f; q = q * t + (-0.142248368f); q = q * t + 0.127414796f; q = q * t;
    const float e = __builtin_amdgcn_exp2f((v * v) * (-0.72134752044f));
    const float m = v * (q * e);
    return v < 0.f ? m : v - m;
}
__device__ __forceinline__ int opaque_tid() { int t = threadIdx.x; asm volatile("" : "+v"(t)); return t; }
__device__ __forceinline__ float silu_f(float x) { return x * fast_rcp(1.0f + __expf(-x)); }

namespace pg8 {
constexpr int BM = 256, BK = 64, HALF = 128, HTB = HALF * BK * 2, STAGE_BYTES = 8 * HTB, NXCD = 8, WGM = 8;
__host__ __device__ __forceinline__ int lds_byte(int r, int c) { const int st = (r >> 4) * 2 + (c >> 5), rr = r & 15, cc = c & 31, ob = rr * 64 + cc * 2; return st * 1024 + (ob ^ (((ob >> 9) & 1) << 5)); }
__host__ __device__ __forceinline__ void stage_rc(int b, int& R, int& C) { const int st = b / 1024, sb = b % 1024, swz = sb ^ (((sb >> 9) & 1) << 5); R = (st >> 1) * 16 + swz / 64; C = (st & 1) * 32 + (swz % 64) / 2; }
__host__ __device__ __forceinline__ int perm32(int rho) { const int n = rho >> 4, i = rho & 15; return 8 * (i >> 2) + 4 * n + (i & 3); }
struct Unit { int pm, pn; };
struct Gemm { const bf16_t* A; const bf16_t* Bt; int M, N, K; };
struct StaticOrder {
    int nM, nN, nwg, G, c;
    __device__ void init(int M, int N, int G_, int c_) { nM = M / BM; nN = N / BM; nwg = nM * nN; G = G_; c = c_; }
    __device__ bool next(int i, Unit& u) const {
        const long L = (long)i * G + c; if (L >= nwg) return false;
        int wgid = (int)L; { const int q = nwg / NXCD, r = nwg % NXCD, xcd = wgid % NXCD, off = wgid / NXCD; wgid = (xcd < r ? xcd * (q + 1) : r * (q + 1) + (xcd - r) * q) + off; }
        const int nig = WGM * nN, gid = wgid / nig, fm = gid * WGM, gsz = (nM - fm) < WGM ? (nM - fm) : WGM;
        u.pm = fm + ((wgid % nig) % gsz); u.pn = (wgid % nig) / gsz; return true;
    }
    __device__ __forceinline__ void a_ready(const Unit&) const {}
    __device__ __forceinline__ void done(const Unit&) const {}
};
struct EpiBf16 {
    static constexpr bool PERM = true;
    bf16_t* O; int ldc; int split_cols; size_t split_stride;
    __device__ __forceinline__ void operator()(const f32x4 (&acc)[2][2][4][2], const Unit& u, int wr, int wc, int fr, int fq) const {
        const int row0 = u.pm * BM + wr * 64 + fr; int colt = u.pn * BM; bf16_t* base = O;
        if (split_cols) { const int t = colt / split_cols; base += (size_t)t * split_stride; colt -= t * split_cols; }
        const int col0 = colt + wc * 32 + 8 * fq;
#pragma unroll
        for (int ai = 0; ai < 2; ++ai)
#pragma unroll
            for (int m = 0; m < 4; ++m) { bf16_t* rowp = base + (size_t)(row0 + ai * HALF + m * 16) * ldc + col0;
#pragma unroll
                for (int bj = 0; bj < 2; ++bj) { const f32x4 v0 = acc[ai][bj][m][0], v1 = acc[ai][bj][m][1];
                    u32x4 w; w.x = pk_bf16(v0[0], v0[1]); w.y = pk_bf16(v0[2], v0[3]); w.z = pk_bf16(v1[0], v1[1]); w.w = pk_bf16(v1[2], v1[3]);
                    *(u32x4*)(rowp + bj * HALF) = w; } }
    }
};
struct EpiRes {
    static constexpr bool PERM = false;
    const float* resL; float* outL; const float* resC; float* outC; const float* gate;
    __device__ __forceinline__ void operator()(const f32x4 (&acc)[2][2][4][2], const Unit& u, int wr, int wc, int fr, int fq) const {
        const float* res; float* out; const float* g; int rowb;
        if (u.pm < NLAT / BM) { res = resL; out = outL; g = gate + (size_t)(u.pm >> 4) * 6144; rowb = u.pm * BM; }
        else { res = resC; out = outC; g = gate + (size_t)8 * 6144; rowb = u.pm * BM - NLAT; }
        const int row0 = rowb + wr * 64 + fr, col0 = u.pn * BM + wc * 32 + 4 * fq;
        f32x4 gv[2][2];
#pragma unroll
        for (int bj = 0; bj < 2; ++bj)
#pragma unroll
            for (int n = 0; n < 2; ++n) gv[bj][n] = *(const f32x4*)(g + col0 + bj * HALF + n * 16);
#pragma unroll
        for (int ai = 0; ai < 2; ++ai)
#pragma unroll
            for (int m = 0; m < 4; ++m) { const size_t ro = (size_t)(row0 + ai * HALF + m * 16) * D + col0;
#pragma unroll
                for (int bj = 0; bj < 2; ++bj)
#pragma unroll
                    for (int n = 0; n < 2; ++n) { const f32x4 r = *(const f32x4*)(res + ro + bj * HALF + n * 16);
                        *(f32x4*)(out + ro + bj * HALF + n * 16) = r + gv[bj][n] * acc[ai][bj][m][n]; } }
    }
};

template <class Epi, class Sched>
__device__ __forceinline__ void gemm_phase(LAS unsigned char* lds, const Gemm g, const Sched& S, const Epi& E) {
    const int tid = opaque_tid(), wid = __builtin_amdgcn_readfirstlane(tid >> 6), lane = tid & 63, wr = wid >> 2, wc = wid & 3, fr = lane & 15, fq = lane >> 4;
    const int K = g.K, nt = K / BK;
    unsigned voffA[2], voffB[2];
#pragma unroll
    for (int i = 0; i < 2; ++i) { int R, C; stage_rc(tid * 16 + i * 8192, R, C); const int Rb = Epi::PERM ? ((R & ~31) + perm32(R & 31)) : R;
        voffA[i] = (unsigned)(R * K + C) * 2u; voffB[i] = (unsigned)(Rb * K + C) * 2u; }
    const size_t kstep = (size_t)(BK * 2);
    const size_t hstep = (size_t)HALF * K * 2;
    const size_t tstep = 2 * hstep;
    const unsigned ldsw = (unsigned)wid * 1024u;
    const int aoff = lds_byte(wr * 64 + fr, fq * 8), boff = lds_byte(wc * 32 + fr, fq * 8);
#define PG8_SA(b, h) (((b) * 2 + (h)) * HTB)
#define PG8_SB(b, h) ((4 + (b) * 2 + (h)) * HTB)
#define PG8_STAGE(bufoff, gbase, voff) do { _Pragma("unroll") for (int _i = 0; _i < 2; ++_i) \
        __builtin_amdgcn_global_load_lds((const unsigned*)((const char*)(gbase) + (voff)[_i]), (LAS unsigned*)(lds + (bufoff) + ldsw + _i * 8192), 16, 0, 0); } while (0)
#define PG8_LDA(dst, b, h) do { _Pragma("unroll") for (int m = 0; m < 4; ++m) _Pragma("unroll") for (int k = 0; k < 2; ++k) dst[m][k] = *(const LAS bf16x8*)(lds + PG8_SA(b, h) + aoff + m * 2048 + k * 1024); } while (0)
#define PG8_LDB(dst, b, h) do { _Pragma("unroll") for (int n = 0; n < 2; ++n) _Pragma("unroll") for (int k = 0; k < 2; ++k) dst[n][k] = *(const LAS bf16x8*)(lds + PG8_SB(b, h) + boff + n * 2048 + k * 1024); } while (0)
#define PG8_MMA(ai, bj, At, Bt) do { __builtin_amdgcn_s_setprio(1); _Pragma("unroll") for (int m = 0; m < 4; ++m) _Pragma("unroll") for (int n = 0; n < 2; ++n) _Pragma("unroll") for (int k = 0; k < 2; ++k) \
        acc[ai][bj][m][n] = __builtin_amdgcn_mfma_f32_16x16x32_bf16(Bt[n][k], At[m][k], acc[ai][bj][m][n], 0, 0, 0); __builtin_amdgcn_s_setprio(0); } while (0)
#define PG8_WAIT_V(n) asm volatile("s_waitcnt vmcnt(" #n ")" ::: "memory")
#define PG8_WAIT_L(n) asm volatile("s_waitcnt lgkmcnt(" #n ")" ::: "memory")
#define PG8_BAR __builtin_amdgcn_s_barrier()
#define PG8_SCHED __builtin_amdgcn_sched_barrier(0)
    Unit cur, nxt; int ui = 0;
    if (!S.next(0, cur)) return;
    f32x4 acc[2][2][4][2];
#pragma unroll
    for (int a = 0; a < 2; ++a)
#pragma unroll
        for (int b = 0; b < 2; ++b)
#pragma unroll
            for (int m = 0; m < 4; ++m)
#pragma unroll
                for (int n = 0; n < 2; ++n) acc[a][b][m][n] = (f32x4){0.f, 0.f, 0.f, 0.f};
    bf16x8 At[4][2], B0[2][2], B1[2][2];
    const char* cA = (const char*)g.A + (size_t)cur.pm * tstep; const char* cB = (const char*)g.Bt + (size_t)cur.pn * tstep;
    S.a_ready(cur);
    PG8_STAGE(PG8_SB(0, 0), cB, voffB); PG8_STAGE(PG8_SA(0, 0), cA, voffA); PG8_STAGE(PG8_SB(0, 1), cB + hstep, voffB); PG8_STAGE(PG8_SA(0, 1), cA + hstep, voffA);
    if (wr == 1) PG8_BAR;
    PG8_WAIT_V(4); PG8_BAR;
    PG8_STAGE(PG8_SB(1, 0), cB + kstep, voffB); PG8_STAGE(PG8_SA(1, 0), cA + kstep, voffA); PG8_STAGE(PG8_SB(1, 1), cB + hstep + kstep, voffB);
    PG8_WAIT_V(6); PG8_BAR;
    for (;;) {
        const bool has_next = S.next(ui + 1, nxt);
        const char* nA = has_next ? (const char*)g.A + (size_t)nxt.pm * tstep : cA; const char* nB = has_next ? (const char*)g.Bt + (size_t)nxt.pn * tstep : cB;
        for (int t = 0; t < nt; t += 2) {
            const bool last = (t == nt - 2);
            const char* a1 = cA + (size_t)(t + 1) * kstep;
            const char* a2 = last ? nA : cA + (size_t)(t + 2) * kstep; const char* b2 = last ? nB : cB + (size_t)(t + 2) * kstep;
            const char* a3 = a2 + kstep; const char* b3 = b2 + kstep;
            if (last && has_next) S.a_ready(nxt);
            PG8_LDB(B0, 0, 0); PG8_SCHED; PG8_LDA(At, 0, 0); PG8_STAGE(PG8_SA(1, 1), a1 + hstep, voffA);
            PG8_WAIT_L(8); PG8_BAR; PG8_WAIT_L(0); PG8_MMA(0, 0, At, B0); PG8_BAR; PG8_SCHED;
            PG8_LDB(B1, 0, 1); PG8_STAGE(PG8_SB(0, 0), b2, voffB);
            PG8_BAR; PG8_WAIT_L(0); PG8_MMA(0, 1, At, B1); PG8_BAR;
            PG8_LDA(At, 0, 1); PG8_STAGE(PG8_SA(0, 0), a2, voffA);
            PG8_BAR; PG8_WAIT_L(0); PG8_MMA(1, 0, At, B0); PG8_BAR; PG8_SCHED;
            PG8_STAGE(PG8_SB(0, 1), b2 + hstep, voffB);
            PG8_WAIT_V(6); PG8_BAR; PG8_MMA(1, 1, At, B1); PG8_BAR;
            PG8_LDB(B0, 1, 0); PG8_SCHED; PG8_LDA(At, 1, 0); PG8_STAGE(PG8_SA(0, 1), a2 + hstep, voffA);
            PG8_WAIT_L(8); PG8_BAR; PG8_WAIT_L(0); PG8_MMA(0, 0, At, B0); PG8_BAR; PG8_SCHED;
            PG8_LDB(B1, 1, 1); PG8_STAGE(PG8_SB(1, 0), b3, voffB);
            PG8_BAR; PG8_WAIT_L(0); PG8_MMA(0, 1, At, B1); PG8_BAR;
            PG8_LDA(At, 1, 1); PG8_STAGE(PG8_SA(1, 0), a3, voffA);
            PG8_BAR; PG8_WAIT_L(0); PG8_MMA(1, 0, At, B0); PG8_BAR; PG8_SCHED;
            PG8_STAGE(PG8_SB(1, 1), b3 + hstep, voffB);
            PG8_WAIT_V(6); PG8_BAR; PG8_MMA(1, 1, At, B1); PG8_BAR;
        }
        E(acc, cur, wr, wc, fr, fq); S.done(cur);
        if (!has_next) break;
#pragma unroll
        for (int a = 0; a < 2; ++a)
#pragma unroll
            for (int b = 0; b < 2; ++b)
#pragma unroll
                for (int m = 0; m < 4; ++m)
#pragma unroll
                    for (int n = 0; n < 2; ++n) acc[a][b][m][n] = (f32x4){0.f, 0.f, 0.f, 0.f};
        cur = nxt; cA = nA; cB = nB; ++ui;
    }
    PG8_WAIT_V(0);
    if (wr == 0) PG8_BAR;
    PG8_BAR;
#undef PG8_SA
#undef PG8_SB
#undef PG8_STAGE
#undef PG8_LDA
#undef PG8_LDB
#undef PG8_MMA
#undef PG8_WAIT_V
#undef PG8_WAIT_L
#undef PG8_BAR
#undef PG8_SCHED
}
}

__device__ void phase_prep(const Params& p, LAS unsigned char* lds) {
    const int tid = opaque_tid();
    constexpr int NT_L = 896 + 256 + 1408 + 704;
    constexpr int J_ADA = 192, J_TR = J_ADA + 2 * NT_L, J_WSP = J_TR + 32, J_LB = J_WSP + 1;
    for (int job = blockIdx.x; job < J_LB; job += gridDim.x) {
        if (job < J_ADA) {
            LAS float* s = (LAS float*)lds;
            LAS float* red = (LAS float*)(lds + 9 * 1024 * 4);
            for (int i = tid; i < 9 * 1024; i += 512) { const int r = i >> 10, d = i & 1023; const float v = r < 8 ? p.in[1][r * 1024 + d] : p.in[3][d]; s[i] = silu_f(v); }
            __syncthreads();
            const int l = job / 96, e0 = (job % 96) * 64, col = tid & 63, dg = tid >> 6;
            const float* w = p.in[4] + ((size_t)l * 1024 + dg * 128) * 6144 + e0 + col;
            float acc[9];
#pragma unroll
            for (int r = 0; r < 9; ++r) acc[r] = 0.f;
            for (int dd = 0; dd < 128; ++dd) { const float wv = w[(size_t)dd * 6144];
#pragma unroll
                for (int r = 0; r < 9; ++r) acc[r] += s[r * 1024 + dg * 128 + dd] * wv; }
#pragma unroll
            for (int r = 0; r < 9; ++r) red[(dg * 9 + r) * 64 + col] = acc[r];
            __syncthreads();
            for (int i = tid; i < 9 * 64; i += 512) { const int r = i >> 6, c = i & 63; float a = 0.f;
#pragma unroll
                for (int g = 0; g < 8; ++g) a += red[(g * 9 + r) * 64 + c];
                ((float*)(p.ws + WS_ADA))[((size_t)l * 9 + r) * 6144 + e0 + c] = a + p.in[5][l * 6144 + e0 + c]; }
            __syncthreads();
        } else if (job < J_TR) {
            const int j = job - J_ADA, l = j / NT_L; int r = j % NT_L;
            const float* src; bf16_t* dst; int K, N;
            if (r < 896) { src = p.in[8] + (size_t)l * D * PW; dst = (bf16_t*)(p.ws + WS_WIN) + (size_t)l * PW * D; K = D; N = PW; }
            else if (r < 1152) { r -= 896; src = p.in[16] + (size_t)l * D * D; dst = (bf16_t*)(p.ws + WS_WOUT) + (size_t)l * D * D; K = D; N = D; }
            else if (r < 2560) { r -= 1152; src = p.in[17] + (size_t)l * D * UPW; dst = (bf16_t*)(p.ws + WS_WUP) + (size_t)l * UPW * D; K = D; N = UPW; }
            else { r -= 2560; src = p.in[20] + (size_t)l * FF * D; dst = (bf16_t*)(p.ws + WS_WDOWN) + (size_t)l * D * FF; K = FF; N = D; }
            const int ntn = N >> 6, kt = r / ntn, nt = r % ntn;
            LAS float* tile = (LAS float*)lds;
            { const int kk = tid >> 3, n8 = (tid & 7) * 8; const float* sp = src + (size_t)(kt * 64 + kk) * N + nt * 64 + n8;
              const f32x4 a = *(const f32x4*)sp, b = *(const f32x4*)(sp + 4);
              LAS float* tp = tile + kk * 65 + n8; tp[0] = a[0]; tp[1] = a[1]; tp[2] = a[2]; tp[3] = a[3]; tp[4] = b[0]; tp[5] = b[1]; tp[6] = b[2]; tp[7] = b[3]; }
            __syncthreads();
            { const int nn = tid >> 3, k8 = (tid & 7) * 8; float v[8];
#pragma unroll
              for (int i = 0; i < 8; ++i) v[i] = tile[(k8 + i) * 65 + nn];
              u32x4 w; w.x = pk_bf16(v[0], v[1]); w.y = pk_bf16(v[2], v[3]); w.z = pk_bf16(v[4], v[5]); w.w = pk_bf16(v[6], v[7]);
              *(u32x4*)(dst + (size_t)(nt * 64 + nn) * K + kt * 64 + k8) = w; }
            __syncthreads();
        } else if (job < J_WSP) {
            const int j = job - J_TR; const size_t i0 = (size_t)j * 4096 + tid * 8;
            const f32x4 a = *(const f32x4*)(p.in[14] + i0), b = *(const f32x4*)(p.in[14] + i0 + 4);
            u32x4 w; w.x = pk_bf16(a[0], a[1]); w.y = pk_bf16(a[2], a[3]); w.z = pk_bf16(b[0], b[1]); w.w = pk_bf16(b[2], b[3]);
            *(u32x4*)((bf16_t*)(p.ws + WS_WSP) + i0) = w;
        } else {
            for (int i = tid; i < 1024; i += 512) { const int dir = i >> 9, c = i & 511; const float* lg = dir ? p.in[10] : p.in[9];
                const float l0 = lg[c], l1 = lg[512 + c]; ((float*)(p.ws + WS_LB))[i] = 1.0f / (1.0f + expf(l0 - l1)); }
        }
    }
}

__device__ void phase_norm(const float* xl, const float* xc, const float* gain, const float* ada_l, int shift_idx, int nrows, bf16_t* H) {
    const int tid_ = opaque_tid(); const int wave = tid_ >> 6, lane = tid_ & 63;
    for (int row = (blockIdx.x * 8 + wave) * 2; row < nrows; row += gridDim.x * 16) {
        const float* src[2]; const float* mod[2];
#pragma unroll
        for (int u = 0; u < 2; ++u) { const int r = row + u;
            if (r < NLAT) { src[u] = xl + (size_t)r * D; mod[u] = ada_l + (size_t)(r >> 12) * 6144; } else { src[u] = xc + (size_t)(r - NLAT) * D; mod[u] = ada_l + (size_t)8 * 6144; } }
        f32x4 v[2][4];
#pragma unroll
        for (int u = 0; u < 2; ++u)
#pragma unroll
            for (int j = 0; j < 4; ++j) v[u][j] = *(const f32x4*)(src[u] + j * 256 + lane * 4);
#pragma unroll
        for (int u = 0; u < 2; ++u) {
            float ss = 0.f;
#pragma unroll
            for (int j = 0; j < 4; ++j) ss += v[u][j][0] * v[u][j][0] + v[u][j][1] * v[u][j][1] + v[u][j][2] * v[u][j][2] + v[u][j][3] * v[u][j][3];
#pragma unroll
            for (int o = 32; o > 0; o >>= 1) ss += __shfl_xor(ss, o);
            const float rs = rsqrtf(ss * (1.0f / D) + EPS);
#pragma unroll
            for (int j = 0; j < 4; ++j) { const int d = j * 256 + lane * 4;
                const f32x4 g = *(const f32x4*)(gain + d), sh = *(const f32x4*)(mod[u] + shift_idx * 1024 + d), sc = *(const f32x4*)(mod[u] + (shift_idx + 1) * 1024 + d);
                f32x4 y = v[u][j] * rs * g; y = y * (sc + 1.0f) + sh;
                u32x2 wv; wv.x = pk_bf16(y[0], y[1]); wv.y = pk_bf16(y[2], y[3]);
                *(u32x2*)(H + (size_t)(row + u) * D + d) = wv; }
        }
    }
}
__device__ void phase_final(float* x, const float* gain) {
    const int tid_ = opaque_tid(); const int wave = tid_ >> 6, lane = tid_ & 63;
    for (int row = (blockIdx.x * 8 + wave) * 2; row < NLAT; row += gridDim.x * 16) {
        f32x4 v[2][4];
#pragma unroll
        for (int u = 0; u < 2; ++u)
#pragma unroll
            for (int j = 0; j < 4; ++j) v[u][j] = *(const f32x4*)(x + (size_t)(row + u) * D + j * 256 + lane * 4);
#pragma unroll
        for (int u = 0; u < 2; ++u) {
            float ss = 0.f;
#pragma unroll
            for (int j = 0; j < 4; ++j) ss += v[u][j][0] * v[u][j][0] + v[u][j][1] * v[u][j][1] + v[u][j][2] * v[u][j][2] + v[u][j][3] * v[u][j][3];
#pragma unroll
            for (int o = 32; o > 0; o >>= 1) ss += __shfl_xor(ss, o);
            const float rs = rsqrtf(ss * (1.0f / D) + EPS);
#pragma unroll
            for (int j = 0; j < 4; ++j) { const int d = j * 256 + lane * 4; const f32x4 g = *(const f32x4*)(gain + d); *(f32x4*)(x + (size_t)(row + u) * D + d) = v[u][j] * rs * g; }
        }
    }
}

constexpr int QS_ST = 136, KT_ST = 40;
constexpr int P1_QS = 0, P1_KH = P1_QS + 32 * QS_ST * 2, P1_VT = P1_KH + 32 * QS_ST * 2, P1_KT = P1_VT + 128 * KT_ST * 2, P1_AW = P1_KT + 128 * KT_ST * 2;
constexpr int NCH = 8 + 128;

template <int CTRL, int RMASK> __device__ __forceinline__ float dpp_mul(float x) {
    const int t = __builtin_amdgcn_update_dpp(0x3f800000, __builtin_bit_cast(int, x), CTRL, RMASK, 0xf, false);
    return x * __builtin_bit_cast(float, t);
}
__device__ __forceinline__ float cumprod32(float x) {
    x = dpp_mul<0x111, 0xf>(x); x = dpp_mul<0x112, 0xf>(x); x = dpp_mul<0x114, 0xf>(x); x = dpp_mul<0x118, 0xf>(x);
    x = dpp_mul<0x142, 0xa>(x);
    return x;
}

__device__ void prep_item(const Params& p, int l, int item, LAS unsigned char* lds) {
    const int tid = opaque_tid(), w = tid >> 6, lane = tid & 63;
    const int tau = lane & 31, kh = lane >> 5, k0 = 16 * w + 8 * kh, l15 = lane & 15, q4 = lane >> 4;
    const int ci = item % NCH, bh = item / NCH, h = bh & 3, b = bh >> 2;
    const int R0 = ci < 8 ? NLAT + b * 256 + 32 * ci : b * 4096 + 32 * (ci - 8);
    bf16_t* P = (bf16_t*)(p.ws + WS_BIG);
    const bool first = (l == 0);
    const bool want_out = first || ci >= 8;
    LAS bf16_t* Qs = (LAS bf16_t*)(lds + P1_QS); LAS bf16_t* Kh = (LAS bf16_t*)(lds + P1_KH);
    LAS bf16_t* Vt = (LAS bf16_t*)(lds + P1_VT); LAS bf16_t* Kt = (LAS bf16_t*)(lds + P1_KT);
    LAS bf16_t* Aw = (LAS bf16_t*)(lds + P1_AW) + w * 32 * KT_ST;
    for (int i = lane; i < 32 * KT_ST / 2; i += 64) ((LAS unsigned*)Aw)[i] = 0u;
    u32x4 rf0, rq0, rv0, rf1, rq1, rv1;
    { const bf16_t* rp = P + (size_t)(R0 + tau) * PW; rf0 = *(const u32x4*)(rp + h * 128 + k0); rq0 = *(const u32x4*)(rp + 1536 + h * 128 + k0); rv0 = *(const u32x4*)(rp + 1024 + h * 128 + k0); }
    { const bf16_t* rp = P + (size_t)(R0 + 31 - tau) * PW; rf1 = *(const u32x4*)(rp + 512 + h * 128 + k0); rq1 = *(const u32x4*)(rp + 1536 + h * 128 + k0); rv1 = *(const u32x4*)(rp + 1024 + h * 128 + k0); }
    asm volatile("s_waitcnt vmcnt(0)" ::: "memory");
    __syncthreads();
    auto one_dir = [&](const int dir, const u32x4& f, const u32x4& q, const u32x4& v) {
        const int tokl = dir ? 31 - tau : tau;
        const float* lbp = (const float*)(p.ws + WS_LB) + dir * 512 + h * 128 + k0;
        float E[8], kk[8];
#pragma unroll
        for (int j = 0; j < 8; ++j) {
            const unsigned fw = f[j >> 1]; const float x = (j & 1) ? bf_hi(fw) : bf_lo(fw);
            const float e = __expf(-fabsf(x)), r = fast_rcp(1.0f + e);
            const float sp = x >= 0.f ? r : e * r, sn = x >= 0.f ? e * r : r;
            if (first) { E[j] = sp; kk[j] = sn; }
            else { const float lb = lbp[j]; const float gate = lb + (1.0f - lb) * sp; E[j] = gate; kk[j] = 1.0f - gate; }
        }
        float qt[8], kh_[8], kt_[8], Tj[8];
#pragma unroll
        for (int j = 0; j < 8; ++j) {
            const float Ej = fmaxf(cumprod32(E[j]), 1e-35f);
            const float T0 = __builtin_bit_cast(float, __builtin_amdgcn_readlane(__builtin_bit_cast(int, Ej), 31)), T1 = __builtin_bit_cast(float, __builtin_amdgcn_readlane(__builtin_bit_cast(int, Ej), 63));
            const float T = kh ? T1 : T0;
            const unsigned qw = q[j >> 1]; const float qx = (j & 1) ? bf_hi(qw) : bf_lo(qw);
            qt[j] = silu_f(qx) * 0.08838834764831845f * Ej;
            kh_[j] = kk[j] * fast_rcp(Ej); kt_[j] = kh_[j] * T;
            Tj[j] = T;
        }
        if (tau == 31) { float* dp = (float*)(p.ws + WS_DS) + ((size_t)((b * 4 + h) * 2 + dir) * NCH + ci) * 128 + k0;
            *(f32x4*)dp = (f32x4){Tj[0], Tj[1], Tj[2], Tj[3]}; *(f32x4*)(dp + 4) = (f32x4){Tj[4], Tj[5], Tj[6], Tj[7]}; }
        u32x4 wq, wk; wq.x = pk_bf16(qt[0], qt[1]); wq.y = pk_bf16(qt[2], qt[3]); wq.z = pk_bf16(qt[4], qt[5]); wq.w = pk_bf16(qt[6], qt[7]);
        wk.x = pk_bf16(kh_[0], kh_[1]); wk.y = pk_bf16(kh_[2], kh_[3]); wk.z = pk_bf16(kh_[4], kh_[5]); wk.w = pk_bf16(kh_[6], kh_[7]);
        *(LAS u32x4*)(Qs + tau * QS_ST + k0) = wq; *(LAS u32x4*)(Kh + tau * QS_ST + k0) = wk;
        {
          bf16_t* qd = (dir == 0) ? P + (size_t)(R0 + tokl) * PW + 1536 + h * 128 : (bf16_t*)(p.ws + WS_QB) + (size_t)(R0 + tokl) * 512 + h * 128;
          const int a32 = k0 & ~31, kkA = k0 & 31, kkB = kkA + 4;
          u32x2 pa, pb; pa.x = wq.x; pa.y = wq.y; pb.x = wq.z; pb.y = wq.w;
          *(u32x2*)(qd + a32 + 8 * ((kkA & 15) >> 2) + 4 * (kkA >> 4)) = pa;
          *(u32x2*)(qd + a32 + 8 * ((kkB & 15) >> 2) + 4 * (kkB >> 4)) = pb; }
#pragma unroll
        for (int j = 0; j < 8; ++j) { Kt[(k0 + j) * KT_ST + tokl] = to_bf1(kt_[j]); const unsigned vw = v[j >> 1]; Vt[(k0 + j) * KT_ST + tau] = (bf16_t)((j & 1) ? (vw >> 16) : (vw & 0xffffu)); }
        __syncthreads();
        if (want_out) {
            f32x4 a00 = (f32x4){0.f, 0.f, 0.f, 0.f}, a10 = a00, a11 = a00;
#pragma unroll
            for (int kb = 0; kb < 4; ++kb) {
                const bf16x8 qn0 = *(const LAS bf16x8*)(Qs + l15 * QS_ST + 32 * kb + 8 * q4), qn1 = *(const LAS bf16x8*)(Qs + (16 + l15) * QS_ST + 32 * kb + 8 * q4);
                const bf16x8 kh0 = *(const LAS bf16x8*)(Kh + l15 * QS_ST + 32 * kb + 8 * q4), kh1 = *(const LAS bf16x8*)(Kh + (16 + l15) * QS_ST + 32 * kb + 8 * q4);
                a00 = __builtin_amdgcn_mfma_f32_16x16x32_bf16(qn0, kh0, a00, 0, 0, 0);
                a10 = __builtin_amdgcn_mfma_f32_16x16x32_bf16(qn1, kh0, a10, 0, 0, 0);
                a11 = __builtin_amdgcn_mfma_f32_16x16x32_bf16(qn1, kh1, a11, 0, 0, 0);
            }
#pragma unroll
            for (int i = 0; i < 4; ++i) { const int t = 4 * q4 + i; const bool keep = l15 <= t;
                Aw[t * KT_ST + l15] = to_bf1(keep ? a00[i] : 0.f);
                Aw[(16 + t) * KT_ST + l15] = to_bf1(a10[i]);
                Aw[(16 + t) * KT_ST + 16 + l15] = to_bf1(keep ? a11[i] : 0.f); }
            asm volatile("s_waitcnt lgkmcnt(0)" ::: "memory");
            const bf16x8 vf = *(const LAS bf16x8*)(Vt + (16 * w + l15) * KT_ST + 8 * q4);
            bf16_t* OFB = (bf16_t*)(p.ws + WS_OFB) + (size_t)dir * NROW * 512;
#pragma unroll
            for (int mt = 0; mt < 2; ++mt) {
                const bf16x8 af = *(const LAS bf16x8*)(Aw + (16 * mt + l15) * KT_ST + 8 * q4);
                const f32x4 o = __builtin_amdgcn_mfma_f32_16x16x32_bf16(vf, af, (f32x4){0.f, 0.f, 0.f, 0.f}, 0, 0, 0);
                const int tl = 16 * mt + l15, tok = dir ? 31 - tl : tl;
                u32x2 wv; wv.x = pk_bf16(o[0], o[1]); wv.y = pk_bf16(o[2], o[3]);
                *(u32x2*)(OFB + (size_t)(R0 + tok) * 512 + h * 128 + 16 * w + 4 * q4) = wv;
            }
        }
        { const int k = tid >> 2, part = tid & 3;
          const u32x4 kv = *(const LAS u32x4*)(Kt + k * KT_ST + 8 * part);
          bf16_t* dst = P + (size_t)(R0 + (k >> 2)) * PW + h * 128 + (k & 3) * 32 + (part ^ ((k >> 2) & 3)) * 8;
          *(u32x4*)(dst + dir * 512) = kv;
          if (dir == 0) { const u32x4 vv = *(const LAS u32x4*)(Vt + k * KT_ST + 8 * part); *(u32x4*)(dst + 1024) = vv; } }
        __syncthreads();
    };
    one_dir(0, rf0, rq0, rv0);
    one_dir(1, rf1, rq1, rv1);
}

constexpr int ST_Q = 0, ST_K = 8192, ST_V = 16384, ST_O = 20480, ST_D = 24576, ST_BYTES = 25088, NSTAGE = 6;
__device__ void scan_chain(const Params& p, int l, int chain, int vhalf, LAS unsigned char* lds) {
    const int tid = opaque_tid(), w = __builtin_amdgcn_readfirstlane(tid >> 6), lane = tid & 63, l15 = lane & 15, q4 = lane >> 4;
    const int dir = chain & 1, h = (chain >> 1) & 3, b = chain >> 3;
    bf16_t* P = (bf16_t*)(p.ws + WS_BIG);
    auto chunk_of = [&](int s) -> int { return dir ? (s < 8 ? 7 - s : 143 - s) : s; };
    auto row0_of = [&](int c) -> int { return c < 8 ? NLAT + b * 256 + 32 * c : b * 4096 + 32 * (c - 8); };
    bf16_t* qb = dir ? (bf16_t*)(p.ws + WS_QB) + h * 128 : P + 1536 + h * 128;
    const int qpitch = dir ? 512 : PW;
    if (w >= 4) {
        const int lw = w - 4;
        const int r16 = lane >> 4, s16 = lane & 15;
        size_t qoff[2], koff[2];
#pragma unroll
        for (int i = 0; i < 2; ++i) { const int row = 8 * lw + 4 * i + r16; qoff[i] = (size_t)row * qpitch + ((s16 ^ (row & 15)) * 8);
            koff[i] = (size_t)(4 * (2 * lw + i) + r16) * PW + dir * 512 + h * 128 + s16 * 8; }
        const size_t voff = (size_t)(16 * vhalf + 4 * lw + r16) * PW + 1024 + h * 128 + s16 * 8;
        const float* dsrc = (const float*)(p.ws + WS_DS) + (size_t)chain * NCH * 128 + (lw & 1) * 64 + lane;
        const int orow = 8 * lw + (lane >> 3);
        const size_t ooff = (size_t)orow * 512 + h * 128 + 64 * vhalf + (((lane & 7) ^ (orow & 7)) * 8);
        const bf16_t* OFBc = (const bf16_t*)(p.ws + WS_OFB) + (size_t)dir * NROW * 512;
        auto issue = [&](int s) {
            const int sc = s < NCH ? s : NCH - 1;
            const int c = chunk_of(sc), R0 = row0_of(c);
            LAS unsigned char* st = lds + (s % NSTAGE) * ST_BYTES;
            const bf16_t* qrow = qb + (size_t)R0 * qpitch; const bf16_t* krow = P + (size_t)R0 * PW;
#pragma unroll
            for (int i = 0; i < 2; ++i) {
                __builtin_amdgcn_global_load_lds((const unsigned*)(qrow + qoff[i]), (LAS unsigned*)(st + ST_Q + (2 * lw + i) * 1024), 16, 0, 0);
                __builtin_amdgcn_global_load_lds((const unsigned*)(krow + koff[i]), (LAS unsigned*)(st + ST_K + (2 * lw + i) * 1024), 16, 0, 0);
            }
            __builtin_amdgcn_global_load_lds((const unsigned*)(krow + voff), (LAS unsigned*)(st + ST_V + lw * 1024), 16, 0, 0);
            __builtin_amdgcn_global_load_lds((const unsigned*)(dsrc + (size_t)c * 128), (LAS unsigned*)(st + ST_D + (lw & 1) * 256), 4, 0, 0);
            __builtin_amdgcn_global_load_lds((const unsigned*)(OFBc + (size_t)R0 * 512 + ooff), (LAS unsigned*)(st + ST_O + lw * 1024), 16, 0, 0);
        };
        issue(0); issue(1); issue(2); issue(3); issue(4);
        asm volatile("s_waitcnt vmcnt(28)" ::: "memory");
        __builtin_amdgcn_s_barrier();
        for (int s = 0; s < NCH; ++s) {
            issue(s + 5);
            asm volatile("s_waitcnt vmcnt(28)" ::: "memory");
            __builtin_amdgcn_s_barrier();
        }
        asm volatile("s_waitcnt vmcnt(0)" ::: "memory");
    } else {
        f32x4 S[8];
#pragma unroll
        for (int j = 0; j < 8; ++j) S[j] = (f32x4){0.f, 0.f, 0.f, 0.f};
        const int swz = (l15 >> 2) & 3, vcol = 64 * vhalf + 16 * w;
        bf16_t* OFBw = (bf16_t*)(p.ws + WS_OFB) + (size_t)dir * NROW * 512;
        __builtin_amdgcn_s_barrier();
        for (int s = 0; s < NCH; ++s) {
            LAS unsigned char* st = lds + (s % NSTAGE) * ST_BYTES;
            bf16x8 qf[4][2], kf[8]; f32x4 dv[8];
#pragma unroll
            for (int kb = 0; kb < 4; ++kb)
#pragma unroll
                for (int mt = 0; mt < 2; ++mt) {
                    qf[kb][mt] = *(const LAS bf16x8*)(st + ST_Q + (16 * mt + l15) * 256 + (((4 * kb + q4) ^ l15) * 16));
                }
            const bf16x8 vf = *(const LAS bf16x8*)(st + ST_V + (16 * w + l15) * 64 + ((q4 ^ swz) * 16));
            u32x2 oi[2];
#pragma unroll
            for (int mt = 0; mt < 2; ++mt) { const int tr = 16 * mt + l15; oi[mt] = *(const LAS u32x2*)(st + ST_O + tr * 128 + (((2 * w + (q4 >> 1)) ^ (tr & 7)) * 16) + (q4 & 1) * 8); }
#pragma unroll
            for (int j = 0; j < 8; ++j) { dv[j] = *(const LAS f32x4*)(st + ST_D + (16 * j + 4 * q4) * 4); kf[j] = *(const LAS bf16x8*)(st + ST_K + (16 * j + l15) * 64 + ((q4 ^ swz) * 16)); }
            __builtin_amdgcn_sched_barrier(0);
            f32x4 o[2]; o[0] = (f32x4){0.f, 0.f, 0.f, 0.f}; o[1] = o[0];
#pragma unroll
            for (int kb = 0; kb < 4; ++kb) {
                u32x4 sb; sb.x = pk_bf16(S[2 * kb][0], S[2 * kb][1]); sb.y = pk_bf16(S[2 * kb][2], S[2 * kb][3]); sb.z = pk_bf16(S[2 * kb + 1][0], S[2 * kb + 1][1]); sb.w = pk_bf16(S[2 * kb + 1][2], S[2 * kb + 1][3]);
                const bf16x8 sfr = __builtin_bit_cast(bf16x8, sb);
                o[0] = __builtin_amdgcn_mfma_f32_16x16x32_bf16(sfr, qf[kb][0], o[0], 0, 0, 0);
                o[1] = __builtin_amdgcn_mfma_f32_16x16x32_bf16(sfr, qf[kb][1], o[1], 0, 0, 0);
            }
#pragma unroll
            for (int j = 0; j < 8; ++j) S[j] = __builtin_amdgcn_mfma_f32_16x16x32_bf16(kf[j], vf, S[j] * dv[j], 0, 0, 0);
            const int R0 = row0_of(chunk_of(s));
#pragma unroll
            for (int mt = 0; mt < 2; ++mt) { const int tr = 16 * mt + l15;
                u32x2 wv; wv.x = pk_bf16(o[mt][0] + bf_lo(oi[mt].x), o[mt][1] + bf_hi(oi[mt].x)); wv.y = pk_bf16(o[mt][2] + bf_lo(oi[mt].y), o[mt][3] + bf_hi(oi[mt].y));
                *(u32x2*)(OFBw + (size_t)(R0 + tr) * 512 + h * 128 + vcol + 4 * q4) = wv; }
            asm volatile("s_waitcnt lgkmcnt(0)" ::: "memory");
            __builtin_amdgcn_s_barrier();
        }
    }
}

constexpr int SG_ST = 136;
__device__ void sgu_tile(const Params& p, int l, int tile, LAS unsigned char* lds) {
    const int tid = opaque_tid(), w = tid >> 6, lane = tid & 63, l15 = lane & 15, q4 = lane >> 4;
    const int h = tile & 3, rowbase = (tile >> 2) * 128;
    const bf16_t* P = (const bf16_t*)(p.ws + WS_BIG);
    bf16_t* O = (bf16_t*)(p.ws + WS_H);
    LAS bf16_t* Vt = (LAS bf16_t*)lds;
    {
        const int q = tid >> 2, cgp = tid & 3;
        const bf16_t* vp = P + (size_t)(rowbase + q) * PW + 3072 + 128 * h + 32 * cgp;
        float g[32];
#pragma unroll
        for (int i = 0; i < 4; ++i) { const u32x4 r = *(const u32x4*)(vp + 8 * i);
#pragma unroll
            for (int j = 0; j < 4; ++j) { g[8 * i + 2 * j] = gelu_f(bf_lo(r[j])); g[8 * i + 2 * j + 1] = gelu_f(bf_hi(r[j])); } }
        float s = 0.f;
#pragma unroll
        for (int i = 0; i < 32; ++i) s += g[i];
        s += __shfl_xor(s, 1); s += __shfl_xor(s, 2);
        const float mu = s * (1.0f / 128.f);
        float vs = 0.f;
#pragma unroll
        for (int i = 0; i < 32; ++i) { const float d = g[i] - mu; vs += d * d; }
        vs += __shfl_xor(vs, 1); vs += __shfl_xor(vs, 2);
        const float rstd = rsqrtf(vs * (1.0f / 128.f) + EPS);
        const float* lng = p.in[12] + l * 512 + h * 128 + 32 * cgp; const float* lnb = p.in[13] + l * 512 + h * 128 + 32 * cgp;
#pragma unroll
        for (int i = 0; i < 32; ++i) { const float y = (g[i] - mu) * rstd * lng[i] + lnb[i]; Vt[(32 * cgp + i) * SG_ST + q] = to_bf1(y); }
    }
    __syncthreads();
    {
        const int prow = 16 * w + l15;
        const bf16_t* wsp = (const bf16_t*)(p.ws + WS_WSP) + ((size_t)(l * 4 + h) * 128 + prow) * 128 + 8 * q4;
        bf16x8 wf[4];
#pragma unroll
        for (int kb = 0; kb < 4; ++kb) wf[kb] = *(const bf16x8*)(wsp + 32 * kb);
        const float bs = p.in[15][(l * 4 + h) * 128 + prow];
        const bf16_t* up = P + (size_t)(rowbase + prow) * PW + 2560 + 128 * h + 4 * q4;
        bf16_t* op = O + (size_t)(rowbase + prow) * D + 512 + 128 * h + 4 * q4;
#pragma unroll
        for (int mt = 0; mt < 8; ++mt) {
            f32x4 acc = (f32x4){0.f, 0.f, 0.f, 0.f};
#pragma unroll
            for (int kb = 0; kb < 4; ++kb) { const bf16x8 af = *(const LAS bf16x8*)(Vt + (16 * mt + l15) * SG_ST + 32 * kb + 8 * q4);
                acc = __builtin_amdgcn_mfma_f32_16x16x32_bf16(af, wf[kb], acc, 0, 0, 0); }
            const u32x2 uu = *(const u32x2*)(up + 16 * mt);
            const float u0 = gelu_f(bf_lo(uu.x)), u1 = gelu_f(bf_hi(uu.x)), u2 = gelu_f(bf_lo(uu.y)), u3 = gelu_f(bf_hi(uu.y));
            u32x2 wv; wv.x = pk_bf16(u0 * (acc[0] + bs), u1 * (acc[1] + bs)); wv.y = pk_bf16(u2 * (acc[2] + bs), u3 * (acc[3] + bs));
            *(u32x2*)(op + 16 * mt) = wv;
        }
    }
    __syncthreads();
}

constexpr int SGU_IN_M2 = 512;
__device__ void phase_mixer(const Params& p, int l, LAS unsigned char* lds) {
    const int G = gridDim.x, bid = blockIdx.x;
    const int ntile = (l == 0) ? (NROW / 128) * 4 : (NLAT / 128) * 4;
    if (G > 128) {
        if (bid < 128) scan_chain(p, l, bid >> 1, bid & 1, lds);
        else for (int t = bid - 128; t < SGU_IN_M2; t += G - 128) sgu_tile(p, l, t, lds);
    } else {
        for (int c = bid; c < 128; c += G) { scan_chain(p, l, c >> 1, c & 1, lds); __syncthreads(); }
        for (int t = bid; t < ntile; t += G) sgu_tile(p, l, t, lds);
    }
}

__device__ void phase_combine(const Params& p, int l, int nrows) {
    const int tid_ = opaque_tid(); const int wave = tid_ >> 6, lane = tid_ & 63, hd = lane >> 4, v0 = (lane & 15) * 8;
    const bf16_t* P = (const bf16_t*)(p.ws + WS_BIG);
    const bf16_t* OF = (const bf16_t*)(p.ws + WS_OFB); const bf16_t* OB = OF + (size_t)NROW * 512;
    bf16_t* O = (bf16_t*)(p.ws + WS_H);
    const float* gn = p.in[11] + l * 512 + hd * 128 + v0;
    const f32x4 g0 = *(const f32x4*)gn, g1 = *(const f32x4*)(gn + 4);
    for (int row = blockIdx.x * 8 + wave; row < nrows; row += gridDim.x * 8) {
        const u32x4 a = *(const u32x4*)(OF + (size_t)row * 512 + hd * 128 + v0), bq = *(const u32x4*)(OB + (size_t)row * 512 + hd * 128 + v0);
        const u32x4 gg = *(const u32x4*)(P + (size_t)row * PW + 2048 + hd * 128 + v0);
        float s[8]; float ss = 0.f;
#pragma unroll
        for (int j = 0; j < 4; ++j) { s[2 * j] = bf_lo(a[j]) + bf_lo(bq[j]); s[2 * j + 1] = bf_hi(a[j]) + bf_hi(bq[j]); ss += s[2 * j] * s[2 * j] + s[2 * j + 1] * s[2 * j + 1]; }
#pragma unroll
        for (int o = 8; o > 0; o >>= 1) ss += __shfl_xor(ss, o);
        const float rs = rsqrtf(ss * (1.0f / 128.f) + EPS);
        float y[8];
#pragma unroll
        for (int j = 0; j < 4; ++j) { y[2 * j] = s[2 * j] * rs * (j < 2 ? g0[2 * j] : g1[2 * j - 4]) * silu_f(bf_lo(gg[j])); y[2 * j + 1] = s[2 * j + 1] * rs * (j < 2 ? g0[2 * j + 1] : g1[2 * j - 3]) * silu_f(bf_hi(gg[j])); }
        u32x4 wv; wv.x = pk_bf16(y[0], y[1]); wv.y = pk_bf16(y[2], y[3]); wv.z = pk_bf16(y[4], y[5]); wv.w = pk_bf16(y[6], y[7]);
        *(u32x4*)(O + (size_t)row * D + hd * 128 + v0) = wv;
    }
}

__device__ void phase_conv(const Params& p, int l, int nrows) {
    bf16_t* Aup = (bf16_t*)(p.ws + WS_BIG); const bf16_t* Gup = Aup + (size_t)NROW * FF;
    const float* cw = p.in[18] + (size_t)l * 9 * FF; const float* cb = p.in[19] + (size_t)l * FF;
    const int tid_ = opaque_tid();
    const long total = (long)(nrows / 16) * 352;
    for (long id = (long)blockIdx.x * 512 + tid_; id < total; id += (long)gridDim.x * 512) {
        const int seg = (int)(id / 352), f0 = (int)(id % 352) * 8;
        const int tok0 = seg * 16;
        int c0, W; bool up, dn;
        if (tok0 < NLAT) { const int t = tok0 & 4095, r = t >> 6; c0 = t & 63; W = 64; up = r > 0; dn = r < 63; }
        else { c0 = (tok0 - NLAT) & 255; W = 256; up = false; dn = false; }
        float tp[9][8]; float bias[8];
#pragma unroll
        for (int k = 0; k < 9; ++k) { const f32x4 t0 = *(const f32x4*)(cw + k * FF + f0), t1 = *(const f32x4*)(cw + k * FF + f0 + 4);
            tp[k][0] = t0[0]; tp[k][1] = t0[1]; tp[k][2] = t0[2]; tp[k][3] = t0[3]; tp[k][4] = t1[0]; tp[k][5] = t1[1]; tp[k][6] = t1[2]; tp[k][7] = t1[3]; }
        { const f32x4 b0 = *(const f32x4*)(cb + f0), b1 = *(const f32x4*)(cb + f0 + 4); bias[0] = b0[0]; bias[1] = b0[1]; bias[2] = b0[2]; bias[3] = b0[3]; bias[4] = b1[0]; bias[5] = b1[1]; bias[6] = b1[2]; bias[7] = b1[3]; }
        const u32x4 zero = (u32x4){0u, 0u, 0u, 0u};
        const bf16_t* gp = Gup + (size_t)tok0 * FF + f0;
        u32x4 L[3], M[3], R[3];
        { const bool v = c0 > 0;
          L[0] = (v && up) ? *(const u32x4*)(gp - (size_t)65 * FF) : zero; L[1] = v ? *(const u32x4*)(gp - (size_t)FF) : zero; L[2] = (v && dn) ? *(const u32x4*)(gp + (size_t)63 * FF) : zero; }
        M[0] = up ? *(const u32x4*)(gp - (size_t)64 * FF) : zero; M[1] = *(const u32x4*)gp; M[2] = dn ? *(const u32x4*)(gp + (size_t)64 * FF) : zero;
#pragma unroll 4
        for (int i = 0; i < 16; ++i) {
            const bf16_t* np = gp + (size_t)(i + 1) * FF;
            const bool v = (c0 + i + 1) < W;
            R[0] = (v && up) ? *(const u32x4*)(np - (size_t)64 * FF) : zero; R[1] = v ? *(const u32x4*)np : zero; R[2] = (v && dn) ? *(const u32x4*)(np + (size_t)64 * FF) : zero;
            float acc[8];
#pragma unroll
            for (int j = 0; j < 8; ++j) acc[j] = bias[j];
#pragma unroll
            for (int rr = 0; rr < 3; ++rr) {
#pragma unroll
                for (int j = 0; j < 4; ++j) {
                    acc[2 * j] += bf_lo(L[rr][j]) * tp[rr * 3 + 0][2 * j] + bf_lo(M[rr][j]) * tp[rr * 3 + 1][2 * j] + bf_lo(R[rr][j]) * tp[rr * 3 + 2][2 * j];
                    acc[2 * j + 1] += bf_hi(L[rr][j]) * tp[rr * 3 + 0][2 * j + 1] + bf_hi(M[rr][j]) * tp[rr * 3 + 1][2 * j + 1] + bf_hi(R[rr][j]) * tp[rr * 3 + 2][2 * j + 1];
                }
            }
            bf16_t* ap = Aup + (size_t)(tok0 + i) * FF + f0;
            const u32x4 av = *(const u32x4*)ap;
            u32x4 wv;
#pragma unroll
            for (int j = 0; j < 4; ++j) wv[j] = pk_bf16(bf_lo(av[j]) * gelu_f(acc[2 * j]), bf_hi(av[j]) * gelu_f(acc[2 * j + 1]));
            *(u32x4*)ap = wv;
#pragma unroll
            for (int rr = 0; rr < 3; ++rr) { L[rr] = M[rr]; M[rr] = R[rr]; }
        }
    }
}

#define XB_TMO      128
#define XB_XCNT(j)  (256  + 64 * (j))
#define XB_XSUB(j)  (1280 + 64 * (j))
#define XB_XGEN(j)  (2304 + 64 * (j))
#define XB_TOP      3328
#define XB_TOPGEN   3392
#define XCD_BAR_WORDS 3456
#define XB_SPIN_CAP (1u << 20)
__device__ __forceinline__ unsigned xb_ld(unsigned* p)              { return __hip_atomic_load(p, __ATOMIC_RELAXED, __HIP_MEMORY_SCOPE_AGENT); }
__device__ __forceinline__ unsigned xb_add(unsigned* p, unsigned v) { return __hip_atomic_fetch_add(p, v, __ATOMIC_RELAXED, __HIP_MEMORY_SCOPE_AGENT); }
__device__ __forceinline__ unsigned xb_xcc_id() { return (unsigned)__builtin_amdgcn_s_getreg((3 << 11) | 20) & 0xFu; }
#define XB_SPIN(cond, bar) do { unsigned _sp = 0; while (cond) { __builtin_amdgcn_s_sleep(1); \
    if ((++_sp & 255u) == 0u) { if (xb_ld(&(bar)[XB_TMO])) break; if (_sp > XB_SPIN_CAP) { atomicAdd(&(bar)[XB_TMO], 1u); break; } } } } while (0)
struct XcdBarrier { unsigned* bar; unsigned x; volatile LAS unsigned* st; };
__device__ __forceinline__ XcdBarrier xcd_barrier_post(unsigned* bar, volatile LAS unsigned* st) {
    XcdBarrier b; b.bar = bar; b.x = xb_xcc_id(); b.st = st;
    if (threadIdx.x == 0) (void)xb_add(&bar[XB_XCNT(b.x)], 1u);
    return b;
}
__device__ __forceinline__ void xcd_barrier_complete(unsigned* bar, unsigned x, unsigned& nloc, unsigned& nx) {
    const unsigned G = gridDim.x * gridDim.y * gridDim.z;
    unsigned sum, cnt, mine, sp = 0u;
    for (;;) {
        sum = 0u; cnt = 0u; mine = 0u;
#pragma unroll
        for (unsigned j = 0; j < 16; ++j) { const unsigned c = xb_ld(&bar[XB_XCNT(j)]); sum += c; cnt += (c > 0u) ? 1u : 0u; mine = (j == x) ? c : mine; }
        if (sum == G) break;
        __builtin_amdgcn_s_sleep(1);
        if ((++sp & 255u) == 0u) { if (xb_ld(&bar[XB_TMO])) break; if (sp > XB_SPIN_CAP) { atomicAdd(&bar[XB_TMO], 1u); break; } }
    }
    nloc = mine > 0u ? mine : 1u; nx = cnt > 0u ? cnt : 1u;
}
__device__ __forceinline__ void xcd_barrier(const XcdBarrier& b) {
    asm volatile("s_waitcnt vmcnt(0)" ::: "memory");
    __syncthreads();
    if (threadIdx.x == 0) {
        unsigned* bar = b.bar;
        __builtin_amdgcn_s_waitcnt(0);
        unsigned nloc = b.st[0], nx = b.st[1];
        if (nloc == 0u) { xcd_barrier_complete(bar, b.x, nloc, nx); b.st[0] = nloc; b.st[1] = nx; }
        const unsigned old = xb_add(&bar[XB_XSUB(b.x)], 1u);
        const unsigned gen = old / nloc;
        if (old + 1u == (gen + 1u) * nloc) {
            __builtin_amdgcn_fence(__ATOMIC_RELEASE, "agent");
            asm volatile("s_waitcnt vmcnt(0)" ::: "memory");
            const unsigned og = xb_add(&bar[XB_TOP], 1u);
            const unsigned tg = og / nx;
            if (og + 1u == (tg + 1u) * nx) xb_add(&bar[XB_TOPGEN], 1u);
            else XB_SPIN(xb_ld(&bar[XB_TOPGEN]) == tg, bar);
            __builtin_amdgcn_fence(__ATOMIC_ACQUIRE, "agent");
            xb_add(&bar[XB_XGEN(b.x)], 1u);
            asm volatile("s_waitcnt vmcnt(0)" ::: "memory");
        } else {
            XB_SPIN(xb_ld(&bar[XB_XGEN(b.x)]) == gen, bar);
            __builtin_amdgcn_fence(__ATOMIC_ACQUIRE, "agent");
            asm volatile("s_waitcnt vmcnt(0)" ::: "memory");
        }
    }
    __syncthreads();
}

__global__ void __launch_bounds__(512, 2) fwd_megakernel(Params p) {
    extern __shared__ __attribute__((aligned(16))) unsigned char shm[];
    LAS unsigned char* lds = (LAS unsigned char*)shm;
    cg::grid_group grid = cg::this_grid();
    __shared__ uint4 xb_words;
    if (threadIdx.x == 0) xb_words = make_uint4(0u, 0u, 0u, 0u);
    __syncthreads();
    const XcdBarrier xb = xcd_barrier_post((unsigned*)(p.ws + WS_BAR), (volatile LAS unsigned*)&xb_words);
    const int G = gridDim.x, bid = blockIdx.x;
    float* XC = (float*)(p.ws + WS_XC);
    bf16_t* H = (bf16_t*)(p.ws + WS_H);
    bf16_t* BIG = (bf16_t*)(p.ws + WS_BIG);
    const float* ADA = (const float*)(p.ws + WS_ADA);

    phase_prep(p, lds);
    grid.sync();
    for (int l = 0; l < DEPTH; ++l) {
        const bool last = (l == DEPTH - 1);
        const float* ada_l = ADA + (size_t)l * 9 * 6144;
        const float* xl = (l == 0) ? p.in[0] : p.out;
        const float* xc = (l == 0) ? p.in[2] : XC;
        const int Mfull = last ? NLAT : NROW;
        phase_norm(xl, xc, p.in[6] + l * D, ada_l, 0, NROW, H);
        xcd_barrier(xb);
        { pg8::StaticOrder S; S.init(NROW, PW, G, bid);
          pg8::EpiBf16 E{BIG, PW, 0, 0};
          pg8::gemm_phase(lds, pg8::Gemm{H, (const bf16_t*)(p.ws + WS_WIN) + (size_t)l * PW * D, NROW, PW, D}, S, E); }
        xcd_barrier(xb);
        { const int ntile = (l == 0) ? (NROW / 128) * 4 : (NLAT / 128) * 4;
          const int nextra = (G > 128) ? ntile - SGU_IN_M2 : 0;
          for (int it = bid; it < 32 * NCH + nextra; it += G) { if (it < 32 * NCH) prep_item(p, l, it, lds); else sgu_tile(p, l, SGU_IN_M2 + it - 32 * NCH, lds); } }
        xcd_barrier(xb);
        phase_mixer(p, l, lds);
        xcd_barrier(xb);
        phase_combine(p, l, Mfull);
        xcd_barrier(xb);
        { pg8::StaticOrder S; S.init(Mfull, D, G, bid);
          pg8::EpiRes E{xl, p.out, xc, XC, ada_l + 2 * 1024};
          pg8::gemm_phase(lds, pg8::Gemm{H, (const bf16_t*)(p.ws + WS_WOUT) + (size_t)l * D * D, Mfull, D, D}, S, E); }
        xcd_barrier(xb);
        phase_norm(p.out, XC, p.in[7] + l * D, ada_l, 3, Mfull, H);
        xcd_barrier(xb);
        { pg8::StaticOrder S; S.init(Mfull, UPW, G, bid);
          pg8::EpiBf16 E{BIG, FF, FF, (size_t)NROW * FF};
          pg8::gemm_phase(lds, pg8::Gemm{H, (const bf16_t*)(p.ws + WS_WUP) + (size_t)l * UPW * D, Mfull, UPW, D}, S, E); }
        xcd_barrier(xb);
        phase_conv(p, l, Mfull);
        xcd_barrier(xb);
        { pg8::StaticOrder S; S.init(Mfull, D, G, bid);
          pg8::EpiRes E{p.out, p.out, XC, XC, ada_l + 5 * 1024};
          pg8::gemm_phase(lds, pg8::Gemm{BIG, (const bf16_t*)(p.ws + WS_WDOWN) + (size_t)l * D * FF, Mfull, D, FF}, S, E); }
        xcd_barrier(xb);
    }
    phase_final(p.out, p.in[21]);
}

extern "C" void kernel_launch(void* const* d_in, const int* in_sizes, int n_in, void* d_out, int out_size, void* d_ws, size_t ws_size, hipStream_t stream) {
    constexpr int LDS_BYTES = 155648;
    static int grid_blocks = 0;
    if (!grid_blocks) {
        int dev = 0, cus = 0, per_cu = 0;
        (void)hipGetDevice(&dev);
        (void)hipDeviceGetAttribute(&cus, hipDeviceAttributeMultiprocessorCount, dev);
        (void)hipFuncSetAttribute((const void*)fwd_megakernel, hipFuncAttributeMaxDynamicSharedMemorySize, LDS_BYTES);
        (void)hipOccupancyMaxActiveBlocksPerMultiprocessor(&per_cu, (const void*)fwd_megakernel, 512, LDS_BYTES);
        if (per_cu < 1) per_cu = 1;
        grid_blocks = cus * per_cu;
        if (ws_size < WS_END) fprintf(stderr, "workspace too small: %zu < %zu\n", ws_size, (size_t)WS_END);
    }
    Params p{};
    for (int i = 0; i < 22; ++i) p.in[i] = (const float*)d_in[i];
    p.out = (float*)d_out; p.ws = (unsigned char*)d_ws;
    (void)hipMemsetAsync((unsigned char*)d_ws + WS_BAR, 0, XCD_BAR_WORDS * 4, stream);
    void* args[] = {&p};
    hipError_t e = hipLaunchCooperativeKernel((const void*)fwd_megakernel, dim3(grid_blocks), dim3(512), args, LDS_BYTES, stream);
    if (e != hipSuccess) fprintf(stderr, "cooperative launch failed: %s (grid %d)\n", hipGetErrorString(e), grid_blocks);
}
```

```cpp
#include <hip/hip_runtime.h>
#include <hip/hip_cooperative_groups.h>
#include <cstdio>
namespace cg = cooperative_groups;

#define LAS __attribute__((address_space(3)))
typedef unsigned short bf16_t;
typedef short bf16x8 __attribute__((ext_vector_type(8)));
typedef float f32x4 __attribute__((ext_vector_type(4)));
typedef float f32x2 __attribute__((ext_vector_type(2)));
typedef unsigned u32x4 __attribute__((ext_vector_type(4)));
typedef unsigned u32x2 __attribute__((ext_vector_type(2)));
typedef __bf16 bf2_t __attribute__((ext_vector_type(2)));

constexpr int D = 1024, NB = 8, SEQ = 4096, DEPTH = 2, CTXL = 256;
constexpr int NLAT = NB * SEQ;
constexpr int NCTX = NB * CTXL;
constexpr int NROW = NLAT + NCTX;
constexpr int PW = 3584, FF = 2816, UPW = 2 * FF;
constexpr float EPS = 1e-6f;

constexpr size_t WS_WIN = 0;
constexpr size_t WS_WOUT = WS_WIN + (size_t)DEPTH * PW * D * 2;
constexpr size_t WS_WUP = WS_WOUT + (size_t)DEPTH * D * D * 2;
constexpr size_t WS_WDOWN = WS_WUP + (size_t)DEPTH * UPW * D * 2;
constexpr size_t WS_WSP = WS_WDOWN + (size_t)DEPTH * D * FF * 2;
constexpr size_t WS_ADA = WS_WSP + (size_t)DEPTH * 4 * 128 * 128 * 2;
constexpr size_t WS_LB = WS_ADA + (size_t)DEPTH * 9 * 6144 * 4;
constexpr size_t WS_XC = WS_LB + 2 * 512 * 4;
constexpr size_t WS_H = WS_XC + (size_t)NCTX * D * 4;
constexpr size_t WS_BIG = WS_H + (size_t)NROW * D * 2;
constexpr size_t WS_OFB = WS_BIG + (size_t)NROW * PW * 2;
constexpr size_t WS_QB = WS_OFB + 2 * (size_t)NROW * 512 * 2;
constexpr size_t WS_DS = WS_BIG + (size_t)NROW * UPW * 2;
constexpr size_t WS_BAR = WS_DS + (size_t)64 * 136 * 128 * 4;
constexpr size_t WS_END = WS_BAR + 16384;

struct Params {
    const float* in[22];
    float* out;
    unsigned char* ws;
};

__device__ __forceinline__ unsigned pk_bf16(float a, float b) { f32x2 v = {a, b}; bf2_t r = __builtin_convertvector(v, bf2_t); return __builtin_bit_cast(unsigned, r); }
__device__ __forceinline__ float bf_lo(unsigned u) { return __uint_as_float(u << 16); }
__device__ __forceinline__ float bf_hi(unsigned u) { return __uint_as_float(u & 0xffff0000u); }
__device__ __forceinline__ float bf1(bf16_t u) { return __uint_as_float(((unsigned)u) << 16); }
__device__ __forceinline__ bf16_t to_bf1(float a) { return (bf16_t)(pk_bf16(a, 0.f) & 0xffffu); }
__device__ __forceinline__ float fast_rcp(float x) { return __builtin_amdgcn_rcpf(x); }
__device__ __forceinline__ float gelu_f(float v) {
    const float av = fabsf(v), t = fast_rcp(av * 0.2316418882f + 1.0f);
    float q = t * 0.5307027145f + (-0.7265760135f); q = q * t + 0.7107068705f; q = q * t + (-0.142248368f); q = q * t + 0.127414796f; q = q * t;
    const float e = __builtin_amdgcn_exp2f((v * v) * (-0.72134752044f));
    const float m = v * (q * e);
    return v < 0.f ? m : v - m;
}
__device__ __forceinline__ int opaque_tid() { int t = threadIdx.x; asm volatile("" : "+v"(t)); return t; }
__device__ __forceinline__ float silu_f(float x) { return x * fast_rcp(1.0f + __expf(-x)); }

namespace pg8 {
constexpr int BM = 256, BK = 64, HALF = 128, HTB = HALF * BK * 2, STAGE_BYTES = 8 * HTB, NXCD = 8, WGM = 8;
__host__ __device__ __forceinline__ int lds_byte(int r, int c) { const int st = (r >> 4) * 2 + (c >> 5), rr = r & 15, cc = c & 31, ob = rr * 64 + cc * 2; return st * 1024 + (ob ^ (((ob >> 9) & 1) << 5)); }
__host__ __device__ __forceinline__ void stage_rc(int b, int& R, int& C) { const int st = b / 1024, sb = b % 1024, swz = sb ^ (((sb >> 9) & 1) << 5); R = (st >> 1) * 16 + swz / 64; C = (st & 1) * 32 + (swz % 64) / 2; }
__host__ __device__ __forceinline__ int perm32(int rho) { const int n = rho >> 4, i = rho & 15; return 8 * (i >> 2) + 4 * n + (i & 3); }
struct Unit { int pm, pn; };
struct Gemm { const bf16_t* A; const bf16_t* Bt; int M, N, K; };
struct StaticOrder {
    int nM, nN, nwg, G, c;
    __device__ void init(int M, int N, int G_, int c_) { nM = M / BM; nN = N / BM; nwg = nM * nN; G = G_; c = c_; }
    __device__ bool next(int i, Unit& u) const {
        const long L = (long)i * G + c; if (L >= nwg) return false;
        int wgid = (int)L; { const int q = nwg / NXCD, r = nwg % NXCD, xcd = wgid % NXCD, off = wgid / NXCD; wgid = (xcd < r ? xcd * (q + 1) : r * (q + 1) + (xcd - r) * q) + off; }
        const int nig = WGM * nN, gid = wgid / nig, fm = gid * WGM, gsz = (nM - fm) < WGM ? (nM - fm) : WGM;
        u.pm = fm + ((wgid % nig) % gsz); u.pn = (wgid % nig) / gsz; return true;
    }
    __device__ __forceinline__ void a_ready(const Unit&) const {}
    __device__ __forceinline__ void done(const Unit&) const {}
};
struct EpiBf16 {
    static constexpr bool PERM = true;
    bf16_t* O; int ldc; int split_cols; size_t split_stride;
    __device__ __forceinline__ void operator()(const f32x4 (&acc)[2][2][4][2], const Unit& u, int wr, int wc, int fr, int fq) const {
        const int row0 = u.pm * BM + wr * 64 + fr; int colt = u.pn * BM; bf16_t* base = O;
        if (split_cols) { const int t = colt / split_cols; base += (size_t)t * split_stride; colt -= t * split_cols; }
        const int col0 = colt + wc * 32 + 8 * fq;
#pragma unroll
        for (int ai = 0; ai < 2; ++ai)
#pragma unroll
            for (int m = 0; m < 4; ++m) { bf16_t* rowp = base + (size_t)(row0 + ai * HALF + m * 16) * ldc + col0;
#pragma unroll
                for (int bj = 0; bj < 2; ++bj) { const f32x4 v0 = acc[ai][bj][m][0], v1 = acc[ai][bj][m][1];
                    u32x4 w; w.x = pk_bf16(v0[0], v0[1]); w.y = pk_bf16(v0[2], v0[3]); w.z = pk_bf16(v1[0], v1[1]); w.w = pk_bf16(v1[2], v1[3]);
                    *(u32x4*)(rowp + bj * HALF) = w; } }
    }
};
struct EpiRes {
    static constexpr bool PERM = false;
    const float* resL; float* outL; const float* resC; float* outC; const float* gate;
    __device__ __forceinline__ void operator()(const f32x4 (&acc)[2][2][4][2], const Unit& u, int wr, int wc, int fr, int fq) const {
        const float* res; float* out; const float* g; int rowb;
        if (u.pm < NLAT / BM) { res = resL; out = outL; g = gate + (size_t)(u.pm >> 4) * 6144; rowb = u.pm * BM; }
        else { res = resC; out = outC; g = gate + (size_t)8 * 6144; rowb = u.pm * BM - NLAT; }
        const int row0 = rowb + wr * 64 + fr, col0 = u.pn * BM + wc * 32 + 4 * fq;
        f32x4 gv[2][2];
#pragma unroll
        for (int bj = 0; bj < 2; ++bj)
#pragma unroll
            for (int n = 0; n < 2; ++n) gv[bj][n] = *(const f32x4*)(g + col0 + bj * HALF + n * 16);
#pragma unroll
        for (int ai = 0; ai < 2; ++ai)
#pragma unroll
            for (int m = 0; m < 4; ++m) { const size_t ro = (size_t)(row0 + ai * HALF + m * 16) * D + col0;
#pragma unroll
                for (int bj = 0; bj < 2; ++bj)
#pragma unroll
                    for (int n = 0; n < 2; ++n) { const f32x4 r = *(const f32x4*)(res + ro + bj * HALF + n * 16);
                        *(f32x4*)(out + ro + bj * HALF + n * 16) = r + gv[bj][n] * acc[ai][bj][m][n]; } }
    }
};

template <class Epi, class Sched>
__device__ __forceinline__ void gemm_phase(LAS unsigned char* lds, const Gemm g, const Sched& S, const Epi& E) {
    const int tid = opaque_tid(), wid = __builtin_amdgcn_readfirstlane(tid >> 6), lane = tid & 63, wr = wid >> 2, wc = wid & 3, fr = lane & 15, fq = lane >> 4;
    const int K = g.K, nt = K / BK;
    unsigned voffA[2], voffB[2];
#pragma unroll
    for (int i = 0; i < 2; ++i) { int R, C; stage_rc(tid * 16 + i * 8192, R, C); const int Rb = Epi::PERM ? ((R & ~31) + perm32(R & 31)) : R;
        voffA[i] = (unsigned)(R * K + C) * 2u; voffB[i] = (unsigned)(Rb * K + C) * 2u; }
    const size_t kstep = (size_t)(BK * 2);
    const size_t hstep = (size_t)HALF * K * 2;
    const size_t tstep = 2 * hstep;
    const unsigned ldsw = (unsigned)wid * 1024u;
    const int aoff = lds_byte(wr * 64 + fr, fq * 8), boff = lds_byte(wc * 32 + fr, fq * 8);
#define PG8_SA(b, h) (((b) * 2 + (h)) * HTB)
#define PG8_SB(b, h) ((4 + (b) * 2 + (h)) * HTB)
#define PG8_STAGE(bufoff, gbase, voff) do { _Pragma("unroll") for (int _i = 0; _i < 2; ++_i) \
        __builtin_amdgcn_global_load_lds((const unsigned*)((const char*)(gbase) + (voff)[_i]), (LAS unsigned*)(lds + (bufoff) + ldsw + _i * 8192), 16, 0, 0); } while (0)
#define PG8_LDA(dst, b, h) do { _Pragma("unroll") for (int m = 0; m < 4; ++m) _Pragma("unroll") for (int k = 0; k < 2; ++k) dst[m][k] = *(const LAS bf16x8*)(lds + PG8_SA(b, h) + aoff + m * 2048 + k * 1024); } while (0)
#define PG8_LDB(dst, b, h) do { _Pragma("unroll") for (int n = 0; n < 2; ++n) _Pragma("unroll") for (int k = 0; k < 2; ++k) dst[n][k] = *(const LAS bf16x8*)(lds + PG8_SB(b, h) + boff + n * 2048 + k * 1024); } while (0)
#define PG8_MMA(ai, bj, At, Bt) do { __builtin_amdgcn_s_setprio(1); _Pragma("unroll") for (int m = 0; m < 4; ++m) _Pragma("unroll") for (int n = 0; n < 2; ++n) _Pragma("unroll") for (int k = 0; k < 2; ++k) \
        acc[ai][bj][m][n] = __builtin_amdgcn_mfma_f32_16x16x32_bf16(Bt[n][k], At[m][k], acc[ai][bj][m][n], 0, 0, 0); __builtin_amdgcn_s_setprio(0); } while (0)
#define PG8_WAIT_V(n) asm volatile("s_waitcnt vmcnt(" #n ")" ::: "memory")
#define PG8_WAIT_L(n) asm volatile("s_waitcnt lgkmcnt(" #n ")" ::: "memory")
#define PG8_BAR __builtin_amdgcn_s_barrier()
#define PG8_SCHED __builtin_amdgcn_sched_barrier(0)
    Unit cur, nxt; int ui = 0;
    if (!S.next(0, cur)) return;
    f32x4 acc[2][2][4][2];
#pragma unroll
    for (int a = 0; a < 2; ++a)
#pragma unroll
        for (int b = 0; b < 2; ++b)
#pragma unroll
            for (int m = 0; m < 4; ++m)
#pragma unroll
                for (int n = 0; n < 2; ++n) acc[a][b][m][n] = (f32x4){0.f, 0.f, 0.f, 0.f};
    bf16x8 At[4][2], B0[2][2], B1[2][2];
    const char* cA = (const char*)g.A + (size_t)cur.pm * tstep; const char* cB = (const char*)g.Bt + (size_t)cur.pn * tstep;
    S.a_ready(cur);
    PG8_STAGE(PG8_SB(0, 0), cB, voffB); PG8_STAGE(PG8_SA(0, 0), cA, voffA); PG8_STAGE(PG8_SB(0, 1), cB + hstep, voffB); PG8_STAGE(PG8_SA(0, 1), cA + hstep, voffA);
    if (wr == 1) PG8_BAR;
    PG8_WAIT_V(4); PG8_BAR;
    PG8_STAGE(PG8_SB(1, 0), cB + kstep, voffB); PG8_STAGE(PG8_SA(1, 0), cA + kstep, voffA); PG8_STAGE(PG8_SB(1, 1), cB + hstep + kstep, voffB);
    PG8_WAIT_V(6); PG8_BAR;
    for (;;) {
        const bool has_next = S.next(ui + 1, nxt);
        const char* nA = has_next ? (const char*)g.A + (size_t)nxt.pm * tstep : cA; const char* nB = has_next ? (const char*)g.Bt + (size_t)nxt.pn * tstep : cB;
        for (int t = 0; t < nt; t += 2) {
            const bool last = (t == nt - 2);
            const char* a1 = cA + (size_t)(t + 1) * kstep;
            const char* a2 = last ? nA : cA + (size_t)(t + 2) * kstep; const char* b2 = last ? nB : cB + (size_t)(t + 2) * kstep;
            const char* a3 = a2 + kstep; const char* b3 = b2 + kstep;
            if (last && has_next) S.a_ready(nxt);
            PG8_LDB(B0, 0, 0); PG8_SCHED; PG8_LDA(At, 0, 0); PG8_STAGE(PG8_SA(1, 1), a1 + hstep, voffA);
            PG8_WAIT_L(8); PG8_BAR; PG8_WAIT_L(0); PG8_MMA(0, 0, At, B0); PG8_BAR; PG8_SCHED;
            PG8_LDB(B1, 0, 1); PG8_STAGE(PG8_SB(0, 0), b2, voffB);
            PG8_BAR; PG8_WAIT_L(0); PG8_MMA(0, 1, At, B1); PG8_BAR;
            PG8_LDA(At, 0, 1); PG8_STAGE(PG8_SA(0, 0), a2, voffA);
            PG8_BAR; PG8_WAIT_L(0); PG8_MMA(1, 0, At, B0); PG8_BAR; PG8_SCHED;
            PG8_STAGE(PG8_SB(0, 1), b2 + hstep, voffB);
            PG8_WAIT_V(6); PG8_BAR; PG8_MMA(1, 1, At, B1); PG8_BAR;
            PG8_LDB(B0, 1, 0); PG8_SCHED; PG8_LDA(At, 1, 0); PG8_STAGE(PG8_SA(0, 1), a2 + hstep, voffA);
            PG8_WAIT_L(8); PG8_BAR; PG8_WAIT_L(0); PG8_MMA(0, 0, At, B0); PG8_BAR; PG8_SCHED;
            PG8_LDB(B1, 1, 1); PG8_STAGE(PG8_SB(1, 0), b3, voffB);
            PG8_BAR; PG8_WAIT_L(0); PG8_MMA(0, 1, At, B1); PG8_BAR;
            PG8_LDA(At, 1, 1); PG8_STAGE(PG8_SA(1, 0), a3, voffA);
            PG8_BAR; PG8_WAIT_L(0); PG8_MMA(1, 0, At, B0); PG8_BAR; PG8_SCHED;
            PG8_STAGE(PG8_SB(1, 1), b3 + hstep, voffB);
            PG8_WAIT_V(6); PG8_BAR; PG8_MMA(1, 1, At, B1); PG8_BAR;
        }
        E(acc, cur, wr, wc, fr, fq); S.done(cur);
        if (!has_next) break;
#pragma unroll
        for (int a = 0; a < 2; ++a)
#pragma unroll
            for (int b = 0; b < 2; ++b)
#pragma unroll
                for (int m = 0; m < 4; ++m)
#pragma unroll
                    for (int n = 0; n < 2; ++n) acc[a][b][m][n] = (f32x4){0.f, 0.f, 0.f, 0.f};
        cur = nxt; cA = nA; cB = nB; ++ui;
    }
    PG8_WAIT_V(0);
    if (wr == 0) PG8_BAR;
    PG8_BAR;
#undef PG8_SA
#undef PG8_SB
#undef PG8_STAGE
#undef PG8_LDA
#undef PG8_LDB
#undef PG8_MMA
#undef PG8_WAIT_V
#undef PG8_WAIT_L
#undef PG8_BAR
#undef PG8_SCHED
}
}

__device__ void phase_prep(const Params& p, LAS unsigned char* lds) {
    const int tid = opaque_tid();
    constexpr int NT_L = 896 + 256 + 1408 + 704;
    constexpr int J_ADA = 192, J_TR = J_ADA + 2 * NT_L, J_WSP = J_TR + 32, J_LB = J_WSP + 1;
    for (int job = blockIdx.x; job < J_LB; job += gridDim.x) {
        if (job < J_ADA) {
            LAS float* s = (LAS float*)lds;
            LAS float* red = (LAS float*)(lds + 9 * 1024 * 4);
            for (int i = tid; i < 9 * 1024; i += 512) { const int r = i >> 10, d = i & 1023; const float v = r < 8 ? p.in[1][r * 1024 + d] : p.in[3][d]; s[i] = silu_f(v); }
            __syncthreads();
            const int l = job / 96, e0 = (job % 96) * 64, col = tid & 63, dg = tid >> 6;
            const float* w = p.in[4] + ((size_t)l * 1024 + dg * 128) * 6144 + e0 + col;
            float acc[9];
#pragma unroll
            for (int r = 0; r < 9; ++r) acc[r] = 0.f;
            for (int dd = 0; dd < 128; ++dd) { const float wv = w[(size_t)dd * 6144];
#pragma unroll
                for (int r = 0; r < 9; ++r) acc[r] += s[r * 1024 + dg * 128 + dd] * wv; }
#pragma unroll
            for (int r = 0; r < 9; ++r) red[(dg * 9 + r) * 64 + col] = acc[r];
            __syncthreads();
            for (int i = tid; i < 9 * 64; i += 512) { const int r = i >> 6, c = i & 63; float a = 0.f;
#pragma unroll
                for (int g = 0; g < 8; ++g) a += red[(g * 9 + r) * 64 + c];
                ((float*)(p.ws + WS_ADA))[((size_t)l * 9 + r) * 6144 + e0 + c] = a + p.in[5][l * 6144 + e0 + c]; }
            __syncthreads();
        } else if (job < J_TR) {
            const int j = job - J_ADA, l = j / NT_L; int r = j % NT_L;
            const float* src; bf16_t* dst; int K, N;
            if (r < 896) { src = p.in[8] + (size_t)l * D * PW; dst = (bf16_t*)(p.ws + WS_WIN) + (size_t)l * PW * D; K = D; N = PW; }
            else if (r < 1152) { r -= 896; src = p.in[16] + (size_t)l * D * D; dst = (bf16_t*)(p.ws + WS_WOUT) + (size_t)l * D * D; K = D; N = D; }
            else if (r < 2560) { r -= 1152; src = p.in[17] + (size_t)l * D * UPW; dst = (bf16_t*)(p.ws + WS_WUP) + (size_t)l * UPW * D; K = D; N = UPW; }
            else { r -= 2560; src = p.in[20] + (size_t)l * FF * D; dst = (bf16_t*)(p.ws + WS_WDOWN) + (size_t)l * D * FF; K = FF; N = D; }
            const int ntn = N >> 6, kt = r / ntn, nt = r % ntn;
            LAS float* tile = (LAS float*)lds;
            { const int kk = tid >> 3, n8 = (tid & 7) * 8; const float* sp = src + (size_t)(kt * 64 + kk) * N + nt * 64 + n8;
              const f32x4 a = *(const f32x4*)sp, b = *(const f32x4*)(sp + 4);
              LAS float* tp = tile + kk * 65 + n8; tp[0] = a[0]; tp[1] = a[1]; tp[2] = a[2]; tp[3] = a[3]; tp[4] = b[0]; tp[5] = b[1]; tp[6] = b[2]; tp[7] = b[3]; }
            __syncthreads();
            { const int nn = tid >> 3, k8 = (tid & 7) * 8; float v[8];
#pragma unroll
              for (int i = 0; i < 8; ++i) v[i] = tile[(k8 + i) * 65 + nn];
              u32x4 w; w.x = pk_bf16(v[0], v[1]); w.y = pk_bf16(v[2], v[3]); w.z = pk_bf16(v[4], v[5]); w.w = pk_bf16(v[6], v[7]);
              *(u32x4*)(dst + (size_t)(nt * 64 + nn) * K + kt * 64 + k8) = w; }
            __syncthreads();
        } else if (job < J_WSP) {
            const int j = job - J_TR; const size_t i0 = (size_t)j * 4096 + tid * 8;
            const f32x4 a = *(const f32x4*)(p.in[14] + i0), b = *(const f32x4*)(p.in[14] + i0 + 4);
            u32x4 w; w.x = pk_bf16(a[0], a[1]); w.y = pk_bf16(a[2], a[3]); w.z = pk_bf16(b[0], b[1]); w.w = pk_bf16(b[2], b[3]);
            *(u32x4*)((bf16_t*)(p.ws + WS_WSP) + i0) = w;
        } else {
            for (int i = tid; i < 1024; i += 512) { const int dir = i >> 9, c = i & 511; const float* lg = dir ? p.in[10] : p.in[9];
                const float l0 = lg[c], l1 = lg[512 + c]; ((float*)(p.ws + WS_LB))[i] = 1.0f / (1.0f + expf(l0 - l1)); }
        }
    }
}

__device__ void phase_norm(const float* xl, const float* xc, const bf16_t* Y, const float* gate  , float* xl_dst, float* xc_dst,
                           const float* gain, const float* ada_l, int shift_idx, int nrows, bf16_t* H) {
    const int tid_ = opaque_tid(); const int wave = tid_ >> 6, lane = tid_ & 63;
    for (int rr = (blockIdx.x * 8 + wave) * 2; rr < nrows; rr += gridDim.x * 16) {
        const int row = nrows - 2 - rr;
        const float* src[2]; const float* mod[2]; float* dst[2]; const float* gt[2];
#pragma unroll
        for (int u = 0; u < 2; ++u) { const int r = row + u;
            if (r < NLAT) { src[u] = xl + (size_t)r * D; mod[u] = ada_l + (size_t)(r >> 12) * 6144; dst[u] = xl_dst ? xl_dst + (size_t)r * D : nullptr; gt[u] = gate + (size_t)(r >> 12) * 6144; }
            else { src[u] = xc + (size_t)(r - NLAT) * D; mod[u] = ada_l + (size_t)8 * 6144; dst[u] = xc_dst ? xc_dst + (size_t)(r - NLAT) * D : nullptr; gt[u] = gate + (size_t)8 * 6144; } }
        f32x4 v[2][4]; u32x2 yv[2][4];
#pragma unroll
        for (int u = 0; u < 2; ++u)
#pragma unroll
            for (int j = 0; j < 4; ++j) { v[u][j] = *(const f32x4*)(src[u] + j * 256 + lane * 4); if (Y) yv[u][j] = *(const u32x2*)(Y + (size_t)(row + u) * D + j * 256 + lane * 4); }
#pragma unroll
        for (int u = 0; u < 2; ++u) {
            if (Y) {
#pragma unroll
                for (int j = 0; j < 4; ++j) { const f32x4 g = *(const f32x4*)(gt[u] + j * 256 + lane * 4);
                    v[u][j][0] += g[0] * bf_lo(yv[u][j].x); v[u][j][1] += g[1] * bf_hi(yv[u][j].x); v[u][j][2] += g[2] * bf_lo(yv[u][j].y); v[u][j][3] += g[3] * bf_hi(yv[u][j].y);
                    if (dst[u]) *(f32x4*)(dst[u] + j * 256 + lane * 4) = v[u][j]; }
            }
            float ss = 0.f;
#pragma unroll
            for (int j = 0; j < 4; ++j) ss += v[u][j][0] * v[u][j][0] + v[u][j][1] * v[u][j][1] + v[u][j][2] * v[u][j][2] + v[u][j][3] * v[u][j][3];
#pragma unroll
            for (int o = 32; o > 0; o >>= 1) ss += __shfl_xor(ss, o);
            const float rs = rsqrtf(ss * (1.0f / D) + EPS);
#pragma unroll
            for (int j = 0; j < 4; ++j) { const int d = j * 256 + lane * 4;
                const f32x4 g = *(const f32x4*)(gain + d), sh = *(const f32x4*)(mod[u] + shift_idx * 1024 + d), sc = *(const f32x4*)(mod[u] + (shift_idx + 1) * 1024 + d);
                f32x4 y = v[u][j] * rs * g; y = y * (sc + 1.0f) + sh;
                u32x2 wv; wv.x = pk_bf16(y[0], y[1]); wv.y = pk_bf16(y[2], y[3]);
                *(u32x2*)(H + (size_t)(row + u) * D + d) = wv; }
        }
    }
}
__device__ void phase_final(float* x, const bf16_t* Y, const float* gate, const float* gain) {
    const int tid_ = opaque_tid(); const int wave = tid_ >> 6, lane = tid_ & 63;
    for (int row = (blockIdx.x * 8 + wave) * 2; row < NLAT; row += gridDim.x * 16) {
        f32x4 v[2][4]; u32x2 yv[2][4];
#pragma unroll
        for (int u = 0; u < 2; ++u)
#pragma unroll
            for (int j = 0; j < 4; ++j) { v[u][j] = *(const f32x4*)(x + (size_t)(row + u) * D + j * 256 + lane * 4); yv[u][j] = *(const u32x2*)(Y + (size_t)(row + u) * D + j * 256 + lane * 4); }
#pragma unroll
        for (int u = 0; u < 2; ++u) {
            const float* gt = gate + (size_t)((row + u) >> 12) * 6144;
            float ss = 0.f;
#pragma unroll
            for (int j = 0; j < 4; ++j) { const f32x4 g = *(const f32x4*)(gt + j * 256 + lane * 4);
                v[u][j][0] += g[0] * bf_lo(yv[u][j].x); v[u][j][1] += g[1] * bf_hi(yv[u][j].x); v[u][j][2] += g[2] * bf_lo(yv[u][j].y); v[u][j][3] += g[3] * bf_hi(yv[u][j].y);
                ss += v[u][j][0] * v[u][j][0] + v[u][j][1] * v[u][j][1] + v[u][j][2] * v[u][j][2] + v[u][j][3] * v[u][j][3]; }
#pragma unroll
            for (int o = 32; o > 0; o >>= 1) ss += __shfl_xor(ss, o);
            const float rs = rsqrtf(ss * (1.0f / D) + EPS);
#pragma unroll
            for (int j = 0; j < 4; ++j) { const int d = j * 256 + lane * 4; const f32x4 g = *(const f32x4*)(gain + d); *(f32x4*)(x + (size_t)(row + u) * D + d) = v[u][j] * rs * g; }
        }
    }
}

constexpr int QS_ST = 136, KT_ST = 40;
constexpr int P1_QS = 0, P1_KH = P1_QS + 32 * QS_ST * 2, P1_VT = P1_KH + 32 * QS_ST * 2, P1_KT = P1_VT + 128 * KT_ST * 2, P1_AW = P1_KT + 128 * KT_ST * 2;
constexpr int P1_DIRSZ = P1_AW + 8 * 32 * KT_ST * 2;
constexpr int NCH = 8 + 128;

template <int CTRL, int RMASK> __device__ __forceinline__ float dpp_mul(float x) {
    const int t = __builtin_amdgcn_update_dpp(0x3f800000, __builtin_bit_cast(int, x), CTRL, RMASK, 0xf, false);
    return x * __builtin_bit_cast(float, t);
}
__device__ __forceinline__ float cumprod32(float x) {
    x = dpp_mul<0x111, 0xf>(x); x = dpp_mul<0x112, 0xf>(x); x = dpp_mul<0x114, 0xf>(x); x = dpp_mul<0x118, 0xf>(x);
    x = dpp_mul<0x142, 0xa>(x);
    return x;
}

#define DPP8_STEP(CTRL) asm volatile("s_nop 1\n\t" \
    "v_mul_f32_dpp %0, %0, %0 " CTRL "\n\tv_mul_f32_dpp %1, %1, %1 " CTRL "\n\tv_mul_f32_dpp %2, %2, %2 " CTRL "\n\tv_mul_f32_dpp %3, %3, %3 " CTRL "\n\t" \
    "v_mul_f32_dpp %4, %4, %4 " CTRL "\n\tv_mul_f32_dpp %5, %5, %5 " CTRL "\n\tv_mul_f32_dpp %6, %6, %6 " CTRL "\n\tv_mul_f32_dpp %7, %7, %7 " CTRL "\n\ts_nop 1" \
    : "+v"(e[0]), "+v"(e[1]), "+v"(e[2]), "+v"(e[3]), "+v"(e[4]), "+v"(e[5]), "+v"(e[6]), "+v"(e[7]))
__device__ __forceinline__ void cumprod32x8(float (&e)[8]) {
    asm volatile("s_nop 4" ::: );
    DPP8_STEP("row_shr:1 row_mask:0xf bank_mask:0xf");
    DPP8_STEP("row_shr:2 row_mask:0xf bank_mask:0xf");
    DPP8_STEP("row_shr:4 row_mask:0xf bank_mask:0xf");
    DPP8_STEP("row_shr:8 row_mask:0xf bank_mask:0xf");
    DPP8_STEP("row_bcast:15 row_mask:0xa bank_mask:0xf");
}
__device__ void prep_item(const Params& p, int l, int item, LAS unsigned char* lds) {
    const int tid = opaque_tid(), w = tid >> 6, lane = tid & 63;
    const int tau = lane & 31, kh = lane >> 5, k0 = 16 * w + 8 * kh, l15 = lane & 15, q4 = lane >> 4;
    const int ci = item % NCH, bh = item / NCH, h = bh & 3, b = bh >> 2;
    const int R0 = ci < 8 ? NLAT + b * 256 + 32 * ci : b * 4096 + 32 * (ci - 8);
    bf16_t* P = (bf16_t*)(p.ws + WS_BIG);
    const bool first = (l == 0);
    const bool want_out = first || ci >= 8;
    for (int dd = 0; dd < 2; ++dd) { LAS unsigned* az = (LAS unsigned*)(lds + dd * P1_DIRSZ + P1_AW) + w * (32 * KT_ST / 2); for (int i = lane; i < 32 * KT_ST / 2; i += 64) az[i] = 0u; }
    u32x4 rf0, rq0, rv0, rf1, rq1, rv1;
    { const bf16_t* rp = P + (size_t)(R0 + tau) * PW; rf0 = *(const u32x4*)(rp + h * 128 + k0); rq0 = *(const u32x4*)(rp + 1536 + h * 128 + k0); rv0 = *(const u32x4*)(rp + 1024 + h * 128 + k0); }
    { const bf16_t* rp = P + (size_t)(R0 + 31 - tau) * PW; rf1 = *(const u32x4*)(rp + 512 + h * 128 + k0); rq1 = *(const u32x4*)(rp + 1536 + h * 128 + k0); rv1 = *(const u32x4*)(rp + 1024 + h * 128 + k0); }
    asm volatile("s_waitcnt vmcnt(0)" ::: "memory");
    __syncthreads();
    auto valu_part = [&](const int dir, const u32x4& f, const u32x4& q, const u32x4& v) {
        LAS unsigned char* db = lds + dir * P1_DIRSZ;
        LAS bf16_t* Qs = (LAS bf16_t*)(db + P1_QS); LAS bf16_t* Kh = (LAS bf16_t*)(db + P1_KH);
        LAS bf16_t* Vt = (LAS bf16_t*)(db + P1_VT); LAS bf16_t* Kt = (LAS bf16_t*)(db + P1_KT);
        LAS bf16_t* Aw = (LAS bf16_t*)(db + P1_AW) + w * 32 * KT_ST;
        const int tokl = dir ? 31 - tau : tau;
        const float* lbp = (const float*)(p.ws + WS_LB) + dir * 512 + h * 128 + k0;
        float E[8], kk[8];
#pragma unroll
        for (int j = 0; j < 8; ++j) {
            const unsigned fw = f[j >> 1]; const float x = (j & 1) ? bf_hi(fw) : bf_lo(fw);
            const float e = __expf(-fabsf(x)), r = fast_rcp(1.0f + e);
            const float sp = x >= 0.f ? r : e * r, sn = x >= 0.f ? e * r : r;
            if (first) { E[j] = sp; kk[j] = sn; }
            else { const float lb = lbp[j]; const float gate = lb + (1.0f - lb) * sp; E[j] = gate; kk[j] = 1.0f - gate; }
        }
        float qt[8], kh_[8], kt_[8], Tj[8];
        cumprod32x8(E);
#pragma unroll
        for (int j = 0; j < 8; ++j) {
            const float Ej = fmaxf(E[j], 1e-35f);
            const float T0 = __builtin_bit_cast(float, __builtin_amdgcn_readlane(__builtin_bit_cast(int, Ej), 31)), T1 = __builtin_bit_cast(float, __builtin_amdgcn_readlane(__builtin_bit_cast(int, Ej), 63));
            const float T = kh ? T1 : T0;
            const unsigned qw = q[j >> 1]; const float qx = (j & 1) ? bf_hi(qw) : bf_lo(qw);
            qt[j] = silu_f(qx) * 0.08838834764831845f * Ej;
            kh_[j] = kk[j] * fast_rcp(Ej); kt_[j] = kh_[j] * T;
            Tj[j] = T;
        }
        if (tau == 31) { float* dp = (float*)(p.ws + WS_DS) + ((size_t)((b * 4 + h) * 2 + dir) * NCH + ci) * 128 + k0;
            *(f32x4*)dp = (f32x4){Tj[0], Tj[1], Tj[2], Tj[3]}; *(f32x4*)(dp + 4) = (f32x4){Tj[4], Tj[5], Tj[6], Tj[7]}; }
        u32x4 wq, wk; wq.x = pk_bf16(qt[0], qt[1]); wq.y = pk_bf16(qt[2], qt[3]); wq.z = pk_bf16(qt[4], qt[5]); wq.w = pk_bf16(qt[6], qt[7]);
        wk.x = pk_bf16(kh_[0], kh_[1]); wk.y = pk_bf16(kh_[2], kh_[3]); wk.z = pk_bf16(kh_[4], kh_[5]); wk.w = pk_bf16(kh_[6], kh_[7]);
        *(LAS u32x4*)(Qs + tau * QS_ST + k0) = wq; *(LAS u32x4*)(Kh + tau * QS_ST + k0) = wk;
        {
          bf16_t* qd = (dir == 0) ? P + (size_t)(R0 + tokl) * PW + 1536 + h * 128 : (bf16_t*)(p.ws + WS_QB) + (size_t)(R0 + tokl) * 512 + h * 128;
          const int a32 = k0 & ~31, kkA = k0 & 31, kkB = kkA + 4;
          u32x2 pa, pb; pa.x = wq.x; pa.y = wq.y; pb.x = wq.z; pb.y = wq.w;
          *(u32x2*)(qd + a32 + 8 * ((kkA & 15) >> 2) + 4 * (kkA >> 4)) = pa;
          *(u32x2*)(qd + a32 + 8 * ((kkB & 15) >> 2) + 4 * (kkB >> 4)) = pb; }
#pragma unroll
        for (int j = 0; j < 8; ++j) { Kt[(k0 + j) * KT_ST + tokl] = to_bf1(kt_[j]); const unsigned vw = v[j >> 1]; Vt[(k0 + j) * KT_ST + tau] = (bf16_t)((j & 1) ? (vw >> 16) : (vw & 0xffffu)); }
    };
    auto mfma_part = [&](const int dir) {
        LAS unsigned char* db = lds + dir * P1_DIRSZ;
        LAS bf16_t* Qs = (LAS bf16_t*)(db + P1_QS); LAS bf16_t* Kh = (LAS bf16_t*)(db + P1_KH);
        LAS bf16_t* Vt = (LAS bf16_t*)(db + P1_VT); LAS bf16_t* Kt = (LAS bf16_t*)(db + P1_KT);
        LAS bf16_t* Aw = (LAS bf16_t*)(db + P1_AW) + w * 32 * KT_ST;
        const int tokl = dir ? 31 - tau : tau; (void)tokl;
        if (want_out) {
            f32x4 a00 = (f32x4){0.f, 0.f, 0.f, 0.f}, a10 = a00, a11 = a00;
#pragma unroll
            for (int kb = 0; kb < 4; ++kb) {
                const bf16x8 qn0 = *(const LAS bf16x8*)(Qs + l15 * QS_ST + 32 * kb + 8 * q4), qn1 = *(const LAS bf16x8*)(Qs + (16 + l15) * QS_ST + 32 * kb + 8 * q4);
                const bf16x8 kh0 = *(const LAS bf16x8*)(Kh + l15 * QS_ST + 32 * kb + 8 * q4), kh1 = *(const LAS bf16x8*)(Kh + (16 + l15) * QS_ST + 32 * kb + 8 * q4);
                a00 = __builtin_amdgcn_mfma_f32_16x16x32_bf16(qn0, kh0, a00, 0, 0, 0);
                a10 = __builtin_amdgcn_mfma_f32_16x16x32_bf16(qn1, kh0, a10, 0, 0, 0);
                a11 = __builtin_amdgcn_mfma_f32_16x16x32_bf16(qn1, kh1, a11, 0, 0, 0);
            }
#pragma unroll
            for (int i = 0; i < 4; ++i) { const int t = 4 * q4 + i; const bool keep = l15 <= t;
                Aw[t * KT_ST + l15] = to_bf1(keep ? a00[i] : 0.f);
                Aw[(16 + t) * KT_ST + l15] = to_bf1(a10[i]);
                Aw[(16 + t) * KT_ST + 16 + l15] = to_bf1(keep ? a11[i] : 0.f); }
            asm volatile("s_waitcnt lgkmcnt(0)" ::: "memory");
            const bf16x8 vf = *(const LAS bf16x8*)(Vt + (16 * w + l15) * KT_ST + 8 * q4);
            bf16_t* OFB = (bf16_t*)(p.ws + WS_OFB) + (size_t)dir * NROW * 512;
#pragma unroll
            for (int mt = 0; mt < 2; ++mt) {
                const bf16x8 af = *(const LAS bf16x8*)(Aw + (16 * mt + l15) * KT_ST + 8 * q4);
                const f32x4 o = __builtin_amdgcn_mfma_f32_16x16x32_bf16(vf, af, (f32x4){0.f, 0.f, 0.f, 0.f}, 0, 0, 0);
                const int tl = 16 * mt + l15, tok = dir ? 31 - tl : tl;
                u32x2 wv; wv.x = pk_bf16(o[0], o[1]); wv.y = pk_bf16(o[2], o[3]);
                *(u32x2*)(OFB + (size_t)(R0 + tok) * 512 + h * 128 + 16 * w + 4 * q4) = wv;
            }
        }
        { const int k = tid >> 2, part = tid & 3;
          const u32x4 kv = *(const LAS u32x4*)(Kt + k * KT_ST + 8 * part);
          bf16_t* dst = P + (size_t)(R0 + (k >> 2)) * PW + h * 128 + (k & 3) * 32 + (part ^ ((k >> 2) & 3)) * 8;
          *(u32x4*)(dst + dir * 512) = kv;
          if (dir == 0) { const u32x4 vv = *(const LAS u32x4*)(Vt + k * KT_ST + 8 * part); *(u32x4*)(dst + 1024) = vv; } }
    };
    valu_part(0, rf0, rq0, rv0);
    valu_part(1, rf1, rq1, rv1);
    __syncthreads();
    mfma_part(0);
    mfma_part(1);
    __syncthreads();
}

constexpr int ST_Q = 0, ST_K = 8192, ST_V = 16384, ST_O = 20480, ST_D = 24576, ST_BYTES = 25088, NSTAGE = 6;
__device__ void scan_chain(const Params& p, int l, int chain, int vhalf, LAS unsigned char* lds) {
    const int tid = opaque_tid(), w = __builtin_amdgcn_readfirstlane(tid >> 6), lane = tid & 63, l15 = lane & 15, q4 = lane >> 4;
    const int dir = chain & 1, h = (chain >> 1) & 3, b = chain >> 3;
    bf16_t* P = (bf16_t*)(p.ws + WS_BIG);
    auto chunk_of = [&](int s) -> int { return dir ? (s < 8 ? 7 - s : 143 - s) : s; };
    auto row0_of = [&](int c) -> int { return c < 8 ? NLAT + b * 256 + 32 * c : b * 4096 + 32 * (c - 8); };
    bf16_t* qb = dir ? (bf16_t*)(p.ws + WS_QB) + h * 128 : P + 1536 + h * 128;
    const int qpitch = dir ? 512 : PW;
    if (w >= 4) {
        const int lw = w - 4;
        const int r16 = lane >> 4, s16 = lane & 15;
        size_t qoff[2], koff[2];
#pragma unroll
        for (int i = 0; i < 2; ++i) { const int row = 8 * lw + 4 * i + r16; qoff[i] = (size_t)row * qpitch + ((s16 ^ (row & 15)) * 8);
            koff[i] = (size_t)(4 * (2 * lw + i) + r16) * PW + dir * 512 + h * 128 + s16 * 8; }
        const size_t voff = (size_t)(16 * vhalf + 4 * lw + r16) * PW + 1024 + h * 128 + s16 * 8;
        const float* dsrc = (const float*)(p.ws + WS_DS) + (size_t)chain * NCH * 128 + (lw & 1) * 64 + lane;
        const int orow = 8 * lw + (lane >> 3);
        const size_t ooff = (size_t)orow * 512 + h * 128 + 64 * vhalf + (((lane & 7) ^ (orow & 7)) * 8);
        const bf16_t* OFBc = (const bf16_t*)(p.ws + WS_OFB) + (size_t)dir * NROW * 512;
        auto issue = [&](int s) {
            const int sc = s < NCH ? s : NCH - 1;
            const int c = chunk_of(sc), R0 = row0_of(c);
            LAS unsigned char* st = lds + (s % NSTAGE) * ST_BYTES;
            const bf16_t* qrow = qb + (size_t)R0 * qpitch; const bf16_t* krow = P + (size_t)R0 * PW;
#pragma unroll
            for (int i = 0; i < 2; ++i) {
                __builtin_amdgcn_global_load_lds((const unsigned*)(qrow + qoff[i]), (LAS unsigned*)(st + ST_Q + (2 * lw + i) * 1024), 16, 0, 0);
                __builtin_amdgcn_global_load_lds((const unsigned*)(krow + koff[i]), (LAS unsigned*)(st + ST_K + (2 * lw + i) * 1024), 16, 0, 0);
            }
            __builtin_amdgcn_global_load_lds((const unsigned*)(krow + voff), (LAS unsigned*)(st + ST_V + lw * 1024), 16, 0, 0);
            __builtin_amdgcn_global_load_lds((const unsigned*)(dsrc + (size_t)c * 128), (LAS unsigned*)(st + ST_D + (lw & 1) * 256), 4, 0, 0);
            __builtin_amdgcn_global_load_lds((const unsigned*)(OFBc + (size_t)R0 * 512 + ooff), (LAS unsigned*)(st + ST_O + lw * 1024), 16, 0, 0);
        };
        issue(0); issue(1); issue(2); issue(3); issue(4);
        asm volatile("s_waitcnt vmcnt(28)" ::: "memory");
        __builtin_amdgcn_s_barrier();
        for (int s = 0; s < NCH; ++s) {
            issue(s + 5);
            asm volatile("s_waitcnt vmcnt(28)" ::: "memory");
            __builtin_amdgcn_s_barrier();
        }
        asm volatile("s_waitcnt vmcnt(0)" ::: "memory");
    } else {
        f32x4 S[8];
#pragma unroll
        for (int j = 0; j < 8; ++j) S[j] = (f32x4){0.f, 0.f, 0.f, 0.f};
        const int swz = (l15 >> 2) & 3, vcol = 64 * vhalf + 16 * w;
        bf16_t* OFBw = (bf16_t*)(p.ws + WS_OFB) + (size_t)dir * NROW * 512;
        __builtin_amdgcn_s_barrier();
        for (int s = 0; s < NCH; ++s) {
            LAS unsigned char* st = lds + (s % NSTAGE) * ST_BYTES;
            bf16x8 qf[4][2], kf[8]; f32x4 dv[8];
#pragma unroll
            for (int kb = 0; kb < 4; ++kb)
#pragma unroll
                for (int mt = 0; mt < 2; ++mt) {
                    qf[kb][mt] = *(const LAS bf16x8*)(st + ST_Q + (16 * mt + l15) * 256 + (((4 * kb + q4) ^ l15) * 16));
                }
            const bf16x8 vf = *(const LAS bf16x8*)(st + ST_V + (16 * w + l15) * 64 + ((q4 ^ swz) * 16));
            u32x2 oi[2];
#pragma unroll
            for (int mt = 0; mt < 2; ++mt) { const int tr = 16 * mt + l15; oi[mt] = *(const LAS u32x2*)(st + ST_O + tr * 128 + (((2 * w + (q4 >> 1)) ^ (tr & 7)) * 16) + (q4 & 1) * 8); }
#pragma unroll
            for (int j = 0; j < 8; ++j) { dv[j] = *(const LAS f32x4*)(st + ST_D + (16 * j + 4 * q4) * 4); kf[j] = *(const LAS bf16x8*)(st + ST_K + (16 * j + l15) * 64 + ((q4 ^ swz) * 16)); }
            __builtin_amdgcn_sched_barrier(0);
            f32x4 o[2]; o[0] = (f32x4){0.f, 0.f, 0.f, 0.f}; o[1] = o[0];
#pragma unroll
            for (int kb = 0; kb < 4; ++kb) {
                u32x4 sb; sb.x = pk_bf16(S[2 * kb][0], S[2 * kb][1]); sb.y = pk_bf16(S[2 * kb][2], S[2 * kb][3]); sb.z = pk_bf16(S[2 * kb + 1][0], S[2 * kb + 1][1]); sb.w = pk_bf16(S[2 * kb + 1][2], S[2 * kb + 1][3]);
                const bf16x8 sfr = __builtin_bit_cast(bf16x8, sb);
                o[0] = __builtin_amdgcn_mfma_f32_16x16x32_bf16(sfr, qf[kb][0], o[0], 0, 0, 0);
                o[1] = __builtin_amdgcn_mfma_f32_16x16x32_bf16(sfr, qf[kb][1], o[1], 0, 0, 0);
            }
#pragma unroll
            for (int j = 0; j < 8; ++j) S[j] = __builtin_amdgcn_mfma_f32_16x16x32_bf16(kf[j], vf, S[j] * dv[j], 0, 0, 0);
            const int R0 = row0_of(chunk_of(s));
#pragma unroll
            for (int mt = 0; mt < 2; ++mt) { const int tr = 16 * mt + l15;
                u32x2 wv; wv.x = pk_bf16(o[mt][0] + bf_lo(oi[mt].x), o[mt][1] + bf_hi(oi[mt].x)); wv.y = pk_bf16(o[mt][2] + bf_lo(oi[mt].y), o[mt][3] + bf_hi(oi[mt].y));
                *(u32x2*)(OFBw + (size_t)(R0 + tr) * 512 + h * 128 + vcol + 4 * q4) = wv; }
            asm volatile("s_waitcnt lgkmcnt(0)" ::: "memory");
            __builtin_amdgcn_s_barrier();
        }
    }
}

constexpr int SG_ST = 136;
__device__ void sgu_tile(const Params& p, int l, int tile, LAS unsigned char* lds) {
    const int tid = opaque_tid(), w = tid >> 6, lane = tid & 63, l15 = lane & 15, q4 = lane >> 4;
    const int h = tile & 3, rowbase = (tile >> 2) * 128;
    const bf16_t* P = (const bf16_t*)(p.ws + WS_BIG);
    bf16_t* O = (bf16_t*)(p.ws + WS_H);
    LAS bf16_t* Vt = (LAS bf16_t*)lds;
    {
        const int q = tid >> 2, cgp = tid & 3;
        const bf16_t* vp = P + (size_t)(rowbase + q) * PW + 3072 + 128 * h + 32 * cgp;
        float g[32];
#pragma unroll
        for (int i = 0; i < 4; ++i) { const u32x4 r = *(const u32x4*)(vp + 8 * i);
#pragma unroll
            for (int j = 0; j < 4; ++j) { g[8 * i + 2 * j] = gelu_f(bf_lo(r[j])); g[8 * i + 2 * j + 1] = gelu_f(bf_hi(r[j])); } }
        float s = 0.f;
#pragma unroll
        for (int i = 0; i < 32; ++i) s += g[i];
        s += __shfl_xor(s, 1); s += __shfl_xor(s, 2);
        const float mu = s * (1.0f / 128.f);
        float vs = 0.f;
#pragma unroll
        for (int i = 0; i < 32; ++i) { const float d = g[i] - mu; vs += d * d; }
        vs += __shfl_xor(vs, 1); vs += __shfl_xor(vs, 2);
        const float rstd = rsqrtf(vs * (1.0f / 128.f) + EPS);
        const float* lng = p.in[12] + l * 512 + h * 128 + 32 * cgp; const float* lnb = p.in[13] + l * 512 + h * 128 + 32 * cgp;
#pragma unroll
        for (int i = 0; i < 32; ++i) { const float y = (g[i] - mu) * rstd * lng[i] + lnb[i]; Vt[(32 * cgp + i) * SG_ST + q] = to_bf1(y); }
    }
    __syncthreads();
    {
        const int prow = 16 * w + l15;
        const bf16_t* wsp = (const bf16_t*)(p.ws + WS_WSP) + ((size_t)(l * 4 + h) * 128 + prow) * 128 + 8 * q4;
        bf16x8 wf[4];
#pragma unroll
        for (int kb = 0; kb < 4; ++kb) wf[kb] = *(const bf16x8*)(wsp + 32 * kb);
        const float bs = p.in[15][(l * 4 + h) * 128 + prow];
        const bf16_t* up = P + (size_t)(rowbase + prow) * PW + 2560 + 128 * h + 4 * q4;
        bf16_t* op = O + (size_t)(rowbase + prow) * D + 512 + 128 * h + 4 * q4;
        u32x2 uall[8];
#pragma unroll
        for (int mt = 0; mt < 8; ++mt) uall[mt] = *(const u32x2*)(up + 16 * mt);
#pragma unroll
        for (int mt = 0; mt < 8; ++mt) {
            f32x4 acc = (f32x4){0.f, 0.f, 0.f, 0.f};
#pragma unroll
            for (int kb = 0; kb < 4; ++kb) { const bf16x8 af = *(const LAS bf16x8*)(Vt + (16 * mt + l15) * SG_ST + 32 * kb + 8 * q4);
                acc = __builtin_amdgcn_mfma_f32_16x16x32_bf16(af, wf[kb], acc, 0, 0, 0); }
            const u32x2 uu = uall[mt];
            const float u0 = gelu_f(bf_lo(uu.x)), u1 = gelu_f(bf_hi(uu.x)), u2 = gelu_f(bf_lo(uu.y)), u3 = gelu_f(bf_hi(uu.y));
            u32x2 wv; wv.x = pk_bf16(u0 * (acc[0] + bs), u1 * (acc[1] + bs)); wv.y = pk_bf16(u2 * (acc[2] + bs), u3 * (acc[3] + bs));
            *(u32x2*)(op + 16 * mt) = wv;
        }
    }
    __syncthreads();
}

constexpr int SGU_IN_M2 = 1088;
__device__ void phase_mixer(const Params& p, int l, LAS unsigned char* lds) {
    const int G = gridDim.x, bid = blockIdx.x;
    const int ntile = (l == 0) ? (NROW / 128) * 4 : (NLAT / 128) * 4;
    if (G > 128) {
        if (bid < 128) scan_chain(p, l, bid >> 1, bid & 1, lds);
        else for (int t = bid - 128; t < (ntile < SGU_IN_M2 ? ntile : SGU_IN_M2); t += G - 128) sgu_tile(p, l, t, lds);
    } else {
        for (int c = bid; c < 128; c += G) { scan_chain(p, l, c >> 1, c & 1, lds); __syncthreads(); }
        for (int t = bid; t < ntile; t += G) sgu_tile(p, l, t, lds);
    }
}

__device__ void phase_combine(const Params& p, int l, int nrows) {
    const int tid_ = opaque_tid(); const int wave = tid_ >> 6, lane = tid_ & 63, hd = lane >> 4, v0 = (lane & 15) * 8;
    const bf16_t* P = (const bf16_t*)(p.ws + WS_BIG);
    const bf16_t* OF = (const bf16_t*)(p.ws + WS_OFB); const bf16_t* OB = OF + (size_t)NROW * 512;
    bf16_t* O = (bf16_t*)(p.ws + WS_H);
    const float* gn = p.in[11] + l * 512 + hd * 128 + v0;
    const f32x4 g0 = *(const f32x4*)gn, g1 = *(const f32x4*)(gn + 4);
    for (int row0 = (blockIdx.x * 8 + wave) * 4; row0 < nrows; row0 += gridDim.x * 32) {
        u32x4 a[4], bq[4], gg[4];
#pragma unroll
        for (int u = 0; u < 4; ++u) { const size_t row = row0 + u;
            a[u] = *(const u32x4*)(OF + row * 512 + hd * 128 + v0); bq[u] = *(const u32x4*)(OB + row * 512 + hd * 128 + v0);
            gg[u] = *(const u32x4*)(P + row * PW + 2048 + hd * 128 + v0); }
#pragma unroll
        for (int u = 0; u < 4; ++u) {
            float s[8]; float ss = 0.f;
#pragma unroll
            for (int j = 0; j < 4; ++j) { s[2 * j] = bf_lo(a[u][j]) + bf_lo(bq[u][j]); s[2 * j + 1] = bf_hi(a[u][j]) + bf_hi(bq[u][j]); ss += s[2 * j] * s[2 * j] + s[2 * j + 1] * s[2 * j + 1]; }
#pragma unroll
            for (int o = 8; o > 0; o >>= 1) ss += __shfl_xor(ss, o);
            const float rs = rsqrtf(ss * (1.0f / 128.f) + EPS);
            float y[8];
#pragma unroll
            for (int j = 0; j < 4; ++j) { y[2 * j] = s[2 * j] * rs * (j < 2 ? g0[2 * j] : g1[2 * j - 4]) * silu_f(bf_lo(gg[u][j])); y[2 * j + 1] = s[2 * j + 1] * rs * (j < 2 ? g0[2 * j + 1] : g1[2 * j - 3]) * silu_f(bf_hi(gg[u][j])); }
            u32x4 wv; wv.x = pk_bf16(y[0], y[1]); wv.y = pk_bf16(y[2], y[3]); wv.z = pk_bf16(y[4], y[5]); wv.w = pk_bf16(y[6], y[7]);
            *(u32x4*)(O + (size_t)(row0 + u) * D + hd * 128 + v0) = wv;
        }
    }
}

__device__ void phase_conv(const Params& p, int l, int nrows) {
    bf16_t* Aup = (bf16_t*)(p.ws + WS_BIG); const bf16_t* Gup = Aup + (size_t)NROW * FF;
    const float* cw = p.in[18] + (size_t)l * 9 * FF; const float* cb = p.in[19] + (size_t)l * FF;
    const int tid_ = opaque_tid();
    const long total = (long)(nrows / 16) * 352;
    for (long id0 = (long)blockIdx.x * 512 + tid_; id0 < total; id0 += (long)gridDim.x * 512) {
        const int seg = (int)((total - 1 - id0) / 352), f0 = (int)(id0 % 352) * 8;
        const int tok0 = seg * 16;
        int c0, W; bool up, dn;
        if (tok0 < NLAT) { const int t = tok0 & 4095, r = t >> 6; c0 = t & 63; W = 64; up = r > 0; dn = r < 63; }
        else { c0 = (tok0 - NLAT) & 255; W = 256; up = false; dn = false; }
        float tp[9][8]; float bias[8];
#pragma unroll
        for (int k = 0; k < 9; ++k) { const f32x4 t0 = *(const f32x4*)(cw + k * FF + f0), t1 = *(const f32x4*)(cw + k * FF + f0 + 4);
            tp[k][0] = t0[0]; tp[k][1] = t0[1]; tp[k][2] = t0[2]; tp[k][3] = t0[3]; tp[k][4] = t1[0]; tp[k][5] = t1[1]; tp[k][6] = t1[2]; tp[k][7] = t1[3]; }
        { const f32x4 b0 = *(const f32x4*)(cb + f0), b1 = *(const f32x4*)(cb + f0 + 4); bias[0] = b0[0]; bias[1] = b0[1]; bias[2] = b0[2]; bias[3] = b0[3]; bias[4] = b1[0]; bias[5] = b1[1]; bias[6] = b1[2]; bias[7] = b1[3]; }
        const u32x4 zero = (u32x4){0u, 0u, 0u, 0u};
        const bf16_t* gp = Gup + (size_t)tok0 * FF + f0;
        u32x4 L[3], M[3], R[3];
        { const bool v = c0 > 0;
          L[0] = (v && up) ? *(const u32x4*)(gp - (size_t)65 * FF) : zero; L[1] = v ? *(const u32x4*)(gp - (size_t)FF) : zero; L[2] = (v && dn) ? *(const u32x4*)(gp + (size_t)63 * FF) : zero; }
        M[0] = up ? *(const u32x4*)(gp - (size_t)64 * FF) : zero; M[1] = *(const u32x4*)gp; M[2] = dn ? *(const u32x4*)(gp + (size_t)64 * FF) : zero;
#pragma unroll 8
        for (int i = 0; i < 16; ++i) {
            const bf16_t* np = gp + (size_t)(i + 1) * FF;
            const bool v = (c0 + i + 1) < W;
            R[0] = (v && up) ? *(const u32x4*)(np - (size_t)64 * FF) : zero; R[1] = v ? *(const u32x4*)np : zero; R[2] = (v && dn) ? *(const u32x4*)(np + (size_t)64 * FF) : zero;
            float acc[8];
#pragma unroll
            for (int j = 0; j < 8; ++j) acc[j] = bias[j];
#pragma unroll
            for (int rr = 0; rr < 3; ++rr) {
#pragma unroll
                for (int j = 0; j < 4; ++j) {
                    acc[2 * j] += bf_lo(L[rr][j]) * tp[rr * 3 + 0][2 * j] + bf_lo(M[rr][j]) * tp[rr * 3 + 1][2 * j] + bf_lo(R[rr][j]) * tp[rr * 3 + 2][2 * j];
                    acc[2 * j + 1] += bf_hi(L[rr][j]) * tp[rr * 3 + 0][2 * j + 1] + bf_hi(M[rr][j]) * tp[rr * 3 + 1][2 * j + 1] + bf_hi(R[rr][j]) * tp[rr * 3 + 2][2 * j + 1];
                }
            }
            bf16_t* ap = Aup + (size_t)(tok0 + i) * FF + f0;
            const u32x4 av = *(const u32x4*)ap;
            u32x4 wv;
#pragma unroll
            for (int j = 0; j < 4; ++j) wv[j] = pk_bf16(bf_lo(av[j]) * gelu_f(acc[2 * j]), bf_hi(av[j]) * gelu_f(acc[2 * j + 1]));
            *(u32x4*)ap = wv;
#pragma unroll
            for (int rr = 0; rr < 3; ++rr) { L[rr] = M[rr]; M[rr] = R[rr]; }
        }
    }
}

#define XB_TMO      128
#define XB_XCNT(j)  (256  + 64 * (j))
#define XB_XSUB(j)  (1280 + 64 * (j))
#define XB_XGEN(j)  (2304 + 64 * (j))
#define XB_TOP      3328
#define XB_TOPGEN   3392
#define XCD_BAR_WORDS 3456
#define XB_SPIN_CAP (1u << 20)
__device__ __forceinline__ unsigned xb_ld(unsigned* p)              { return __hip_atomic_load(p, __ATOMIC_RELAXED, __HIP_MEMORY_SCOPE_AGENT); }
__device__ __forceinline__ unsigned xb_add(unsigned* p, unsigned v) { return __hip_atomic_fetch_add(p, v, __ATOMIC_RELAXED, __HIP_MEMORY_SCOPE_AGENT); }
__device__ __forceinline__ unsigned xb_xcc_id() { return (unsigned)__builtin_amdgcn_s_getreg((3 << 11) | 20) & 0xFu; }
#define XB_SPIN(cond, bar) do { unsigned _sp = 0; while (cond) { __builtin_amdgcn_s_sleep(1); \
    if ((++_sp & 255u) == 0u) { if (xb_ld(&(bar)[XB_TMO])) break; if (_sp > XB_SPIN_CAP) { atomicAdd(&(bar)[XB_TMO], 1u); break; } } } } while (0)
struct XcdBarrier { unsigned* bar; unsigned x; volatile LAS unsigned* st; };
__device__ __forceinline__ XcdBarrier xcd_barrier_post(unsigned* bar, volatile LAS unsigned* st) {
    XcdBarrier b; b.bar = bar; b.x = xb_xcc_id(); b.st = st;
    if (threadIdx.x == 0) (void)xb_add(&bar[XB_XCNT(b.x)], 1u);
    return b;
}
__device__ __forceinline__ void xcd_barrier_complete(unsigned* bar, unsigned x, unsigned& nloc, unsigned& nx) {
    const unsigned G = gridDim.x * gridDim.y * gridDim.z;
    unsigned sum, cnt, mine, sp = 0u;
    for (;;) {
        sum = 0u; cnt = 0u; mine = 0u;
#pragma unroll
        for (unsigned j = 0; j < 16; ++j) { const unsigned c = xb_ld(&bar[XB_XCNT(j)]); sum += c; cnt += (c > 0u) ? 1u : 0u; mine = (j == x) ? c : mine; }
        if (sum == G) break;
        __builtin_amdgcn_s_sleep(1);
        if ((++sp & 255u) == 0u) { if (xb_ld(&bar[XB_TMO])) break; if (sp > XB_SPIN_CAP) { atomicAdd(&bar[XB_TMO], 1u); break; } }
    }
    nloc = mine > 0u ? mine : 1u; nx = cnt > 0u ? cnt : 1u;
}
__device__ __forceinline__ void xcd_barrier(const XcdBarrier& b) {
    asm volatile("s_waitcnt vmcnt(0)" ::: "memory");
    __syncthreads();
    if (threadIdx.x == 0) {
        unsigned* bar = b.bar;
        __builtin_amdgcn_s_waitcnt(0);
        unsigned nloc = b.st[0], nx = b.st[1];
        if (nloc == 0u) { xcd_barrier_complete(bar, b.x, nloc, nx); b.st[0] = nloc; b.st[1] = nx; }
        const unsigned old = xb_add(&bar[XB_XSUB(b.x)], 1u);
        const unsigned gen = old / nloc;
        if (old + 1u == (gen + 1u) * nloc) {
            __builtin_amdgcn_fence(__ATOMIC_RELEASE, "agent");
            asm volatile("s_waitcnt vmcnt(0)" ::: "memory");
            const unsigned og = xb_add(&bar[XB_TOP], 1u);
            const unsigned tg = og / nx;
            if (og + 1u == (tg + 1u) * nx) xb_add(&bar[XB_TOPGEN], 1u);
            else XB_SPIN(xb_ld(&bar[XB_TOPGEN]) == tg, bar);
            __builtin_amdgcn_fence(__ATOMIC_ACQUIRE, "agent");
            xb_add(&bar[XB_XGEN(b.x)], 1u);
            asm volatile("s_waitcnt vmcnt(0)" ::: "memory");
        } else {
            XB_SPIN(xb_ld(&bar[XB_XGEN(b.x)]) == gen, bar);
            __builtin_amdgcn_fence(__ATOMIC_ACQUIRE, "agent");
            asm volatile("s_waitcnt vmcnt(0)" ::: "memory");
        }
    }
    __syncthreads();
}

__global__ void __launch_bounds__(512, 2) fwd_megakernel(Params p) {
    extern __shared__ __attribute__((aligned(16))) unsigned char shm[];
    LAS unsigned char* lds = (LAS unsigned char*)shm;
    cg::grid_group grid = cg::this_grid();
    __shared__ uint4 xb_words;
    if (threadIdx.x == 0) xb_words = make_uint4(0u, 0u, 0u, 0u);
    __syncthreads();
    const XcdBarrier xb = xcd_barrier_post((unsigned*)(p.ws + WS_BAR), (volatile LAS unsigned*)&xb_words);
    const int G = gridDim.x, bid = blockIdx.x;
    float* XC = (float*)(p.ws + WS_XC);
    bf16_t* H = (bf16_t*)(p.ws + WS_H);
    bf16_t* BIG = (bf16_t*)(p.ws + WS_BIG);
    const float* ADA = (const float*)(p.ws + WS_ADA);
    bf16_t* Y2 = BIG + (size_t)NROW * FF;

    phase_prep(p, lds);
    if (p.ws == nullptr) grid.sync();
    xcd_barrier(xb);
    for (int l = 0; l < DEPTH; ++l) {
        const bool last = (l == DEPTH - 1);
        const float* ada_l = ADA + (size_t)l * 9 * 6144;
        const float* xl = (l == 0) ? p.in[0] : p.out;
        const float* xc = (l == 0) ? p.in[2] : XC;
        const int Mfull = last ? NLAT : NROW;
        if (l == 0) phase_norm(xl, xc, nullptr, nullptr, nullptr, nullptr, p.in[6] + l * D, ada_l, 0, NROW, H);
        else phase_norm(p.out, XC, Y2, ADA + (size_t)(l - 1) * 9 * 6144 + 5 * 1024, p.out, nullptr, p.in[6] + l * D, ada_l, 0, NROW, H);
        xcd_barrier(xb);
        { pg8::StaticOrder S; S.init(NROW, PW, G, bid);
          pg8::EpiBf16 E{BIG, PW, 0, 0};
          pg8::gemm_phase(lds, pg8::Gemm{H, (const bf16_t*)(p.ws + WS_WIN) + (size_t)l * PW * D, NROW, PW, D}, S, E); }
        xcd_barrier(xb);
        { const int ntile = (l == 0) ? (NROW / 128) * 4 : (NLAT / 128) * 4;
          const int nextra = (G > 128 && ntile > SGU_IN_M2) ? ntile - SGU_IN_M2 : 0;
          for (int it = bid; it < 32 * NCH + nextra; it += G) { if (it < 32 * NCH) prep_item(p, l, 32 * NCH - 1 - it, lds); else sgu_tile(p, l, SGU_IN_M2 + it - 32 * NCH, lds); } }
        xcd_barrier(xb);
        phase_mixer(p, l, lds);
        xcd_barrier(xb);
        phase_combine(p, l, Mfull);
        xcd_barrier(xb);
        { pg8::StaticOrder S; S.init(Mfull, D, G, bid);
          pg8::EpiBf16 E{BIG, D, 0, 0};
          pg8::gemm_phase(lds, pg8::Gemm{H, (const bf16_t*)(p.ws + WS_WOUT) + (size_t)l * D * D, Mfull, D, D}, S, E); }
        xcd_barrier(xb);
        phase_norm(xl, xc, BIG, ada_l + 2 * 1024, p.out, XC, p.in[7] + l * D, ada_l, 3, Mfull, H);
        xcd_barrier(xb);
        { pg8::StaticOrder S; S.init(Mfull, UPW, G, bid);
          pg8::EpiBf16 E{BIG, FF, FF, (size_t)NROW * FF};
          pg8::gemm_phase(lds, pg8::Gemm{H, (const bf16_t*)(p.ws + WS_WUP) + (size_t)l * UPW * D, Mfull, UPW, D}, S, E); }
        xcd_barrier(xb);
        phase_conv(p, l, Mfull);
        xcd_barrier(xb);
        { pg8::StaticOrder S; S.init(Mfull, D, G, bid);
          pg8::EpiBf16 E{Y2, D, 0, 0};
          pg8::gemm_phase(lds, pg8::Gemm{BIG, (const bf16_t*)(p.ws + WS_WDOWN) + (size_t)l * D * FF, Mfull, D, FF}, S, E); }
        xcd_barrier(xb);
    }
    phase_final(p.out, Y2, ADA + (size_t)(DEPTH - 1) * 9 * 6144 + 5 * 1024, p.in[21]);
}

extern "C" void kernel_launch(void* const* d_in, const int* in_sizes, int n_in, void* d_out, int out_size, void* d_ws, size_t ws_size, hipStream_t stream) {
    constexpr int LDS_BYTES = 155648;
    static int grid_blocks = 0;
    if (!grid_blocks) {
        int dev = 0, cus = 0, per_cu = 0;
        (void)hipGetDevice(&dev);
        (void)hipDeviceGetAttribute(&cus, hipDeviceAttributeMultiprocessorCount, dev);
        (void)hipFuncSetAttribute((const void*)fwd_megakernel, hipFuncAttributeMaxDynamicSharedMemorySize, LDS_BYTES);
        (void)hipOccupancyMaxActiveBlocksPerMultiprocessor(&per_cu, (const void*)fwd_megakernel, 512, LDS_BYTES);
        if (per_cu < 1) per_cu = 1;
        grid_blocks = cus * per_cu;
        if (ws_size < WS_END) fprintf(stderr, "workspace too small: %zu < %zu\n", ws_size, (size_t)WS_END);
    }
    Params p{};
    for (int i = 0; i < 22; ++i) p.in[i] = (const float*)d_in[i];
    p.out = (float*)d_out; p.ws = (unsigned char*)d_ws;
    (void)hipMemsetAsync((unsigned char*)d_ws + WS_BAR, 0, XCD_BAR_WORDS * 4, stream);
    void* args[] = {&p};
    hipError_t e = hipLaunchCooperativeKernel((const void*)fwd_megakernel, dim3(grid_blocks), dim3(512), args, LDS_BYTES, stream);
    if (e != hipSuccess) fprintf(stderr, "cooperative launch failed: %s (grid %d)\n", hipGetErrorString(e), grid_blocks);
}
```

```cpp
#include <hip/hip_runtime.h>
#include <hip/hip_cooperative_groups.h>
#include <cstdio>
namespace cg = cooperative_groups;

#define LAS __attribute__((address_space(3)))
typedef unsigned short bf16_t;
typedef short bf16x8 __attribute__((ext_vector_type(8)));
typedef float f32x4 __attribute__((ext_vector_type(4)));
typedef float f32x2 __attribute__((ext_vector_type(2)));
typedef unsigned u32x4 __attribute__((ext_vector_type(4)));
typedef unsigned u32x2 __attribute__((ext_vector_type(2)));
typedef __bf16 bf2_t __attribute__((ext_vector_type(2)));

constexpr int D = 1024, NB = 8, SEQ = 4096, DEPTH = 2, CTXL = 256;
constexpr int NLAT = NB * SEQ;
constexpr int NCTX = NB * CTXL;
constexpr int NROW = NLAT + NCTX;
constexpr int PW = 3584, FF = 2816, UPW = 2 * FF;
constexpr float EPS = 1e-6f;

constexpr size_t WS_WIN = 0;
constexpr size_t WS_WOUT = WS_WIN + (size_t)DEPTH * PW * D * 2;
constexpr size_t WS_WUP = WS_WOUT + (size_t)DEPTH * D * D * 2;
constexpr size_t WS_WDOWN = WS_WUP + (size_t)DEPTH * UPW * D * 2;
constexpr size_t WS_WSP = WS_WDOWN + (size_t)DEPTH * D * FF * 2;
constexpr size_t WS_ADA = WS_WSP + (size_t)DEPTH * 4 * 128 * 128 * 2;
constexpr size_t WS_LB = WS_ADA + (size_t)DEPTH * 9 * 6144 * 4;
constexpr size_t WS_XC = WS_LB + 2 * 512 * 4;
constexpr size_t WS_H = WS_XC + (size_t)NCTX * D * 4;
constexpr size_t WS_BIG = WS_H + (size_t)NROW * D * 2;
constexpr size_t WS_OFB = WS_BIG + (size_t)NROW * PW * 2;
constexpr size_t WS_QB = WS_OFB + 2 * (size_t)NROW * 512 * 2;
constexpr size_t WS_DS = WS_BIG + (size_t)NROW * UPW * 2;
constexpr size_t WS_BAR = WS_DS + (size_t)64 * 136 * 128 * 4;
constexpr size_t WS_END = WS_BAR + 16384;

struct Params {
    const float* in[22];
    float* out;
    unsigned char* ws;
};

__device__ __forceinline__ unsigned pk_bf16(float a, float b) { f32x2 v = {a, b}; bf2_t r = __builtin_convertvector(v, bf2_t); return __builtin_bit_cast(unsigned, r); }
__device__ __forceinline__ float bf_lo(unsigned u) { return __uint_as_float(u << 16); }
__device__ __forceinline__ float bf_hi(unsigned u) { return __uint_as_float(u & 0xffff0000u); }
__device__ __forceinline__ float bf1(bf16_t u) { return __uint_as_float(((unsigned)u) << 16); }
__device__ __forceinline__ bf16_t to_bf1(float a) { return (bf16_t)(pk_bf16(a, 0.f) & 0xffffu); }
__device__ __forceinline__ float fast_rcp(float x) { return __builtin_amdgcn_rcpf(x); }
__device__ __forceinline__ float gelu_f(float v) {
    const float av = fabsf(v), t = fast_rcp(av * 0.2316418882f + 1.0f);
    float q = t * 0.5307027145f + (-0.7265760135f); q = q * t + 0.7107068705f; q = q * t + (-0.142248368f); q = q * t + 0.127414796f; q = q * t;
    const float e = __builtin_amdgcn_exp2f((v * v) * (-0.72134752044f));
    const float m = v * (q * e);
    return v < 0.f ? m : v - m;
}
__device__ __forceinline__ int opaque_tid() { int t = threadIdx.x; asm volatile("" : "+v"(t)); return t; }
__device__ __forceinline__ float silu_f(float x) { return x * fast_rcp(1.0f + __expf(-x)); }

namespace pg8 {
constexpr int BM = 256, BK = 64, HALF = 128, HTB = HALF * BK * 2, STAGE_BYTES = 8 * HTB, NXCD = 8, WGM = 8;
__host__ __device__ __forceinline__ int lds_byte(int r, int c) { const int st = (r >> 4) * 2 + (c >> 5), rr = r & 15, cc = c & 31, ob = rr * 64 + cc * 2; return st * 1024 + (ob ^ (((ob >> 9) & 1) << 5)); }
__host__ __device__ __forceinline__ void stage_rc(int b, int& R, int& C) { const int st = b / 1024, sb = b % 1024, swz = sb ^ (((sb >> 9) & 1) << 5); R = (st >> 1) * 16 + swz / 64; C = (st & 1) * 32 + (swz % 64) / 2; }
__host__ __device__ __forceinline__ int perm32(int rho) { const int n = rho >> 4, i = rho & 15; return 8 * (i >> 2) + 4 * n + (i & 3); }
struct Unit { int pm, pn; };
struct Gemm { const bf16_t* A; const bf16_t* Bt; int M, N, K; };
struct StaticOrder {
    int nM, nN, nwg, G, c;
    __device__ void init(int M, int N, int G_, int c_) { nM = M / BM; nN = N / BM; nwg = nM * nN; G = G_; c = c_; }
    __device__ bool next(int i, Unit& u) const {
        const long L = (long)i * G + c; if (L >= nwg) return false;
        int wgid = (int)L; { const int q = nwg / NXCD, r = nwg % NXCD, xcd = wgid % NXCD, off = wgid / NXCD; wgid = (xcd < r ? xcd * (q + 1) : r * (q + 1) + (xcd - r) * q) + off; }
        const int nig = WGM * nN, gid = wgid / nig, fm = gid * WGM, gsz = (nM - fm) < WGM ? (nM - fm) : WGM;
        u.pm = fm + ((wgid % nig) % gsz); u.pn = (wgid % nig) / gsz; return true;
    }
    __device__ __forceinline__ void a_ready(const Unit&) const {}
    __device__ __forceinline__ void done(const Unit&) const {}
};
struct EpiBf16 {
    static constexpr bool PERM = true;
    bf16_t* O; int ldc; int split_cols; size_t split_stride;
    __device__ __forceinline__ void operator()(const f32x4 (&acc)[2][2][4][2], const Unit& u, int wr, int wc, int fr, int fq) const {
        const int row0 = u.pm * BM + wr * 64 + fr; int colt = u.pn * BM; bf16_t* base = O;
        if (split_cols) { const int t = colt / split_cols; base += (size_t)t * split_stride; colt -= t * split_cols; }
        const int col0 = colt + wc * 32 + 8 * fq;
#pragma unroll
        for (int ai = 0; ai < 2; ++ai)
#pragma unroll
            for (int m = 0; m < 4; ++m) { bf16_t* rowp = base + (size_t)(row0 + ai * HALF + m * 16) * ldc + col0;
#pragma unroll
                for (int bj = 0; bj < 2; ++bj) { const f32x4 v0 = acc[ai][bj][m][0], v1 = acc[ai][bj][m][1];
                    u32x4 w; w.x = pk_bf16(v0[0], v0[1]); w.y = pk_bf16(v0[2], v0[3]); w.z = pk_bf16(v1[0], v1[1]); w.w = pk_bf16(v1[2], v1[3]);
                    *(u32x4*)(rowp + bj * HALF) = w; } }
    }
};
struct EpiRes {
    static constexpr bool PERM = false;
    const float* resL; float* outL; const float* resC; float* outC; const float* gate;
    __device__ __forceinline__ void operator()(const f32x4 (&acc)[2][2][4][2], const Unit& u, int wr, int wc, int fr, int fq) const {
        const float* res; float* out; const float* g; int rowb;
        if (u.pm < NLAT / BM) { res = resL; out = outL; g = gate + (size_t)(u.pm >> 4) * 6144; rowb = u.pm * BM; }
        else { res = resC; out = outC; g = gate + (size_t)8 * 6144; rowb = u.pm * BM - NLAT; }
        const int row0 = rowb + wr * 64 + fr, col0 = u.pn * BM + wc * 32 + 4 * fq;
        f32x4 gv[2][2];
#pragma unroll
        for (int bj = 0; bj < 2; ++bj)
#pragma unroll
            for (int n = 0; n < 2; ++n) gv[bj][n] = *(const f32x4*)(g + col0 + bj * HALF + n * 16);
#pragma unroll
        for (int ai = 0; ai < 2; ++ai)
#pragma unroll
            for (int m = 0; m < 4; ++m) { const size_t ro = (size_t)(row0 + ai * HALF + m * 16) * D + col0;
#pragma unroll
                for (int bj = 0; bj < 2; ++bj)
#pragma unroll
                    for (int n = 0; n < 2; ++n) { const f32x4 r = *(const f32x4*)(res + ro + bj * HALF + n * 16);
                        *(f32x4*)(out + ro + bj * HALF + n * 16) = r + gv[bj][n] * acc[ai][bj][m][n]; } }
    }
};

template <class Epi, class Sched>
__device__ __forceinline__ void gemm_phase(LAS unsigned char* lds, const Gemm g, const Sched& S, const Epi& E) {
    const int tid = opaque_tid(), wid = __builtin_amdgcn_readfirstlane(tid >> 6), lane = tid & 63, wr = wid >> 2, wc = wid & 3, fr = lane & 15, fq = lane >> 4;
    const int K = g.K, nt = K / BK;
    unsigned voffA[2], voffB[2];
#pragma unroll
    for (int i = 0; i < 2; ++i) { int R, C; stage_rc(tid * 16 + i * 8192, R, C); const int Rb = Epi::PERM ? ((R & ~31) + perm32(R & 31)) : R;
        voffA[i] = (unsigned)(R * K + C) * 2u; voffB[i] = (unsigned)(Rb * K + C) * 2u; }
    const size_t kstep = (size_t)(BK * 2);
    const size_t hstep = (size_t)HALF * K * 2;
    const size_t tstep = 2 * hstep;
    const unsigned ldsw = (unsigned)wid * 1024u;
    const int aoff = lds_byte(wr * 64 + fr, fq * 8), boff = lds_byte(wc * 32 + fr, fq * 8);
#define PG8_SA(b, h) (((b) * 2 + (h)) * HTB)
#define PG8_SB(b, h) ((4 + (b) * 2 + (h)) * HTB)
#define PG8_STAGE(bufoff, gbase, voff) do { _Pragma("unroll") for (int _i = 0; _i < 2; ++_i) \
        __builtin_amdgcn_global_load_lds((const unsigned*)((const char*)(gbase) + (voff)[_i]), (LAS unsigned*)(lds + (bufoff) + ldsw + _i * 8192), 16, 0, 0); } while (0)
#define PG8_LDA(dst, b, h) do { _Pragma("unroll") for (int m = 0; m < 4; ++m) _Pragma("unroll") for (int k = 0; k < 2; ++k) dst[m][k] = *(const LAS bf16x8*)(lds + PG8_SA(b, h) + aoff + m * 2048 + k * 1024); } while (0)
#define PG8_LDB(dst, b, h) do { _Pragma("unroll") for (int n = 0; n < 2; ++n) _Pragma("unroll") for (int k = 0; k < 2; ++k) dst[n][k] = *(const LAS bf16x8*)(lds + PG8_SB(b, h) + boff + n * 2048 + k * 1024); } while (0)
#define PG8_MMA(ai, bj, At, Bt) do { __builtin_amdgcn_s_setprio(1); _Pragma("unroll") for (int m = 0; m < 4; ++m) _Pragma("unroll") for (int n = 0; n < 2; ++n) _Pragma("unroll") for (int k = 0; k < 2; ++k) \
        acc[ai][bj][m][n] = __builtin_amdgcn_mfma_f32_16x16x32_bf16(Bt[n][k], At[m][k], acc[ai][bj][m][n], 0, 0, 0); __builtin_amdgcn_s_setprio(0); } while (0)
#define PG8_WAIT_V(n) asm volatile("s_waitcnt vmcnt(" #n ")" ::: "memory")
#define PG8_WAIT_L(n) asm volatile("s_waitcnt lgkmcnt(" #n ")" ::: "memory")
#define PG8_BAR __builtin_amdgcn_s_barrier()
#define PG8_SCHED __builtin_amdgcn_sched_barrier(0)
    Unit cur, nxt; int ui = 0;
    if (!S.next(0, cur)) return;
    f32x4 acc[2][2][4][2];
#pragma unroll
    for (int a = 0; a < 2; ++a)
#pragma unroll
        for (int b = 0; b < 2; ++b)
#pragma unroll
            for (int m = 0; m < 4; ++m)
#pragma unroll
                for (int n = 0; n < 2; ++n) acc[a][b][m][n] = (f32x4){0.f, 0.f, 0.f, 0.f};
    bf16x8 At[4][2], B0[2][2], B1[2][2];
    const char* cA = (const char*)g.A + (size_t)cur.pm * tstep; const char* cB = (const char*)g.Bt + (size_t)cur.pn * tstep;
    S.a_ready(cur);
    PG8_STAGE(PG8_SB(0, 0), cB, voffB); PG8_STAGE(PG8_SA(0, 0), cA, voffA); PG8_STAGE(PG8_SB(0, 1), cB + hstep, voffB); PG8_STAGE(PG8_SA(0, 1), cA + hstep, voffA);
    if (wr == 1) PG8_BAR;
    PG8_WAIT_V(4); PG8_BAR;
    PG8_STAGE(PG8_SB(1, 0), cB + kstep, voffB); PG8_STAGE(PG8_SA(1, 0), cA + kstep, voffA); PG8_STAGE(PG8_SB(1, 1), cB + hstep + kstep, voffB);
    PG8_WAIT_V(6); PG8_BAR;
    for (;;) {
        const bool has_next = S.next(ui + 1, nxt);
        const char* nA = has_next ? (const char*)g.A + (size_t)nxt.pm * tstep : cA; const char* nB = has_next ? (const char*)g.Bt + (size_t)nxt.pn * tstep : cB;
        for (int t = 0; t < nt; t += 2) {
            const bool last = (t == nt - 2);
            const char* a1 = cA + (size_t)(t + 1) * kstep;
            const char* a2 = last ? nA : cA + (size_t)(t + 2) * kstep; const char* b2 = last ? nB : cB + (size_t)(t + 2) * kstep;
            const char* a3 = a2 + kstep; const char* b3 = b2 + kstep;
            if (last && has_next) S.a_ready(nxt);
            PG8_LDB(B0, 0, 0); PG8_SCHED; PG8_LDA(At, 0, 0); PG8_STAGE(PG8_SA(1, 1), a1 + hstep, voffA);
            PG8_WAIT_L(8); PG8_BAR; PG8_WAIT_L(0); PG8_MMA(0, 0, At, B0); PG8_BAR; PG8_SCHED;
            PG8_LDB(B1, 0, 1); PG8_STAGE(PG8_SB(0, 0), b2, voffB);
            PG8_BAR; PG8_WAIT_L(0); PG8_MMA(0, 1, At, B1); PG8_BAR;
            PG8_LDA(At, 0, 1); PG8_STAGE(PG8_SA(0, 0), a2, voffA);
            PG8_BAR; PG8_WAIT_L(0); PG8_MMA(1, 0, At, B0); PG8_BAR; PG8_SCHED;
            PG8_STAGE(PG8_SB(0, 1), b2 + hstep, voffB);
            PG8_WAIT_V(6); PG8_BAR; PG8_MMA(1, 1, At, B1); PG8_BAR;
            PG8_LDB(B0, 1, 0); PG8_SCHED; PG8_LDA(At, 1, 0); PG8_STAGE(PG8_SA(0, 1), a2 + hstep, voffA);
            PG8_WAIT_L(8); PG8_BAR; PG8_WAIT_L(0); PG8_MMA(0, 0, At, B0); PG8_BAR; PG8_SCHED;
            PG8_LDB(B1, 1, 1); PG8_STAGE(PG8_SB(1, 0), b3, voffB);
            PG8_BAR; PG8_WAIT_L(0); PG8_MMA(0, 1, At, B1); PG8_BAR;
            PG8_LDA(At, 1, 1); PG8_STAGE(PG8_SA(1, 0), a3, voffA);
            PG8_BAR; PG8_WAIT_L(0); PG8_MMA(1, 0, At, B0); PG8_BAR; PG8_SCHED;
            PG8_STAGE(PG8_SB(1, 1), b3 + hstep, voffB);
            PG8_WAIT_V(6); PG8_BAR; PG8_MMA(1, 1, At, B1); PG8_BAR;
        }
        E(acc, cur, wr, wc, fr, fq); S.done(cur);
        if (!has_next) break;
#pragma unroll
        for (int a = 0; a < 2; ++a)
#pragma unroll
            for (int b = 0; b < 2; ++b)
#pragma unroll
                for (int m = 0; m < 4; ++m)
#pragma unroll
                    for (int n = 0; n < 2; ++n) acc[a][b][m][n] = (f32x4){0.f, 0.f, 0.f, 0.f};
        cur = nxt; cA = nA; cB = nB; ++ui;
    }
    PG8_WAIT_V(0);
    if (wr == 0) PG8_BAR;
    PG8_BAR;
#undef PG8_SA
#undef PG8_SB
#undef PG8_STAGE
#undef PG8_LDA
#undef PG8_LDB
#undef PG8_MMA
#undef PG8_WAIT_V
#undef PG8_WAIT_L
#undef PG8_BAR
#undef PG8_SCHED
}
}

__device__ void phase_prep(const Params& p, LAS unsigned char* lds) {
    const int tid = opaque_tid();
    constexpr int NT_L = 896 + 256 + 1408 + 704;
    constexpr int J_ADA = 192, J_TR = J_ADA + 2 * NT_L, J_WSP = J_TR + 32, J_LB = J_WSP + 1;
    for (int job = blockIdx.x; job < J_LB; job += gridDim.x) {
        if (job < J_ADA) {
            LAS float* s = (LAS float*)lds;
            LAS float* red = (LAS float*)(lds + 9 * 1024 * 4);
            for (int i = tid; i < 9 * 1024; i += 512) { const int r = i >> 10, d = i & 1023; const float v = r < 8 ? p.in[1][r * 1024 + d] : p.in[3][d]; s[i] = silu_f(v); }
            __syncthreads();
            const int l = job / 96, e0 = (job % 96) * 64, col = tid & 63, dg = tid >> 6;
            const float* w = p.in[4] + ((size_t)l * 1024 + dg * 128) * 6144 + e0 + col;
            float acc[9];
#pragma unroll
            for (int r = 0; r < 9; ++r) acc[r] = 0.f;
            for (int dd = 0; dd < 128; ++dd) { const float wv = w[(size_t)dd * 6144];
#pragma unroll
                for (int r = 0; r < 9; ++r) acc[r] += s[r * 1024 + dg * 128 + dd] * wv; }
#pragma unroll
            for (int r = 0; r < 9; ++r) red[(dg * 9 + r) * 64 + col] = acc[r];
            __syncthreads();
            for (int i = tid; i < 9 * 64; i += 512) { const int r = i >> 6, c = i & 63; float a = 0.f;
#pragma unroll
                for (int g = 0; g < 8; ++g) a += red[(g * 9 + r) * 64 + c];
                ((float*)(p.ws + WS_ADA))[((size_t)l * 9 + r) * 6144 + e0 + c] = a + p.in[5][l * 6144 + e0 + c]; }
            __syncthreads();
        } else if (job < J_TR) {
            const int j = job - J_ADA, l = j / NT_L; int r = j % NT_L;
            const float* src; bf16_t* dst; int K, N;
            if (r < 896) { src = p.in[8] + (size_t)l * D * PW; dst = (bf16_t*)(p.ws + WS_WIN) + (size_t)l * PW * D; K = D; N = PW; }
            else if (r < 1152) { r -= 896; src = p.in[16] + (size_t)l * D * D; dst = (bf16_t*)(p.ws + WS_WOUT) + (size_t)l * D * D; K = D; N = D; }
            else if (r < 2560) { r -= 1152; src = p.in[17] + (size_t)l * D * UPW; dst = (bf16_t*)(p.ws + WS_WUP) + (size_t)l * UPW * D; K = D; N = UPW; }
            else { r -= 2560; src = p.in[20] + (size_t)l * FF * D; dst = (bf16_t*)(p.ws + WS_WDOWN) + (size_t)l * D * FF; K = FF; N = D; }
            const int ntn = N >> 6, kt = r / ntn, nt = r % ntn;
            LAS float* tile = (LAS float*)lds;
            { const int kk = tid >> 3, n8 = (tid & 7) * 8; const float* sp = src + (size_t)(kt * 64 + kk) * N + nt * 64 + n8;
              const f32x4 a = *(const f32x4*)sp, b = *(const f32x4*)(sp + 4);
              LAS float* tp = tile + kk * 65 + n8; tp[0] = a[0]; tp[1] = a[1]; tp[2] = a[2]; tp[3] = a[3]; tp[4] = b[0]; tp[5] = b[1]; tp[6] = b[2]; tp[7] = b[3]; }
            __syncthreads();
            { const int nn = tid >> 3, k8 = (tid & 7) * 8; float v[8];
#pragma unroll
              for (int i = 0; i < 8; ++i) v[i] = tile[(k8 + i) * 65 + nn];
              u32x4 w; w.x = pk_bf16(v[0], v[1]); w.y = pk_bf16(v[2], v[3]); w.z = pk_bf16(v[4], v[5]); w.w = pk_bf16(v[6], v[7]);
              *(u32x4*)(dst + (size_t)(nt * 64 + nn) * K + kt * 64 + k8) = w; }
            __syncthreads();
        } else if (job < J_WSP) {
            const int j = job - J_TR; const size_t i0 = (size_t)j * 4096 + tid * 8;
            const f32x4 a = *(const f32x4*)(p.in[14] + i0), b = *(const f32x4*)(p.in[14] + i0 + 4);
            u32x4 w; w.x = pk_bf16(a[0], a[1]); w.y = pk_bf16(a[2], a[3]); w.z = pk_bf16(b[0], b[1]); w.w = pk_bf16(b[2], b[3]);
            *(u32x4*)((bf16_t*)(p.ws + WS_WSP) + i0) = w;
        } else {
            for (int i = tid; i < 1024; i += 512) { const int dir = i >> 9, c = i & 511; const float* lg = dir ? p.in[10] : p.in[9];
                const float l0 = lg[c], l1 = lg[512 + c]; ((float*)(p.ws + WS_LB))[i] = 1.0f / (1.0f + expf(l0 - l1)); }
        }
    }
}

__device__ void phase_norm(const float* xl, const float* xc, const bf16_t* Y, const float* gate  , float* xl_dst, float* xc_dst,
                           const float* gain, const float* ada_l, int shift_idx, int nrows, bf16_t* H) {
    const int tid_ = opaque_tid(); const int wave = tid_ >> 6, lane = tid_ & 63;
    f32x4 gn[4];
#pragma unroll
    for (int j = 0; j < 4; ++j) gn[j] = *(const f32x4*)(gain + j * 256 + lane * 4);
    for (int rr = (blockIdx.x * 8 + wave) * 2; rr < nrows; rr += gridDim.x * 16) {
        const int row = nrows - 2 - rr;
        const float* src; const float* mod; float* dst; const float* gt;
        if (row < NLAT) { src = xl + (size_t)row * D; mod = ada_l + (size_t)(row >> 12) * 6144; dst = xl_dst ? xl_dst + (size_t)row * D : nullptr; gt = gate + (size_t)(row >> 12) * 6144; }
        else { src = xc + (size_t)(row - NLAT) * D; mod = ada_l + (size_t)8 * 6144; dst = xc_dst ? xc_dst + (size_t)(row - NLAT) * D : nullptr; gt = gate + (size_t)8 * 6144; }
        f32x4 v[2][4], sh[4], sc[4], gg[4]; u32x2 yv[2][4];
#pragma unroll
        for (int u = 0; u < 2; ++u)
#pragma unroll
            for (int j = 0; j < 4; ++j) { v[u][j] = *(const f32x4*)(src + (size_t)u * D + j * 256 + lane * 4); if (Y) yv[u][j] = *(const u32x2*)(Y + (size_t)(row + u) * D + j * 256 + lane * 4); }
#pragma unroll
        for (int j = 0; j < 4; ++j) { const int d = j * 256 + lane * 4; sh[j] = *(const f32x4*)(mod + shift_idx * 1024 + d); sc[j] = *(const f32x4*)(mod + (shift_idx + 1) * 1024 + d); if (Y) gg[j] = *(const f32x4*)(gt + d); }
#pragma unroll
        for (int u = 0; u < 2; ++u) {
            if (Y) {
#pragma unroll
                for (int j = 0; j < 4; ++j) {
                    v[u][j][0] += gg[j][0] * bf_lo(yv[u][j].x); v[u][j][1] += gg[j][1] * bf_hi(yv[u][j].x); v[u][j][2] += gg[j][2] * bf_lo(yv[u][j].y); v[u][j][3] += gg[j][3] * bf_hi(yv[u][j].y);
                    if (dst) *(f32x4*)(dst + (size_t)u * D + j * 256 + lane * 4) = v[u][j]; }
            }
            float ss = 0.f;
#pragma unroll
            for (int j = 0; j < 4; ++j) ss += v[u][j][0] * v[u][j][0] + v[u][j][1] * v[u][j][1] + v[u][j][2] * v[u][j][2] + v[u][j][3] * v[u][j][3];
#pragma unroll
            for (int o = 32; o > 0; o >>= 1) ss += __shfl_xor(ss, o);
            const float rs = rsqrtf(ss * (1.0f / D) + EPS);
#pragma unroll
            for (int j = 0; j < 4; ++j) { const int d = j * 256 + lane * 4;
                f32x4 y = v[u][j] * rs * gn[j]; y = y * (sc[j] + 1.0f) + sh[j];
                u32x2 wv; wv.x = pk_bf16(y[0], y[1]); wv.y = pk_bf16(y[2], y[3]);
                *(u32x2*)(H + (size_t)(row + u) * D + d) = wv; }
        }
    }
}
__device__ void phase_final(float* x, const bf16_t* Y, const float* gate, const float* gain) {
    const int tid_ = opaque_tid(); const int wave = tid_ >> 6, lane = tid_ & 63;
    f32x4 gn[4];
#pragma unroll
    for (int j = 0; j < 4; ++j) gn[j] = *(const f32x4*)(gain + j * 256 + lane * 4);
    for (int row = (blockIdx.x * 8 + wave) * 2; row < NLAT; row += gridDim.x * 16) {
        const float* gt = gate + (size_t)(row >> 12) * 6144;
        f32x4 v[2][4], gg[4]; u32x2 yv[2][4];
#pragma unroll
        for (int u = 0; u < 2; ++u)
#pragma unroll
            for (int j = 0; j < 4; ++j) { v[u][j] = *(const f32x4*)(x + (size_t)(row + u) * D + j * 256 + lane * 4); yv[u][j] = *(const u32x2*)(Y + (size_t)(row + u) * D + j * 256 + lane * 4); }
#pragma unroll
        for (int j = 0; j < 4; ++j) gg[j] = *(const f32x4*)(gt + j * 256 + lane * 4);
#pragma unroll
        for (int u = 0; u < 2; ++u) {
            float ss = 0.f;
#pragma unroll
            for (int j = 0; j < 4; ++j) {
                v[u][j][0] += gg[j][0] * bf_lo(yv[u][j].x); v[u][j][1] += gg[j][1] * bf_hi(yv[u][j].x); v[u][j][2] += gg[j][2] * bf_lo(yv[u][j].y); v[u][j][3] += gg[j][3] * bf_hi(yv[u][j].y);
                ss += v[u][j][0] * v[u][j][0] + v[u][j][1] * v[u][j][1] + v[u][j][2] * v[u][j][2] + v[u][j][3] * v[u][j][3]; }
#pragma unroll
            for (int o = 32; o > 0; o >>= 1) ss += __shfl_xor(ss, o);
            const float rs = rsqrtf(ss * (1.0f / D) + EPS);
#pragma unroll
            for (int j = 0; j < 4; ++j) { const int d = j * 256 + lane * 4; *(f32x4*)(x + (size_t)(row + u) * D + d) = v[u][j] * rs * gn[j]; }
        }
    }
}

constexpr int QS_ST = 136, KT_ST = 40;
constexpr int P1_QS = 0, P1_KH = P1_QS + 32 * QS_ST * 2, P1_VT = P1_KH + 32 * QS_ST * 2, P1_KT = P1_VT + 128 * KT_ST * 2, P1_AW = P1_KT + 128 * KT_ST * 2;
constexpr int P1_DIRSZ = P1_AW + 8 * 32 * KT_ST * 2;
constexpr int NCH = 8 + 128;

template <int CTRL, int RMASK> __device__ __forceinline__ float dpp_mul(float x) {
    const int t = __builtin_amdgcn_update_dpp(0x3f800000, __builtin_bit_cast(int, x), CTRL, RMASK, 0xf, false);
    return x * __builtin_bit_cast(float, t);
}
__device__ __forceinline__ float cumprod32(float x) {
    x = dpp_mul<0x111, 0xf>(x); x = dpp_mul<0x112, 0xf>(x); x = dpp_mul<0x114, 0xf>(x); x = dpp_mul<0x118, 0xf>(x);
    x = dpp_mul<0x142, 0xa>(x);
    return x;
}

#define DPP8_STEP(CTRL) asm volatile("s_nop 1\n\t" \
    "v_mul_f32_dpp %0, %0, %0 " CTRL "\n\tv_mul_f32_dpp %1, %1, %1 " CTRL "\n\tv_mul_f32_dpp %2, %2, %2 " CTRL "\n\tv_mul_f32_dpp %3, %3, %3 " CTRL "\n\t" \
    "v_mul_f32_dpp %4, %4, %4 " CTRL "\n\tv_mul_f32_dpp %5, %5, %5 " CTRL "\n\tv_mul_f32_dpp %6, %6, %6 " CTRL "\n\tv_mul_f32_dpp %7, %7, %7 " CTRL "\n\ts_nop 1" \
    : "+v"(e[0]), "+v"(e[1]), "+v"(e[2]), "+v"(e[3]), "+v"(e[4]), "+v"(e[5]), "+v"(e[6]), "+v"(e[7]))
__device__ __forceinline__ void cumprod32x8(float (&e)[8]) {
    asm volatile("s_nop 4" ::: );
    DPP8_STEP("row_shr:1 row_mask:0xf bank_mask:0xf");
    DPP8_STEP("row_shr:2 row_mask:0xf bank_mask:0xf");
    DPP8_STEP("row_shr:4 row_mask:0xf bank_mask:0xf");
    DPP8_STEP("row_shr:8 row_mask:0xf bank_mask:0xf");
    DPP8_STEP("row_bcast:15 row_mask:0xa bank_mask:0xf");
}
__device__ void prep_item(const Params& p, int l, int item, LAS unsigned char* lds) {
    const int tid = opaque_tid(), w = tid >> 6, lane = tid & 63;
    const int tau = lane & 31, kh = lane >> 5, k0 = 16 * w + 8 * kh, l15 = lane & 15, q4 = lane >> 4;
    const int ci = item % NCH, bh = item / NCH, h = bh & 3, b = bh >> 2;
    const int R0 = ci < 8 ? NLAT + b * 256 + 32 * ci : b * 4096 + 32 * (ci - 8);
    bf16_t* P = (bf16_t*)(p.ws + WS_BIG);
    const bool first = (l == 0);
    const bool want_out = first || ci >= 8;
    for (int dd = 0; dd < 2; ++dd) { LAS unsigned* az = (LAS unsigned*)(lds + dd * P1_DIRSZ + P1_AW) + w * (32 * KT_ST / 2); for (int i = lane; i < 32 * KT_ST / 2; i += 64) az[i] = 0u; }
    u32x4 rf0, rq0, rv0, rf1, rq1, rv1;
    { const bf16_t* rp = P + (size_t)(R0 + tau) * PW; rf0 = *(const u32x4*)(rp + h * 128 + k0); rq0 = *(const u32x4*)(rp + 1536 + h * 128 + k0); rv0 = *(const u32x4*)(rp + 1024 + h * 128 + k0); }
    { const bf16_t* rp = P + (size_t)(R0 + 31 - tau) * PW; rf1 = *(const u32x4*)(rp + 512 + h * 128 + k0); rq1 = *(const u32x4*)(rp + 1536 + h * 128 + k0); rv1 = *(const u32x4*)(rp + 1024 + h * 128 + k0); }
    asm volatile("s_waitcnt vmcnt(0)" ::: "memory");
    __syncthreads();
    auto valu_part = [&](const int dir, const u32x4& f, const u32x4& q, const u32x4& v) {
        LAS unsigned char* db = lds + dir * P1_DIRSZ;
        LAS bf16_t* Qs = (LAS bf16_t*)(db + P1_QS); LAS bf16_t* Kh = (LAS bf16_t*)(db + P1_KH);
        LAS bf16_t* Vt = (LAS bf16_t*)(db + P1_VT); LAS bf16_t* Kt = (LAS bf16_t*)(db + P1_KT);
        LAS bf16_t* Aw = (LAS bf16_t*)(db + P1_AW) + w * 32 * KT_ST;
        const int tokl = dir ? 31 - tau : tau;
        const float* lbp = (const float*)(p.ws + WS_LB) + dir * 512 + h * 128 + k0;
        float E[8], kk[8];
#pragma unroll
        for (int j = 0; j < 8; ++j) {
            const unsigned fw = f[j >> 1]; const float x = (j & 1) ? bf_hi(fw) : bf_lo(fw);
            const float e = __expf(-fabsf(x)), r = fast_rcp(1.0f + e);
            const float sp = x >= 0.f ? r : e * r, sn = x >= 0.f ? e * r : r;
            if (first) { E[j] = sp; kk[j] = sn; }
            else { const float lb = lbp[j]; const float gate = lb + (1.0f - lb) * sp; E[j] = gate; kk[j] = 1.0f - gate; }
        }
        float qt[8], kh_[8], kt_[8], Tj[8];
        cumprod32x8(E);
#pragma unroll
        for (int j = 0; j < 8; ++j) {
            const float Ej = fmaxf(E[j], 1e-35f);
            const float T0 = __builtin_bit_cast(float, __builtin_amdgcn_readlane(__builtin_bit_cast(int, Ej), 31)), T1 = __builtin_bit_cast(float, __builtin_amdgcn_readlane(__builtin_bit_cast(int, Ej), 63));
            const float T = kh ? T1 : T0;
            const unsigned qw = q[j >> 1]; const float qx = (j & 1) ? bf_hi(qw) : bf_lo(qw);
            qt[j] = silu_f(qx) * 0.08838834764831845f * Ej;
            kh_[j] = kk[j] * fast_rcp(Ej); kt_[j] = kh_[j] * T;
            Tj[j] = T;
        }
        if (tau == 31) { float* dp = (float*)(p.ws + WS_DS) + ((size_t)((b * 4 + h) * 2 + dir) * NCH + ci) * 128 + k0;
            *(f32x4*)dp = (f32x4){Tj[0], Tj[1], Tj[2], Tj[3]}; *(f32x4*)(dp + 4) = (f32x4){Tj[4], Tj[5], Tj[6], Tj[7]}; }
        u32x4 wq, wk; wq.x = pk_bf16(qt[0], qt[1]); wq.y = pk_bf16(qt[2], qt[3]); wq.z = pk_bf16(qt[4], qt[5]); wq.w = pk_bf16(qt[6], qt[7]);
        wk.x = pk_bf16(kh_[0], kh_[1]); wk.y = pk_bf16(kh_[2], kh_[3]); wk.z = pk_bf16(kh_[4], kh_[5]); wk.w = pk_bf16(kh_[6], kh_[7]);
        *(LAS u32x4*)(Qs + tau * QS_ST + k0) = wq; *(LAS u32x4*)(Kh + tau * QS_ST + k0) = wk;
        {
          bf16_t* qd = (dir == 0) ? P + (size_t)(R0 + tokl) * PW + 1536 + h * 128 : (bf16_t*)(p.ws + WS_QB) + (size_t)(R0 + tokl) * 512 + h * 128;
          const int a32 = k0 & ~31, kkA = k0 & 31, kkB = kkA + 4;
          u32x2 pa, pb; pa.x = wq.x; pa.y = wq.y; pb.x = wq.z; pb.y = wq.w;
          *(u32x2*)(qd + a32 + 8 * ((kkA & 15) >> 2) + 4 * (kkA >> 4)) = pa;
          *(u32x2*)(qd + a32 + 8 * ((kkB & 15) >> 2) + 4 * (kkB >> 4)) = pb; }
#pragma unroll
        for (int j = 0; j < 8; ++j) { Kt[(k0 + j) * KT_ST + tokl] = to_bf1(kt_[j]); const unsigned vw = v[j >> 1]; Vt[(k0 + j) * KT_ST + tau] = (bf16_t)((j & 1) ? (vw >> 16) : (vw & 0xffffu)); }
    };
    auto mfma_part = [&](const int dir) {
        LAS unsigned char* db = lds + dir * P1_DIRSZ;
        LAS bf16_t* Qs = (LAS bf16_t*)(db + P1_QS); LAS bf16_t* Kh = (LAS bf16_t*)(db + P1_KH);
        LAS bf16_t* Vt = (LAS bf16_t*)(db + P1_VT); LAS bf16_t* Kt = (LAS bf16_t*)(db + P1_KT);
        LAS bf16_t* Aw = (LAS bf16_t*)(db + P1_AW) + w * 32 * KT_ST;
        const int tokl = dir ? 31 - tau : tau; (void)tokl;
        if (want_out) {
            f32x4 a00 = (f32x4){0.f, 0.f, 0.f, 0.f}, a10 = a00, a11 = a00;
#pragma unroll
            for (int kb = 0; kb < 4; ++kb) {
                const bf16x8 qn0 = *(const LAS bf16x8*)(Qs + l15 * QS_ST + 32 * kb + 8 * q4), qn1 = *(const LAS bf16x8*)(Qs + (16 + l15) * QS_ST + 32 * kb + 8 * q4);
                const bf16x8 kh0 = *(const LAS bf16x8*)(Kh + l15 * QS_ST + 32 * kb + 8 * q4), kh1 = *(const LAS bf16x8*)(Kh + (16 + l15) * QS_ST + 32 * kb + 8 * q4);
                a00 = __builtin_amdgcn_mfma_f32_16x16x32_bf16(qn0, kh0, a00, 0, 0, 0);
                a10 = __builtin_amdgcn_mfma_f32_16x16x32_bf16(qn1, kh0, a10, 0, 0, 0);
                a11 = __builtin_amdgcn_mfma_f32_16x16x32_bf16(qn1, kh1, a11, 0, 0, 0);
            }
#pragma unroll
            for (int i = 0; i < 4; ++i) { const int t = 4 * q4 + i; const bool keep = l15 <= t;
                Aw[t * KT_ST + l15] = to_bf1(keep ? a00[i] : 0.f);
                Aw[(16 + t) * KT_ST + l15] = to_bf1(a10[i]);
                Aw[(16 + t) * KT_ST + 16 + l15] = to_bf1(keep ? a11[i] : 0.f); }
            asm volatile("s_waitcnt lgkmcnt(0)" ::: "memory");
            const bf16x8 vf = *(const LAS bf16x8*)(Vt + (16 * w + l15) * KT_ST + 8 * q4);
            bf16_t* OFB = (bf16_t*)(p.ws + WS_OFB) + (size_t)dir * NROW * 512;
#pragma unroll
            for (int mt = 0; mt < 2; ++mt) {
                const bf16x8 af = *(const LAS bf16x8*)(Aw + (16 * mt + l15) * KT_ST + 8 * q4);
                const f32x4 o = __builtin_amdgcn_mfma_f32_16x16x32_bf16(vf, af, (f32x4){0.f, 0.f, 0.f, 0.f}, 0, 0, 0);
                const int tl = 16 * mt + l15, tok = dir ? 31 - tl : tl;
                u32x2 wv; wv.x = pk_bf16(o[0], o[1]); wv.y = pk_bf16(o[2], o[3]);
                *(u32x2*)(OFB + (size_t)(R0 + tok) * 512 + h * 128 + 16 * w + 4 * q4) = wv;
            }
        }
        { const int k = tid >> 2, part = tid & 3;
          const u32x4 kv = *(const LAS u32x4*)(Kt + k * KT_ST + 8 * part);
          bf16_t* dst = P + (size_t)(R0 + (k >> 2)) * PW + h * 128 + (k & 3) * 32 + (part ^ ((k >> 2) & 3)) * 8;
          *(u32x4*)(dst + dir * 512) = kv;
          if (dir == 0) { const u32x4 vv = *(const LAS u32x4*)(Vt + k * KT_ST + 8 * part); *(u32x4*)(dst + 1024) = vv; } }
    };
    valu_part(0, rf0, rq0, rv0);
    valu_part(1, rf1, rq1, rv1);
    __syncthreads();
    mfma_part(0);
    mfma_part(1);
    __syncthreads();
}

constexpr int ST_Q = 0, ST_K = 8192, ST_V = 16384, ST_O = 20480, ST_D = 24576, ST_BYTES = 25088, NSTAGE = 6;
__device__ void scan_chain(const Params& p, int l, int chain, int vhalf, LAS unsigned char* lds) {
    const int tid = opaque_tid(), w = __builtin_amdgcn_readfirstlane(tid >> 6), lane = tid & 63, l15 = lane & 15, q4 = lane >> 4;
    const int dir = chain & 1, h = (chain >> 1) & 3, b = chain >> 3;
    bf16_t* P = (bf16_t*)(p.ws + WS_BIG);
    auto chunk_of = [&](int s) -> int { return dir ? (s < 8 ? 7 - s : 143 - s) : s; };
    auto row0_of = [&](int c) -> int { return c < 8 ? NLAT + b * 256 + 32 * c : b * 4096 + 32 * (c - 8); };
    bf16_t* qb = dir ? (bf16_t*)(p.ws + WS_QB) + h * 128 : P + 1536 + h * 128;
    const int qpitch = dir ? 512 : PW;
    if (w >= 4) {
        const int lw = w - 4;
        const int r16 = lane >> 4, s16 = lane & 15;
        size_t qoff[2], koff[2];
#pragma unroll
        for (int i = 0; i < 2; ++i) { const int row = 8 * lw + 4 * i + r16; qoff[i] = (size_t)row * qpitch + ((s16 ^ (row & 15)) * 8);
            koff[i] = (size_t)(4 * (2 * lw + i) + r16) * PW + dir * 512 + h * 128 + s16 * 8; }
        const size_t voff = (size_t)(16 * vhalf + 4 * lw + r16) * PW + 1024 + h * 128 + s16 * 8;
        const float* dsrc = (const float*)(p.ws + WS_DS) + (size_t)chain * NCH * 128 + (lw & 1) * 64 + lane;
        const int orow = 8 * lw + (lane >> 3);
        const size_t ooff = (size_t)orow * 512 + h * 128 + 64 * vhalf + (((lane & 7) ^ (orow & 7)) * 8);
        const bf16_t* OFBc = (const bf16_t*)(p.ws + WS_OFB) + (size_t)dir * NROW * 512;
        auto issue = [&](int s) {
            const int sc = s < NCH ? s : NCH - 1;
            const int c = chunk_of(sc), R0 = row0_of(c);
            LAS unsigned char* st = lds + (s % NSTAGE) * ST_BYTES;
            const bf16_t* qrow = qb + (size_t)R0 * qpitch; const bf16_t* krow = P + (size_t)R0 * PW;
#pragma unroll
            for (int i = 0; i < 2; ++i) {
                __builtin_amdgcn_global_load_lds((const unsigned*)(qrow + qoff[i]), (LAS unsigned*)(st + ST_Q + (2 * lw + i) * 1024), 16, 0, 0);
                __builtin_amdgcn_global_load_lds((const unsigned*)(krow + koff[i]), (LAS unsigned*)(st + ST_K + (2 * lw + i) * 1024), 16, 0, 0);
            }
            __builtin_amdgcn_global_load_lds((const unsigned*)(krow + voff), (LAS unsigned*)(st + ST_V + lw * 1024), 16, 0, 0);
            __builtin_amdgcn_global_load_lds((const unsigned*)(dsrc + (size_t)c * 128), (LAS unsigned*)(st + ST_D + (lw & 1) * 256), 4, 0, 0);
            __builtin_amdgcn_global_load_lds((const unsigned*)(OFBc + (size_t)R0 * 512 + ooff), (LAS unsigned*)(st + ST_O + lw * 1024), 16, 0, 0);
        };
        issue(0); issue(1); issue(2); issue(3); issue(4);
        asm volatile("s_waitcnt vmcnt(28)" ::: "memory");
        __builtin_amdgcn_s_barrier();
        for (int s = 0; s < NCH; ++s) {
            issue(s + 5);
            asm volatile("s_waitcnt vmcnt(28)" ::: "memory");
            __builtin_amdgcn_s_barrier();
        }
        asm volatile("s_waitcnt vmcnt(0)" ::: "memory");
    } else {
        f32x4 S[8];
#pragma unroll
        for (int j = 0; j < 8; ++j) S[j] = (f32x4){0.f, 0.f, 0.f, 0.f};
        const int swz = (l15 >> 2) & 3, vcol = 64 * vhalf + 16 * w;
        bf16_t* OFBw = (bf16_t*)(p.ws + WS_OFB) + (size_t)dir * NROW * 512;
        __builtin_amdgcn_s_barrier();
        for (int s = 0; s < NCH; ++s) {
            LAS unsigned char* st = lds + (s % NSTAGE) * ST_BYTES;
            bf16x8 qf[4][2], kf[8]; f32x4 dv[8];
#pragma unroll
            for (int kb = 0; kb < 4; ++kb)
#pragma unroll
                for (int mt = 0; mt < 2; ++mt) {
                    qf[kb][mt] = *(const LAS bf16x8*)(st + ST_Q + (16 * mt + l15) * 256 + (((4 * kb + q4) ^ l15) * 16));
                }
            const bf16x8 vf = *(const LAS bf16x8*)(st + ST_V + (16 * w + l15) * 64 + ((q4 ^ swz) * 16));
            u32x2 oi[2];
#pragma unroll
            for (int mt = 0; mt < 2; ++mt) { const int tr = 16 * mt + l15; oi[mt] = *(const LAS u32x2*)(st + ST_O + tr * 128 + (((2 * w + (q4 >> 1)) ^ (tr & 7)) * 16) + (q4 & 1) * 8); }
#pragma unroll
            for (int j = 0; j < 8; ++j) { dv[j] = *(const LAS f32x4*)(st + ST_D + (16 * j + 4 * q4) * 4); kf[j] = *(const LAS bf16x8*)(st + ST_K + (16 * j + l15) * 64 + ((q4 ^ swz) * 16)); }
            __builtin_amdgcn_sched_barrier(0);
            f32x4 o[2]; o[0] = (f32x4){0.f, 0.f, 0.f, 0.f}; o[1] = o[0];
#pragma unroll
            for (int kb = 0; kb < 4; ++kb) {
                u32x4 sb; sb.x = pk_bf16(S[2 * kb][0], S[2 * kb][1]); sb.y = pk_bf16(S[2 * kb][2], S[2 * kb][3]); sb.z = pk_bf16(S[2 * kb + 1][0], S[2 * kb + 1][1]); sb.w = pk_bf16(S[2 * kb + 1][2], S[2 * kb + 1][3]);
                const bf16x8 sfr = __builtin_bit_cast(bf16x8, sb);
                o[0] = __builtin_amdgcn_mfma_f32_16x16x32_bf16(sfr, qf[kb][0], o[0], 0, 0, 0);
                o[1] = __builtin_amdgcn_mfma_f32_16x16x32_bf16(sfr, qf[kb][1], o[1], 0, 0, 0);
            }
#pragma unroll
            for (int j = 0; j < 8; ++j) S[j] = __builtin_amdgcn_mfma_f32_16x16x32_bf16(kf[j], vf, S[j] * dv[j], 0, 0, 0);
            const int R0 = row0_of(chunk_of(s));
#pragma unroll
            for (int mt = 0; mt < 2; ++mt) { const int tr = 16 * mt + l15;
                u32x2 wv; wv.x = pk_bf16(o[mt][0] + bf_lo(oi[mt].x), o[mt][1] + bf_hi(oi[mt].x)); wv.y = pk_bf16(o[mt][2] + bf_lo(oi[mt].y), o[mt][3] + bf_hi(oi[mt].y));
                *(u32x2*)(OFBw + (size_t)(R0 + tr) * 512 + h * 128 + vcol + 4 * q4) = wv; }
            asm volatile("s_waitcnt lgkmcnt(0)" ::: "memory");
            __builtin_amdgcn_s_barrier();
        }
    }
}

constexpr int SG_ST = 136;
__device__ void sgu_tile(const Params& p, int l, int tile, LAS unsigned char* lds) {
    const int tid = opaque_tid(), w = tid >> 6, lane = tid & 63, l15 = lane & 15, q4 = lane >> 4;
    const int h = tile & 3, rowbase = (tile >> 2) * 128;
    const bf16_t* P = (const bf16_t*)(p.ws + WS_BIG);
    bf16_t* O = (bf16_t*)(p.ws + WS_H);
    LAS bf16_t* Vt = (LAS bf16_t*)lds;
    {
        const int q = tid >> 2, cgp = tid & 3;
        const bf16_t* vp = P + (size_t)(rowbase + q) * PW + 3072 + 128 * h + 32 * cgp;
        float g[32];
#pragma unroll
        for (int i = 0; i < 4; ++i) { const u32x4 r = *(const u32x4*)(vp + 8 * i);
#pragma unroll
            for (int j = 0; j < 4; ++j) { g[8 * i + 2 * j] = gelu_f(bf_lo(r[j])); g[8 * i + 2 * j + 1] = gelu_f(bf_hi(r[j])); } }
        float s = 0.f;
#pragma unroll
        for (int i = 0; i < 32; ++i) s += g[i];
        s += __shfl_xor(s, 1); s += __shfl_xor(s, 2);
        const float mu = s * (1.0f / 128.f);
        float vs = 0.f;
#pragma unroll
        for (int i = 0; i < 32; ++i) { const float d = g[i] - mu; vs += d * d; }
        vs += __shfl_xor(vs, 1); vs += __shfl_xor(vs, 2);
        const float rstd = rsqrtf(vs * (1.0f / 128.f) + EPS);
        const float* lng = p.in[12] + l * 512 + h * 128 + 32 * cgp; const float* lnb = p.in[13] + l * 512 + h * 128 + 32 * cgp;
#pragma unroll
        for (int i = 0; i < 32; ++i) { const float y = (g[i] - mu) * rstd * lng[i] + lnb[i]; Vt[(32 * cgp + i) * SG_ST + q] = to_bf1(y); }
    }
    __syncthreads();
    {
        const int prow = 16 * w + l15;
        const bf16_t* wsp = (const bf16_t*)(p.ws + WS_WSP) + ((size_t)(l * 4 + h) * 128 + prow) * 128 + 8 * q4;
        bf16x8 wf[4];
#pragma unroll
        for (int kb = 0; kb < 4; ++kb) wf[kb] = *(const bf16x8*)(wsp + 32 * kb);
        const float bs = p.in[15][(l * 4 + h) * 128 + prow];
        const bf16_t* up = P + (size_t)(rowbase + prow) * PW + 2560 + 128 * h + 4 * q4;
        bf16_t* op = O + (size_t)(rowbase + prow) * D + 512 + 128 * h + 4 * q4;
        u32x2 uall[8];
#pragma unroll
        for (int mt = 0; mt < 8; ++mt) uall[mt] = *(const u32x2*)(up + 16 * mt);
#pragma unroll
        for (int mt = 0; mt < 8; ++mt) {
            f32x4 acc = (f32x4){0.f, 0.f, 0.f, 0.f};
#pragma unroll
            for (int kb = 0; kb < 4; ++kb) { const bf16x8 af = *(const LAS bf16x8*)(Vt + (16 * mt + l15) * SG_ST + 32 * kb + 8 * q4);
                acc = __builtin_amdgcn_mfma_f32_16x16x32_bf16(af, wf[kb], acc, 0, 0, 0); }
            const u32x2 uu = uall[mt];
            const float u0 = gelu_f(bf_lo(uu.x)), u1 = gelu_f(bf_hi(uu.x)), u2 = gelu_f(bf_lo(uu.y)), u3 = gelu_f(bf_hi(uu.y));
            u32x2 wv; wv.x = pk_bf16(u0 * (acc[0] + bs), u1 * (acc[1] + bs)); wv.y = pk_bf16(u2 * (acc[2] + bs), u3 * (acc[3] + bs));
            *(u32x2*)(op + 16 * mt) = wv;
        }
    }
    __syncthreads();
}

constexpr int SGU_IN_M2 = 1088;
__device__ void phase_mixer(const Params& p, int l, LAS unsigned char* lds) {
    const int G = gridDim.x, bid = blockIdx.x;
    const int ntile = (l == 0) ? (NROW / 128) * 4 : (NLAT / 128) * 4;
    if (G > 128) {
        if (bid < 128) scan_chain(p, l, bid >> 1, bid & 1, lds);
        else for (int t = bid - 128; t < (ntile < SGU_IN_M2 ? ntile : SGU_IN_M2); t += G - 128) sgu_tile(p, l, t, lds);
    } else {
        for (int c = bid; c < 128; c += G) { scan_chain(p, l, c >> 1, c & 1, lds); __syncthreads(); }
        for (int t = bid; t < ntile; t += G) sgu_tile(p, l, t, lds);
    }
}

__device__ void phase_combine(const Params& p, int l, int nrows) {
    const int tid_ = opaque_tid(); const int wave = tid_ >> 6, lane = tid_ & 63, hd = lane >> 4, v0 = (lane & 15) * 8;
    const bf16_t* P = (const bf16_t*)(p.ws + WS_BIG);
    const bf16_t* OF = (const bf16_t*)(p.ws + WS_OFB); const bf16_t* OB = OF + (size_t)NROW * 512;
    bf16_t* O = (bf16_t*)(p.ws + WS_H);
    const float* gn = p.in[11] + l * 512 + hd * 128 + v0;
    const f32x4 g0 = *(const f32x4*)gn, g1 = *(const f32x4*)(gn + 4);
    for (int row0 = (blockIdx.x * 8 + wave) * 4; row0 < nrows; row0 += gridDim.x * 32) {
        u32x4 a[4], bq[4], gg[4];
#pragma unroll
        for (int u = 0; u < 4; ++u) { const size_t row = row0 + u;
            a[u] = *(const u32x4*)(OF + row * 512 + hd * 128 + v0); bq[u] = *(const u32x4*)(OB + row * 512 + hd * 128 + v0);
            gg[u] = *(const u32x4*)(P + row * PW + 2048 + hd * 128 + v0); }
#pragma unroll
        for (int u = 0; u < 4; ++u) {
            float s[8]; float ss = 0.f;
#pragma unroll
            for (int j = 0; j < 4; ++j) { s[2 * j] = bf_lo(a[u][j]) + bf_lo(bq[u][j]); s[2 * j + 1] = bf_hi(a[u][j]) + bf_hi(bq[u][j]); ss += s[2 * j] * s[2 * j] + s[2 * j + 1] * s[2 * j + 1]; }
#pragma unroll
            for (int o = 8; o > 0; o >>= 1) ss += __shfl_xor(ss, o);
            const float rs = rsqrtf(ss * (1.0f / 128.f) + EPS);
            float y[8];
#pragma unroll
            for (int j = 0; j < 4; ++j) { y[2 * j] = s[2 * j] * rs * (j < 2 ? g0[2 * j] : g1[2 * j - 4]) * silu_f(bf_lo(gg[u][j])); y[2 * j + 1] = s[2 * j + 1] * rs * (j < 2 ? g0[2 * j + 1] : g1[2 * j - 3]) * silu_f(bf_hi(gg[u][j])); }
            u32x4 wv; wv.x = pk_bf16(y[0], y[1]); wv.y = pk_bf16(y[2], y[3]); wv.z = pk_bf16(y[4], y[5]); wv.w = pk_bf16(y[6], y[7]);
            *(u32x4*)(O + (size_t)(row0 + u) * D + hd * 128 + v0) = wv;
        }
    }
}

__device__ void phase_conv(const Params& p, int l, int nrows) {
    bf16_t* Aup = (bf16_t*)(p.ws + WS_BIG); const bf16_t* Gup = Aup + (size_t)NROW * FF;
    const float* cw = p.in[18] + (size_t)l * 9 * FF; const float* cb = p.in[19] + (size_t)l * FF;
    const int tid_ = opaque_tid();
    const long total = (long)(nrows / 16) * 352;
    for (long id0 = (long)blockIdx.x * 512 + tid_; id0 < total; id0 += (long)gridDim.x * 512) {
        const int seg = (int)((total - 1 - id0) / 352), f0 = (int)(id0 % 352) * 8;
        const int tok0 = seg * 16;
        int c0, W; bool up, dn;
        if (tok0 < NLAT) { const int t = tok0 & 4095, r = t >> 6; c0 = t & 63; W = 64; up = r > 0; dn = r < 63; }
        else { c0 = (tok0 - NLAT) & 255; W = 256; up = false; dn = false; }
        float tp[9][8]; float bias[8];
#pragma unroll
        for (int k = 0; k < 9; ++k) { const f32x4 t0 = *(const f32x4*)(cw + k * FF + f0), t1 = *(const f32x4*)(cw + k * FF + f0 + 4);
            tp[k][0] = t0[0]; tp[k][1] = t0[1]; tp[k][2] = t0[2]; tp[k][3] = t0[3]; tp[k][4] = t1[0]; tp[k][5] = t1[1]; tp[k][6] = t1[2]; tp[k][7] = t1[3]; }
        { const f32x4 b0 = *(const f32x4*)(cb + f0), b1 = *(const f32x4*)(cb + f0 + 4); bias[0] = b0[0]; bias[1] = b0[1]; bias[2] = b0[2]; bias[3] = b0[3]; bias[4] = b1[0]; bias[5] = b1[1]; bias[6] = b1[2]; bias[7] = b1[3]; }
        const u32x4 zero = (u32x4){0u, 0u, 0u, 0u};
        const bf16_t* gp = Gup + (size_t)tok0 * FF + f0;
        u32x4 L[3], M[3], R[3];
        { const bool v = c0 > 0;
          L[0] = (v && up) ? *(const u32x4*)(gp - (size_t)65 * FF) : zero; L[1] = v ? *(const u32x4*)(gp - (size_t)FF) : zero; L[2] = (v && dn) ? *(const u32x4*)(gp + (size_t)63 * FF) : zero; }
        M[0] = up ? *(const u32x4*)(gp - (size_t)64 * FF) : zero; M[1] = *(const u32x4*)gp; M[2] = dn ? *(const u32x4*)(gp + (size_t)64 * FF) : zero;
#pragma unroll 8
        for (int i = 0; i < 16; ++i) {
            const bf16_t* np = gp + (size_t)(i + 1) * FF;
            const bool v = (c0 + i + 1) < W;
            R[0] = (v && up) ? *(const u32x4*)(np - (size_t)64 * FF) : zero; R[1] = v ? *(const u32x4*)np : zero; R[2] = (v && dn) ? *(const u32x4*)(np + (size_t)64 * FF) : zero;
            float acc[8];
#pragma unroll
            for (int j = 0; j < 8; ++j) acc[j] = bias[j];
#pragma unroll
            for (int rr = 0; rr < 3; ++rr) {
#pragma unroll
                for (int j = 0; j < 4; ++j) {
                    acc[2 * j] += bf_lo(L[rr][j]) * tp[rr * 3 + 0][2 * j] + bf_lo(M[rr][j]) * tp[rr * 3 + 1][2 * j] + bf_lo(R[rr][j]) * tp[rr * 3 + 2][2 * j];
                    acc[2 * j + 1] += bf_hi(L[rr][j]) * tp[rr * 3 + 0][2 * j + 1] + bf_hi(M[rr][j]) * tp[rr * 3 + 1][2 * j + 1] + bf_hi(R[rr][j]) * tp[rr * 3 + 2][2 * j + 1];
                }
            }
            bf16_t* ap = Aup + (size_t)(tok0 + i) * FF + f0;
            const u32x4 av = *(const u32x4*)ap;
            u32x4 wv;
#pragma unroll
            for (int j = 0; j < 4; ++j) wv[j] = pk_bf16(bf_lo(av[j]) * gelu_f(acc[2 * j]), bf_hi(av[j]) * gelu_f(acc[2 * j + 1]));
            *(u32x4*)ap = wv;
#pragma unroll
            for (int rr = 0; rr < 3; ++rr) { L[rr] = M[rr]; M[rr] = R[rr]; }
        }
    }
}

#define XB_TMO      128
#define XB_XCNT(j)  (256  + 64 * (j))
#define XB_XSUB(j)  (1280 + 64 * (j))
#define XB_XGEN(j)  (2304 + 64 * (j))
#define XB_TOP      3328
#define XB_TOPGEN   3392
#define XCD_BAR_WORDS 3456
#define XB_SPIN_CAP (1u << 20)
__device__ __forceinline__ unsigned xb_ld(unsigned* p)              { return __hip_atomic_load(p, __ATOMIC_RELAXED, __HIP_MEMORY_SCOPE_AGENT); }
__device__ __forceinline__ unsigned xb_add(unsigned* p, unsigned v) { return __hip_atomic_fetch_add(p, v, __ATOMIC_RELAXED, __HIP_MEMORY_SCOPE_AGENT); }
__device__ __forceinline__ unsigned xb_xcc_id() { return (unsigned)__builtin_amdgcn_s_getreg((3 << 11) | 20) & 0xFu; }
#define XB_SPIN(cond, bar) do { unsigned _sp = 0; while (cond) { __builtin_amdgcn_s_sleep(1); \
    if ((++_sp & 255u) == 0u) { if (xb_ld(&(bar)[XB_TMO])) break; if (_sp > XB_SPIN_CAP) { atomicAdd(&(bar)[XB_TMO], 1u); break; } } } } while (0)
struct XcdBarrier { unsigned* bar; unsigned x; volatile LAS unsigned* st; };
__device__ __forceinline__ XcdBarrier xcd_barrier_post(unsigned* bar, volatile LAS unsigned* st) {
    XcdBarrier b; b.bar = bar; b.x = xb_xcc_id(); b.st = st;
    if (threadIdx.x == 0) (void)xb_add(&bar[XB_XCNT(b.x)], 1u);
    return b;
}
__device__ __forceinline__ void xcd_barrier_complete(unsigned* bar, unsigned x, unsigned& nloc, unsigned& nx) {
    const unsigned G = gridDim.x * gridDim.y * gridDim.z;
    unsigned sum, cnt, mine, sp = 0u;
    for (;;) {
        sum = 0u; cnt = 0u; mine = 0u;
#pragma unroll
        for (unsigned j = 0; j < 16; ++j) { const unsigned c = xb_ld(&bar[XB_XCNT(j)]); sum += c; cnt += (c > 0u) ? 1u : 0u; mine = (j == x) ? c : mine; }
        if (sum == G) break;
        __builtin_amdgcn_s_sleep(1);
        if ((++sp & 255u) == 0u) { if (xb_ld(&bar[XB_TMO])) break; if (sp > XB_SPIN_CAP) { atomicAdd(&bar[XB_TMO], 1u); break; } }
    }
    nloc = mine > 0u ? mine : 1u; nx = cnt > 0u ? cnt : 1u;
}
__device__ __forceinline__ void xcd_barrier(const XcdBarrier& b) {
    asm volatile("s_waitcnt vmcnt(0)" ::: "memory");
    __syncthreads();
    if (threadIdx.x == 0) {
        unsigned* bar = b.bar;
        __builtin_amdgcn_s_waitcnt(0);
        unsigned nloc = b.st[0], nx = b.st[1];
        if (nloc == 0u) { xcd_barrier_complete(bar, b.x, nloc, nx); b.st[0] = nloc; b.st[1] = nx; }
        const unsigned old = xb_add(&bar[XB_XSUB(b.x)], 1u);
        const unsigned gen = old / nloc;
        if (old + 1u == (gen + 1u) * nloc) {
            __builtin_amdgcn_fence(__ATOMIC_RELEASE, "agent");
            asm volatile("s_waitcnt vmcnt(0)" ::: "memory");
            const unsigned og = xb_add(&bar[XB_TOP], 1u);
            const unsigned tg = og / nx;
            if (og + 1u == (tg + 1u) * nx) xb_add(&bar[XB_TOPGEN], 1u);
            else XB_SPIN(xb_ld(&bar[XB_TOPGEN]) == tg, bar);
            __builtin_amdgcn_fence(__ATOMIC_ACQUIRE, "agent");
            xb_add(&bar[XB_XGEN(b.x)], 1u);
            asm volatile("s_waitcnt vmcnt(0)" ::: "memory");
        } else {
            XB_SPIN(xb_ld(&bar[XB_XGEN(b.x)]) == gen, bar);
            __builtin_amdgcn_fence(__ATOMIC_ACQUIRE, "agent");
            asm volatile("s_waitcnt vmcnt(0)" ::: "memory");
        }
    }
    __syncthreads();
}

__global__ void __launch_bounds__(512, 2) fwd_megakernel(Params p) {
    extern __shared__ __attribute__((aligned(16))) unsigned char shm[];
    LAS unsigned char* lds = (LAS unsigned char*)shm;
    cg::grid_group grid = cg::this_grid();
    __shared__ uint4 xb_words;
    if (threadIdx.x == 0) xb_words = make_uint4(0u, 0u, 0u, 0u);
    __syncthreads();
    const XcdBarrier xb = xcd_barrier_post((unsigned*)(p.ws + WS_BAR), (volatile LAS unsigned*)&xb_words);
    const int G = gridDim.x, bid = blockIdx.x;
    float* XC = (float*)(p.ws + WS_XC);
    bf16_t* H = (bf16_t*)(p.ws + WS_H);
    bf16_t* BIG = (bf16_t*)(p.ws + WS_BIG);
    const float* ADA = (const float*)(p.ws + WS_ADA);
    bf16_t* Y2 = BIG + (size_t)NROW * FF;

    phase_prep(p, lds);
    if (p.ws == nullptr) grid.sync();
    xcd_barrier(xb);
    for (int l = 0; l < DEPTH; ++l) {
        const bool last = (l == DEPTH - 1);
        const float* ada_l = ADA + (size_t)l * 9 * 6144;
        const float* xl = (l == 0) ? p.in[0] : p.out;
        const float* xc = (l == 0) ? p.in[2] : XC;
        const int Mfull = last ? NLAT : NROW;
        if (l == 0) phase_norm(xl, xc, nullptr, nullptr, nullptr, nullptr, p.in[6] + l * D, ada_l, 0, NROW, H);
        else phase_norm(p.out, XC, Y2, ADA + (size_t)(l - 1) * 9 * 6144 + 5 * 1024, p.out, nullptr, p.in[6] + l * D, ada_l, 0, NROW, H);
        xcd_barrier(xb);
        { pg8::StaticOrder S; S.init(NROW, PW, G, bid);
          pg8::EpiBf16 E{BIG, PW, 0, 0};
          pg8::gemm_phase(lds, pg8::Gemm{H, (const bf16_t*)(p.ws + WS_WIN) + (size_t)l * PW * D, NROW, PW, D}, S, E); }
        xcd_barrier(xb);
        { const int ntile = (l == 0) ? (NROW / 128) * 4 : (NLAT / 128) * 4;
          const int nextra = (G > 128 && ntile > SGU_IN_M2) ? ntile - SGU_IN_M2 : 0;
          for (int it = bid; it < 32 * NCH + nextra; it += G) { if (it < 32 * NCH) prep_item(p, l, 32 * NCH - 1 - it, lds); else sgu_tile(p, l, SGU_IN_M2 + it - 32 * NCH, lds); } }
        xcd_barrier(xb);
        phase_mixer(p, l, lds);
        xcd_barrier(xb);
        phase_combine(p, l, Mfull);
        xcd_barrier(xb);
        { pg8::StaticOrder S; S.init(Mfull, D, G, bid);
          pg8::EpiBf16 E{BIG, D, 0, 0};
          pg8::gemm_phase(lds, pg8::Gemm{H, (const bf16_t*)(p.ws + WS_WOUT) + (size_t)l * D * D, Mfull, D, D}, S, E); }
        xcd_barrier(xb);
        phase_norm(xl, xc, BIG, ada_l + 2 * 1024, p.out, XC, p.in[7] + l * D, ada_l, 3, Mfull, H);
        xcd_barrier(xb);
        { pg8::StaticOrder S; S.init(Mfull, UPW, G, bid);
          pg8::EpiBf16 E{BIG, FF, FF, (size_t)NROW * FF};
          pg8::gemm_phase(lds, pg8::Gemm{H, (const bf16_t*)(p.ws + WS_WUP) + (size_t)l * UPW * D, Mfull, UPW, D}, S, E); }
        xcd_barrier(xb);
        phase_conv(p, l, Mfull);
        xcd_barrier(xb);
        { pg8::StaticOrder S; S.init(Mfull, D, G, bid);
          pg8::EpiBf16 E{Y2, D, 0, 0};
          pg8::gemm_phase(lds, pg8::Gemm{BIG, (const bf16_t*)(p.ws + WS_WDOWN) + (size_t)l * D * FF, Mfull, D, FF}, S, E); }
        xcd_barrier(xb);
    }
    phase_final(p.out, Y2, ADA + (size_t)(DEPTH - 1) * 9 * 6144 + 5 * 1024, p.in[21]);
}

extern "C" void kernel_launch(void* const* d_in, const int* in_sizes, int n_in, void* d_out, int out_size, void* d_ws, size_t ws_size, hipStream_t stream) {
    constexpr int LDS_BYTES = 155648;
    static int grid_blocks = 0;
    if (!grid_blocks) {
        int dev = 0, cus = 0, per_cu = 0;
        (void)hipGetDevice(&dev);
        (void)hipDeviceGetAttribute(&cus, hipDeviceAttributeMultiprocessorCount, dev);
        (void)hipFuncSetAttribute((const void*)fwd_megakernel, hipFuncAttributeMaxDynamicSharedMemorySize, LDS_BYTES);
        (void)hipOccupancyMaxActiveBlocksPerMultiprocessor(&per_cu, (const void*)fwd_megakernel, 512, LDS_BYTES);
        if (per_cu < 1) per_cu = 1;
        grid_blocks = cus * per_cu;
        if (ws_size < WS_END) fprintf(stderr, "workspace too small: %zu < %zu\n", ws_size, (size_t)WS_END);
    }
    Params p{};
    for (int i = 0; i < 22; ++i) p.in[i] = (const float*)d_in[i];
    p.out = (float*)d_out; p.ws = (unsigned char*)d_ws;
    (void)hipMemsetAsync((unsigned char*)d_ws + WS_BAR, 0, XCD_BAR_WORDS * 4, stream);
    void* args[] = {&p};
    hipError_t e = hipLaunchCooperativeKernel((const void*)fwd_megakernel, dim3(grid_blocks), dim3(512), args, LDS_BYTES, stream);
    if (e != hipSuccess) fprintf(stderr, "cooperative launch failed: %s (grid %d)\n", hipGetErrorString(e), grid_blocks);
}
```

```cpp
#include <hip/hip_runtime.h>
#include <hip/hip_cooperative_groups.h>
#include <cstdio>
namespace cg = cooperative_groups;

#define LAS __attribute__((address_space(3)))
typedef unsigned short bf16_t;
typedef short bf16x8 __attribute__((ext_vector_type(8)));
typedef float f32x4 __attribute__((ext_vector_type(4)));
typedef float f32x2 __attribute__((ext_vector_type(2)));
typedef unsigned u32x4 __attribute__((ext_vector_type(4)));
typedef unsigned u32x2 __attribute__((ext_vector_type(2)));
typedef __bf16 bf2_t __attribute__((ext_vector_type(2)));

constexpr int D = 1024, NB = 8, SEQ = 4096, DEPTH = 2, CTXL = 256;
constexpr int NLAT = NB * SEQ;
constexpr int NCTX = NB * CTXL;
constexpr int NROW = NLAT + NCTX;
constexpr int PW = 3584, FF = 2816, UPW = 2 * FF;
constexpr float EPS = 1e-6f;

constexpr size_t WS_WIN = 0;
constexpr size_t WS_WOUT = WS_WIN + (size_t)DEPTH * PW * D * 2;
constexpr size_t WS_WUP = WS_WOUT + (size_t)DEPTH * D * D * 2;
constexpr size_t WS_WDOWN = WS_WUP + (size_t)DEPTH * UPW * D * 2;
constexpr size_t WS_WSP = WS_WDOWN + (size_t)DEPTH * D * FF * 2;
constexpr size_t WS_ADA = WS_WSP + (size_t)DEPTH * 4 * 128 * 128 * 2;
constexpr size_t WS_LB = WS_ADA + (size_t)DEPTH * 9 * 6144 * 4;
constexpr size_t WS_XC = WS_LB + 2 * 512 * 4;
constexpr size_t WS_H = WS_XC + (size_t)NCTX * D * 4;
constexpr size_t WS_BIG = WS_H + (size_t)NROW * D * 2;
constexpr size_t WS_OFB = WS_BIG + (size_t)NROW * PW * 2;
constexpr size_t WS_QB = WS_OFB + 2 * (size_t)NROW * 512 * 2;
constexpr size_t WS_DS = WS_BIG + (size_t)NROW * UPW * 2;
constexpr size_t WS_BAR = WS_DS + (size_t)64 * 136 * 128 * 4;
constexpr size_t WS_END = WS_BAR + 16384;

constexpr size_t PSLOT = (size_t)NROW * 128;
__device__ __forceinline__ size_t PIX(int row, int col) { return (size_t)(col >> 7) * PSLOT + (size_t)row * 128 + (col & 127); }
struct Params {
    const float* in[22];
    float* out;
    unsigned char* ws;
};

__device__ __forceinline__ unsigned pk_bf16(float a, float b) { f32x2 v = {a, b}; bf2_t r = __builtin_convertvector(v, bf2_t); return __builtin_bit_cast(unsigned, r); }
__device__ __forceinline__ float bf_lo(unsigned u) { return __uint_as_float(u << 16); }
__device__ __forceinline__ float bf_hi(unsigned u) { return __uint_as_float(u & 0xffff0000u); }
__device__ __forceinline__ float bf1(bf16_t u) { return __uint_as_float(((unsigned)u) << 16); }
__device__ __forceinline__ bf16_t to_bf1(float a) { return (bf16_t)(pk_bf16(a, 0.f) & 0xffffu); }
__device__ __forceinline__ float fast_rcp(float x) { return __builtin_amdgcn_rcpf(x); }
__device__ __forceinline__ float gelu_f(float v) {
    const float av = fabsf(v), t = fast_rcp(av * 0.2316418882f + 1.0f);
    float q = t * 0.5307027145f + (-0.7265760135f); q = q * t + 0.7107068705f; q = q * t + (-0.142248368f); q = q * t + 0.127414796f; q = q * t;
    const float e = __builtin_amdgcn_exp2f((v * v) * (-0.72134752044f));
    const float m = v * (q * e);
    return v < 0.f ? m : v - m;
}
__device__ __forceinline__ int opaque_tid() { int t = threadIdx.x; asm volatile("" : "+v"(t)); return t; }
__device__ __forceinline__ float silu_f(float x) { return x * fast_rcp(1.0f + __expf(-x)); }

namespace pg8 {
constexpr int BM = 256, BK = 64, HALF = 128, HTB = HALF * BK * 2, STAGE_BYTES = 8 * HTB, NXCD = 8, WGM = 8;
__host__ __device__ __forceinline__ int lds_byte(int r, int c) { const int st = (r >> 4) * 2 + (c >> 5), rr = r & 15, cc = c & 31, ob = rr * 64 + cc * 2; return st * 1024 + (ob ^ (((ob >> 9) & 1) << 5)); }
__host__ __device__ __forceinline__ void stage_rc(int b, int& R, int& C) { const int st = b / 1024, sb = b % 1024, swz = sb ^ (((sb >> 9) & 1) << 5); R = (st >> 1) * 16 + swz / 64; C = (st & 1) * 32 + (swz % 64) / 2; }
__host__ __device__ __forceinline__ int perm32(int rho) { const int n = rho >> 4, i = rho & 15; return 8 * (i >> 2) + 4 * n + (i & 3); }
struct Unit { int pm, pn; };
struct Gemm { const bf16_t* A; const bf16_t* Bt; int M, N, K; };
struct StaticOrder {
    int nM, nN, nwg, G, c;
    __device__ void init(int M, int N, int G_, int c_) { nM = M / BM; nN = N / BM; nwg = nM * nN; G = G_; c = c_; }
    __device__ bool next(int i, Unit& u) const {
        const long L = (long)i * G + c; if (L >= nwg) return false;
        int wgid = (int)L; { const int q = nwg / NXCD, r = nwg % NXCD, xcd = wgid % NXCD, off = wgid / NXCD; wgid = (xcd < r ? xcd * (q + 1) : r * (q + 1) + (xcd - r) * q) + off; }
        const int nig = WGM * nN, gid = wgid / nig, fm = gid * WGM, gsz = (nM - fm) < WGM ? (nM - fm) : WGM;
        u.pm = fm + ((wgid % nig) % gsz); u.pn = (wgid % nig) / gsz; return true;
    }
    __device__ __forceinline__ void a_ready(const Unit&) const {}
    __device__ __forceinline__ void done(const Unit&) const {}
};
struct EpiBf16 {
    static constexpr bool PERM = true;
    bf16_t* O; int ldc; int split_cols; size_t split_stride; size_t slot_stride;
    __device__ __forceinline__ void operator()(const f32x4 (&acc)[2][2][4][2], const Unit& u, int wr, int wc, int fr, int fq) const {
        const int row0 = u.pm * BM + wr * 64 + fr; int colt = u.pn * BM; bf16_t* base = O;
        if (split_cols) { const int t = colt / split_cols; base += (size_t)t * split_stride; colt -= t * split_cols; }
        const int col0 = colt + wc * 32 + 8 * fq;
#pragma unroll
        for (int ai = 0; ai < 2; ++ai)
#pragma unroll
            for (int m = 0; m < 4; ++m) { const int row = row0 + ai * HALF + m * 16;
                bf16_t* rowp = slot_stride ? base + (size_t)(colt >> 7) * slot_stride + (size_t)row * 128 + wc * 32 + 8 * fq : base + (size_t)row * ldc + col0;
#pragma unroll
                for (int bj = 0; bj < 2; ++bj) { const f32x4 v0 = acc[ai][bj][m][0], v1 = acc[ai][bj][m][1];
                    u32x4 w; w.x = pk_bf16(v0[0], v0[1]); w.y = pk_bf16(v0[2], v0[3]); w.z = pk_bf16(v1[0], v1[1]); w.w = pk_bf16(v1[2], v1[3]);
                    *(u32x4*)(rowp + (slot_stride ? (size_t)bj * slot_stride : (size_t)bj * HALF)) = w; } }
    }
};
struct EpiRes {
    static constexpr bool PERM = false;
    const float* resL; float* outL; const float* resC; float* outC; const float* gate;
    __device__ __forceinline__ void operator()(const f32x4 (&acc)[2][2][4][2], const Unit& u, int wr, int wc, int fr, int fq) const {
        const float* res; float* out; const float* g; int rowb;
        if (u.pm < NLAT / BM) { res = resL; out = outL; g = gate + (size_t)(u.pm >> 4) * 6144; rowb = u.pm * BM; }
        else { res = resC; out = outC; g = gate + (size_t)8 * 6144; rowb = u.pm * BM - NLAT; }
        const int row0 = rowb + wr * 64 + fr, col0 = u.pn * BM + wc * 32 + 4 * fq;
        f32x4 gv[2][2];
#pragma unroll
        for (int bj = 0; bj < 2; ++bj)
#pragma unroll
            for (int n = 0; n < 2; ++n) gv[bj][n] = *(const f32x4*)(g + col0 + bj * HALF + n * 16);
#pragma unroll
        for (int ai = 0; ai < 2; ++ai)
#pragma unroll
            for (int m = 0; m < 4; ++m) { const size_t ro = (size_t)(row0 + ai * HALF + m * 16) * D + col0;
#pragma unroll
                for (int bj = 0; bj < 2; ++bj)
#pragma unroll
                    for (int n = 0; n < 2; ++n) { const f32x4 r = *(const f32x4*)(res + ro + bj * HALF + n * 16);
                        *(f32x4*)(out + ro + bj * HALF + n * 16) = r + gv[bj][n] * acc[ai][bj][m][n]; } }
    }
};

template <class Epi, class Sched>
__device__ __forceinline__ void gemm_phase(LAS unsigned char* lds, const Gemm g, const Sched& S, const Epi& E) {
    const int tid = opaque_tid(), wid = __builtin_amdgcn_readfirstlane(tid >> 6), lane = tid & 63, wr = wid >> 2, wc = wid & 3, fr = lane & 15, fq = lane >> 4;
    const int K = g.K, nt = K / BK;
    unsigned voffA[2], voffB[2];
#pragma unroll
    for (int i = 0; i < 2; ++i) { int R, C; stage_rc(tid * 16 + i * 8192, R, C); const int Rb = Epi::PERM ? ((R & ~31) + perm32(R & 31)) : R;
        voffA[i] = (unsigned)(R * K + C) * 2u; voffB[i] = (unsigned)(Rb * K + C) * 2u; }
    const size_t kstep = (size_t)(BK * 2);
    const size_t hstep = (size_t)HALF * K * 2;
    const size_t tstep = 2 * hstep;
    const unsigned ldsw = (unsigned)wid * 1024u;
    const int aoff = lds_byte(wr * 64 + fr, fq * 8), boff = lds_byte(wc * 32 + fr, fq * 8);
#define PG8_SA(b, h) (((b) * 2 + (h)) * HTB)
#define PG8_SB(b, h) ((4 + (b) * 2 + (h)) * HTB)
#define PG8_STAGE(bufoff, gbase, voff) do { _Pragma("unroll") for (int _i = 0; _i < 2; ++_i) \
        __builtin_amdgcn_global_load_lds((const unsigned*)((const char*)(gbase) + (voff)[_i]), (LAS unsigned*)(lds + (bufoff) + ldsw + _i * 8192), 16, 0, 0); } while (0)
#define PG8_LDA(dst, b, h) do { _Pragma("unroll") for (int m = 0; m < 4; ++m) _Pragma("unroll") for (int k = 0; k < 2; ++k) dst[m][k] = *(const LAS bf16x8*)(lds + PG8_SA(b, h) + aoff + m * 2048 + k * 1024); } while (0)
#define PG8_LDB(dst, b, h) do { _Pragma("unroll") for (int n = 0; n < 2; ++n) _Pragma("unroll") for (int k = 0; k < 2; ++k) dst[n][k] = *(const LAS bf16x8*)(lds + PG8_SB(b, h) + boff + n * 2048 + k * 1024); } while (0)
#define PG8_MMA(ai, bj, At, Bt) do { __builtin_amdgcn_s_setprio(1); _Pragma("unroll") for (int m = 0; m < 4; ++m) _Pragma("unroll") for (int n = 0; n < 2; ++n) _Pragma("unroll") for (int k = 0; k < 2; ++k) \
        acc[ai][bj][m][n] = __builtin_amdgcn_mfma_f32_16x16x32_bf16(Bt[n][k], At[m][k], acc[ai][bj][m][n], 0, 0, 0); __builtin_amdgcn_s_setprio(0); } while (0)
#define PG8_WAIT_V(n) asm volatile("s_waitcnt vmcnt(" #n ")" ::: "memory")
#define PG8_WAIT_L(n) asm volatile("s_waitcnt lgkmcnt(" #n ")" ::: "memory")
#define PG8_BAR __builtin_amdgcn_s_barrier()
#define PG8_SCHED __builtin_amdgcn_sched_barrier(0)
    Unit cur, nxt; int ui = 0;
    if (!S.next(0, cur)) return;
    f32x4 acc[2][2][4][2];
#pragma unroll
    for (int a = 0; a < 2; ++a)
#pragma unroll
        for (int b = 0; b < 2; ++b)
#pragma unroll
            for (int m = 0; m < 4; ++m)
#pragma unroll
                for (int n = 0; n < 2; ++n) acc[a][b][m][n] = (f32x4){0.f, 0.f, 0.f, 0.f};
    bf16x8 At[4][2], B0[2][2], B1[2][2];
    const char* cA = (const char*)g.A + (size_t)cur.pm * tstep; const char* cB = (const char*)g.Bt + (size_t)cur.pn * tstep;
    S.a_ready(cur);
    PG8_STAGE(PG8_SB(0, 0), cB, voffB); PG8_STAGE(PG8_SA(0, 0), cA, voffA); PG8_STAGE(PG8_SB(0, 1), cB + hstep, voffB); PG8_STAGE(PG8_SA(0, 1), cA + hstep, voffA);
    if (wr == 1) PG8_BAR;
    PG8_WAIT_V(4); PG8_BAR;
    PG8_STAGE(PG8_SB(1, 0), cB + kstep, voffB); PG8_STAGE(PG8_SA(1, 0), cA + kstep, voffA); PG8_STAGE(PG8_SB(1, 1), cB + hstep + kstep, voffB);
    PG8_WAIT_V(6); PG8_BAR;
    for (;;) {
        const bool has_next = S.next(ui + 1, nxt);
        const char* nA = has_next ? (const char*)g.A + (size_t)nxt.pm * tstep : cA; const char* nB = has_next ? (const char*)g.Bt + (size_t)nxt.pn * tstep : cB;
        for (int t = 0; t < nt; t += 2) {
            const bool last = (t == nt - 2);
            const char* a1 = cA + (size_t)(t + 1) * kstep;
            const char* a2 = last ? nA : cA + (size_t)(t + 2) * kstep; const char* b2 = last ? nB : cB + (size_t)(t + 2) * kstep;
            const char* a3 = a2 + kstep; const char* b3 = b2 + kstep;
            if (last && has_next) S.a_ready(nxt);
            PG8_LDB(B0, 0, 0); PG8_SCHED; PG8_LDA(At, 0, 0); PG8_STAGE(PG8_SA(1, 1), a1 + hstep, voffA);
            PG8_WAIT_L(8); PG8_BAR; PG8_WAIT_L(0); PG8_MMA(0, 0, At, B0); PG8_BAR; PG8_SCHED;
            PG8_LDB(B1, 0, 1); PG8_STAGE(PG8_SB(0, 0), b2, voffB);
            PG8_BAR; PG8_WAIT_L(0); PG8_MMA(0, 1, At, B1); PG8_BAR;
            PG8_LDA(At, 0, 1); PG8_STAGE(PG8_SA(0, 0), a2, voffA);
            PG8_BAR; PG8_WAIT_L(0); PG8_MMA(1, 0, At, B0); PG8_BAR; PG8_SCHED;
            PG8_STAGE(PG8_SB(0, 1), b2 + hstep, voffB);
            PG8_WAIT_V(6); PG8_BAR; PG8_MMA(1, 1, At, B1); PG8_BAR;
            PG8_LDB(B0, 1, 0); PG8_SCHED; PG8_LDA(At, 1, 0); PG8_STAGE(PG8_SA(0, 1), a2 + hstep, voffA);
            PG8_WAIT_L(8); PG8_BAR; PG8_WAIT_L(0); PG8_MMA(0, 0, At, B0); PG8_BAR; PG8_SCHED;
            PG8_LDB(B1, 1, 1); PG8_STAGE(PG8_SB(1, 0), b3, voffB);
            PG8_BAR; PG8_WAIT_L(0); PG8_MMA(0, 1, At, B1); PG8_BAR;
            PG8_LDA(At, 1, 1); PG8_STAGE(PG8_SA(1, 0), a3, voffA);
            PG8_BAR; PG8_WAIT_L(0); PG8_MMA(1, 0, At, B0); PG8_BAR; PG8_SCHED;
            PG8_STAGE(PG8_SB(1, 1), b3 + hstep, voffB);
            PG8_WAIT_V(6); PG8_BAR; PG8_MMA(1, 1, At, B1); PG8_BAR;
        }
        E(acc, cur, wr, wc, fr, fq); S.done(cur);
        if (!has_next) break;
#pragma unroll
        for (int a = 0; a < 2; ++a)
#pragma unroll
            for (int b = 0; b < 2; ++b)
#pragma unroll
                for (int m = 0; m < 4; ++m)
#pragma unroll
                    for (int n = 0; n < 2; ++n) acc[a][b][m][n] = (f32x4){0.f, 0.f, 0.f, 0.f};
        cur = nxt; cA = nA; cB = nB; ++ui;
    }
    PG8_WAIT_V(0);
    if (wr == 0) PG8_BAR;
    PG8_BAR;
#undef PG8_SA
#undef PG8_SB
#undef PG8_STAGE
#undef PG8_LDA
#undef PG8_LDB
#undef PG8_MMA
#undef PG8_WAIT_V
#undef PG8_WAIT_L
#undef PG8_BAR
#undef PG8_SCHED
}
}

__device__ void phase_prep(const Params& p, LAS unsigned char* lds) {
    const int tid = opaque_tid();
    constexpr int NT_L = 896 + 256 + 1408 + 704;
    constexpr int J_ADA = 192, J_TR = J_ADA + 2 * NT_L, J_WSP = J_TR + 32, J_LB = J_WSP + 1;
    for (int job = blockIdx.x; job < J_LB; job += gridDim.x) {
        if (job < J_ADA) {
            LAS float* s = (LAS float*)lds;
            LAS float* red = (LAS float*)(lds + 9 * 1024 * 4);
            for (int i = tid; i < 9 * 1024; i += 512) { const int r = i >> 10, d = i & 1023; const float v = r < 8 ? p.in[1][r * 1024 + d] : p.in[3][d]; s[i] = silu_f(v); }
            __syncthreads();
            const int l = job / 96, e0 = (job % 96) * 64, col = tid & 63, dg = tid >> 6;
            const float* w = p.in[4] + ((size_t)l * 1024 + dg * 128) * 6144 + e0 + col;
            float acc[9];
#pragma unroll
            for (int r = 0; r < 9; ++r) acc[r] = 0.f;
            for (int dd = 0; dd < 128; ++dd) { const float wv = w[(size_t)dd * 6144];
#pragma unroll
                for (int r = 0; r < 9; ++r) acc[r] += s[r * 1024 + dg * 128 + dd] * wv; }
#pragma unroll
            for (int r = 0; r < 9; ++r) red[(dg * 9 + r) * 64 + col] = acc[r];
            __syncthreads();
            for (int i = tid; i < 9 * 64; i += 512) { const int r = i >> 6, c = i & 63; float a = 0.f;
#pragma unroll
                for (int g = 0; g < 8; ++g) a += red[(g * 9 + r) * 64 + c];
                ((float*)(p.ws + WS_ADA))[((size_t)l * 9 + r) * 6144 + e0 + c] = a + p.in[5][l * 6144 + e0 + c]; }
            __syncthreads();
        } else if (job < J_TR) {
            const int j = job - J_ADA, l = j / NT_L; int r = j % NT_L;
            const float* src; bf16_t* dst; int K, N;
            if (r < 896) { src = p.in[8] + (size_t)l * D * PW; dst = (bf16_t*)(p.ws + WS_WIN) + (size_t)l * PW * D; K = D; N = PW; }
            else if (r < 1152) { r -= 896; src = p.in[16] + (size_t)l * D * D; dst = (bf16_t*)(p.ws + WS_WOUT) + (size_t)l * D * D; K = D; N = D; }
            else if (r < 2560) { r -= 1152; src = p.in[17] + (size_t)l * D * UPW; dst = (bf16_t*)(p.ws + WS_WUP) + (size_t)l * UPW * D; K = D; N = UPW; }
            else { r -= 2560; src = p.in[20] + (size_t)l * FF * D; dst = (bf16_t*)(p.ws + WS_WDOWN) + (size_t)l * D * FF; K = FF; N = D; }
            const int ntn = N >> 6, kt = r / ntn, nt = r % ntn;
            LAS float* tile = (LAS float*)lds;
            { const int kk = tid >> 3, n8 = (tid & 7) * 8; const float* sp = src + (size_t)(kt * 64 + kk) * N + nt * 64 + n8;
              const f32x4 a = *(const f32x4*)sp, b = *(const f32x4*)(sp + 4);
              LAS float* tp = tile + kk * 65 + n8; tp[0] = a[0]; tp[1] = a[1]; tp[2] = a[2]; tp[3] = a[3]; tp[4] = b[0]; tp[5] = b[1]; tp[6] = b[2]; tp[7] = b[3]; }
            __syncthreads();
            { const int nn = tid >> 3, k8 = (tid & 7) * 8; float v[8];
#pragma unroll
              for (int i = 0; i < 8; ++i) v[i] = tile[(k8 + i) * 65 + nn];
              u32x4 w; w.x = pk_bf16(v[0], v[1]); w.y = pk_bf16(v[2], v[3]); w.z = pk_bf16(v[4], v[5]); w.w = pk_bf16(v[6], v[7]);
              *(u32x4*)(dst + (size_t)(nt * 64 + nn) * K + kt * 64 + k8) = w; }
            __syncthreads();
        } else if (job < J_WSP) {
            const int j = job - J_TR; const size_t i0 = (size_t)j * 4096 + tid * 8;
            const f32x4 a = *(const f32x4*)(p.in[14] + i0), b = *(const f32x4*)(p.in[14] + i0 + 4);
            u32x4 w; w.x = pk_bf16(a[0], a[1]); w.y = pk_bf16(a[2], a[3]); w.z = pk_bf16(b[0], b[1]); w.w = pk_bf16(b[2], b[3]);
            *(u32x4*)((bf16_t*)(p.ws + WS_WSP) + i0) = w;
        } else {
            for (int i = tid; i < 1024; i += 512) { const int dir = i >> 9, c = i & 511; const float* lg = dir ? p.in[10] : p.in[9];
                const float l0 = lg[c], l1 = lg[512 + c]; ((float*)(p.ws + WS_LB))[i] = 1.0f / (1.0f + expf(l0 - l1)); }
        }
    }
}

__device__ void phase_norm(const float* xl, const float* xc, const bf16_t* Y, const float* gate  , float* xl_dst, float* xc_dst,
                           const float* gain, const float* ada_l, int shift_idx, int nrows, bf16_t* H) {
    const int tid_ = opaque_tid(); const int wave = tid_ >> 6, lane = tid_ & 63;
    f32x4 gn[4];
#pragma unroll
    for (int j = 0; j < 4; ++j) gn[j] = *(const f32x4*)(gain + j * 256 + lane * 4);
    for (int rr = (blockIdx.x * 8 + wave) * 2; rr < nrows; rr += gridDim.x * 16) {
        const int row = nrows - 2 - rr;
        const float* src; const float* mod; float* dst; const float* gt;
        if (row < NLAT) { src = xl + (size_t)row * D; mod = ada_l + (size_t)(row >> 12) * 6144; dst = xl_dst ? xl_dst + (size_t)row * D : nullptr; gt = gate + (size_t)(row >> 12) * 6144; }
        else { src = xc + (size_t)(row - NLAT) * D; mod = ada_l + (size_t)8 * 6144; dst = xc_dst ? xc_dst + (size_t)(row - NLAT) * D : nullptr; gt = gate + (size_t)8 * 6144; }
        f32x4 v[2][4], sh[4], sc[4], gg[4]; u32x2 yv[2][4];
#pragma unroll
        for (int u = 0; u < 2; ++u)
#pragma unroll
            for (int j = 0; j < 4; ++j) { v[u][j] = *(const f32x4*)(src + (size_t)u * D + j * 256 + lane * 4); if (Y) yv[u][j] = *(const u32x2*)(Y + (size_t)(row + u) * D + j * 256 + lane * 4); }
#pragma unroll
        for (int j = 0; j < 4; ++j) { const int d = j * 256 + lane * 4; sh[j] = *(const f32x4*)(mod + shift_idx * 1024 + d); sc[j] = *(const f32x4*)(mod + (shift_idx + 1) * 1024 + d); if (Y) gg[j] = *(const f32x4*)(gt + d); }
#pragma unroll
        for (int u = 0; u < 2; ++u) {
            if (Y) {
#pragma unroll
                for (int j = 0; j < 4; ++j) {
                    v[u][j][0] += gg[j][0] * bf_lo(yv[u][j].x); v[u][j][1] += gg[j][1] * bf_hi(yv[u][j].x); v[u][j][2] += gg[j][2] * bf_lo(yv[u][j].y); v[u][j][3] += gg[j][3] * bf_hi(yv[u][j].y);
                    if (dst) *(f32x4*)(dst + (size_t)u * D + j * 256 + lane * 4) = v[u][j]; }
            }
            float ss = 0.f;
#pragma unroll
            for (int j = 0; j < 4; ++j) ss += v[u][j][0] * v[u][j][0] + v[u][j][1] * v[u][j][1] + v[u][j][2] * v[u][j][2] + v[u][j][3] * v[u][j][3];
#pragma unroll
            for (int o = 32; o > 0; o >>= 1) ss += __shfl_xor(ss, o);
            const float rs = rsqrtf(ss * (1.0f / D) + EPS);
#pragma unroll
            for (int j = 0; j < 4; ++j) { const int d = j * 256 + lane * 4;
                f32x4 y = v[u][j] * rs * gn[j]; y = y * (sc[j] + 1.0f) + sh[j];
                u32x2 wv; wv.x = pk_bf16(y[0], y[1]); wv.y = pk_bf16(y[2], y[3]);
                *(u32x2*)(H + (size_t)(row + u) * D + d) = wv; }
        }
    }
}
__device__ void phase_final(float* x, const bf16_t* Y, const float* gate, const float* gain) {
    const int tid_ = opaque_tid(); const int wave = tid_ >> 6, lane = tid_ & 63;
    f32x4 gn[4];
#pragma unroll
    for (int j = 0; j < 4; ++j) gn[j] = *(const f32x4*)(gain + j * 256 + lane * 4);
    for (int row = (blockIdx.x * 8 + wave) * 2; row < NLAT; row += gridDim.x * 16) {
        const float* gt = gate + (size_t)(row >> 12) * 6144;
        f32x4 v[2][4], gg[4]; u32x2 yv[2][4];
#pragma unroll
        for (int u = 0; u < 2; ++u)
#pragma unroll
            for (int j = 0; j < 4; ++j) { v[u][j] = *(const f32x4*)(x + (size_t)(row + u) * D + j * 256 + lane * 4); yv[u][j] = *(const u32x2*)(Y + (size_t)(row + u) * D + j * 256 + lane * 4); }
#pragma unroll
        for (int j = 0; j < 4; ++j) gg[j] = *(const f32x4*)(gt + j * 256 + lane * 4);
#pragma unroll
        for (int u = 0; u < 2; ++u) {
            float ss = 0.f;
#pragma unroll
            for (int j = 0; j < 4; ++j) {
                v[u][j][0] += gg[j][0] * bf_lo(yv[u][j].x); v[u][j][1] += gg[j][1] * bf_hi(yv[u][j].x); v[u][j][2] += gg[j][2] * bf_lo(yv[u][j].y); v[u][j][3] += gg[j][3] * bf_hi(yv[u][j].y);
                ss += v[u][j][0] * v[u][j][0] + v[u][j][1] * v[u][j][1] + v[u][j][2] * v[u][j][2] + v[u][j][3] * v[u][j][3]; }
#pragma unroll
            for (int o = 32; o > 0; o >>= 1) ss += __shfl_xor(ss, o);
            const float rs = rsqrtf(ss * (1.0f / D) + EPS);
#pragma unroll
            for (int j = 0; j < 4; ++j) { const int d = j * 256 + lane * 4; *(f32x4*)(x + (size_t)(row + u) * D + d) = v[u][j] * rs * gn[j]; }
        }
    }
}

constexpr int QS_ST = 136, KT_ST = 40;
constexpr int P1_QS = 0, P1_KH = P1_QS + 32 * QS_ST * 2, P1_VT = P1_KH + 32 * QS_ST * 2, P1_KT = P1_VT + 128 * KT_ST * 2, P1_AW = P1_KT + 128 * KT_ST * 2;
constexpr int P1_DIRSZ = P1_AW + 8 * 32 * KT_ST * 2;
constexpr int NCH = 8 + 128;

template <int CTRL, int RMASK> __device__ __forceinline__ float dpp_mul(float x) {
    const int t = __builtin_amdgcn_update_dpp(0x3f800000, __builtin_bit_cast(int, x), CTRL, RMASK, 0xf, false);
    return x * __builtin_bit_cast(float, t);
}
__device__ __forceinline__ float cumprod32(float x) {
    x = dpp_mul<0x111, 0xf>(x); x = dpp_mul<0x112, 0xf>(x); x = dpp_mul<0x114, 0xf>(x); x = dpp_mul<0x118, 0xf>(x);
    x = dpp_mul<0x142, 0xa>(x);
    return x;
}

#define DPP8_STEP(CTRL) asm volatile("s_nop 1\n\t" \
    "v_mul_f32_dpp %0, %0, %0 " CTRL "\n\tv_mul_f32_dpp %1, %1, %1 " CTRL "\n\tv_mul_f32_dpp %2, %2, %2 " CTRL "\n\tv_mul_f32_dpp %3, %3, %3 " CTRL "\n\t" \
    "v_mul_f32_dpp %4, %4, %4 " CTRL "\n\tv_mul_f32_dpp %5, %5, %5 " CTRL "\n\tv_mul_f32_dpp %6, %6, %6 " CTRL "\n\tv_mul_f32_dpp %7, %7, %7 " CTRL "\n\ts_nop 1" \
    : "+v"(e[0]), "+v"(e[1]), "+v"(e[2]), "+v"(e[3]), "+v"(e[4]), "+v"(e[5]), "+v"(e[6]), "+v"(e[7]))
__device__ __forceinline__ void cumprod32x8(float (&e)[8]) {
    asm volatile("s_nop 4" ::: );
    DPP8_STEP("row_shr:1 row_mask:0xf bank_mask:0xf");
    DPP8_STEP("row_shr:2 row_mask:0xf bank_mask:0xf");
    DPP8_STEP("row_shr:4 row_mask:0xf bank_mask:0xf");
    DPP8_STEP("row_shr:8 row_mask:0xf bank_mask:0xf");
    DPP8_STEP("row_bcast:15 row_mask:0xa bank_mask:0xf");
}
__device__ void prep_item(const Params& p, int l, int item, LAS unsigned char* lds) {
    const int tid = opaque_tid(), w = tid >> 6, lane = tid & 63;
    const int tau = lane & 31, kh = lane >> 5, k0 = 16 * w + 8 * kh, l15 = lane & 15, q4 = lane >> 4;
    const int ci = item % NCH, bh = item / NCH, h = bh & 3, b = bh >> 2;
    const int R0 = ci < 8 ? NLAT + b * 256 + 32 * ci : b * 4096 + 32 * (ci - 8);
    bf16_t* P = (bf16_t*)(p.ws + WS_BIG);
    const bool first = (l == 0);
    const bool want_out = first || ci >= 8;
    for (int dd = 0; dd < 2; ++dd) { LAS unsigned* az = (LAS unsigned*)(lds + dd * P1_DIRSZ + P1_AW) + w * (32 * KT_ST / 2); for (int i = lane; i < 32 * KT_ST / 2; i += 64) az[i] = 0u; }
    u32x4 rf0, rq0, rv0, rf1, rq1, rv1;
    { const int r_ = R0 + tau; rf0 = *(const u32x4*)(P + PIX(r_, h * 128 + k0)); rq0 = *(const u32x4*)(P + PIX(r_, 1536 + h * 128 + k0)); rv0 = *(const u32x4*)(P + PIX(r_, 1024 + h * 128 + k0)); }
    { const int r_ = R0 + 31 - tau; rf1 = *(const u32x4*)(P + PIX(r_, 512 + h * 128 + k0)); rq1 = *(const u32x4*)(P + PIX(r_, 1536 + h * 128 + k0)); rv1 = *(const u32x4*)(P + PIX(r_, 1024 + h * 128 + k0)); }
    asm volatile("s_waitcnt vmcnt(0)" ::: "memory");
    __syncthreads();
    auto valu_part = [&](const int dir, const u32x4& f, const u32x4& q, const u32x4& v) {
        LAS unsigned char* db = lds + dir * P1_DIRSZ;
        LAS bf16_t* Qs = (LAS bf16_t*)(db + P1_QS); LAS bf16_t* Kh = (LAS bf16_t*)(db + P1_KH);
        LAS bf16_t* Vt = (LAS bf16_t*)(db + P1_VT); LAS bf16_t* Kt = (LAS bf16_t*)(db + P1_KT);
        LAS bf16_t* Aw = (LAS bf16_t*)(db + P1_AW) + w * 32 * KT_ST;
        const int tokl = dir ? 31 - tau : tau;
        const float* lbp = (const float*)(p.ws + WS_LB) + dir * 512 + h * 128 + k0;
        float E[8], kk[8];
#pragma unroll
        for (int j = 0; j < 8; ++j) {
            const unsigned fw = f[j >> 1]; const float x = (j & 1) ? bf_hi(fw) : bf_lo(fw);
            const float e = __expf(-fabsf(x)), r = fast_rcp(1.0f + e);
            const float sp = x >= 0.f ? r : e * r, sn = x >= 0.f ? e * r : r;
            if (first) { E[j] = sp; kk[j] = sn; }
            else { const float lb = lbp[j]; const float gate = lb + (1.0f - lb) * sp; E[j] = gate; kk[j] = 1.0f - gate; }
        }
        float qt[8], kh_[8], kt_[8], Tj[8];
        cumprod32x8(E);
#pragma unroll
        for (int j = 0; j < 8; ++j) {
            const float Ej = fmaxf(E[j], 1e-35f);
            const float T0 = __builtin_bit_cast(float, __builtin_amdgcn_readlane(__builtin_bit_cast(int, Ej), 31)), T1 = __builtin_bit_cast(float, __builtin_amdgcn_readlane(__builtin_bit_cast(int, Ej), 63));
            const float T = kh ? T1 : T0;
            const unsigned qw = q[j >> 1]; const float qx = (j & 1) ? bf_hi(qw) : bf_lo(qw);
            qt[j] = silu_f(qx) * 0.08838834764831845f * Ej;
            kh_[j] = kk[j] * fast_rcp(Ej); kt_[j] = kh_[j] * T;
            Tj[j] = T;
        }
        if (tau == 31) { float* dp = (float*)(p.ws + WS_DS) + ((size_t)((b * 4 + h) * 2 + dir) * NCH + ci) * 128 + k0;
            *(f32x4*)dp = (f32x4){Tj[0], Tj[1], Tj[2], Tj[3]}; *(f32x4*)(dp + 4) = (f32x4){Tj[4], Tj[5], Tj[6], Tj[7]}; }
        u32x4 wq, wk; wq.x = pk_bf16(qt[0], qt[1]); wq.y = pk_bf16(qt[2], qt[3]); wq.z = pk_bf16(qt[4], qt[5]); wq.w = pk_bf16(qt[6], qt[7]);
        wk.x = pk_bf16(kh_[0], kh_[1]); wk.y = pk_bf16(kh_[2], kh_[3]); wk.z = pk_bf16(kh_[4], kh_[5]); wk.w = pk_bf16(kh_[6], kh_[7]);
        *(LAS u32x4*)(Qs + tau * QS_ST + k0) = wq; *(LAS u32x4*)(Kh + tau * QS_ST + k0) = wk;
        {
          bf16_t* qd = (dir == 0) ? P + PIX(R0 + tokl, 1536 + h * 128) : (bf16_t*)(p.ws + WS_QB) + (size_t)h * PSLOT + (size_t)(R0 + tokl) * 128;
          const int a32 = k0 & ~31, kkA = k0 & 31, kkB = kkA + 4;
          u32x2 pa, pb; pa.x = wq.x; pa.y = wq.y; pb.x = wq.z; pb.y = wq.w;
          *(u32x2*)(qd + a32 + 8 * ((kkA & 15) >> 2) + 4 * (kkA >> 4)) = pa;
          *(u32x2*)(qd + a32 + 8 * ((kkB & 15) >> 2) + 4 * (kkB >> 4)) = pb; }
#pragma unroll
        for (int j = 0; j < 8; ++j) { Kt[(k0 + j) * KT_ST + tokl] = to_bf1(kt_[j]); const unsigned vw = v[j >> 1]; Vt[(k0 + j) * KT_ST + tau] = (bf16_t)((j & 1) ? (vw >> 16) : (vw & 0xffffu)); }
    };
    auto mfma_part = [&](const int dir) {
        LAS unsigned char* db = lds + dir * P1_DIRSZ;
        LAS bf16_t* Qs = (LAS bf16_t*)(db + P1_QS); LAS bf16_t* Kh = (LAS bf16_t*)(db + P1_KH);
        LAS bf16_t* Vt = (LAS bf16_t*)(db + P1_VT); LAS bf16_t* Kt = (LAS bf16_t*)(db + P1_KT);
        LAS bf16_t* Aw = (LAS bf16_t*)(db + P1_AW) + w * 32 * KT_ST;
        const int tokl = dir ? 31 - tau : tau; (void)tokl;
        if (want_out) {
            f32x4 a00 = (f32x4){0.f, 0.f, 0.f, 0.f}, a10 = a00, a11 = a00;
#pragma unroll
            for (int kb = 0; kb < 4; ++kb) {
                const bf16x8 qn0 = *(const LAS bf16x8*)(Qs + l15 * QS_ST + 32 * kb + 8 * q4), qn1 = *(const LAS bf16x8*)(Qs + (16 + l15) * QS_ST + 32 * kb + 8 * q4);
                const bf16x8 kh0 = *(const LAS bf16x8*)(Kh + l15 * QS_ST + 32 * kb + 8 * q4), kh1 = *(const LAS bf16x8*)(Kh + (16 + l15) * QS_ST + 32 * kb + 8 * q4);
                a00 = __builtin_amdgcn_mfma_f32_16x16x32_bf16(qn0, kh0, a00, 0, 0, 0);
                a10 = __builtin_amdgcn_mfma_f32_16x16x32_bf16(qn1, kh0, a10, 0, 0, 0);
                a11 = __builtin_amdgcn_mfma_f32_16x16x32_bf16(qn1, kh1, a11, 0, 0, 0);
            }
#pragma unroll
            for (int i = 0; i < 4; ++i) { const int t = 4 * q4 + i; const bool keep = l15 <= t;
                Aw[t * KT_ST + l15] = to_bf1(keep ? a00[i] : 0.f);
                Aw[(16 + t) * KT_ST + l15] = to_bf1(a10[i]);
                Aw[(16 + t) * KT_ST + 16 + l15] = to_bf1(keep ? a11[i] : 0.f); }
            asm volatile("s_waitcnt lgkmcnt(0)" ::: "memory");
            const bf16x8 vf = *(const LAS bf16x8*)(Vt + (16 * w + l15) * KT_ST + 8 * q4);
            bf16_t* OFB = (bf16_t*)(p.ws + WS_OFB) + (size_t)dir * NROW * 512;
#pragma unroll
            for (int mt = 0; mt < 2; ++mt) {
                const bf16x8 af = *(const LAS bf16x8*)(Aw + (16 * mt + l15) * KT_ST + 8 * q4);
                const f32x4 o = __builtin_amdgcn_mfma_f32_16x16x32_bf16(vf, af, (f32x4){0.f, 0.f, 0.f, 0.f}, 0, 0, 0);
                const int tl = 16 * mt + l15, tok = dir ? 31 - tl : tl;
                u32x2 wv; wv.x = pk_bf16(o[0], o[1]); wv.y = pk_bf16(o[2], o[3]);
                *(u32x2*)(OFB + (size_t)h * PSLOT + (size_t)(R0 + tok) * 128 + 16 * w + 4 * q4) = wv;
            }
        }
        { const int k = tid >> 2, part = tid & 3;
          const u32x4 kv = *(const LAS u32x4*)(Kt + k * KT_ST + 8 * part);
          const int pc = h * 128 + (k & 3) * 32 + (part ^ ((k >> 2) & 3)) * 8;
          *(u32x4*)(P + PIX(R0 + (k >> 2), dir * 512 + pc)) = kv;
          if (dir == 0) { const u32x4 vv = *(const LAS u32x4*)(Vt + k * KT_ST + 8 * part); *(u32x4*)(P + PIX(R0 + (k >> 2), 1024 + pc)) = vv; } }
    };
    valu_part(0, rf0, rq0, rv0);
    valu_part(1, rf1, rq1, rv1);
    __syncthreads();
    mfma_part(0);
    mfma_part(1);
    __syncthreads();
}

constexpr int ST_Q = 0, ST_K = 8192, ST_V = 16384, ST_O = 20480, ST_D = 24576, ST_BYTES = 25088, NSTAGE = 6;
__device__ void scan_chain(const Params& p, int l, int chain, int vhalf, LAS unsigned char* lds) {
    const int tid = opaque_tid(), w = __builtin_amdgcn_readfirstlane(tid >> 6), lane = tid & 63, l15 = lane & 15, q4 = lane >> 4;
    const int dir = chain & 1, h = (chain >> 1) & 3, b = chain >> 3;
    bf16_t* P = (bf16_t*)(p.ws + WS_BIG);
    auto chunk_of = [&](int s) -> int { return dir ? (s < 8 ? 7 - s : 143 - s) : s; };
    auto row0_of = [&](int c) -> int { return c < 8 ? NLAT + b * 256 + 32 * c : b * 4096 + 32 * (c - 8); };
    bf16_t* qb = dir ? (bf16_t*)(p.ws + WS_QB) + (size_t)h * PSLOT : P + PIX(0, 1536 + h * 128);
    const int qpitch = 128;
    if (w >= 4) {
        const int lw = w - 4;
        const int r16 = lane >> 4, s16 = lane & 15;
        size_t qoff[2], koff[2];
#pragma unroll
        for (int i = 0; i < 2; ++i) { const int row = 8 * lw + 4 * i + r16; qoff[i] = (size_t)row * qpitch + ((s16 ^ (row & 15)) * 8);
            koff[i] = PIX(4 * (2 * lw + i) + r16, dir * 512 + h * 128) + s16 * 8; }
        const size_t voff = PIX(16 * vhalf + 4 * lw + r16, 1024 + h * 128) + s16 * 8;
        const float* dsrc = (const float*)(p.ws + WS_DS) + (size_t)chain * NCH * 128 + (lw & 1) * 64 + lane;
        const int orow = 8 * lw + (lane >> 3);
        const size_t ooff = (size_t)h * PSLOT + (size_t)orow * 128 + 64 * vhalf + (((lane & 7) ^ (orow & 7)) * 8);
        const bf16_t* OFBc = (const bf16_t*)(p.ws + WS_OFB) + (size_t)dir * NROW * 512;
        auto issue = [&](int s) {
            const int sc = s < NCH ? s : NCH - 1;
            const int c = chunk_of(sc), R0 = row0_of(c);
            LAS unsigned char* st = lds + (s % NSTAGE) * ST_BYTES;
            const bf16_t* qrow = qb + (size_t)R0 * qpitch; const bf16_t* krow = P + (size_t)R0 * 128;
#pragma unroll
            for (int i = 0; i < 2; ++i) {
                __builtin_amdgcn_global_load_lds((const unsigned*)(qrow + qoff[i]), (LAS unsigned*)(st + ST_Q + (2 * lw + i) * 1024), 16, 0, 0);
                __builtin_amdgcn_global_load_lds((const unsigned*)(krow + koff[i]), (LAS unsigned*)(st + ST_K + (2 * lw + i) * 1024), 16, 0, 0);
            }
            __builtin_amdgcn_global_load_lds((const unsigned*)(krow + voff), (LAS unsigned*)(st + ST_V + lw * 1024), 16, 0, 0);
            __builtin_amdgcn_global_load_lds((const unsigned*)(dsrc + (size_t)c * 128), (LAS unsigned*)(st + ST_D + (lw & 1) * 256), 4, 0, 0);
            __builtin_amdgcn_global_load_lds((const unsigned*)(OFBc + (size_t)R0 * 128 + ooff), (LAS unsigned*)(st + ST_O + lw * 1024), 16, 0, 0);
        };
        issue(0); issue(1); issue(2); issue(3); issue(4);
        asm volatile("s_waitcnt vmcnt(28)" ::: "memory");
        __builtin_amdgcn_s_barrier();
        for (int s = 0; s < NCH; ++s) {
            issue(s + 5);
            asm volatile("s_waitcnt vmcnt(28)" ::: "memory");
            __builtin_amdgcn_s_barrier();
        }
        asm volatile("s_waitcnt vmcnt(0)" ::: "memory");
    } else {
        f32x4 S[8];
#pragma unroll
        for (int j = 0; j < 8; ++j) S[j] = (f32x4){0.f, 0.f, 0.f, 0.f};
        const int swz = (l15 >> 2) & 3, vcol = 64 * vhalf + 16 * w;
        bf16_t* OFBw = (bf16_t*)(p.ws + WS_OFB) + (size_t)dir * NROW * 512;
        __builtin_amdgcn_s_barrier();
        for (int s = 0; s < NCH; ++s) {
            LAS unsigned char* st = lds + (s % NSTAGE) * ST_BYTES;
            bf16x8 qf[4][2], kf[8]; f32x4 dv[8];
#pragma unroll
            for (int kb = 0; kb < 4; ++kb)
#pragma unroll
                for (int mt = 0; mt < 2; ++mt) {
                    qf[kb][mt] = *(const LAS bf16x8*)(st + ST_Q + (16 * mt + l15) * 256 + (((4 * kb + q4) ^ l15) * 16));
                }
            const bf16x8 vf = *(const LAS bf16x8*)(st + ST_V + (16 * w + l15) * 64 + ((q4 ^ swz) * 16));
            u32x2 oi[2];
#pragma unroll
            for (int mt = 0; mt < 2; ++mt) { const int tr = 16 * mt + l15; oi[mt] = *(const LAS u32x2*)(st + ST_O + tr * 128 + (((2 * w + (q4 >> 1)) ^ (tr & 7)) * 16) + (q4 & 1) * 8); }
#pragma unroll
            for (int j = 0; j < 8; ++j) { dv[j] = *(const LAS f32x4*)(st + ST_D + (16 * j + 4 * q4) * 4); kf[j] = *(const LAS bf16x8*)(st + ST_K + (16 * j + l15) * 64 + ((q4 ^ swz) * 16)); }
            __builtin_amdgcn_sched_barrier(0);
            f32x4 o[2]; o[0] = (f32x4){0.f, 0.f, 0.f, 0.f}; o[1] = o[0];
#pragma unroll
            for (int kb = 0; kb < 4; ++kb) {
                u32x4 sb; sb.x = pk_bf16(S[2 * kb][0], S[2 * kb][1]); sb.y = pk_bf16(S[2 * kb][2], S[2 * kb][3]); sb.z = pk_bf16(S[2 * kb + 1][0], S[2 * kb + 1][1]); sb.w = pk_bf16(S[2 * kb + 1][2], S[2 * kb + 1][3]);
                const bf16x8 sfr = __builtin_bit_cast(bf16x8, sb);
                o[0] = __builtin_amdgcn_mfma_f32_16x16x32_bf16(sfr, qf[kb][0], o[0], 0, 0, 0);
                o[1] = __builtin_amdgcn_mfma_f32_16x16x32_bf16(sfr, qf[kb][1], o[1], 0, 0, 0);
            }
#pragma unroll
            for (int j = 0; j < 8; ++j) S[j] = __builtin_amdgcn_mfma_f32_16x16x32_bf16(kf[j], vf, S[j] * dv[j], 0, 0, 0);
            const int R0 = row0_of(chunk_of(s));
#pragma unroll
            for (int mt = 0; mt < 2; ++mt) { const int tr = 16 * mt + l15;
                u32x2 wv; wv.x = pk_bf16(o[mt][0] + bf_lo(oi[mt].x), o[mt][1] + bf_hi(oi[mt].x)); wv.y = pk_bf16(o[mt][2] + bf_lo(oi[mt].y), o[mt][3] + bf_hi(oi[mt].y));
                *(u32x2*)(OFBw + (size_t)h * PSLOT + (size_t)(R0 + tr) * 128 + vcol + 4 * q4) = wv; }
            asm volatile("s_waitcnt lgkmcnt(0)" ::: "memory");
            __builtin_amdgcn_s_barrier();
        }
    }
}

constexpr int SG_ST = 136;
__device__ void sgu_tile(const Params& p, int l, int tile, LAS unsigned char* lds) {
    const int tid = opaque_tid(), w = tid >> 6, lane = tid & 63, l15 = lane & 15, q4 = lane >> 4;
    const int h = tile & 3, rowbase = (tile >> 2) * 128;
    const bf16_t* P = (const bf16_t*)(p.ws + WS_BIG);
    bf16_t* O = (bf16_t*)(p.ws + WS_H);
    LAS bf16_t* Vt = (LAS bf16_t*)lds;
    {
        const int q = tid >> 2, cgp = tid & 3;
        const bf16_t* vp = P + PIX(rowbase + q, 3072 + 128 * h + 32 * cgp);
        float g[32];
#pragma unroll
        for (int i = 0; i < 4; ++i) { const u32x4 r = *(const u32x4*)(vp + 8 * i);
#pragma unroll
            for (int j = 0; j < 4; ++j) { g[8 * i + 2 * j] = gelu_f(bf_lo(r[j])); g[8 * i + 2 * j + 1] = gelu_f(bf_hi(r[j])); } }
        float s = 0.f;
#pragma unroll
        for (int i = 0; i < 32; ++i) s += g[i];
        s += __shfl_xor(s, 1); s += __shfl_xor(s, 2);
        const float mu = s * (1.0f / 128.f);
        float vs = 0.f;
#pragma unroll
        for (int i = 0; i < 32; ++i) { const float d = g[i] - mu; vs += d * d; }
        vs += __shfl_xor(vs, 1); vs += __shfl_xor(vs, 2);
        const float rstd = rsqrtf(vs * (1.0f / 128.f) + EPS);
        const float* lng = p.in[12] + l * 512 + h * 128 + 32 * cgp; const float* lnb = p.in[13] + l * 512 + h * 128 + 32 * cgp;
#pragma unroll
        for (int i = 0; i < 32; ++i) { const float y = (g[i] - mu) * rstd * lng[i] + lnb[i]; Vt[(32 * cgp + i) * SG_ST + q] = to_bf1(y); }
    }
    __syncthreads();
    {
        const int prow = 16 * w + l15;
        const bf16_t* wsp = (const bf16_t*)(p.ws + WS_WSP) + ((size_t)(l * 4 + h) * 128 + prow) * 128 + 8 * q4;
        bf16x8 wf[4];
#pragma unroll
        for (int kb = 0; kb < 4; ++kb) wf[kb] = *(const bf16x8*)(wsp + 32 * kb);
        const float bs = p.in[15][(l * 4 + h) * 128 + prow];
        const bf16_t* up = P + PIX(rowbase + prow, 2560 + 128 * h + 4 * q4);
        bf16_t* op = O + (size_t)(rowbase + prow) * D + 512 + 128 * h + 4 * q4;
        u32x2 uall[8];
#pragma unroll
        for (int mt = 0; mt < 8; ++mt) uall[mt] = *(const u32x2*)(up + 16 * mt);
#pragma unroll
        for (int mt = 0; mt < 8; ++mt) {
            f32x4 acc = (f32x4){0.f, 0.f, 0.f, 0.f};
#pragma unroll
            for (int kb = 0; kb < 4; ++kb) { const bf16x8 af = *(const LAS bf16x8*)(Vt + (16 * mt + l15) * SG_ST + 32 * kb + 8 * q4);
                acc = __builtin_amdgcn_mfma_f32_16x16x32_bf16(af, wf[kb], acc, 0, 0, 0); }
            const u32x2 uu = uall[mt];
            const float u0 = gelu_f(bf_lo(uu.x)), u1 = gelu_f(bf_hi(uu.x)), u2 = gelu_f(bf_lo(uu.y)), u3 = gelu_f(bf_hi(uu.y));
            u32x2 wv; wv.x = pk_bf16(u0 * (acc[0] + bs), u1 * (acc[1] + bs)); wv.y = pk_bf16(u2 * (acc[2] + bs), u3 * (acc[3] + bs));
            *(u32x2*)(op + 16 * mt) = wv;
        }
    }
    __syncthreads();
}

constexpr int SGU_IN_M2 = 1088;
__device__ void phase_mixer(const Params& p, int l, LAS unsigned char* lds) {
    const int G = gridDim.x, bid = blockIdx.x;
    const int ntile = (l == 0) ? (NROW / 128) * 4 : (NLAT / 128) * 4;
    if (G > 128) {
        if (bid < 128) scan_chain(p, l, bid >> 1, bid & 1, lds);
        else for (int t = bid - 128; t < (ntile < SGU_IN_M2 ? ntile : SGU_IN_M2); t += G - 128) sgu_tile(p, l, t, lds);
    } else {
        for (int c = bid; c < 128; c += G) { scan_chain(p, l, c >> 1, c & 1, lds); __syncthreads(); }
        for (int t = bid; t < ntile; t += G) sgu_tile(p, l, t, lds);
    }
}

__device__ void phase_combine(const Params& p, int l, int nrows) {
    const int tid_ = opaque_tid(); const int wave = tid_ >> 6, lane = tid_ & 63, hd = lane >> 4, v0 = (lane & 15) * 8;
    const bf16_t* P = (const bf16_t*)(p.ws + WS_BIG);
    const bf16_t* OF = (const bf16_t*)(p.ws + WS_OFB); const bf16_t* OB = OF + (size_t)NROW * 512;
    bf16_t* O = (bf16_t*)(p.ws + WS_H);
    const float* gn = p.in[11] + l * 512 + hd * 128 + v0;
    const f32x4 g0 = *(const f32x4*)gn, g1 = *(const f32x4*)(gn + 4);
    for (int row0 = (blockIdx.x * 8 + wave) * 4; row0 < nrows; row0 += gridDim.x * 32) {
        u32x4 a[4], bq[4], gg[4];
#pragma unroll
        for (int u = 0; u < 4; ++u) { const size_t row = row0 + u;
            a[u] = *(const u32x4*)(OF + (size_t)hd * PSLOT + row * 128 + v0); bq[u] = *(const u32x4*)(OB + (size_t)hd * PSLOT + row * 128 + v0);
            gg[u] = *(const u32x4*)(P + PIX((int)row, 2048 + hd * 128 + v0)); }
#pragma unroll
        for (int u = 0; u < 4; ++u) {
            float s[8]; float ss = 0.f;
#pragma unroll
            for (int j = 0; j < 4; ++j) { s[2 * j] = bf_lo(a[u][j]) + bf_lo(bq[u][j]); s[2 * j + 1] = bf_hi(a[u][j]) + bf_hi(bq[u][j]); ss += s[2 * j] * s[2 * j] + s[2 * j + 1] * s[2 * j + 1]; }
#pragma unroll
            for (int o = 8; o > 0; o >>= 1) ss += __shfl_xor(ss, o);
            const float rs = rsqrtf(ss * (1.0f / 128.f) + EPS);
            float y[8];
#pragma unroll
            for (int j = 0; j < 4; ++j) { y[2 * j] = s[2 * j] * rs * (j < 2 ? g0[2 * j] : g1[2 * j - 4]) * silu_f(bf_lo(gg[u][j])); y[2 * j + 1] = s[2 * j + 1] * rs * (j < 2 ? g0[2 * j + 1] : g1[2 * j - 3]) * silu_f(bf_hi(gg[u][j])); }
            u32x4 wv; wv.x = pk_bf16(y[0], y[1]); wv.y = pk_bf16(y[2], y[3]); wv.z = pk_bf16(y[4], y[5]); wv.w = pk_bf16(y[6], y[7]);
            *(u32x4*)(O + (size_t)(row0 + u) * D + hd * 128 + v0) = wv;
        }
    }
}

__device__ void phase_conv(const Params& p, int l, int nrows) {
    bf16_t* Aup = (bf16_t*)(p.ws + WS_BIG); const bf16_t* Gup = Aup + (size_t)NROW * FF;
    const float* cw = p.in[18] + (size_t)l * 9 * FF; const float* cb = p.in[19] + (size_t)l * FF;
    const int tid_ = opaque_tid();
    const long total = (long)(nrows / 16) * 352;
    for (long id0 = (long)blockIdx.x * 512 + tid_; id0 < total; id0 += (long)gridDim.x * 512) {
        const int seg = (int)((total - 1 - id0) / 352), f0 = (int)(id0 % 352) * 8;
        const int tok0 = seg * 16;
        int c0, W; bool up, dn;
        if (tok0 < NLAT) { const int t = tok0 & 4095, r = t >> 6; c0 = t & 63; W = 64; up = r > 0; dn = r < 63; }
        else { c0 = (tok0 - NLAT) & 255; W = 256; up = false; dn = false; }
        float tp[9][8]; float bias[8];
#pragma unroll
        for (int k = 0; k < 9; ++k) { const f32x4 t0 = *(const f32x4*)(cw + k * FF + f0), t1 = *(const f32x4*)(cw + k * FF + f0 + 4);
            tp[k][0] = t0[0]; tp[k][1] = t0[1]; tp[k][2] = t0[2]; tp[k][3] = t0[3]; tp[k][4] = t1[0]; tp[k][5] = t1[1]; tp[k][6] = t1[2]; tp[k][7] = t1[3]; }
        { const f32x4 b0 = *(const f32x4*)(cb + f0), b1 = *(const f32x4*)(cb + f0 + 4); bias[0] = b0[0]; bias[1] = b0[1]; bias[2] = b0[2]; bias[3] = b0[3]; bias[4] = b1[0]; bias[5] = b1[1]; bias[6] = b1[2]; bias[7] = b1[3]; }
        const u32x4 zero = (u32x4){0u, 0u, 0u, 0u};
        const bf16_t* gp = Gup + (size_t)tok0 * FF + f0;
        u32x4 L[3], M[3], R[3];
        { const bool v = c0 > 0;
          L[0] = (v && up) ? *(const u32x4*)(gp - (size_t)65 * FF) : zero; L[1] = v ? *(const u32x4*)(gp - (size_t)FF) : zero; L[2] = (v && dn) ? *(const u32x4*)(gp + (size_t)63 * FF) : zero; }
        M[0] = up ? *(const u32x4*)(gp - (size_t)64 * FF) : zero; M[1] = *(const u32x4*)gp; M[2] = dn ? *(const u32x4*)(gp + (size_t)64 * FF) : zero;
#pragma unroll 8
        for (int i = 0; i < 16; ++i) {
            const bf16_t* np = gp + (size_t)(i + 1) * FF;
            const bool v = (c0 + i + 1) < W;
            R[0] = (v && up) ? *(const u32x4*)(np - (size_t)64 * FF) : zero; R[1] = v ? *(const u32x4*)np : zero; R[2] = (v && dn) ? *(const u32x4*)(np + (size_t)64 * FF) : zero;
            float acc[8];
#pragma unroll
            for (int j = 0; j < 8; ++j) acc[j] = bias[j];
#pragma unroll
            for (int rr = 0; rr < 3; ++rr) {
#pragma unroll
                for (int j = 0; j < 4; ++j) {
                    acc[2 * j] += bf_lo(L[rr][j]) * tp[rr * 3 + 0][2 * j] + bf_lo(M[rr][j]) * tp[rr * 3 + 1][2 * j] + bf_lo(R[rr][j]) * tp[rr * 3 + 2][2 * j];
                    acc[2 * j + 1] += bf_hi(L[rr][j]) * tp[rr * 3 + 0][2 * j + 1] + bf_hi(M[rr][j]) * tp[rr * 3 + 1][2 * j + 1] + bf_hi(R[rr][j]) * tp[rr * 3 + 2][2 * j + 1];
                }
            }
            bf16_t* ap = Aup + (size_t)(tok0 + i) * FF + f0;
            const u32x4 av = *(const u32x4*)ap;
            u32x4 wv;
#pragma unroll
            for (int j = 0; j < 4; ++j) wv[j] = pk_bf16(bf_lo(av[j]) * gelu_f(acc[2 * j]), bf_hi(av[j]) * gelu_f(acc[2 * j + 1]));
            *(u32x4*)ap = wv;
#pragma unroll
            for (int rr = 0; rr < 3; ++rr) { L[rr] = M[rr]; M[rr] = R[rr]; }
        }
    }
}

#define XB_TMO      128
#define XB_XCNT(j)  (256  + 64 * (j))
#define XB_XSUB(j)  (1280 + 64 * (j))
#define XB_XGEN(j)  (2304 + 64 * (j))
#define XB_TOP      3328
#define XB_TOPGEN   3392
#define XCD_BAR_WORDS 3456
#define XB_SPIN_CAP (1u << 20)
__device__ __forceinline__ unsigned xb_ld(unsigned* p)              { return __hip_atomic_load(p, __ATOMIC_RELAXED, __HIP_MEMORY_SCOPE_AGENT); }
__device__ __forceinline__ unsigned xb_add(unsigned* p, unsigned v) { return __hip_atomic_fetch_add(p, v, __ATOMIC_RELAXED, __HIP_MEMORY_SCOPE_AGENT); }
__device__ __forceinline__ unsigned xb_xcc_id() { return (unsigned)__builtin_amdgcn_s_getreg((3 << 11) | 20) & 0xFu; }
#define XB_SPIN(cond, bar) do { unsigned _sp = 0; while (cond) { __builtin_amdgcn_s_sleep(1); \
    if ((++_sp & 255u) == 0u) { if (xb_ld(&(bar)[XB_TMO])) break; if (_sp > XB_SPIN_CAP) { atomicAdd(&(bar)[XB_TMO], 1u); break; } } } } while (0)
struct XcdBarrier { unsigned* bar; unsigned x; volatile LAS unsigned* st; };
__device__ __forceinline__ XcdBarrier xcd_barrier_post(unsigned* bar, volatile LAS unsigned* st) {
    XcdBarrier b; b.bar = bar; b.x = xb_xcc_id(); b.st = st;
    if (threadIdx.x == 0) (void)xb_add(&bar[XB_XCNT(b.x)], 1u);
    return b;
}
__device__ __forceinline__ void xcd_barrier_complete(unsigned* bar, unsigned x, unsigned& nloc, unsigned& nx) {
    const unsigned G = gridDim.x * gridDim.y * gridDim.z;
    unsigned sum, cnt, mine, sp = 0u;
    for (;;) {
        sum = 0u; cnt = 0u; mine = 0u;
#pragma unroll
        for (unsigned j = 0; j < 16; ++j) { const unsigned c = xb_ld(&bar[XB_XCNT(j)]); sum += c; cnt += (c > 0u) ? 1u : 0u; mine = (j == x) ? c : mine; }
        if (sum == G) break;
        __builtin_amdgcn_s_sleep(1);
        if ((++sp & 255u) == 0u) { if (xb_ld(&bar[XB_TMO])) break; if (sp > XB_SPIN_CAP) { atomicAdd(&bar[XB_TMO], 1u); break; } }
    }
    nloc = mine > 0u ? mine : 1u; nx = cnt > 0u ? cnt : 1u;
}
__device__ __forceinline__ void xcd_barrier(const XcdBarrier& b) {
    asm volatile("s_waitcnt vmcnt(0)" ::: "memory");
    __syncthreads();
    if (threadIdx.x == 0) {
        unsigned* bar = b.bar;
        __builtin_amdgcn_s_waitcnt(0);
        unsigned nloc = b.st[0], nx = b.st[1];
        if (nloc == 0u) { xcd_barrier_complete(bar, b.x, nloc, nx); b.st[0] = nloc; b.st[1] = nx; }
        const unsigned old = xb_add(&bar[XB_XSUB(b.x)], 1u);
        const unsigned gen = old / nloc;
        if (old + 1u == (gen + 1u) * nloc) {
            __builtin_amdgcn_fence(__ATOMIC_RELEASE, "agent");
            asm volatile("s_waitcnt vmcnt(0)" ::: "memory");
            const unsigned og = xb_add(&bar[XB_TOP], 1u);
            const unsigned tg = og / nx;
            if (og + 1u == (tg + 1u) * nx) xb_add(&bar[XB_TOPGEN], 1u);
            else XB_SPIN(xb_ld(&bar[XB_TOPGEN]) == tg, bar);
            __builtin_amdgcn_fence(__ATOMIC_ACQUIRE, "agent");
            xb_add(&bar[XB_XGEN(b.x)], 1u);
            asm volatile("s_waitcnt vmcnt(0)" ::: "memory");
        } else {
            XB_SPIN(xb_ld(&bar[XB_XGEN(b.x)]) == gen, bar);
            __builtin_amdgcn_fence(__ATOMIC_ACQUIRE, "agent");
            asm volatile("s_waitcnt vmcnt(0)" ::: "memory");
        }
    }
    __syncthreads();
}

__global__ void __launch_bounds__(512, 2) fwd_megakernel(Params p) {
    extern __shared__ __attribute__((aligned(16))) unsigned char shm[];
    LAS unsigned char* lds = (LAS unsigned char*)shm;
    cg::grid_group grid = cg::this_grid();
    __shared__ uint4 xb_words;
    if (threadIdx.x == 0) xb_words = make_uint4(0u, 0u, 0u, 0u);
    __syncthreads();
    const XcdBarrier xb = xcd_barrier_post((unsigned*)(p.ws + WS_BAR), (volatile LAS unsigned*)&xb_words);
    const int G = gridDim.x, bid = blockIdx.x;
    float* XC = (float*)(p.ws + WS_XC);
    bf16_t* H = (bf16_t*)(p.ws + WS_H);
    bf16_t* BIG = (bf16_t*)(p.ws + WS_BIG);
    const float* ADA = (const float*)(p.ws + WS_ADA);
    bf16_t* Y2 = BIG + (size_t)NROW * FF;

    phase_prep(p, lds);
    if (p.ws == nullptr) grid.sync();
    xcd_barrier(xb);
    for (int l = 0; l < DEPTH; ++l) {
        const bool last = (l == DEPTH - 1);
        const float* ada_l = ADA + (size_t)l * 9 * 6144;
        const float* xl = (l == 0) ? p.in[0] : p.out;
        const float* xc = (l == 0) ? p.in[2] : XC;
        const int Mfull = last ? NLAT : NROW;
        if (l == 0) phase_norm(xl, xc, nullptr, nullptr, nullptr, nullptr, p.in[6] + l * D, ada_l, 0, NROW, H);
        else phase_norm(p.out, XC, Y2, ADA + (size_t)(l - 1) * 9 * 6144 + 5 * 1024, p.out, nullptr, p.in[6] + l * D, ada_l, 0, NROW, H);
        xcd_barrier(xb);
        { pg8::StaticOrder S; S.init(NROW, PW, G, bid);
          pg8::EpiBf16 E{BIG, PW, 0, 0, PSLOT};
          pg8::gemm_phase(lds, pg8::Gemm{H, (const bf16_t*)(p.ws + WS_WIN) + (size_t)l * PW * D, NROW, PW, D}, S, E); }
        xcd_barrier(xb);
        { const int ntile = (l == 0) ? (NROW / 128) * 4 : (NLAT / 128) * 4;
          const int nextra = (G > 128 && ntile > SGU_IN_M2) ? ntile - SGU_IN_M2 : 0;
          for (int it = bid; it < 32 * NCH + nextra; it += G) { if (it < 32 * NCH) prep_item(p, l, 32 * NCH - 1 - it, lds); else sgu_tile(p, l, SGU_IN_M2 + it - 32 * NCH, lds); } }
        xcd_barrier(xb);
        phase_mixer(p, l, lds);
        xcd_barrier(xb);
        phase_combine(p, l, Mfull);
        xcd_barrier(xb);
        { pg8::StaticOrder S; S.init(Mfull, D, G, bid);
          pg8::EpiBf16 E{BIG, D, 0, 0, 0};
          pg8::gemm_phase(lds, pg8::Gemm{H, (const bf16_t*)(p.ws + WS_WOUT) + (size_t)l * D * D, Mfull, D, D}, S, E); }
        xcd_barrier(xb);
        phase_norm(xl, xc, BIG, ada_l + 2 * 1024, p.out, XC, p.in[7] + l * D, ada_l, 3, Mfull, H);
        xcd_barrier(xb);
        { pg8::StaticOrder S; S.init(Mfull, UPW, G, bid);
          pg8::EpiBf16 E{BIG, FF, FF, (size_t)NROW * FF, 0};
          pg8::gemm_phase(lds, pg8::Gemm{H, (const bf16_t*)(p.ws + WS_WUP) + (size_t)l * UPW * D, Mfull, UPW, D}, S, E); }
        xcd_barrier(xb);
        phase_conv(p, l, Mfull);
        xcd_barrier(xb);
        { pg8::StaticOrder S; S.init(Mfull, D, G, bid);
          pg8::EpiBf16 E{Y2, D, 0, 0, 0};
          pg8::gemm_phase(lds, pg8::Gemm{BIG, (const bf16_t*)(p.ws + WS_WDOWN) + (size_t)l * D * FF, Mfull, D, FF}, S, E); }
        xcd_barrier(xb);
    }
    phase_final(p.out, Y2, ADA + (size_t)(DEPTH - 1) * 9 * 6144 + 5 * 1024, p.in[21]);
}

extern "C" void kernel_launch(void* const* d_in, const int* in_sizes, int n_in, void* d_out, int out_size, void* d_ws, size_t ws_size, hipStream_t stream) {
    constexpr int LDS_BYTES = 155648;
    static int grid_blocks = 0;
    if (!grid_blocks) {
        int dev = 0, cus = 0, per_cu = 0;
        (void)hipGetDevice(&dev);
        (void)hipDeviceGetAttribute(&cus, hipDeviceAttributeMultiprocessorCount, dev);
        (void)hipFuncSetAttribute((const void*)fwd_megakernel, hipFuncAttributeMaxDynamicSharedMemorySize, LDS_BYTES);
        (void)hipOccupancyMaxActiveBlocksPerMultiprocessor(&per_cu, (const void*)fwd_megakernel, 512, LDS_BYTES);
        if (per_cu < 1) per_cu = 1;
        grid_blocks = cus * per_cu;
        if (ws_size < WS_END) fprintf(stderr, "workspace too small: %zu < %zu\n", ws_size, (size_t)WS_END);
    }
    Params p{};
    for (int i = 0; i < 22; ++i) p.in[i] = (const float*)d_in[i];
    p.out = (float*)d_out; p.ws = (unsigned char*)d_ws;
    (void)hipMemsetAsync((unsigned char*)d_ws + WS_BAR, 0, XCD_BAR_WORDS * 4, stream);
    void* args[] = {&p};
    hipError_t e = hipLaunchCooperativeKernel((const void*)fwd_megakernel, dim3(grid_blocks), dim3(512), args, LDS_BYTES, stream);
    if (e != hipSuccess) fprintf(stderr, "cooperative launch failed: %s (grid %d)\n", hipGetErrorString(e), grid_blocks);
}
```

```cpp
#include <hip/hip_runtime.h>
#include <hip/hip_cooperative_groups.h>
#include <cstdio>
namespace cg = cooperative_groups;

#define LAS __attribute__((address_space(3)))
typedef unsigned short bf16_t;
typedef short bf16x8 __attribute__((ext_vector_type(8)));
typedef float f32x4 __attribute__((ext_vector_type(4)));
typedef float f32x2 __attribute__((ext_vector_type(2)));
typedef unsigned u32x4 __attribute__((ext_vector_type(4)));
typedef unsigned u32x2 __attribute__((ext_vector_type(2)));
typedef __bf16 bf2_t __attribute__((ext_vector_type(2)));

constexpr int D = 1024, NB = 8, SEQ = 4096, DEPTH = 2, CTXL = 256;
constexpr int NLAT = NB * SEQ;
constexpr int NCTX = NB * CTXL;
constexpr int NROW = NLAT + NCTX;
constexpr int PW = 3584, FF = 2816, UPW = 2 * FF;
constexpr float EPS = 1e-6f;

constexpr size_t WS_WIN = 0;
constexpr size_t WS_WOUT = WS_WIN + (size_t)DEPTH * PW * D * 2;
constexpr size_t WS_WUP = WS_WOUT + (size_t)DEPTH * D * D * 2;
constexpr size_t WS_WDOWN = WS_WUP + (size_t)DEPTH * UPW * D * 2;
constexpr size_t WS_WSP = WS_WDOWN + (size_t)DEPTH * D * FF * 2;
constexpr size_t WS_ADA = WS_WSP + (size_t)DEPTH * 4 * 128 * 128 * 2;
constexpr size_t WS_LB = WS_ADA + (size_t)DEPTH * 9 * 6144 * 4;
constexpr size_t WS_XC = WS_LB + 2 * 512 * 4;
constexpr size_t WS_H = WS_XC + (size_t)NCTX * D * 4;
constexpr size_t WS_BIG = WS_H + (size_t)NROW * D * 2;
constexpr size_t WS_OFB = WS_BIG + (size_t)NROW * PW * 2;
constexpr size_t WS_QB = WS_OFB + 2 * (size_t)NROW * 512 * 2;
constexpr size_t WS_DS = WS_BIG + (size_t)NROW * UPW * 2;
constexpr size_t WS_BAR = WS_DS + (size_t)64 * 136 * 128 * 4;
constexpr size_t WS_END = WS_BAR + 16384;

constexpr size_t PSLOT = (size_t)NROW * 128;
__device__ __forceinline__ size_t PIX(int row, int col) { return (size_t)(col >> 7) * PSLOT + (size_t)row * 128 + (col & 127); }
struct Params {
    const float* in[22];
    float* out;
    unsigned char* ws;
};

__device__ __forceinline__ unsigned pk_bf16(float a, float b) { f32x2 v = {a, b}; bf2_t r = __builtin_convertvector(v, bf2_t); return __builtin_bit_cast(unsigned, r); }
__device__ __forceinline__ float bf_lo(unsigned u) { return __uint_as_float(u << 16); }
__device__ __forceinline__ float bf_hi(unsigned u) { return __uint_as_float(u & 0xffff0000u); }
__device__ __forceinline__ float bf1(bf16_t u) { return __uint_as_float(((unsigned)u) << 16); }
__device__ __forceinline__ bf16_t to_bf1(float a) { return (bf16_t)(pk_bf16(a, 0.f) & 0xffffu); }
__device__ __forceinline__ float fast_rcp(float x) { return __builtin_amdgcn_rcpf(x); }
__device__ __forceinline__ float gelu_f(float v) {
    const float av = fabsf(v), t = fast_rcp(av * 0.2316418882f + 1.0f);
    float q = t * 0.5307027145f + (-0.7265760135f); q = q * t + 0.7107068705f; q = q * t + (-0.142248368f); q = q * t + 0.127414796f; q = q * t;
    const float e = __builtin_amdgcn_exp2f((v * v) * (-0.72134752044f));
    const float m = v * (q * e);
    return v < 0.f ? m : v - m;
}
__device__ __forceinline__ int opaque_tid() { int t = threadIdx.x; asm volatile("" : "+v"(t)); return t; }
__device__ __forceinline__ float silu_f(float x) { return x * fast_rcp(1.0f + __expf(-x)); }

namespace pg8 {
constexpr int BM = 256, BK = 64, HALF = 128, HTB = HALF * BK * 2, STAGE_BYTES = 8 * HTB, NXCD = 8, WGM = 8;
__host__ __device__ __forceinline__ int lds_byte(int r, int c) { const int st = (r >> 4) * 2 + (c >> 5), rr = r & 15, cc = c & 31, ob = rr * 64 + cc * 2; return st * 1024 + (ob ^ (((ob >> 9) & 1) << 5)); }
__host__ __device__ __forceinline__ void stage_rc(int b, int& R, int& C) { const int st = b / 1024, sb = b % 1024, swz = sb ^ (((sb >> 9) & 1) << 5); R = (st >> 1) * 16 + swz / 64; C = (st & 1) * 32 + (swz % 64) / 2; }
__host__ __device__ __forceinline__ int perm32(int rho) { const int n = rho >> 4, i = rho & 15; return 8 * (i >> 2) + 4 * n + (i & 3); }
struct Unit { int pm, pn; };
struct Gemm { const bf16_t* A; const bf16_t* Bt; int M, N, K; };
struct StaticOrder {
    int nM, nN, nwg, G, c;
    __device__ void init(int M, int N, int G_, int c_) { nM = M / BM; nN = N / BM; nwg = nM * nN; G = G_; c = c_; }
    __device__ bool next(int i, Unit& u) const {
        const long L = (long)i * G + c; if (L >= nwg) return false;
        int wgid = (int)L; { const int q = nwg / NXCD, r = nwg % NXCD, xcd = wgid % NXCD, off = wgid / NXCD; wgid = (xcd < r ? xcd * (q + 1) : r * (q + 1) + (xcd - r) * q) + off; }
        const int nig = WGM * nN, gid = wgid / nig, fm = gid * WGM, gsz = (nM - fm) < WGM ? (nM - fm) : WGM;
        u.pm = fm + ((wgid % nig) % gsz); u.pn = (wgid % nig) / gsz; return true;
    }
    __device__ __forceinline__ void a_ready(const Unit&) const {}
    __device__ __forceinline__ void done(const Unit&) const {}
};
struct EpiBf16 {
    static constexpr bool PERM = true;
    bf16_t* O; int ldc; int split_cols; size_t split_stride; size_t slot_stride;
    __device__ __forceinline__ void operator()(const f32x4 (&acc)[2][2][4][2], const Unit& u, int wr, int wc, int fr, int fq) const {
        const int row0 = u.pm * BM + wr * 64 + fr; int colt = u.pn * BM; bf16_t* base = O;
        if (split_cols) { const int t = colt / split_cols; base += (size_t)t * split_stride; colt -= t * split_cols; }
        const int col0 = colt + wc * 32 + 8 * fq;
#pragma unroll
        for (int ai = 0; ai < 2; ++ai)
#pragma unroll
            for (int m = 0; m < 4; ++m) { const int row = row0 + ai * HALF + m * 16;
                bf16_t* rowp = slot_stride ? base + (size_t)(colt >> 7) * slot_stride + (size_t)row * 128 + wc * 32 + 8 * fq : base + (size_t)row * ldc + col0;
#pragma unroll
                for (int bj = 0; bj < 2; ++bj) { const f32x4 v0 = acc[ai][bj][m][0], v1 = acc[ai][bj][m][1];
                    u32x4 w; w.x = pk_bf16(v0[0], v0[1]); w.y = pk_bf16(v0[2], v0[3]); w.z = pk_bf16(v1[0], v1[1]); w.w = pk_bf16(v1[2], v1[3]);
                    *(u32x4*)(rowp + (slot_stride ? (size_t)bj * slot_stride : (size_t)bj * HALF)) = w; } }
    }
};
struct EpiRes {
    static constexpr bool PERM = false;
    const float* resL; float* outL; const float* resC; float* outC; const float* gate;
    __device__ __forceinline__ void operator()(const f32x4 (&acc)[2][2][4][2], const Unit& u, int wr, int wc, int fr, int fq) const {
        const float* res; float* out; const float* g; int rowb;
        if (u.pm < NLAT / BM) { res = resL; out = outL; g = gate + (size_t)(u.pm >> 4) * 6144; rowb = u.pm * BM; }
        else { res = resC; out = outC; g = gate + (size_t)8 * 6144; rowb = u.pm * BM - NLAT; }
        const int row0 = rowb + wr * 64 + fr, col0 = u.pn * BM + wc * 32 + 4 * fq;
        f32x4 gv[2][2];
#pragma unroll
        for (int bj = 0; bj < 2; ++bj)
#pragma unroll
            for (int n = 0; n < 2; ++n) gv[bj][n] = *(const f32x4*)(g + col0 + bj * HALF + n * 16);
#pragma unroll
        for (int ai = 0; ai < 2; ++ai)
#pragma unroll
            for (int m = 0; m < 4; ++m) { const size_t ro = (size_t)(row0 + ai * HALF + m * 16) * D + col0;
#pragma unroll
                for (int bj = 0; bj < 2; ++bj)
#pragma unroll
                    for (int n = 0; n < 2; ++n) { const f32x4 r = *(const f32x4*)(res + ro + bj * HALF + n * 16);
                        *(f32x4*)(out + ro + bj * HALF + n * 16) = r + gv[bj][n] * acc[ai][bj][m][n]; } }
    }
};

template <class Epi, class Sched>
__device__ __forceinline__ void gemm_phase(LAS unsigned char* lds, const Gemm g, const Sched& S, const Epi& E) {
    const int tid = opaque_tid(), wid = __builtin_amdgcn_readfirstlane(tid >> 6), lane = tid & 63, wr = wid >> 2, wc = wid & 3, fr = lane & 15, fq = lane >> 4;
    const int K = g.K, nt = K / BK;
    unsigned voffA[2], voffB[2];
#pragma unroll
    for (int i = 0; i < 2; ++i) { int R, C; stage_rc(tid * 16 + i * 8192, R, C); const int Rb = Epi::PERM ? ((R & ~31) + perm32(R & 31)) : R;
        voffA[i] = (unsigned)(R * K + C) * 2u; voffB[i] = (unsigned)(Rb * K + C) * 2u; }
    const size_t kstep = (size_t)(BK * 2);
    const size_t hstep = (size_t)HALF * K * 2;
    const size_t tstep = 2 * hstep;
    const unsigned ldsw = (unsigned)wid * 1024u;
    const int aoff = lds_byte(wr * 64 + fr, fq * 8), boff = lds_byte(wc * 32 + fr, fq * 8);
#define PG8_SA(b, h) (((b) * 2 + (h)) * HTB)
#define PG8_SB(b, h) ((4 + (b) * 2 + (h)) * HTB)
#define PG8_STAGE(bufoff, gbase, voff) do { _Pragma("unroll") for (int _i = 0; _i < 2; ++_i) \
        __builtin_amdgcn_global_load_lds((const unsigned*)((const char*)(gbase) + (voff)[_i]), (LAS unsigned*)(lds + (bufoff) + ldsw + _i * 8192), 16, 0, 0); } while (0)
#define PG8_LDA(dst, b, h) do { _Pragma("unroll") for (int m = 0; m < 4; ++m) _Pragma("unroll") for (int k = 0; k < 2; ++k) dst[m][k] = *(const LAS bf16x8*)(lds + PG8_SA(b, h) + aoff + m * 2048 + k * 1024); } while (0)
#define PG8_LDB(dst, b, h) do { _Pragma("unroll") for (int n = 0; n < 2; ++n) _Pragma("unroll") for (int k = 0; k < 2; ++k) dst[n][k] = *(const LAS bf16x8*)(lds + PG8_SB(b, h) + boff + n * 2048 + k * 1024); } while (0)
#define PG8_MMA(ai, bj, At, Bt) do { __builtin_amdgcn_s_setprio(1); _Pragma("unroll") for (int m = 0; m < 4; ++m) _Pragma("unroll") for (int n = 0; n < 2; ++n) _Pragma("unroll") for (int k = 0; k < 2; ++k) \
        acc[ai][bj][m][n] = __builtin_amdgcn_mfma_f32_16x16x32_bf16(Bt[n][k], At[m][k], acc[ai][bj][m][n], 0, 0, 0); __builtin_amdgcn_s_setprio(0); } while (0)
#define PG8_WAIT_V(n) asm volatile("s_waitcnt vmcnt(" #n ")" ::: "memory")
#define PG8_WAIT_L(n) asm volatile("s_waitcnt lgkmcnt(" #n ")" ::: "memory")
#define PG8_BAR __builtin_amdgcn_s_barrier()
#define PG8_SCHED __builtin_amdgcn_sched_barrier(0)
    Unit cur, nxt; int ui = 0;
    if (!S.next(0, cur)) return;
    f32x4 acc[2][2][4][2];
#pragma unroll
    for (int a = 0; a < 2; ++a)
#pragma unroll
        for (int b = 0; b < 2; ++b)
#pragma unroll
            for (int m = 0; m < 4; ++m)
#pragma unroll
                for (int n = 0; n < 2; ++n) acc[a][b][m][n] = (f32x4){0.f, 0.f, 0.f, 0.f};
    bf16x8 At[4][2], B0[2][2], B1[2][2];
    const char* cA = (const char*)g.A + (size_t)cur.pm * tstep; const char* cB = (const char*)g.Bt + (size_t)cur.pn * tstep;
    S.a_ready(cur);
    PG8_STAGE(PG8_SB(0, 0), cB, voffB); PG8_STAGE(PG8_SA(0, 0), cA, voffA); PG8_STAGE(PG8_SB(0, 1), cB + hstep, voffB); PG8_STAGE(PG8_SA(0, 1), cA + hstep, voffA);
    if (wr == 1) PG8_BAR;
    PG8_WAIT_V(4); PG8_BAR;
    PG8_STAGE(PG8_SB(1, 0), cB + kstep, voffB); PG8_STAGE(PG8_SA(1, 0), cA + kstep, voffA); PG8_STAGE(PG8_SB(1, 1), cB + hstep + kstep, voffB);
    PG8_WAIT_V(6); PG8_BAR;
    for (;;) {
        const bool has_next = S.next(ui + 1, nxt);
        const char* nA = has_next ? (const char*)g.A + (size_t)nxt.pm * tstep : cA; const char* nB = has_next ? (const char*)g.Bt + (size_t)nxt.pn * tstep : cB;
        for (int t = 0; t < nt; t += 2) {
            const bool last = (t == nt - 2);
            const char* a1 = cA + (size_t)(t + 1) * kstep;
            const char* a2 = last ? nA : cA + (size_t)(t + 2) * kstep; const char* b2 = last ? nB : cB + (size_t)(t + 2) * kstep;
            const char* a3 = a2 + kstep; const char* b3 = b2 + kstep;
            if (last && has_next) S.a_ready(nxt);
            PG8_LDB(B0, 0, 0); PG8_SCHED; PG8_LDA(At, 0, 0); PG8_STAGE(PG8_SA(1, 1), a1 + hstep, voffA);
            PG8_WAIT_L(8); PG8_BAR; PG8_WAIT_L(0); PG8_MMA(0, 0, At, B0); PG8_BAR; PG8_SCHED;
            PG8_LDB(B1, 0, 1); PG8_STAGE(PG8_SB(0, 0), b2, voffB);
            PG8_BAR; PG8_WAIT_L(0); PG8_MMA(0, 1, At, B1); PG8_BAR;
            PG8_LDA(At, 0, 1); PG8_STAGE(PG8_SA(0, 0), a2, voffA);
            PG8_BAR; PG8_WAIT_L(0); PG8_MMA(1, 0, At, B0); PG8_BAR; PG8_SCHED;
            PG8_STAGE(PG8_SB(0, 1), b2 + hstep, voffB);
            PG8_WAIT_V(6); PG8_BAR; PG8_MMA(1, 1, At, B1); PG8_BAR;
            PG8_LDB(B0, 1, 0); PG8_SCHED; PG8_LDA(At, 1, 0); PG8_STAGE(PG8_SA(0, 1), a2 + hstep, voffA);
            PG8_WAIT_L(8); PG8_BAR; PG8_WAIT_L(0); PG8_MMA(0, 0, At, B0); PG8_BAR; PG8_SCHED;
            PG8_LDB(B1, 1, 1); PG8_STAGE(PG8_SB(1, 0), b3, voffB);
            PG8_BAR; PG8_WAIT_L(0); PG8_MMA(0, 1, At, B1); PG8_BAR;
            PG8_LDA(At, 1, 1); PG8_STAGE(PG8_SA(1, 0), a3, voffA);
            PG8_BAR; PG8_WAIT_L(0); PG8_MMA(1, 0, At, B0); PG8_BAR; PG8_SCHED;
            PG8_STAGE(PG8_SB(1, 1), b3 + hstep, voffB);
            PG8_WAIT_V(6); PG8_BAR; PG8_MMA(1, 1, At, B1); PG8_BAR;
        }
        E(acc, cur, wr, wc, fr, fq); S.done(cur);
        if (!has_next) break;
#pragma unroll
        for (int a = 0; a < 2; ++a)
#pragma unroll
            for (int b = 0; b < 2; ++b)
#pragma unroll
                for (int m = 0; m < 4; ++m)
#pragma unroll
                    for (int n = 0; n < 2; ++n) acc[a][b][m][n] = (f32x4){0.f, 0.f, 0.f, 0.f};
        cur = nxt; cA = nA; cB = nB; ++ui;
    }
    PG8_WAIT_V(0);
    if (wr == 0) PG8_BAR;
    PG8_BAR;
#undef PG8_SA
#undef PG8_SB
#undef PG8_STAGE
#undef PG8_LDA
#undef PG8_LDB
#undef PG8_MMA
#undef PG8_WAIT_V
#undef PG8_WAIT_L
#undef PG8_BAR
#undef PG8_SCHED
}
}

__device__ void phase_prep(const Params& p, LAS unsigned char* lds) {
    const int tid = opaque_tid();
    constexpr int NT_L = 896 + 256 + 1408 + 704;
    constexpr int J_ADA = 192, J_TR = J_ADA + 2 * NT_L, J_WSP = J_TR + 32, J_LB = J_WSP + 1;
    for (int job = blockIdx.x; job < J_LB; job += gridDim.x) {
        if (job < J_ADA) {
            LAS float* s = (LAS float*)lds;
            LAS float* red = (LAS float*)(lds + 9 * 1024 * 4);
            for (int i = tid; i < 9 * 1024; i += 512) { const int r = i >> 10, d = i & 1023; const float v = r < 8 ? p.in[1][r * 1024 + d] : p.in[3][d]; s[i] = silu_f(v); }
            __syncthreads();
            const int l = job / 96, e0 = (job % 96) * 64, col = tid & 63, dg = tid >> 6;
            const float* w = p.in[4] + ((size_t)l * 1024 + dg * 128) * 6144 + e0 + col;
            float acc[9];
#pragma unroll
            for (int r = 0; r < 9; ++r) acc[r] = 0.f;
            for (int dd = 0; dd < 128; ++dd) { const float wv = w[(size_t)dd * 6144];
#pragma unroll
                for (int r = 0; r < 9; ++r) acc[r] += s[r * 1024 + dg * 128 + dd] * wv; }
#pragma unroll
            for (int r = 0; r < 9; ++r) red[(dg * 9 + r) * 64 + col] = acc[r];
            __syncthreads();
            for (int i = tid; i < 9 * 64; i += 512) { const int r = i >> 6, c = i & 63; float a = 0.f;
#pragma unroll
                for (int g = 0; g < 8; ++g) a += red[(g * 9 + r) * 64 + c];
                ((float*)(p.ws + WS_ADA))[((size_t)l * 9 + r) * 6144 + e0 + c] = a + p.in[5][l * 6144 + e0 + c]; }
            __syncthreads();
        } else if (job < J_TR) {
            const int j = job - J_ADA, l = j / NT_L; int r = j % NT_L;
            const float* src; bf16_t* dst; int K, N;
            if (r < 896) { src = p.in[8] + (size_t)l * D * PW; dst = (bf16_t*)(p.ws + WS_WIN) + (size_t)l * PW * D; K = D; N = PW; }
            else if (r < 1152) { r -= 896; src = p.in[16] + (size_t)l * D * D; dst = (bf16_t*)(p.ws + WS_WOUT) + (size_t)l * D * D; K = D; N = D; }
            else if (r < 2560) { r -= 1152; src = p.in[17] + (size_t)l * D * UPW; dst = (bf16_t*)(p.ws + WS_WUP) + (size_t)l * UPW * D; K = D; N = UPW; }
            else { r -= 2560; src = p.in[20] + (size_t)l * FF * D; dst = (bf16_t*)(p.ws + WS_WDOWN) + (size_t)l * D * FF; K = FF; N = D; }
            const int ntn = N >> 6, kt = r / ntn, nt = r % ntn;
            LAS float* tile = (LAS float*)lds;
            { const int kk = tid >> 3, n8 = (tid & 7) * 8; const float* sp = src + (size_t)(kt * 64 + kk) * N + nt * 64 + n8;
              const f32x4 a = *(const f32x4*)sp, b = *(const f32x4*)(sp + 4);
              LAS float* tp = tile + kk * 65 + n8; tp[0] = a[0]; tp[1] = a[1]; tp[2] = a[2]; tp[3] = a[3]; tp[4] = b[0]; tp[5] = b[1]; tp[6] = b[2]; tp[7] = b[3]; }
            __syncthreads();
            { const int nn = tid >> 3, k8 = (tid & 7) * 8; float v[8];
#pragma unroll
              for (int i = 0; i < 8; ++i) v[i] = tile[(k8 + i) * 65 + nn];
              u32x4 w; w.x = pk_bf16(v[0], v[1]); w.y = pk_bf16(v[2], v[3]); w.z = pk_bf16(v[4], v[5]); w.w = pk_bf16(v[6], v[7]);
              *(u32x4*)(dst + (size_t)(nt * 64 + nn) * K + kt * 64 + k8) = w; }
            __syncthreads();
        } else if (job < J_WSP) {
            const int j = job - J_TR; const size_t i0 = (size_t)j * 4096 + tid * 8;
            const f32x4 a = *(const f32x4*)(p.in[14] + i0), b = *(const f32x4*)(p.in[14] + i0 + 4);
            u32x4 w; w.x = pk_bf16(a[0], a[1]); w.y = pk_bf16(a[2], a[3]); w.z = pk_bf16(b[0], b[1]); w.w = pk_bf16(b[2], b[3]);
            *(u32x4*)((bf16_t*)(p.ws + WS_WSP) + i0) = w;
        } else {
            for (int i = tid; i < 1024; i += 512) { const int dir = i >> 9, c = i & 511; const float* lg = dir ? p.in[10] : p.in[9];
                const float l0 = lg[c], l1 = lg[512 + c]; ((float*)(p.ws + WS_LB))[i] = 1.0f / (1.0f + expf(l0 - l1)); }
        }
    }
}

__device__ void phase_norm(const float* xl, const float* xc, const bf16_t* Y, const float* gate  , float* xl_dst, float* xc_dst,
                           const float* gain, const float* ada_l, int shift_idx, int nrows, bf16_t* H) {
    const int tid_ = opaque_tid(); const int wave = tid_ >> 6, lane = tid_ & 63;
    f32x4 gn[4];
#pragma unroll
    for (int j = 0; j < 4; ++j) gn[j] = *(const f32x4*)(gain + j * 256 + lane * 4);
    for (int rr = (blockIdx.x * 8 + wave) * 2; rr < nrows; rr += gridDim.x * 16) {
        const int row = nrows - 2 - rr;
        const float* src; const float* mod; float* dst; const float* gt;
        if (row < NLAT) { src = xl + (size_t)row * D; mod = ada_l + (size_t)(row >> 12) * 6144; dst = xl_dst ? xl_dst + (size_t)row * D : nullptr; gt = gate + (size_t)(row >> 12) * 6144; }
        else { src = xc + (size_t)(row - NLAT) * D; mod = ada_l + (size_t)8 * 6144; dst = xc_dst ? xc_dst + (size_t)(row - NLAT) * D : nullptr; gt = gate + (size_t)8 * 6144; }
        f32x4 v[2][4], sh[4], sc[4], gg[4]; u32x2 yv[2][4];
#pragma unroll
        for (int u = 0; u < 2; ++u)
#pragma unroll
            for (int j = 0; j < 4; ++j) { v[u][j] = *(const f32x4*)(src + (size_t)u * D + j * 256 + lane * 4); if (Y) yv[u][j] = *(const u32x2*)(Y + (size_t)(row + u) * D + j * 256 + lane * 4); }
#pragma unroll
        for (int j = 0; j < 4; ++j) { const int d = j * 256 + lane * 4; sh[j] = *(const f32x4*)(mod + shift_idx * 1024 + d); sc[j] = *(const f32x4*)(mod + (shift_idx + 1) * 1024 + d); if (Y) gg[j] = *(const f32x4*)(gt + d); }
#pragma unroll
        for (int u = 0; u < 2; ++u) {
            if (Y) {
#pragma unroll
                for (int j = 0; j < 4; ++j) {
                    v[u][j][0] += gg[j][0] * bf_lo(yv[u][j].x); v[u][j][1] += gg[j][1] * bf_hi(yv[u][j].x); v[u][j][2] += gg[j][2] * bf_lo(yv[u][j].y); v[u][j][3] += gg[j][3] * bf_hi(yv[u][j].y);
                    if (dst) *(f32x4*)(dst + (size_t)u * D + j * 256 + lane * 4) = v[u][j]; }
            }
            float ss = 0.f;
#pragma unroll
            for (int j = 0; j < 4; ++j) ss += v[u][j][0] * v[u][j][0] + v[u][j][1] * v[u][j][1] + v[u][j][2] * v[u][j][2] + v[u][j][3] * v[u][j][3];
#pragma unroll
            for (int o = 32; o > 0; o >>= 1) ss += __shfl_xor(ss, o);
            const float rs = rsqrtf(ss * (1.0f / D) + EPS);
#pragma unroll
            for (int j = 0; j < 4; ++j) { const int d = j * 256 + lane * 4;
                f32x4 y = v[u][j] * rs * gn[j]; y = y * (sc[j] + 1.0f) + sh[j];
                u32x2 wv; wv.x = pk_bf16(y[0], y[1]); wv.y = pk_bf16(y[2], y[3]);
                *(u32x2*)(H + (size_t)(row + u) * D + d) = wv; }
        }
    }
}
__device__ void phase_final(float* x, const bf16_t* Y, const float* gate, const float* gain) {
    const int tid_ = opaque_tid(); const int wave = tid_ >> 6, lane = tid_ & 63;
    f32x4 gn[4];
#pragma unroll
    for (int j = 0; j < 4; ++j) gn[j] = *(const f32x4*)(gain + j * 256 + lane * 4);
    for (int row = (blockIdx.x * 8 + wave) * 2; row < NLAT; row += gridDim.x * 16) {
        const float* gt = gate + (size_t)(row >> 12) * 6144;
        f32x4 v[2][4], gg[4]; u32x2 yv[2][4];
#pragma unroll
        for (int u = 0; u < 2; ++u)
#pragma unroll
            for (int j = 0; j < 4; ++j) { v[u][j] = *(const f32x4*)(x + (size_t)(row + u) * D + j * 256 + lane * 4); yv[u][j] = *(const u32x2*)(Y + (size_t)(row + u) * D + j * 256 + lane * 4); }
#pragma unroll
        for (int j = 0; j < 4; ++j) gg[j] = *(const f32x4*)(gt + j * 256 + lane * 4);
#pragma unroll
        for (int u = 0; u < 2; ++u) {
            float ss = 0.f;
#pragma unroll
            for (int j = 0; j < 4; ++j) {
                v[u][j][0] += gg[j][0] * bf_lo(yv[u][j].x); v[u][j][1] += gg[j][1] * bf_hi(yv[u][j].x); v[u][j][2] += gg[j][2] * bf_lo(yv[u][j].y); v[u][j][3] += gg[j][3] * bf_hi(yv[u][j].y);
                ss += v[u][j][0] * v[u][j][0] + v[u][j][1] * v[u][j][1] + v[u][j][2] * v[u][j][2] + v[u][j][3] * v[u][j][3]; }
#pragma unroll
            for (int o = 32; o > 0; o >>= 1) ss += __shfl_xor(ss, o);
            const float rs = rsqrtf(ss * (1.0f / D) + EPS);
#pragma unroll
            for (int j = 0; j < 4; ++j) { const int d = j * 256 + lane * 4; *(f32x4*)(x + (size_t)(row + u) * D + d) = v[u][j] * rs * gn[j]; }
        }
    }
}

constexpr int QS_ST = 136, KT_ST = 40;
constexpr int P1_QS = 0, P1_KH = P1_QS + 32 * QS_ST * 2, P1_VT = P1_KH + 32 * QS_ST * 2, P1_KT = P1_VT + 128 * KT_ST * 2, P1_AW = P1_KT + 128 * KT_ST * 2;
constexpr int P1_DIRSZ = P1_AW + 8 * 32 * KT_ST * 2;
constexpr int NCH = 8 + 128;

template <int CTRL, int RMASK> __device__ __forceinline__ float dpp_mul(float x) {
    const int t = __builtin_amdgcn_update_dpp(0x3f800000, __builtin_bit_cast(int, x), CTRL, RMASK, 0xf, false);
    return x * __builtin_bit_cast(float, t);
}
__device__ __forceinline__ float cumprod32(float x) {
    x = dpp_mul<0x111, 0xf>(x); x = dpp_mul<0x112, 0xf>(x); x = dpp_mul<0x114, 0xf>(x); x = dpp_mul<0x118, 0xf>(x);
    x = dpp_mul<0x142, 0xa>(x);
    return x;
}

#define DPP8_STEP(CTRL) asm volatile("s_nop 1\n\t" \
    "v_mul_f32_dpp %0, %0, %0 " CTRL "\n\tv_mul_f32_dpp %1, %1, %1 " CTRL "\n\tv_mul_f32_dpp %2, %2, %2 " CTRL "\n\tv_mul_f32_dpp %3, %3, %3 " CTRL "\n\t" \
    "v_mul_f32_dpp %4, %4, %4 " CTRL "\n\tv_mul_f32_dpp %5, %5, %5 " CTRL "\n\tv_mul_f32_dpp %6, %6, %6 " CTRL "\n\tv_mul_f32_dpp %7, %7, %7 " CTRL "\n\ts_nop 1" \
    : "+v"(e[0]), "+v"(e[1]), "+v"(e[2]), "+v"(e[3]), "+v"(e[4]), "+v"(e[5]), "+v"(e[6]), "+v"(e[7]))
__device__ __forceinline__ void cumprod32x8(float (&e)[8]) {
    asm volatile("s_nop 4" ::: );
    DPP8_STEP("row_shr:1 row_mask:0xf bank_mask:0xf");
    DPP8_STEP("row_shr:2 row_mask:0xf bank_mask:0xf");
    DPP8_STEP("row_shr:4 row_mask:0xf bank_mask:0xf");
    DPP8_STEP("row_shr:8 row_mask:0xf bank_mask:0xf");
    DPP8_STEP("row_bcast:15 row_mask:0xa bank_mask:0xf");
}
__device__ void prep_item(const Params& p, int l, int item, LAS unsigned char* lds) {
    const int tid = opaque_tid(), w = tid >> 6, lane = tid & 63;
    const int tau = lane & 31, kh = lane >> 5, k0 = 16 * w + 8 * kh, l15 = lane & 15, q4 = lane >> 4;
    const int ci = item % NCH, bh = item / NCH, h = bh & 3, b = bh >> 2;
    const int R0 = ci < 8 ? NLAT + b * 256 + 32 * ci : b * 4096 + 32 * (ci - 8);
    bf16_t* P = (bf16_t*)(p.ws + WS_BIG);
    const bool first = (l == 0);
    const bool want_out = first || ci >= 8;
    for (int dd = 0; dd < 2; ++dd) { LAS unsigned* az = (LAS unsigned*)(lds + dd * P1_DIRSZ + P1_AW) + w * (32 * KT_ST / 2); for (int i = lane; i < 32 * KT_ST / 2; i += 64) az[i] = 0u; }
    u32x4 rf0, rq0, rv0, rf1, rq1, rv1;
    { const int r_ = R0 + tau; rf0 = *(const u32x4*)(P + PIX(r_, h * 128 + k0)); rq0 = *(const u32x4*)(P + PIX(r_, 1536 + h * 128 + k0)); rv0 = *(const u32x4*)(P + PIX(r_, 1024 + h * 128 + k0)); }
    { const int r_ = R0 + 31 - tau; rf1 = *(const u32x4*)(P + PIX(r_, 512 + h * 128 + k0)); rq1 = *(const u32x4*)(P + PIX(r_, 1536 + h * 128 + k0)); rv1 = *(const u32x4*)(P + PIX(r_, 1024 + h * 128 + k0)); }
    asm volatile("s_waitcnt vmcnt(0)" ::: "memory");
    __syncthreads();
    auto valu_part = [&](const int dir, const u32x4& f, const u32x4& q, const u32x4& v) {
        LAS unsigned char* db = lds + dir * P1_DIRSZ;
        LAS bf16_t* Qs = (LAS bf16_t*)(db + P1_QS); LAS bf16_t* Kh = (LAS bf16_t*)(db + P1_KH);
        LAS bf16_t* Vt = (LAS bf16_t*)(db + P1_VT); LAS bf16_t* Kt = (LAS bf16_t*)(db + P1_KT);
        LAS bf16_t* Aw = (LAS bf16_t*)(db + P1_AW) + w * 32 * KT_ST;
        const int tokl = dir ? 31 - tau : tau;
        const float* lbp = (const float*)(p.ws + WS_LB) + dir * 512 + h * 128 + k0;
        float E[8], kk[8];
#pragma unroll
        for (int j = 0; j < 8; ++j) {
            const unsigned fw = f[j >> 1]; const float x = (j & 1) ? bf_hi(fw) : bf_lo(fw);
            const float e = __expf(-fabsf(x)), r = fast_rcp(1.0f + e);
            const float sp = x >= 0.f ? r : e * r, sn = x >= 0.f ? e * r : r;
            if (first) { E[j] = sp; kk[j] = sn; }
            else { const float lb = lbp[j]; const float gate = lb + (1.0f - lb) * sp; E[j] = gate; kk[j] = 1.0f - gate; }
        }
        float qt[8], kh_[8], kt_[8], Tj[8];
        cumprod32x8(E);
#pragma unroll
        for (int j = 0; j < 8; ++j) {
            const float Ej = fmaxf(E[j], 1e-35f);
            const float T0 = __builtin_bit_cast(float, __builtin_amdgcn_readlane(__builtin_bit_cast(int, Ej), 31)), T1 = __builtin_bit_cast(float, __builtin_amdgcn_readlane(__builtin_bit_cast(int, Ej), 63));
            const float T = kh ? T1 : T0;
            const unsigned qw = q[j >> 1]; const float qx = (j & 1) ? bf_hi(qw) : bf_lo(qw);
            qt[j] = silu_f(qx) * 0.08838834764831845f * Ej;
            kh_[j] = kk[j] * fast_rcp(Ej); kt_[j] = kh_[j] * T;
            Tj[j] = T;
        }
        if (tau == 31) { float* dp = (float*)(p.ws + WS_DS) + ((size_t)((b * 4 + h) * 2 + dir) * NCH + ci) * 128 + k0;
            *(f32x4*)dp = (f32x4){Tj[0], Tj[1], Tj[2], Tj[3]}; *(f32x4*)(dp + 4) = (f32x4){Tj[4], Tj[5], Tj[6], Tj[7]}; }
        u32x4 wq, wk; wq.x = pk_bf16(qt[0], qt[1]); wq.y = pk_bf16(qt[2], qt[3]); wq.z = pk_bf16(qt[4], qt[5]); wq.w = pk_bf16(qt[6], qt[7]);
        wk.x = pk_bf16(kh_[0], kh_[1]); wk.y = pk_bf16(kh_[2], kh_[3]); wk.z = pk_bf16(kh_[4], kh_[5]); wk.w = pk_bf16(kh_[6], kh_[7]);
        *(LAS u32x4*)(Qs + tau * QS_ST + k0) = wq; *(LAS u32x4*)(Kh + tau * QS_ST + k0) = wk;
        {
          bf16_t* qd = (dir == 0) ? P + PIX(R0 + tokl, 1536 + h * 128) : (bf16_t*)(p.ws + WS_QB) + (size_t)h * PSLOT + (size_t)(R0 + tokl) * 128;
          const int a32 = k0 & ~31, kkA = k0 & 31, kkB = kkA + 4;
          u32x2 pa, pb; pa.x = wq.x; pa.y = wq.y; pb.x = wq.z; pb.y = wq.w;
          *(u32x2*)(qd + a32 + 8 * ((kkA & 15) >> 2) + 4 * (kkA >> 4)) = pa;
          *(u32x2*)(qd + a32 + 8 * ((kkB & 15) >> 2) + 4 * (kkB >> 4)) = pb; }
#pragma unroll
        for (int j = 0; j < 8; ++j) { Kt[(k0 + j) * KT_ST + tokl] = to_bf1(kt_[j]); const unsigned vw = v[j >> 1]; Vt[(k0 + j) * KT_ST + tau] = (bf16_t)((j & 1) ? (vw >> 16) : (vw & 0xffffu)); }
    };
    auto mfma_part = [&](const int dir) {
        LAS unsigned char* db = lds + dir * P1_DIRSZ;
        LAS bf16_t* Qs = (LAS bf16_t*)(db + P1_QS); LAS bf16_t* Kh = (LAS bf16_t*)(db + P1_KH);
        LAS bf16_t* Vt = (LAS bf16_t*)(db + P1_VT); LAS bf16_t* Kt = (LAS bf16_t*)(db + P1_KT);
        LAS bf16_t* Aw = (LAS bf16_t*)(db + P1_AW) + w * 32 * KT_ST;
        const int tokl = dir ? 31 - tau : tau; (void)tokl;
        if (want_out) {
            f32x4 a00 = (f32x4){0.f, 0.f, 0.f, 0.f}, a10 = a00, a11 = a00;
#pragma unroll
            for (int kb = 0; kb < 4; ++kb) {
                const bf16x8 qn0 = *(const LAS bf16x8*)(Qs + l15 * QS_ST + 32 * kb + 8 * q4), qn1 = *(const LAS bf16x8*)(Qs + (16 + l15) * QS_ST + 32 * kb + 8 * q4);
                const bf16x8 kh0 = *(const LAS bf16x8*)(Kh + l15 * QS_ST + 32 * kb + 8 * q4), kh1 = *(const LAS bf16x8*)(Kh + (16 + l15) * QS_ST + 32 * kb + 8 * q4);
                a00 = __builtin_amdgcn_mfma_f32_16x16x32_bf16(qn0, kh0, a00, 0, 0, 0);
                a10 = __builtin_amdgcn_mfma_f32_16x16x32_bf16(qn1, kh0, a10, 0, 0, 0);
                a11 = __builtin_amdgcn_mfma_f32_16x16x32_bf16(qn1, kh1, a11, 0, 0, 0);
            }
#pragma unroll
            for (int i = 0; i < 4; ++i) { const int t = 4 * q4 + i; const bool keep = l15 <= t;
                Aw[t * KT_ST + l15] = to_bf1(keep ? a00[i] : 0.f);
                Aw[(16 + t) * KT_ST + l15] = to_bf1(a10[i]);
                Aw[(16 + t) * KT_ST + 16 + l15] = to_bf1(keep ? a11[i] : 0.f); }
            asm volatile("s_waitcnt lgkmcnt(0)" ::: "memory");
            const bf16x8 vf = *(const LAS bf16x8*)(Vt + (16 * w + l15) * KT_ST + 8 * q4);
            bf16_t* OFB = (bf16_t*)(p.ws + WS_OFB) + (size_t)dir * NROW * 512;
#pragma unroll
            for (int mt = 0; mt < 2; ++mt) {
                const bf16x8 af = *(const LAS bf16x8*)(Aw + (16 * mt + l15) * KT_ST + 8 * q4);
                const f32x4 o = __builtin_amdgcn_mfma_f32_16x16x32_bf16(vf, af, (f32x4){0.f, 0.f, 0.f, 0.f}, 0, 0, 0);
                const int tl = 16 * mt + l15, tok = dir ? 31 - tl : tl;
                u32x2 wv; wv.x = pk_bf16(o[0], o[1]); wv.y = pk_bf16(o[2], o[3]);
                *(u32x2*)(OFB + (size_t)h * PSLOT + (size_t)(R0 + tok) * 128 + 16 * w + 4 * q4) = wv;
            }
        }
        { const int k = tid >> 2, part = tid & 3;
          const u32x4 kv = *(const LAS u32x4*)(Kt + k * KT_ST + 8 * part);
          const int pc = h * 128 + (k & 3) * 32 + (part ^ ((k >> 2) & 3)) * 8;
          *(u32x4*)(P + PIX(R0 + (k >> 2), dir * 512 + pc)) = kv;
          if (dir == 0) { const u32x4 vv = *(const LAS u32x4*)(Vt + k * KT_ST + 8 * part); *(u32x4*)(P + PIX(R0 + (k >> 2), 1024 + pc)) = vv; } }
    };
    valu_part(0, rf0, rq0, rv0);
    valu_part(1, rf1, rq1, rv1);
    __syncthreads();
    mfma_part(0);
    mfma_part(1);
    __syncthreads();
}

constexpr int ST_Q = 0, ST_K = 8192, ST_V = 16384, ST_O = 20480, ST_D = 24576, ST_BYTES = 25088, NSTAGE = 6;
__device__ void scan_chain(const Params& p, int l, int chain, int vhalf, LAS unsigned char* lds) {
    const int tid = opaque_tid(), w = __builtin_amdgcn_readfirstlane(tid >> 6), lane = tid & 63, l15 = lane & 15, q4 = lane >> 4;
    const int dir = chain & 1, h = (chain >> 1) & 3, b = chain >> 3;
    bf16_t* P = (bf16_t*)(p.ws + WS_BIG);
    auto chunk_of = [&](int s) -> int { return dir ? (s < 8 ? 7 - s : 143 - s) : s; };
    auto row0_of = [&](int c) -> int { return c < 8 ? NLAT + b * 256 + 32 * c : b * 4096 + 32 * (c - 8); };
    bf16_t* qb = dir ? (bf16_t*)(p.ws + WS_QB) + (size_t)h * PSLOT : P + PIX(0, 1536 + h * 128);
    const int qpitch = 128;
    if (w >= 4) {
        const int lw = w - 4;
        const int r16 = lane >> 4, s16 = lane & 15;
        size_t qoff[2], koff[2];
#pragma unroll
        for (int i = 0; i < 2; ++i) { const int row = 8 * lw + 4 * i + r16; qoff[i] = (size_t)row * qpitch + ((s16 ^ (row & 15)) * 8);
            koff[i] = PIX(4 * (2 * lw + i) + r16, dir * 512 + h * 128) + s16 * 8; }
        const size_t voff = PIX(16 * vhalf + 4 * lw + r16, 1024 + h * 128) + s16 * 8;
        const float* dsrc = (const float*)(p.ws + WS_DS) + (size_t)chain * NCH * 128 + (lw & 1) * 64 + lane;
        const int orow = 8 * lw + (lane >> 3);
        const size_t ooff = (size_t)h * PSLOT + (size_t)orow * 128 + 64 * vhalf + (((lane & 7) ^ (orow & 7)) * 8);
        const bf16_t* OFBc = (const bf16_t*)(p.ws + WS_OFB) + (size_t)dir * NROW * 512;
        auto issue = [&](int s) {
            const int sc = s < NCH ? s : NCH - 1;
            const int c = chunk_of(sc), R0 = row0_of(c);
            LAS unsigned char* st = lds + (s % NSTAGE) * ST_BYTES;
            const bf16_t* qrow = qb + (size_t)R0 * qpitch; const bf16_t* krow = P + (size_t)R0 * 128;
#pragma unroll
            for (int i = 0; i < 2; ++i) {
                __builtin_amdgcn_global_load_lds((const unsigned*)(qrow + qoff[i]), (LAS unsigned*)(st + ST_Q + (2 * lw + i) * 1024), 16, 0, 0);
                __builtin_amdgcn_global_load_lds((const unsigned*)(krow + koff[i]), (LAS unsigned*)(st + ST_K + (2 * lw + i) * 1024), 16, 0, 0);
            }
            __builtin_amdgcn_global_load_lds((const unsigned*)(krow + voff), (LAS unsigned*)(st + ST_V + lw * 1024), 16, 0, 0);
            __builtin_amdgcn_global_load_lds((const unsigned*)(dsrc + (size_t)c * 128), (LAS unsigned*)(st + ST_D + (lw & 1) * 256), 4, 0, 0);
            __builtin_amdgcn_global_load_lds((const unsigned*)(OFBc + (size_t)R0 * 128 + ooff), (LAS unsigned*)(st + ST_O + lw * 1024), 16, 0, 0);
        };
        issue(0); issue(1); issue(2); issue(3); issue(4);
        asm volatile("s_waitcnt vmcnt(28)" ::: "memory");
        __builtin_amdgcn_s_barrier();
        for (int s = 0; s < NCH; ++s) {
            issue(s + 5);
            asm volatile("s_waitcnt vmcnt(28)" ::: "memory");
            __builtin_amdgcn_s_barrier();
        }
        asm volatile("s_waitcnt vmcnt(0)" ::: "memory");
    } else {
        f32x4 S[8];
#pragma unroll
        for (int j = 0; j < 8; ++j) S[j] = (f32x4){0.f, 0.f, 0.f, 0.f};
        const int swz = (l15 >> 2) & 3, vcol = 64 * vhalf + 16 * w;
        bf16_t* OFBw = (bf16_t*)(p.ws + WS_OFB) + (size_t)dir * NROW * 512;
        __builtin_amdgcn_s_barrier();
        for (int s = 0; s < NCH; ++s) {
            LAS unsigned char* st = lds + (s % NSTAGE) * ST_BYTES;
            bf16x8 qf[4][2], kf[8]; f32x4 dv[8];
#pragma unroll
            for (int kb = 0; kb < 4; ++kb)
#pragma unroll
                for (int mt = 0; mt < 2; ++mt) {
                    qf[kb][mt] = *(const LAS bf16x8*)(st + ST_Q + (16 * mt + l15) * 256 + (((4 * kb + q4) ^ l15) * 16));
                }
            const bf16x8 vf = *(const LAS bf16x8*)(st + ST_V + (16 * w + l15) * 64 + ((q4 ^ swz) * 16));
            u32x2 oi[2];
#pragma unroll
            for (int mt = 0; mt < 2; ++mt) { const int tr = 16 * mt + l15; oi[mt] = *(const LAS u32x2*)(st + ST_O + tr * 128 + (((2 * w + (q4 >> 1)) ^ (tr & 7)) * 16) + (q4 & 1) * 8); }
#pragma unroll
            for (int j = 0; j < 8; ++j) { dv[j] = *(const LAS f32x4*)(st + ST_D + (16 * j + 4 * q4) * 4); kf[j] = *(const LAS bf16x8*)(st + ST_K + (16 * j + l15) * 64 + ((q4 ^ swz) * 16)); }
            __builtin_amdgcn_sched_barrier(0);
            f32x4 o[2]; o[0] = (f32x4){0.f, 0.f, 0.f, 0.f}; o[1] = o[0];
#pragma unroll
            for (int kb = 0; kb < 4; ++kb) {
                u32x4 sb; sb.x = pk_bf16(S[2 * kb][0], S[2 * kb][1]); sb.y = pk_bf16(S[2 * kb][2], S[2 * kb][3]); sb.z = pk_bf16(S[2 * kb + 1][0], S[2 * kb + 1][1]); sb.w = pk_bf16(S[2 * kb + 1][2], S[2 * kb + 1][3]);
                const bf16x8 sfr = __builtin_bit_cast(bf16x8, sb);
                o[0] = __builtin_amdgcn_mfma_f32_16x16x32_bf16(sfr, qf[kb][0], o[0], 0, 0, 0);
                o[1] = __builtin_amdgcn_mfma_f32_16x16x32_bf16(sfr, qf[kb][1], o[1], 0, 0, 0);
            }
#pragma unroll
            for (int j = 0; j < 8; ++j) S[j] = __builtin_amdgcn_mfma_f32_16x16x32_bf16(kf[j], vf, S[j] * dv[j], 0, 0, 0);
            const int R0 = row0_of(chunk_of(s));
#pragma unroll
            for (int mt = 0; mt < 2; ++mt) { const int tr = 16 * mt + l15;
                u32x2 wv; wv.x = pk_bf16(o[mt][0] + bf_lo(oi[mt].x), o[mt][1] + bf_hi(oi[mt].x)); wv.y = pk_bf16(o[mt][2] + bf_lo(oi[mt].y), o[mt][3] + bf_hi(oi[mt].y));
                *(u32x2*)(OFBw + (size_t)h * PSLOT + (size_t)(R0 + tr) * 128 + vcol + 4 * q4) = wv; }
            asm volatile("s_waitcnt lgkmcnt(0)" ::: "memory");
            __builtin_amdgcn_s_barrier();
        }
    }
}

constexpr int SG_ST = 136;
__device__ void sgu_tile(const Params& p, int l, int tile, LAS unsigned char* lds) {
    const int tid = opaque_tid(), w = tid >> 6, lane = tid & 63, l15 = lane & 15, q4 = lane >> 4;
    const int h = tile & 3, rowbase = (tile >> 2) * 128;
    const bf16_t* P = (const bf16_t*)(p.ws + WS_BIG);
    bf16_t* O = (bf16_t*)(p.ws + WS_H);
    LAS bf16_t* Vt = (LAS bf16_t*)lds;
    {
        const int q = tid >> 2, cgp = tid & 3;
        const bf16_t* vp = P + PIX(rowbase + q, 3072 + 128 * h + 32 * cgp);
        float g[32];
#pragma unroll
        for (int i = 0; i < 4; ++i) { const u32x4 r = *(const u32x4*)(vp + 8 * i);
#pragma unroll
            for (int j = 0; j < 4; ++j) { g[8 * i + 2 * j] = gelu_f(bf_lo(r[j])); g[8 * i + 2 * j + 1] = gelu_f(bf_hi(r[j])); } }
        float s = 0.f;
#pragma unroll
        for (int i = 0; i < 32; ++i) s += g[i];
        s += __shfl_xor(s, 1); s += __shfl_xor(s, 2);
        const float mu = s * (1.0f / 128.f);
        float vs = 0.f;
#pragma unroll
        for (int i = 0; i < 32; ++i) { const float d = g[i] - mu; vs += d * d; }
        vs += __shfl_xor(vs, 1); vs += __shfl_xor(vs, 2);
        const float rstd = rsqrtf(vs * (1.0f / 128.f) + EPS);
        const float* lng = p.in[12] + l * 512 + h * 128 + 32 * cgp; const float* lnb = p.in[13] + l * 512 + h * 128 + 32 * cgp;
#pragma unroll
        for (int i = 0; i < 32; ++i) { const float y = (g[i] - mu) * rstd * lng[i] + lnb[i]; Vt[(32 * cgp + i) * SG_ST + q] = to_bf1(y); }
    }
    __syncthreads();
    {
        const int prow = 16 * w + l15;
        const bf16_t* wsp = (const bf16_t*)(p.ws + WS_WSP) + ((size_t)(l * 4 + h) * 128 + prow) * 128 + 8 * q4;
        bf16x8 wf[4];
#pragma unroll
        for (int kb = 0; kb < 4; ++kb) wf[kb] = *(const bf16x8*)(wsp + 32 * kb);
        const float bs = p.in[15][(l * 4 + h) * 128 + prow];
        const bf16_t* up = P + PIX(rowbase + prow, 2560 + 128 * h + 4 * q4);
        bf16_t* op = O + (size_t)(rowbase + prow) * D + 512 + 128 * h + 4 * q4;
        u32x2 uall[8];
#pragma unroll
        for (int mt = 0; mt < 8; ++mt) uall[mt] = *(const u32x2*)(up + 16 * mt);
#pragma unroll
        for (int mt = 0; mt < 8; ++mt) {
            f32x4 acc = (f32x4){0.f, 0.f, 0.f, 0.f};
#pragma unroll
            for (int kb = 0; kb < 4; ++kb) { const bf16x8 af = *(const LAS bf16x8*)(Vt + (16 * mt + l15) * SG_ST + 32 * kb + 8 * q4);
                acc = __builtin_amdgcn_mfma_f32_16x16x32_bf16(af, wf[kb], acc, 0, 0, 0); }
            const u32x2 uu = uall[mt];
            const float u0 = gelu_f(bf_lo(uu.x)), u1 = gelu_f(bf_hi(uu.x)), u2 = gelu_f(bf_lo(uu.y)), u3 = gelu_f(bf_hi(uu.y));
            u32x2 wv; wv.x = pk_bf16(u0 * (acc[0] + bs), u1 * (acc[1] + bs)); wv.y = pk_bf16(u2 * (acc[2] + bs), u3 * (acc[3] + bs));
            *(u32x2*)(op + 16 * mt) = wv;
        }
    }
    __syncthreads();
}

constexpr int SGU_IN_M2 = 1088;
__device__ void phase_mixer(const Params& p, int l, LAS unsigned char* lds) {
    const int G = gridDim.x, bid = blockIdx.x;
    const int ntile = (l == 0) ? (NROW / 128) * 4 : (NLAT / 128) * 4;
    if (G > 128) {
        if (bid < 128) scan_chain(p, l, (bid >> 4) * 8 + (bid & 7), (bid >> 3) & 1, lds);
        else for (int t = bid - 128; t < (ntile < SGU_IN_M2 ? ntile : SGU_IN_M2); t += G - 128) sgu_tile(p, l, t, lds);
    } else {
        for (int c = bid; c < 128; c += G) { scan_chain(p, l, c >> 1, c & 1, lds); __syncthreads(); }
        for (int t = bid; t < ntile; t += G) sgu_tile(p, l, t, lds);
    }
}

__device__ void phase_combine(const Params& p, int l, int nrows) {
    const int tid_ = opaque_tid(); const int wave = tid_ >> 6, lane = tid_ & 63, hd = lane >> 4, v0 = (lane & 15) * 8;
    const bf16_t* P = (const bf16_t*)(p.ws + WS_BIG);
    const bf16_t* OF = (const bf16_t*)(p.ws + WS_OFB); const bf16_t* OB = OF + (size_t)NROW * 512;
    bf16_t* O = (bf16_t*)(p.ws + WS_H);
    const float* gn = p.in[11] + l * 512 + hd * 128 + v0;
    const f32x4 g0 = *(const f32x4*)gn, g1 = *(const f32x4*)(gn + 4);
    for (int row0 = (blockIdx.x * 8 + wave) * 4; row0 < nrows; row0 += gridDim.x * 32) {
        u32x4 a[4], bq[4], gg[4];
#pragma unroll
        for (int u = 0; u < 4; ++u) { const size_t row = row0 + u;
            a[u] = *(const u32x4*)(OF + (size_t)hd * PSLOT + row * 128 + v0); bq[u] = *(const u32x4*)(OB + (size_t)hd * PSLOT + row * 128 + v0);
            gg[u] = *(const u32x4*)(P + PIX((int)row, 2048 + hd * 128 + v0)); }
#pragma unroll
        for (int u = 0; u < 4; ++u) {
            float s[8]; float ss = 0.f;
#pragma unroll
            for (int j = 0; j < 4; ++j) { s[2 * j] = bf_lo(a[u][j]) + bf_lo(bq[u][j]); s[2 * j + 1] = bf_hi(a[u][j]) + bf_hi(bq[u][j]); ss += s[2 * j] * s[2 * j] + s[2 * j + 1] * s[2 * j + 1]; }
#pragma unroll
            for (int o = 8; o > 0; o >>= 1) ss += __shfl_xor(ss, o);
            const float rs = rsqrtf(ss * (1.0f / 128.f) + EPS);
            float y[8];
#pragma unroll
            for (int j = 0; j < 4; ++j) { y[2 * j] = s[2 * j] * rs * (j < 2 ? g0[2 * j] : g1[2 * j - 4]) * silu_f(bf_lo(gg[u][j])); y[2 * j + 1] = s[2 * j + 1] * rs * (j < 2 ? g0[2 * j + 1] : g1[2 * j - 3]) * silu_f(bf_hi(gg[u][j])); }
            u32x4 wv; wv.x = pk_bf16(y[0], y[1]); wv.y = pk_bf16(y[2], y[3]); wv.z = pk_bf16(y[4], y[5]); wv.w = pk_bf16(y[6], y[7]);
            *(u32x4*)(O + (size_t)(row0 + u) * D + hd * 128 + v0) = wv;
        }
    }
}

__device__ void phase_conv(const Params& p, int l, int nrows) {
    bf16_t* Aup = (bf16_t*)(p.ws + WS_BIG); const bf16_t* Gup = Aup + (size_t)NROW * FF;
    const float* cw = p.in[18] + (size_t)l * 9 * FF; const float* cb = p.in[19] + (size_t)l * FF;
    const int tid_ = opaque_tid();
    const long total = (long)(nrows / 16) * 352;
    for (long id0 = (long)blockIdx.x * 512 + tid_; id0 < total; id0 += (long)gridDim.x * 512) {
        const int seg = (int)((total - 1 - id0) / 352), f0 = (int)(id0 % 352) * 8;
        const int tok0 = seg * 16;
        int c0, W; bool up, dn;
        if (tok0 < NLAT) { const int t = tok0 & 4095, r = t >> 6; c0 = t & 63; W = 64; up = r > 0; dn = r < 63; }
        else { c0 = (tok0 - NLAT) & 255; W = 256; up = false; dn = false; }
        float tp[9][8]; float bias[8];
#pragma unroll
        for (int k = 0; k < 9; ++k) { const f32x4 t0 = *(const f32x4*)(cw + k * FF + f0), t1 = *(const f32x4*)(cw + k * FF + f0 + 4);
            tp[k][0] = t0[0]; tp[k][1] = t0[1]; tp[k][2] = t0[2]; tp[k][3] = t0[3]; tp[k][4] = t1[0]; tp[k][5] = t1[1]; tp[k][6] = t1[2]; tp[k][7] = t1[3]; }
        { const f32x4 b0 = *(const f32x4*)(cb + f0), b1 = *(const f32x4*)(cb + f0 + 4); bias[0] = b0[0]; bias[1] = b0[1]; bias[2] = b0[2]; bias[3] = b0[3]; bias[4] = b1[0]; bias[5] = b1[1]; bias[6] = b1[2]; bias[7] = b1[3]; }
        const u32x4 zero = (u32x4){0u, 0u, 0u, 0u};
        const bf16_t* gp = Gup + (size_t)tok0 * FF + f0;
        u32x4 L[3], M[3], R[3];
        { const bool v = c0 > 0;
          L[0] = (v && up) ? *(const u32x4*)(gp - (size_t)65 * FF) : zero; L[1] = v ? *(const u32x4*)(gp - (size_t)FF) : zero; L[2] = (v && dn) ? *(const u32x4*)(gp + (size_t)63 * FF) : zero; }
        M[0] = up ? *(const u32x4*)(gp - (size_t)64 * FF) : zero; M[1] = *(const u32x4*)gp; M[2] = dn ? *(const u32x4*)(gp + (size_t)64 * FF) : zero;
#pragma unroll 8
        for (int i = 0; i < 16; ++i) {
            const bf16_t* np = gp + (size_t)(i + 1) * FF;
            const bool v = (c0 + i + 1) < W;
            R[0] = (v && up) ? *(const u32x4*)(np - (size_t)64 * FF) : zero; R[1] = v ? *(const u32x4*)np : zero; R[2] = (v && dn) ? *(const u32x4*)(np + (size_t)64 * FF) : zero;
            float acc[8];
#pragma unroll
            for (int j = 0; j < 8; ++j) acc[j] = bias[j];
#pragma unroll
            for (int rr = 0; rr < 3; ++rr) {
#pragma unroll
                for (int j = 0; j < 4; ++j) {
                    acc[2 * j] += bf_lo(L[rr][j]) * tp[rr * 3 + 0][2 * j] + bf_lo(M[rr][j]) * tp[rr * 3 + 1][2 * j] + bf_lo(R[rr][j]) * tp[rr * 3 + 2][2 * j];
                    acc[2 * j + 1] += bf_hi(L[rr][j]) * tp[rr * 3 + 0][2 * j + 1] + bf_hi(M[rr][j]) * tp[rr * 3 + 1][2 * j + 1] + bf_hi(R[rr][j]) * tp[rr * 3 + 2][2 * j + 1];
                }
            }
            bf16_t* ap = Aup + (size_t)(tok0 + i) * FF + f0;
            const u32x4 av = *(const u32x4*)ap;
            u32x4 wv;
#pragma unroll
            for (int j = 0; j < 4; ++j) wv[j] = pk_bf16(bf_lo(av[j]) * gelu_f(acc[2 * j]), bf_hi(av[j]) * gelu_f(acc[2 * j + 1]));
            *(u32x4*)ap = wv;
#pragma unroll
            for (int rr = 0; rr < 3; ++rr) { L[rr] = M[rr]; M[rr] = R[rr]; }
        }
    }
}

#define XB_TMO      128
#define XB_XCNT(j)  (256  + 64 * (j))
#define XB_XSUB(j)  (1280 + 64 * (j))
#define XB_XGEN(j)  (2304 + 64 * (j))
#define XB_TOP      3328
#define XB_TOPGEN   3392
#define XCD_BAR_WORDS 3456
#define XB_SPIN_CAP (1u << 20)
__device__ __forceinline__ unsigned xb_ld(unsigned* p)              { return __hip_atomic_load(p, __ATOMIC_RELAXED, __HIP_MEMORY_SCOPE_AGENT); }
__device__ __forceinline__ unsigned xb_add(unsigned* p, unsigned v) { return __hip_atomic_fetch_add(p, v, __ATOMIC_RELAXED, __HIP_MEMORY_SCOPE_AGENT); }
__device__ __forceinline__ unsigned xb_xcc_id() { return (unsigned)__builtin_amdgcn_s_getreg((3 << 11) | 20) & 0xFu; }
#define XB_SPIN(cond, bar) do { unsigned _sp = 0; while (cond) { __builtin_amdgcn_s_sleep(1); \
    if ((++_sp & 255u) == 0u) { if (xb_ld(&(bar)[XB_TMO])) break; if (_sp > XB_SPIN_CAP) { atomicAdd(&(bar)[XB_TMO], 1u); break; } } } } while (0)
struct XcdBarrier { unsigned* bar; unsigned x; volatile LAS unsigned* st; };
__device__ __forceinline__ XcdBarrier xcd_barrier_post(unsigned* bar, volatile LAS unsigned* st) {
    XcdBarrier b; b.bar = bar; b.x = xb_xcc_id(); b.st = st;
    if (threadIdx.x == 0) (void)xb_add(&bar[XB_XCNT(b.x)], 1u);
    return b;
}
__device__ __forceinline__ void xcd_barrier_complete(unsigned* bar, unsigned x, unsigned& nloc, unsigned& nx) {
    const unsigned G = gridDim.x * gridDim.y * gridDim.z;
    unsigned sum, cnt, mine, sp = 0u;
    for (;;) {
        sum = 0u; cnt = 0u; mine = 0u;
#pragma unroll
        for (unsigned j = 0; j < 16; ++j) { const unsigned c = xb_ld(&bar[XB_XCNT(j)]); sum += c; cnt += (c > 0u) ? 1u : 0u; mine = (j == x) ? c : mine; }
        if (sum == G) break;
        __builtin_amdgcn_s_sleep(1);
        if ((++sp & 255u) == 0u) { if (xb_ld(&bar[XB_TMO])) break; if (sp > XB_SPIN_CAP) { atomicAdd(&bar[XB_TMO], 1u); break; } }
    }
    nloc = mine > 0u ? mine : 1u; nx = cnt > 0u ? cnt : 1u;
}
__device__ __forceinline__ void xcd_barrier(const XcdBarrier& b) {
    asm volatile("s_waitcnt vmcnt(0)" ::: "memory");
    __syncthreads();
    if (threadIdx.x == 0) {
        unsigned* bar = b.bar;
        __builtin_amdgcn_s_waitcnt(0);
        unsigned nloc = b.st[0], nx = b.st[1];
        if (nloc == 0u) { xcd_barrier_complete(bar, b.x, nloc, nx); b.st[0] = nloc; b.st[1] = nx; }
        const unsigned old = xb_add(&bar[XB_XSUB(b.x)], 1u);
        const unsigned gen = old / nloc;
        if (old + 1u == (gen + 1u) * nloc) {
            __builtin_amdgcn_fence(__ATOMIC_RELEASE, "agent");
            asm volatile("s_waitcnt vmcnt(0)" ::: "memory");
            const unsigned og = xb_add(&bar[XB_TOP], 1u);
            const unsigned tg = og / nx;
            if (og + 1u == (tg + 1u) * nx) xb_add(&bar[XB_TOPGEN], 1u);
            else XB_SPIN(xb_ld(&bar[XB_TOPGEN]) == tg, bar);
            __builtin_amdgcn_fence(__ATOMIC_ACQUIRE, "agent");
            xb_add(&bar[XB_XGEN(b.x)], 1u);
            asm volatile("s_waitcnt vmcnt(0)" ::: "memory");
        } else {
            XB_SPIN(xb_ld(&bar[XB_XGEN(b.x)]) == gen, bar);
            __builtin_amdgcn_fence(__ATOMIC_ACQUIRE, "agent");
            asm volatile("s_waitcnt vmcnt(0)" ::: "memory");
        }
    }
    __syncthreads();
}

__global__ void __launch_bounds__(512, 2) fwd_megakernel(Params p) {
    extern __shared__ __attribute__((aligned(16))) unsigned char shm[];
    LAS unsigned char* lds = (LAS unsigned char*)shm;
    cg::grid_group grid = cg::this_grid();
    __shared__ uint4 xb_words;
    if (threadIdx.x == 0) xb_words = make_uint4(0u, 0u, 0u, 0u);
    __syncthreads();
    const XcdBarrier xb = xcd_barrier_post((unsigned*)(p.ws + WS_BAR), (volatile LAS unsigned*)&xb_words);
    const int G = gridDim.x, bid = blockIdx.x;
    float* XC = (float*)(p.ws + WS_XC);
    bf16_t* H = (bf16_t*)(p.ws + WS_H);
    bf16_t* BIG = (bf16_t*)(p.ws + WS_BIG);
    const float* ADA = (const float*)(p.ws + WS_ADA);
    bf16_t* Y2 = BIG + (size_t)NROW * FF;

    phase_prep(p, lds);
    if (p.ws == nullptr) grid.sync();
    xcd_barrier(xb);
    for (int l = 0; l < DEPTH; ++l) {
        const bool last = (l == DEPTH - 1);
        const float* ada_l = ADA + (size_t)l * 9 * 6144;
        const float* xl = (l == 0) ? p.in[0] : p.out;
        const float* xc = (l == 0) ? p.in[2] : XC;
        const int Mfull = last ? NLAT : NROW;
        if (l == 0) phase_norm(xl, xc, nullptr, nullptr, nullptr, nullptr, p.in[6] + l * D, ada_l, 0, NROW, H);
        else phase_norm(p.out, XC, Y2, ADA + (size_t)(l - 1) * 9 * 6144 + 5 * 1024, p.out, nullptr, p.in[6] + l * D, ada_l, 0, NROW, H);
        xcd_barrier(xb);
        { pg8::StaticOrder S; S.init(NROW, PW, G, bid);
          pg8::EpiBf16 E{BIG, PW, 0, 0, PSLOT};
          pg8::gemm_phase(lds, pg8::Gemm{H, (const bf16_t*)(p.ws + WS_WIN) + (size_t)l * PW * D, NROW, PW, D}, S, E); }
        xcd_barrier(xb);
        { const int ntile = (l == 0) ? (NROW / 128) * 4 : (NLAT / 128) * 4;
          const int nextra = (G > 128 && ntile > SGU_IN_M2) ? ntile - SGU_IN_M2 : 0;
          for (int it = bid; it < 32 * NCH + nextra; it += G) { if (it < 32 * NCH) prep_item(p, l, 32 * NCH - 1 - it, lds); else sgu_tile(p, l, SGU_IN_M2 + it - 32 * NCH, lds); } }
        xcd_barrier(xb);
        phase_mixer(p, l, lds);
        xcd_barrier(xb);
        phase_combine(p, l, Mfull);
        xcd_barrier(xb);
        { pg8::StaticOrder S; S.init(Mfull, D, G, bid);
          pg8::EpiBf16 E{BIG, D, 0, 0, 0};
          pg8::gemm_phase(lds, pg8::Gemm{H, (const bf16_t*)(p.ws + WS_WOUT) + (size_t)l * D * D, Mfull, D, D}, S, E); }
        xcd_barrier(xb);
        phase_norm(xl, xc, BIG, ada_l + 2 * 1024, p.out, XC, p.in[7] + l * D, ada_l, 3, Mfull, H);
        xcd_barrier(xb);
        { pg8::StaticOrder S; S.init(Mfull, UPW, G, bid);
          pg8::EpiBf16 E{BIG, FF, FF, (size_t)NROW * FF, 0};
          pg8::gemm_phase(lds, pg8::Gemm{H, (const bf16_t*)(p.ws + WS_WUP) + (size_t)l * UPW * D, Mfull, UPW, D}, S, E); }
        xcd_barrier(xb);
        phase_conv(p, l, Mfull);
        xcd_barrier(xb);
        { pg8::StaticOrder S; S.init(Mfull, D, G, bid);
          pg8::EpiBf16 E{Y2, D, 0, 0, 0};
          pg8::gemm_phase(lds, pg8::Gemm{BIG, (const bf16_t*)(p.ws + WS_WDOWN) + (size_t)l * D * FF, Mfull, D, FF}, S, E); }
        xcd_barrier(xb);
    }
    phase_final(p.out, Y2, ADA + (size_t)(DEPTH - 1) * 9 * 6144 + 5 * 1024, p.in[21]);
}

extern "C" void kernel_launch(void* const* d_in, const int* in_sizes, int n_in, void* d_out, int out_size, void* d_ws, size_t ws_size, hipStream_t stream) {
    constexpr int LDS_BYTES = 155648;
    static int grid_blocks = 0;
    if (!grid_blocks) {
        int dev = 0, cus = 0, per_cu = 0;
        (void)hipGetDevice(&dev);
        (void)hipDeviceGetAttribute(&cus, hipDeviceAttributeMultiprocessorCount, dev);
        (void)hipFuncSetAttribute((const void*)fwd_megakernel, hipFuncAttributeMaxDynamicSharedMemorySize, LDS_BYTES);
        (void)hipOccupancyMaxActiveBlocksPerMultiprocessor(&per_cu, (const void*)fwd_megakernel, 512, LDS_BYTES);
        if (per_cu < 1) per_cu = 1;
        grid_blocks = cus * per_cu;
        if (ws_size < WS_END) fprintf(stderr, "workspace too small: %zu < %zu\n", ws_size, (size_t)WS_END);
    }
    Params p{};
    for (int i = 0; i < 22; ++i) p.in[i] = (const float*)d_in[i];
    p.out = (float*)d_out; p.ws = (unsigned char*)d_ws;
    (void)hipMemsetAsync((unsigned char*)d_ws + WS_BAR, 0, XCD_BAR_WORDS * 4, stream);
    void* args[] = {&p};
    hipError_t e = hipLaunchCooperativeKernel((const void*)fwd_megakernel, dim3(grid_blocks), dim3(512), args, LDS_BYTES, stream);
    if (e != hipSuccess) fprintf(stderr, "cooperative launch failed: %s (grid %d)\n", hipGetErrorString(e), grid_blocks);
}
```

```cpp
#include <hip/hip_runtime.h>
#include <hip/hip_cooperative_groups.h>
#include <cstdio>
namespace cg = cooperative_groups;

#define LAS __attribute__((address_space(3)))
typedef unsigned short bf16_t;
typedef short bf16x8 __attribute__((ext_vector_type(8)));
typedef float f32x4 __attribute__((ext_vector_type(4)));
typedef float f32x2 __attribute__((ext_vector_type(2)));
typedef unsigned u32x4 __attribute__((ext_vector_type(4)));
typedef unsigned u32x2 __attribute__((ext_vector_type(2)));
typedef __bf16 bf2_t __attribute__((ext_vector_type(2)));

constexpr int D = 1024, NB = 8, SEQ = 4096, DEPTH = 2, CTXL = 256;
constexpr int NLAT = NB * SEQ;
constexpr int NCTX = NB * CTXL;
constexpr int NROW = NLAT + NCTX;
constexpr int PW = 3584, FF = 2816, UPW = 2 * FF;
constexpr float EPS = 1e-6f;

constexpr size_t WS_WIN = 0;
constexpr size_t WS_WOUT = WS_WIN + (size_t)DEPTH * PW * D * 2;
constexpr size_t WS_WUP = WS_WOUT + (size_t)DEPTH * D * D * 2;
constexpr size_t WS_WDOWN = WS_WUP + (size_t)DEPTH * UPW * D * 2;
constexpr size_t WS_WSP = WS_WDOWN + (size_t)DEPTH * D * FF * 2;
constexpr size_t WS_ADA = WS_WSP + (size_t)DEPTH * 4 * 128 * 128 * 2;
constexpr size_t WS_LB = WS_ADA + (size_t)DEPTH * 9 * 6144 * 4;
constexpr size_t WS_XC = WS_LB + 2 * 512 * 4;
constexpr size_t WS_H = WS_XC + (size_t)NCTX * D * 4;
constexpr size_t WS_BIG = WS_H + (size_t)NROW * D * 2;
constexpr size_t WS_OFB = WS_BIG + (size_t)NROW * PW * 2;
constexpr size_t WS_QB = WS_OFB + 2 * (size_t)NROW * 512 * 2;
constexpr size_t WS_DS = WS_BIG + (size_t)NROW * UPW * 2;
constexpr size_t WS_BAR = WS_DS + (size_t)64 * 136 * 128 * 4;
constexpr size_t WS_END = WS_BAR + 16384;

constexpr size_t PSLOT = (size_t)NROW * 128;
__device__ __forceinline__ size_t PIX(int row, int col) { return (size_t)(col >> 7) * PSLOT + (size_t)row * 128 + (col & 127); }
struct Params {
    const float* in[22];
    float* out;
    unsigned char* ws;
};

__device__ __forceinline__ unsigned pk_bf16(float a, float b) { f32x2 v = {a, b}; bf2_t r = __builtin_convertvector(v, bf2_t); return __builtin_bit_cast(unsigned, r); }
__device__ __forceinline__ float bf_lo(unsigned u) { return __uint_as_float(u << 16); }
__device__ __forceinline__ float bf_hi(unsigned u) { return __uint_as_float(u & 0xffff0000u); }
__device__ __forceinline__ float bf1(bf16_t u) { return __uint_as_float(((unsigned)u) << 16); }
__device__ __forceinline__ bf16_t to_bf1(float a) { return (bf16_t)(pk_bf16(a, 0.f) & 0xffffu); }
__device__ __forceinline__ float fast_rcp(float x) { return __builtin_amdgcn_rcpf(x); }
__device__ __forceinline__ float gelu_f(float v) {
    const float av = fabsf(v), t = fast_rcp(av * 0.2316418882f + 1.0f);
    float q = t * 0.5307027145f + (-0.7265760135f); q = q * t + 0.7107068705f; q = q * t + (-0.142248368f); q = q * t + 0.127414796f; q = q * t;
    const float e = __builtin_amdgcn_exp2f((v * v) * (-0.72134752044f));
    const float m = v * (q * e);
    return v < 0.f ? m : v - m;
}
__device__ __forceinline__ int opaque_tid() { int t = threadIdx.x; asm volatile("" : "+v"(t)); return t; }
__device__ __forceinline__ float silu_f(float x) { return x * fast_rcp(1.0f + __expf(-x)); }

namespace pg8 {
constexpr int BM = 256, BK = 64, HALF = 128, HTB = HALF * BK * 2, STAGE_BYTES = 8 * HTB, NXCD = 8, WGM = 8;
__host__ __device__ __forceinline__ int lds_byte(int r, int c) { const int st = (r >> 4) * 2 + (c >> 5), rr = r & 15, cc = c & 31, ob = rr * 64 + cc * 2; return st * 1024 + (ob ^ (((ob >> 9) & 1) << 5)); }
__host__ __device__ __forceinline__ void stage_rc(int b, int& R, int& C) { const int st = b / 1024, sb = b % 1024, swz = sb ^ (((sb >> 9) & 1) << 5); R = (st >> 1) * 16 + swz / 64; C = (st & 1) * 32 + (swz % 64) / 2; }
__host__ __device__ __forceinline__ int perm32(int rho) { const int n = rho >> 4, i = rho & 15; return 8 * (i >> 2) + 4 * n + (i & 3); }
struct Unit { int pm, pn; };
struct Gemm { const bf16_t* A; const bf16_t* Bt; int M, N, K; };
struct StaticOrder {
    int nM, nN, nwg, G, c;
    __device__ void init(int M, int N, int G_, int c_) { nM = M / BM; nN = N / BM; nwg = nM * nN; G = G_; c = c_; }
    __device__ bool next(int i, Unit& u) const {
        const long L = (long)i * G + c; if (L >= nwg) return false;
        int wgid = (int)L; { const int q = nwg / NXCD, r = nwg % NXCD, xcd = wgid % NXCD, off = wgid / NXCD; wgid = (xcd < r ? xcd * (q + 1) : r * (q + 1) + (xcd - r) * q) + off; }
        const int nig = WGM * nN, gid = wgid / nig, fm = gid * WGM, gsz = (nM - fm) < WGM ? (nM - fm) : WGM;
        u.pm = fm + ((wgid % nig) % gsz); u.pn = (wgid % nig) / gsz; return true;
    }
    __device__ __forceinline__ void a_ready(const Unit&) const {}
    __device__ __forceinline__ void done(const Unit&) const {}
};
struct EpiBf16 {
    static constexpr bool PERM = true;
    bf16_t* O; int ldc; int split_cols; size_t split_stride; size_t slot_stride;
    __device__ __forceinline__ void operator()(const f32x4 (&acc)[2][2][4][2], const Unit& u, int wr, int wc, int fr, int fq) const {
        const int row0 = u.pm * BM + wr * 64 + fr; int colt = u.pn * BM; bf16_t* base = O;
        if (split_cols) { const int t = colt / split_cols; base += (size_t)t * split_stride; colt -= t * split_cols; }
        const int col0 = colt + wc * 32 + 8 * fq;
#pragma unroll
        for (int ai = 0; ai < 2; ++ai)
#pragma unroll
            for (int m = 0; m < 4; ++m) { const int row = row0 + ai * HALF + m * 16;
                bf16_t* rowp = slot_stride ? base + (size_t)(colt >> 7) * slot_stride + (size_t)row * 128 + wc * 32 + 8 * fq : base + (size_t)row * ldc + col0;
#pragma unroll
                for (int bj = 0; bj < 2; ++bj) { const f32x4 v0 = acc[ai][bj][m][0], v1 = acc[ai][bj][m][1];
                    u32x4 w; w.x = pk_bf16(v0[0], v0[1]); w.y = pk_bf16(v0[2], v0[3]); w.z = pk_bf16(v1[0], v1[1]); w.w = pk_bf16(v1[2], v1[3]);
                    *(u32x4*)(rowp + (slot_stride ? (size_t)bj * slot_stride : (size_t)bj * HALF)) = w; } }
    }
};
struct EpiRes {
    static constexpr bool PERM = false;
    const float* resL; float* outL; const float* resC; float* outC; const float* gate;
    __device__ __forceinline__ void operator()(const f32x4 (&acc)[2][2][4][2], const Unit& u, int wr, int wc, int fr, int fq) const {
        const float* res; float* out; const float* g; int rowb;
        if (u.pm < NLAT / BM) { res = resL; out = outL; g = gate + (size_t)(u.pm >> 4) * 6144; rowb = u.pm * BM; }
        else { res = resC; out = outC; g = gate + (size_t)8 * 6144; rowb = u.pm * BM - NLAT; }
        const int row0 = rowb + wr * 64 + fr, col0 = u.pn * BM + wc * 32 + 4 * fq;
        f32x4 gv[2][2];
#pragma unroll
        for (int bj = 0; bj < 2; ++bj)
#pragma unroll
            for (int n = 0; n < 2; ++n) gv[bj][n] = *(const f32x4*)(g + col0 + bj * HALF + n * 16);
#pragma unroll
        for (int ai = 0; ai < 2; ++ai)
#pragma unroll
            for (int m = 0; m < 4; ++m) { const size_t ro = (size_t)(row0 + ai * HALF + m * 16) * D + col0;
#pragma unroll
                for (int bj = 0; bj < 2; ++bj)
#pragma unroll
                    for (int n = 0; n < 2; ++n) { const f32x4 r = *(const f32x4*)(res + ro + bj * HALF + n * 16);
                        *(f32x4*)(out + ro + bj * HALF + n * 16) = r + gv[bj][n] * acc[ai][bj][m][n]; } }
    }
};

template <class Epi, class Sched>
__device__ __forceinline__ void gemm_phase(LAS unsigned char* lds, const Gemm g, const Sched& S, const Epi& E) {
    const int tid = opaque_tid(), wid = __builtin_amdgcn_readfirstlane(tid >> 6), lane = tid & 63, wr = wid >> 2, wc = wid & 3, fr = lane & 15, fq = lane >> 4;
    const int K = g.K, nt = K / BK;
    unsigned voffA[2], voffB[2];
#pragma unroll
    for (int i = 0; i < 2; ++i) { int R, C; stage_rc(tid * 16 + i * 8192, R, C); const int Rb = Epi::PERM ? ((R & ~31) + perm32(R & 31)) : R;
        voffA[i] = (unsigned)(R * K + C) * 2u; voffB[i] = (unsigned)(Rb * K + C) * 2u; }
    const size_t kstep = (size_t)(BK * 2);
    const size_t hstep = (size_t)HALF * K * 2;
    const size_t tstep = 2 * hstep;
    const unsigned ldsw = (unsigned)wid * 1024u;
    const int aoff = lds_byte(wr * 64 + fr, fq * 8), boff = lds_byte(wc * 32 + fr, fq * 8);
#define PG8_SA(b, h) (((b) * 2 + (h)) * HTB)
#define PG8_SB(b, h) ((4 + (b) * 2 + (h)) * HTB)
#define PG8_STAGE(bufoff, gbase, voff) do { _Pragma("unroll") for (int _i = 0; _i < 2; ++_i) \
        __builtin_amdgcn_global_load_lds((const unsigned*)((const char*)(gbase) + (voff)[_i]), (LAS unsigned*)(lds + (bufoff) + ldsw + _i * 8192), 16, 0, 0); } while (0)
#define PG8_LDA(dst, b, h) do { _Pragma("unroll") for (int m = 0; m < 4; ++m) _Pragma("unroll") for (int k = 0; k < 2; ++k) dst[m][k] = *(const LAS bf16x8*)(lds + PG8_SA(b, h) + aoff + m * 2048 + k * 1024); } while (0)
#define PG8_LDB(dst, b, h) do { _Pragma("unroll") for (int n = 0; n < 2; ++n) _Pragma("unroll") for (int k = 0; k < 2; ++k) dst[n][k] = *(const LAS bf16x8*)(lds + PG8_SB(b, h) + boff + n * 2048 + k * 1024); } while (0)
#define PG8_MMA(ai, bj, At, Bt) do { __builtin_amdgcn_s_setprio(1); _Pragma("unroll") for (int m = 0; m < 4; ++m) _Pragma("unroll") for (int n = 0; n < 2; ++n) _Pragma("unroll") for (int k = 0; k < 2; ++k) \
        acc[ai][bj][m][n] = __builtin_amdgcn_mfma_f32_16x16x32_bf16(Bt[n][k], At[m][k], acc[ai][bj][m][n], 0, 0, 0); __builtin_amdgcn_s_setprio(0); } while (0)
#define PG8_WAIT_V(n) asm volatile("s_waitcnt vmcnt(" #n ")" ::: "memory")
#define PG8_WAIT_L(n) asm volatile("s_waitcnt lgkmcnt(" #n ")" ::: "memory")
#define PG8_BAR __builtin_amdgcn_s_barrier()
#define PG8_SCHED __builtin_amdgcn_sched_barrier(0)
    Unit cur, nxt; int ui = 0;
    if (!S.next(0, cur)) return;
    f32x4 acc[2][2][4][2];
#pragma unroll
    for (int a = 0; a < 2; ++a)
#pragma unroll
        for (int b = 0; b < 2; ++b)
#pragma unroll
            for (int m = 0; m < 4; ++m)
#pragma unroll
                for (int n = 0; n < 2; ++n) acc[a][b][m][n] = (f32x4){0.f, 0.f, 0.f, 0.f};
    bf16x8 At[4][2], B0[2][2], B1[2][2];
    const char* cA = (const char*)g.A + (size_t)cur.pm * tstep; const char* cB = (const char*)g.Bt + (size_t)cur.pn * tstep;
    S.a_ready(cur);
    PG8_STAGE(PG8_SB(0, 0), cB, voffB); PG8_STAGE(PG8_SA(0, 0), cA, voffA); PG8_STAGE(PG8_SB(0, 1), cB + hstep, voffB); PG8_STAGE(PG8_SA(0, 1), cA + hstep, voffA);
    if (wr == 1) PG8_BAR;
    PG8_WAIT_V(4); PG8_BAR;
    PG8_STAGE(PG8_SB(1, 0), cB + kstep, voffB); PG8_STAGE(PG8_SA(1, 0), cA + kstep, voffA); PG8_STAGE(PG8_SB(1, 1), cB + hstep + kstep, voffB);
    PG8_WAIT_V(6); PG8_BAR;
    for (;;) {
        const bool has_next = S.next(ui + 1, nxt);
        const char* nA = has_next ? (const char*)g.A + (size_t)nxt.pm * tstep : cA; const char* nB = has_next ? (const char*)g.Bt + (size_t)nxt.pn * tstep : cB;
        for (int t = 0; t < nt; t += 2) {
            const bool last = (t == nt - 2);
            const char* a1 = cA + (size_t)(t + 1) * kstep;
            const char* a2 = last ? nA : cA + (size_t)(t + 2) * kstep; const char* b2 = last ? nB : cB + (size_t)(t + 2) * kstep;
            const char* a3 = a2 + kstep; const char* b3 = b2 + kstep;
            if (last && has_next) S.a_ready(nxt);
            PG8_LDB(B0, 0, 0); PG8_SCHED; PG8_LDA(At, 0, 0); PG8_STAGE(PG8_SA(1, 1), a1 + hstep, voffA);
            PG8_WAIT_L(8); PG8_BAR; PG8_WAIT_L(0); PG8_MMA(0, 0, At, B0); PG8_BAR; PG8_SCHED;
            PG8_LDB(B1, 0, 1); PG8_STAGE(PG8_SB(0, 0), b2, voffB);
            PG8_BAR; PG8_WAIT_L(0); PG8_MMA(0, 1, At, B1); PG8_BAR;
            PG8_LDA(At, 0, 1); PG8_STAGE(PG8_SA(0, 0), a2, voffA);
            PG8_BAR; PG8_WAIT_L(0); PG8_MMA(1, 0, At, B0); PG8_BAR; PG8_SCHED;
            PG8_STAGE(PG8_SB(0, 1), b2 + hstep, voffB);
            PG8_WAIT_V(6); PG8_BAR; PG8_MMA(1, 1, At, B1); PG8_BAR;
            PG8_LDB(B0, 1, 0); PG8_SCHED; PG8_LDA(At, 1, 0); PG8_STAGE(PG8_SA(0, 1), a2 + hstep, voffA);
            PG8_WAIT_L(8); PG8_BAR; PG8_WAIT_L(0); PG8_MMA(0, 0, At, B0); PG8_BAR; PG8_SCHED;
            PG8_LDB(B1, 1, 1); PG8_STAGE(PG8_SB(1, 0), b3, voffB);
            PG8_BAR; PG8_WAIT_L(0); PG8_MMA(0, 1, At, B1); PG8_BAR;
            PG8_LDA(At, 1, 1); PG8_STAGE(PG8_SA(1, 0), a3, voffA);
            PG8_BAR; PG8_WAIT_L(0); PG8_MMA(1, 0, At, B0); PG8_BAR; PG8_SCHED;
            PG8_STAGE(PG8_SB(1, 1), b3 + hstep, voffB);
            PG8_WAIT_V(6); PG8_BAR; PG8_MMA(1, 1, At, B1); PG8_BAR;
        }
        E(acc, cur, wr, wc, fr, fq); S.done(cur);
        if (!has_next) break;
#pragma unroll
        for (int a = 0; a < 2; ++a)
#pragma unroll
            for (int b = 0; b < 2; ++b)
#pragma unroll
                for (int m = 0; m < 4; ++m)
#pragma unroll
                    for (int n = 0; n < 2; ++n) acc[a][b][m][n] = (f32x4){0.f, 0.f, 0.f, 0.f};
        cur = nxt; cA = nA; cB = nB; ++ui;
    }
    PG8_WAIT_V(0);
    if (wr == 0) PG8_BAR;
    PG8_BAR;
#undef PG8_SA
#undef PG8_SB
#undef PG8_STAGE
#undef PG8_LDA
#undef PG8_LDB
#undef PG8_MMA
#undef PG8_WAIT_V
#undef PG8_WAIT_L
#undef PG8_BAR
#undef PG8_SCHED
}
}

__device__ void phase_prep(const Params& p, LAS unsigned char* lds) {
    const int tid = opaque_tid();
    constexpr int NT_L = 896 + 256 + 1408 + 704;
    constexpr int J_ADA = 192, J_TR = J_ADA + 2 * NT_L, J_WSP = J_TR + 32, J_LB = J_WSP + 1;
    for (int job = blockIdx.x; job < J_LB; job += gridDim.x) {
        if (job < J_ADA) {
            LAS float* s = (LAS float*)lds;
            LAS float* red = (LAS float*)(lds + 9 * 1024 * 4);
            { float vv[18];
#pragma unroll
              for (int u = 0; u < 18; ++u) { const int i = tid + 512 * u, r = i >> 10, d = i & 1023; vv[u] = r < 8 ? p.in[1][r * 1024 + d] : p.in[3][d]; }
#pragma unroll
              for (int u = 0; u < 18; ++u) s[tid + 512 * u] = silu_f(vv[u]); }
            __syncthreads();
            const int l = job / 96, e0 = (job % 96) * 64, col = tid & 63, dg = tid >> 6;
            const float* w = p.in[4] + ((size_t)l * 1024 + dg * 128) * 6144 + e0 + col;
            float acc[9];
#pragma unroll
            for (int r = 0; r < 9; ++r) acc[r] = 0.f;
            for (int dd = 0; dd < 128; ++dd) { const float wv = w[(size_t)dd * 6144];
#pragma unroll
                for (int r = 0; r < 9; ++r) acc[r] += s[r * 1024 + dg * 128 + dd] * wv; }
#pragma unroll
            for (int r = 0; r < 9; ++r) red[(dg * 9 + r) * 64 + col] = acc[r];
            __syncthreads();
            for (int i = tid; i < 9 * 64; i += 512) { const int r = i >> 6, c = i & 63; float a = 0.f;
#pragma unroll
                for (int g = 0; g < 8; ++g) a += red[(g * 9 + r) * 64 + c];
                ((float*)(p.ws + WS_ADA))[((size_t)l * 9 + r) * 6144 + e0 + c] = a + p.in[5][l * 6144 + e0 + c]; }
            __syncthreads();
        } else if (job < J_TR) {
            const int j = job - J_ADA, l = j / NT_L; int r = j % NT_L;
            const float* src; bf16_t* dst; int K, N;
            if (r < 896) { src = p.in[8] + (size_t)l * D * PW; dst = (bf16_t*)(p.ws + WS_WIN) + (size_t)l * PW * D; K = D; N = PW; }
            else if (r < 1152) { r -= 896; src = p.in[16] + (size_t)l * D * D; dst = (bf16_t*)(p.ws + WS_WOUT) + (size_t)l * D * D; K = D; N = D; }
            else if (r < 2560) { r -= 1152; src = p.in[17] + (size_t)l * D * UPW; dst = (bf16_t*)(p.ws + WS_WUP) + (size_t)l * UPW * D; K = D; N = UPW; }
            else { r -= 2560; src = p.in[20] + (size_t)l * FF * D; dst = (bf16_t*)(p.ws + WS_WDOWN) + (size_t)l * D * FF; K = FF; N = D; }
            const int ntn = N >> 6, kt = r / ntn, nt = r % ntn;
            LAS float* tile = (LAS float*)lds;
            { const int kk = tid >> 3, n8 = (tid & 7) * 8; const float* sp = src + (size_t)(kt * 64 + kk) * N + nt * 64 + n8;
              const f32x4 a = *(const f32x4*)sp, b = *(const f32x4*)(sp + 4);
              LAS float* tp = tile + kk * 65 + n8; tp[0] = a[0]; tp[1] = a[1]; tp[2] = a[2]; tp[3] = a[3]; tp[4] = b[0]; tp[5] = b[1]; tp[6] = b[2]; tp[7] = b[3]; }
            __syncthreads();
            { const int nn = tid >> 3, k8 = (tid & 7) * 8; float v[8];
#pragma unroll
              for (int i = 0; i < 8; ++i) v[i] = tile[(k8 + i) * 65 + nn];
              u32x4 w; w.x = pk_bf16(v[0], v[1]); w.y = pk_bf16(v[2], v[3]); w.z = pk_bf16(v[4], v[5]); w.w = pk_bf16(v[6], v[7]);
              *(u32x4*)(dst + (size_t)(nt * 64 + nn) * K + kt * 64 + k8) = w; }
            __syncthreads();
        } else if (job < J_WSP) {
            const int j = job - J_TR; const size_t i0 = (size_t)j * 4096 + tid * 8;
            const f32x4 a = *(const f32x4*)(p.in[14] + i0), b = *(const f32x4*)(p.in[14] + i0 + 4);
            u32x4 w; w.x = pk_bf16(a[0], a[1]); w.y = pk_bf16(a[2], a[3]); w.z = pk_bf16(b[0], b[1]); w.w = pk_bf16(b[2], b[3]);
            *(u32x4*)((bf16_t*)(p.ws + WS_WSP) + i0) = w;
        } else {
            for (int i = tid; i < 1024; i += 512) { const int dir = i >> 9, c = i & 511; const float* lg = dir ? p.in[10] : p.in[9];
                const float l0 = lg[c], l1 = lg[512 + c]; ((float*)(p.ws + WS_LB))[i] = 1.0f / (1.0f + expf(l0 - l1)); }
        }
    }
}

__device__ void phase_norm(const float* xl, const float* xc, const bf16_t* Y, const float* gate  , float* xl_dst, float* xc_dst,
                           const float* gain, const float* ada_l, int shift_idx, int nrows, bf16_t* H) {
    const int tid_ = opaque_tid(); const int wave = tid_ >> 6, lane = tid_ & 63;
    f32x4 gn[4];
#pragma unroll
    for (int j = 0; j < 4; ++j) gn[j] = *(const f32x4*)(gain + j * 256 + lane * 4);
    for (int rr = (blockIdx.x * 8 + wave) * 2; rr < nrows; rr += gridDim.x * 16) {
        const int row = nrows - 2 - rr;
        const float* src; const float* mod; float* dst; const float* gt;
        if (row < NLAT) { src = xl + (size_t)row * D; mod = ada_l + (size_t)(row >> 12) * 6144; dst = xl_dst ? xl_dst + (size_t)row * D : nullptr; gt = gate + (size_t)(row >> 12) * 6144; }
        else { src = xc + (size_t)(row - NLAT) * D; mod = ada_l + (size_t)8 * 6144; dst = xc_dst ? xc_dst + (size_t)(row - NLAT) * D : nullptr; gt = gate + (size_t)8 * 6144; }
        f32x4 v[2][4], sh[4], sc[4], gg[4]; u32x2 yv[2][4];
#pragma unroll
        for (int u = 0; u < 2; ++u)
#pragma unroll
            for (int j = 0; j < 4; ++j) { v[u][j] = *(const f32x4*)(src + (size_t)u * D + j * 256 + lane * 4); if (Y) yv[u][j] = *(const u32x2*)(Y + (size_t)(row + u) * D + j * 256 + lane * 4); }
#pragma unroll
        for (int j = 0; j < 4; ++j) { const int d = j * 256 + lane * 4; sh[j] = *(const f32x4*)(mod + shift_idx * 1024 + d); sc[j] = *(const f32x4*)(mod + (shift_idx + 1) * 1024 + d); if (Y) gg[j] = *(const f32x4*)(gt + d); }
#pragma unroll
        for (int u = 0; u < 2; ++u) {
            if (Y) {
#pragma unroll
                for (int j = 0; j < 4; ++j) {
                    v[u][j][0] += gg[j][0] * bf_lo(yv[u][j].x); v[u][j][1] += gg[j][1] * bf_hi(yv[u][j].x); v[u][j][2] += gg[j][2] * bf_lo(yv[u][j].y); v[u][j][3] += gg[j][3] * bf_hi(yv[u][j].y);
                    if (dst) *(f32x4*)(dst + (size_t)u * D + j * 256 + lane * 4) = v[u][j]; }
            }
            float ss = 0.f;
#pragma unroll
            for (int j = 0; j < 4; ++j) ss += v[u][j][0] * v[u][j][0] + v[u][j][1] * v[u][j][1] + v[u][j][2] * v[u][j][2] + v[u][j][3] * v[u][j][3];
#pragma unroll
            for (int o = 32; o > 0; o >>= 1) ss += __shfl_xor(ss, o);
            const float rs = rsqrtf(ss * (1.0f / D) + EPS);
#pragma unroll
            for (int j = 0; j < 4; ++j) { const int d = j * 256 + lane * 4;
                f32x4 y = v[u][j] * rs * gn[j]; y = y * (sc[j] + 1.0f) + sh[j];
                u32x2 wv; wv.x = pk_bf16(y[0], y[1]); wv.y = pk_bf16(y[2], y[3]);
                *(u32x2*)(H + (size_t)(row + u) * D + d) = wv; }
        }
    }
}
__device__ void phase_final(float* x, const bf16_t* Y, const float* gate, const float* gain) {
    const int tid_ = opaque_tid(); const int wave = tid_ >> 6, lane = tid_ & 63;
    f32x4 gn[4];
#pragma unroll
    for (int j = 0; j < 4; ++j) gn[j] = *(const f32x4*)(gain + j * 256 + lane * 4);
    for (int row = (blockIdx.x * 8 + wave) * 2; row < NLAT; row += gridDim.x * 16) {
        const float* gt = gate + (size_t)(row >> 12) * 6144;
        f32x4 v[2][4], gg[4]; u32x2 yv[2][4];
#pragma unroll
        for (int u = 0; u < 2; ++u)
#pragma unroll
            for (int j = 0; j < 4; ++j) { v[u][j] = *(const f32x4*)(x + (size_t)(row + u) * D + j * 256 + lane * 4); yv[u][j] = *(const u32x2*)(Y + (size_t)(row + u) * D + j * 256 + lane * 4); }
#pragma unroll
        for (int j = 0; j < 4; ++j) gg[j] = *(const f32x4*)(gt + j * 256 + lane * 4);
#pragma unroll
        for (int u = 0; u < 2; ++u) {
            float ss = 0.f;
#pragma unroll
            for (int j = 0; j < 4; ++j) {
                v[u][j][0] += gg[j][0] * bf_lo(yv[u][j].x); v[u][j][1] += gg[j][1] * bf_hi(yv[u][j].x); v[u][j][2] += gg[j][2] * bf_lo(yv[u][j].y); v[u][j][3] += gg[j][3] * bf_hi(yv[u][j].y);
                ss += v[u][j][0] * v[u][j][0] + v[u][j][1] * v[u][j][1] + v[u][j][2] * v[u][j][2] + v[u][j][3] * v[u][j][3]; }
#pragma unroll
            for (int o = 32; o > 0; o >>= 1) ss += __shfl_xor(ss, o);
            const float rs = rsqrtf(ss * (1.0f / D) + EPS);
#pragma unroll
            for (int j = 0; j < 4; ++j) { const int d = j * 256 + lane * 4; *(f32x4*)(x + (size_t)(row + u) * D + d) = v[u][j] * rs * gn[j]; }
        }
    }
}

constexpr int QS_ST = 136, KT_ST = 40;
constexpr int P1_QS = 0, P1_KH = P1_QS + 32 * QS_ST * 2, P1_VT = P1_KH + 32 * QS_ST * 2, P1_KT = P1_VT + 128 * KT_ST * 2, P1_AW = P1_KT + 128 * KT_ST * 2;
constexpr int P1_DIRSZ = P1_AW + 8 * 32 * KT_ST * 2;
constexpr int NCH = 8 + 128;

template <int CTRL, int RMASK> __device__ __forceinline__ float dpp_mul(float x) {
    const int t = __builtin_amdgcn_update_dpp(0x3f800000, __builtin_bit_cast(int, x), CTRL, RMASK, 0xf, false);
    return x * __builtin_bit_cast(float, t);
}
__device__ __forceinline__ float cumprod32(float x) {
    x = dpp_mul<0x111, 0xf>(x); x = dpp_mul<0x112, 0xf>(x); x = dpp_mul<0x114, 0xf>(x); x = dpp_mul<0x118, 0xf>(x);
    x = dpp_mul<0x142, 0xa>(x);
    return x;
}

#define DPP8_STEP(CTRL) asm volatile("s_nop 1\n\t" \
    "v_mul_f32_dpp %0, %0, %0 " CTRL "\n\tv_mul_f32_dpp %1, %1, %1 " CTRL "\n\tv_mul_f32_dpp %2, %2, %2 " CTRL "\n\tv_mul_f32_dpp %3, %3, %3 " CTRL "\n\t" \
    "v_mul_f32_dpp %4, %4, %4 " CTRL "\n\tv_mul_f32_dpp %5, %5, %5 " CTRL "\n\tv_mul_f32_dpp %6, %6, %6 " CTRL "\n\tv_mul_f32_dpp %7, %7, %7 " CTRL "\n\ts_nop 1" \
    : "+v"(e[0]), "+v"(e[1]), "+v"(e[2]), "+v"(e[3]), "+v"(e[4]), "+v"(e[5]), "+v"(e[6]), "+v"(e[7]))
__device__ __forceinline__ void cumprod32x8(float (&e)[8]) {
    asm volatile("s_nop 4" ::: );
    DPP8_STEP("row_shr:1 row_mask:0xf bank_mask:0xf");
    DPP8_STEP("row_shr:2 row_mask:0xf bank_mask:0xf");
    DPP8_STEP("row_shr:4 row_mask:0xf bank_mask:0xf");
    DPP8_STEP("row_shr:8 row_mask:0xf bank_mask:0xf");
    DPP8_STEP("row_bcast:15 row_mask:0xa bank_mask:0xf");
}
__device__ void prep_item(const Params& p, int l, int item, LAS unsigned char* lds) {
    const int tid = opaque_tid(), w = tid >> 6, lane = tid & 63;
    const int tau = lane & 31, kh = lane >> 5, k0 = 16 * w + 8 * kh, l15 = lane & 15, q4 = lane >> 4;
    const int ci = item % NCH, bh = item / NCH, h = bh & 3, b = bh >> 2;
    const int R0 = ci < 8 ? NLAT + b * 256 + 32 * ci : b * 4096 + 32 * (ci - 8);
    bf16_t* P = (bf16_t*)(p.ws + WS_BIG);
    const bool first = (l == 0);
    const bool want_out = first || ci >= 8;
    for (int dd = 0; dd < 2; ++dd) { LAS unsigned* az = (LAS unsigned*)(lds + dd * P1_DIRSZ + P1_AW) + w * (32 * KT_ST / 2); for (int i = lane; i < 32 * KT_ST / 2; i += 64) az[i] = 0u; }
    u32x4 rf0, rq0, rv0, rf1, rq1, rv1;
    { const int r_ = R0 + tau; rf0 = *(const u32x4*)(P + PIX(r_, h * 128 + k0)); rq0 = *(const u32x4*)(P + PIX(r_, 1536 + h * 128 + k0)); rv0 = *(const u32x4*)(P + PIX(r_, 1024 + h * 128 + k0)); }
    { const int r_ = R0 + 31 - tau; rf1 = *(const u32x4*)(P + PIX(r_, 512 + h * 128 + k0)); rq1 = *(const u32x4*)(P + PIX(r_, 1536 + h * 128 + k0)); rv1 = *(const u32x4*)(P + PIX(r_, 1024 + h * 128 + k0)); }
    asm volatile("s_waitcnt vmcnt(0)" ::: "memory");
    __syncthreads();
    auto valu_part = [&](const int dir, const u32x4& f, const u32x4& q, const u32x4& v) {
        LAS unsigned char* db = lds + dir * P1_DIRSZ;
        LAS bf16_t* Qs = (LAS bf16_t*)(db + P1_QS); LAS bf16_t* Kh = (LAS bf16_t*)(db + P1_KH);
        LAS bf16_t* Vt = (LAS bf16_t*)(db + P1_VT); LAS bf16_t* Kt = (LAS bf16_t*)(db + P1_KT);
        LAS bf16_t* Aw = (LAS bf16_t*)(db + P1_AW) + w * 32 * KT_ST;
        const int tokl = dir ? 31 - tau : tau;
        const float* lbp = (const float*)(p.ws + WS_LB) + dir * 512 + h * 128 + k0;
        float E[8], kk[8];
#pragma unroll
        for (int j = 0; j < 8; ++j) {
            const unsigned fw = f[j >> 1]; const float x = (j & 1) ? bf_hi(fw) : bf_lo(fw);
            const float e = __expf(-fabsf(x)), r = fast_rcp(1.0f + e);
            const float sp = x >= 0.f ? r : e * r, sn = x >= 0.f ? e * r : r;
            if (first) { E[j] = sp; kk[j] = sn; }
            else { const float lb = lbp[j]; const float gate = lb + (1.0f - lb) * sp; E[j] = gate; kk[j] = 1.0f - gate; }
        }
        float qt[8], kh_[8], kt_[8], Tj[8];
        cumprod32x8(E);
#pragma unroll
        for (int j = 0; j < 8; ++j) {
            const float Ej = fmaxf(E[j], 1e-35f);
            const float T0 = __builtin_bit_cast(float, __builtin_amdgcn_readlane(__builtin_bit_cast(int, Ej), 31)), T1 = __builtin_bit_cast(float, __builtin_amdgcn_readlane(__builtin_bit_cast(int, Ej), 63));
            const float T = kh ? T1 : T0;
            const unsigned qw = q[j >> 1]; const float qx = (j & 1) ? bf_hi(qw) : bf_lo(qw);
            qt[j] = silu_f(qx) * 0.08838834764831845f * Ej;
            kh_[j] = kk[j] * fast_rcp(Ej); kt_[j] = kh_[j] * T;
            Tj[j] = T;
        }
        if (tau == 31) { float* dp = (float*)(p.ws + WS_DS) + ((size_t)((b * 4 + h) * 2 + dir) * NCH + ci) * 128 + k0;
            *(f32x4*)dp = (f32x4){Tj[0], Tj[1], Tj[2], Tj[3]}; *(f32x4*)(dp + 4) = (f32x4){Tj[4], Tj[5], Tj[6], Tj[7]}; }
        u32x4 wq, wk; wq.x = pk_bf16(qt[0], qt[1]); wq.y = pk_bf16(qt[2], qt[3]); wq.z = pk_bf16(qt[4], qt[5]); wq.w = pk_bf16(qt[6], qt[7]);
        wk.x = pk_bf16(kh_[0], kh_[1]); wk.y = pk_bf16(kh_[2], kh_[3]); wk.z = pk_bf16(kh_[4], kh_[5]); wk.w = pk_bf16(kh_[6], kh_[7]);
        *(LAS u32x4*)(Qs + tau * QS_ST + k0) = wq; *(LAS u32x4*)(Kh + tau * QS_ST + k0) = wk;
        {
          bf16_t* qd = (dir == 0) ? P + PIX(R0 + tokl, 1536 + h * 128) : (bf16_t*)(p.ws + WS_QB) + (size_t)h * PSLOT + (size_t)(R0 + tokl) * 128;
          const int a32 = k0 & ~31, kkA = k0 & 31, kkB = kkA + 4;
          u32x2 pa, pb; pa.x = wq.x; pa.y = wq.y; pb.x = wq.z; pb.y = wq.w;
          *(u32x2*)(qd + a32 + 8 * ((kkA & 15) >> 2) + 4 * (kkA >> 4)) = pa;
          *(u32x2*)(qd + a32 + 8 * ((kkB & 15) >> 2) + 4 * (kkB >> 4)) = pb; }
#pragma unroll
        for (int j = 0; j < 8; ++j) { Kt[(k0 + j) * KT_ST + tokl] = to_bf1(kt_[j]); const unsigned vw = v[j >> 1]; Vt[(k0 + j) * KT_ST + tau] = (bf16_t)((j & 1) ? (vw >> 16) : (vw & 0xffffu)); }
    };
    auto mfma_part = [&](const int dir) {
        LAS unsigned char* db = lds + dir * P1_DIRSZ;
        LAS bf16_t* Qs = (LAS bf16_t*)(db + P1_QS); LAS bf16_t* Kh = (LAS bf16_t*)(db + P1_KH);
        LAS bf16_t* Vt = (LAS bf16_t*)(db + P1_VT); LAS bf16_t* Kt = (LAS bf16_t*)(db + P1_KT);
        LAS bf16_t* Aw = (LAS bf16_t*)(db + P1_AW) + w * 32 * KT_ST;
        const int tokl = dir ? 31 - tau : tau; (void)tokl;
        if (want_out) {
            f32x4 a00 = (f32x4){0.f, 0.f, 0.f, 0.f}, a10 = a00, a11 = a00;
#pragma unroll
            for (int kb = 0; kb < 4; ++kb) {
                const bf16x8 qn0 = *(const LAS bf16x8*)(Qs + l15 * QS_ST + 32 * kb + 8 * q4), qn1 = *(const LAS bf16x8*)(Qs + (16 + l15) * QS_ST + 32 * kb + 8 * q4);
                const bf16x8 kh0 = *(const LAS bf16x8*)(Kh + l15 * QS_ST + 32 * kb + 8 * q4), kh1 = *(const LAS bf16x8*)(Kh + (16 + l15) * QS_ST + 32 * kb + 8 * q4);
                a00 = __builtin_amdgcn_mfma_f32_16x16x32_bf16(qn0, kh0, a00, 0, 0, 0);
                a10 = __builtin_amdgcn_mfma_f32_16x16x32_bf16(qn1, kh0, a10, 0, 0, 0);
                a11 = __builtin_amdgcn_mfma_f32_16x16x32_bf16(qn1, kh1, a11, 0, 0, 0);
            }
#pragma unroll
            for (int i = 0; i < 4; ++i) { const int t = 4 * q4 + i; const bool keep = l15 <= t;
                Aw[t * KT_ST + l15] = to_bf1(keep ? a00[i] : 0.f);
                Aw[(16 + t) * KT_ST + l15] = to_bf1(a10[i]);
                Aw[(16 + t) * KT_ST + 16 + l15] = to_bf1(keep ? a11[i] : 0.f); }
            asm volatile("s_waitcnt lgkmcnt(0)" ::: "memory");
            const bf16x8 vf = *(const LAS bf16x8*)(Vt + (16 * w + l15) * KT_ST + 8 * q4);
            bf16_t* OFB = (bf16_t*)(p.ws + WS_OFB) + (size_t)dir * NROW * 512;
#pragma unroll
            for (int mt = 0; mt < 2; ++mt) {
                const bf16x8 af = *(const LAS bf16x8*)(Aw + (16 * mt + l15) * KT_ST + 8 * q4);
                const f32x4 o = __builtin_amdgcn_mfma_f32_16x16x32_bf16(vf, af, (f32x4){0.f, 0.f, 0.f, 0.f}, 0, 0, 0);
                const int tl = 16 * mt + l15, tok = dir ? 31 - tl : tl;
                u32x2 wv; wv.x = pk_bf16(o[0], o[1]); wv.y = pk_bf16(o[2], o[3]);
                *(u32x2*)(OFB + (size_t)h * PSLOT + (size_t)(R0 + tok) * 128 + 16 * w + 4 * q4) = wv;
            }
        }
        { const int k = tid >> 2, part = tid & 3;
          const u32x4 kv = *(const LAS u32x4*)(Kt + k * KT_ST + 8 * part);
          const int pc = h * 128 + (k & 3) * 32 + (part ^ ((k >> 2) & 3)) * 8;
          *(u32x4*)(P + PIX(R0 + (k >> 2), dir * 512 + pc)) = kv;
          if (dir == 0) { const u32x4 vv = *(const LAS u32x4*)(Vt + k * KT_ST + 8 * part); *(u32x4*)(P + PIX(R0 + (k >> 2), 1024 + pc)) = vv; } }
    };
    valu_part(0, rf0, rq0, rv0);
    valu_part(1, rf1, rq1, rv1);
    __syncthreads();
    mfma_part(0);
    mfma_part(1);
    __syncthreads();
}

constexpr int ST_Q = 0, ST_K = 8192, ST_V = 16384, ST_O = 20480, ST_D = 24576, ST_BYTES = 25088, NSTAGE = 6;
__device__ void scan_chain(const Params& p, int l, int chain, int vhalf, LAS unsigned char* lds) {
    const int tid = opaque_tid(), w = __builtin_amdgcn_readfirstlane(tid >> 6), lane = tid & 63, l15 = lane & 15, q4 = lane >> 4;
    const int dir = chain & 1, h = (chain >> 1) & 3, b = chain >> 3;
    bf16_t* P = (bf16_t*)(p.ws + WS_BIG);
    auto chunk_of = [&](int s) -> int { return dir ? (s < 8 ? 7 - s : 143 - s) : s; };
    auto row0_of = [&](int c) -> int { return c < 8 ? NLAT + b * 256 + 32 * c : b * 4096 + 32 * (c - 8); };
    bf16_t* qb = dir ? (bf16_t*)(p.ws + WS_QB) + (size_t)h * PSLOT : P + PIX(0, 1536 + h * 128);
    const int qpitch = 128;
    if (w >= 4) {
        const int lw = w - 4;
        const int r16 = lane >> 4, s16 = lane & 15;
        size_t qoff[2], koff[2];
#pragma unroll
        for (int i = 0; i < 2; ++i) { const int row = 8 * lw + 4 * i + r16; qoff[i] = (size_t)row * qpitch + ((s16 ^ (row & 15)) * 8);
            koff[i] = PIX(4 * (2 * lw + i) + r16, dir * 512 + h * 128) + s16 * 8; }
        const size_t voff = PIX(16 * vhalf + 4 * lw + r16, 1024 + h * 128) + s16 * 8;
        const float* dsrc = (const float*)(p.ws + WS_DS) + (size_t)chain * NCH * 128 + (lw & 1) * 64 + lane;
        const int orow = 8 * lw + (lane >> 3);
        const size_t ooff = (size_t)h * PSLOT + (size_t)orow * 128 + 64 * vhalf + (((lane & 7) ^ (orow & 7)) * 8);
        const bf16_t* OFBc = (const bf16_t*)(p.ws + WS_OFB) + (size_t)dir * NROW * 512;
        auto issue = [&](int s) {
            const int sc = s < NCH ? s : NCH - 1;
            const int c = chunk_of(sc), R0 = row0_of(c);
            LAS unsigned char* st = lds + (s % NSTAGE) * ST_BYTES;
            const bf16_t* qrow = qb + (size_t)R0 * qpitch; const bf16_t* krow = P + (size_t)R0 * 128;
#pragma unroll
            for (int i = 0; i < 2; ++i) {
                __builtin_amdgcn_global_load_lds((const unsigned*)(qrow + qoff[i]), (LAS unsigned*)(st + ST_Q + (2 * lw + i) * 1024), 16, 0, 0);
                __builtin_amdgcn_global_load_lds((const unsigned*)(krow + koff[i]), (LAS unsigned*)(st + ST_K + (2 * lw + i) * 1024), 16, 0, 0);
            }
            __builtin_amdgcn_global_load_lds((const unsigned*)(krow + voff), (LAS unsigned*)(st + ST_V + lw * 1024), 16, 0, 0);
            __builtin_amdgcn_global_load_lds((const unsigned*)(dsrc + (size_t)c * 128), (LAS unsigned*)(st + ST_D + (lw & 1) * 256), 4, 0, 0);
            __builtin_amdgcn_global_load_lds((const unsigned*)(OFBc + (size_t)R0 * 128 + ooff), (LAS unsigned*)(st + ST_O + lw * 1024), 16, 0, 0);
        };
        issue(0); issue(1); issue(2); issue(3); issue(4);
        asm volatile("s_waitcnt vmcnt(28)" ::: "memory");
        __builtin_amdgcn_s_barrier();
        for (int s = 0; s < NCH; ++s) {
            issue(s + 5);
            asm volatile("s_waitcnt vmcnt(28)" ::: "memory");
            __builtin_amdgcn_s_barrier();
        }
        asm volatile("s_waitcnt vmcnt(0)" ::: "memory");
    } else {
        f32x4 S[8];
#pragma unroll
        for (int j = 0; j < 8; ++j) S[j] = (f32x4){0.f, 0.f, 0.f, 0.f};
        const int swz = (l15 >> 2) & 3, vcol = 64 * vhalf + 16 * w;
        bf16_t* OFBw = (bf16_t*)(p.ws + WS_OFB) + (size_t)dir * NROW * 512;
        __builtin_amdgcn_s_barrier();
        for (int s = 0; s < NCH; ++s) {
            LAS unsigned char* st = lds + (s % NSTAGE) * ST_BYTES;
            bf16x8 qf[4][2], kf[8]; f32x4 dv[8];
#pragma unroll
            for (int kb = 0; kb < 4; ++kb)
#pragma unroll
                for (int mt = 0; mt < 2; ++mt) {
                    qf[kb][mt] = *(const LAS bf16x8*)(st + ST_Q + (16 * mt + l15) * 256 + (((4 * kb + q4) ^ l15) * 16));
                }
            const bf16x8 vf = *(const LAS bf16x8*)(st + ST_V + (16 * w + l15) * 64 + ((q4 ^ swz) * 16));
            u32x2 oi[2];
#pragma unroll
            for (int mt = 0; mt < 2; ++mt) { const int tr = 16 * mt + l15; oi[mt] = *(const LAS u32x2*)(st + ST_O + tr * 128 + (((2 * w + (q4 >> 1)) ^ (tr & 7)) * 16) + (q4 & 1) * 8); }
#pragma unroll
            for (int j = 0; j < 8; ++j) { dv[j] = *(const LAS f32x4*)(st + ST_D + (16 * j + 4 * q4) * 4); kf[j] = *(const LAS bf16x8*)(st + ST_K + (16 * j + l15) * 64 + ((q4 ^ swz) * 16)); }
            __builtin_amdgcn_sched_barrier(0);
            f32x4 o[2]; o[0] = (f32x4){0.f, 0.f, 0.f, 0.f}; o[1] = o[0];
#pragma unroll
            for (int kb = 0; kb < 4; ++kb) {
                u32x4 sb; sb.x = pk_bf16(S[2 * kb][0], S[2 * kb][1]); sb.y = pk_bf16(S[2 * kb][2], S[2 * kb][3]); sb.z = pk_bf16(S[2 * kb + 1][0], S[2 * kb + 1][1]); sb.w = pk_bf16(S[2 * kb + 1][2], S[2 * kb + 1][3]);
                const bf16x8 sfr = __builtin_bit_cast(bf16x8, sb);
                o[0] = __builtin_amdgcn_mfma_f32_16x16x32_bf16(sfr, qf[kb][0], o[0], 0, 0, 0);
                o[1] = __builtin_amdgcn_mfma_f32_16x16x32_bf16(sfr, qf[kb][1], o[1], 0, 0, 0);
            }
#pragma unroll
            for (int j = 0; j < 8; ++j) S[j] = __builtin_amdgcn_mfma_f32_16x16x32_bf16(kf[j], vf, S[j] * dv[j], 0, 0, 0);
            const int R0 = row0_of(chunk_of(s));
#pragma unroll
            for (int mt = 0; mt < 2; ++mt) { const int tr = 16 * mt + l15;
                u32x2 wv; wv.x = pk_bf16(o[mt][0] + bf_lo(oi[mt].x), o[mt][1] + bf_hi(oi[mt].x)); wv.y = pk_bf16(o[mt][2] + bf_lo(oi[mt].y), o[mt][3] + bf_hi(oi[mt].y));
                *(u32x2*)(OFBw + (size_t)h * PSLOT + (size_t)(R0 + tr) * 128 + vcol + 4 * q4) = wv; }
            asm volatile("s_waitcnt lgkmcnt(0)" ::: "memory");
            __builtin_amdgcn_s_barrier();
        }
    }
}

constexpr int SG_ST = 136;
__device__ void sgu_tile(const Params& p, int l, int tile, LAS unsigned char* lds) {
    const int tid = opaque_tid(), w = tid >> 6, lane = tid & 63, l15 = lane & 15, q4 = lane >> 4;
    const int h = tile & 3, rowbase = (tile >> 2) * 128;
    const bf16_t* P = (const bf16_t*)(p.ws + WS_BIG);
    bf16_t* O = (bf16_t*)(p.ws + WS_H);
    LAS bf16_t* Vt = (LAS bf16_t*)lds;
    {
        const int q = tid >> 2, cgp = tid & 3;
        const bf16_t* vp = P + PIX(rowbase + q, 3072 + 128 * h + 32 * cgp);
        float g[32];
#pragma unroll
        for (int i = 0; i < 4; ++i) { const u32x4 r = *(const u32x4*)(vp + 8 * i);
#pragma unroll
            for (int j = 0; j < 4; ++j) { g[8 * i + 2 * j] = gelu_f(bf_lo(r[j])); g[8 * i + 2 * j + 1] = gelu_f(bf_hi(r[j])); } }
        float s = 0.f;
#pragma unroll
        for (int i = 0; i < 32; ++i) s += g[i];
        s += __shfl_xor(s, 1); s += __shfl_xor(s, 2);
        const float mu = s * (1.0f / 128.f);
        float vs = 0.f;
#pragma unroll
        for (int i = 0; i < 32; ++i) { const float d = g[i] - mu; vs += d * d; }
        vs += __shfl_xor(vs, 1); vs += __shfl_xor(vs, 2);
        const float rstd = rsqrtf(vs * (1.0f / 128.f) + EPS);
        const float* lng = p.in[12] + l * 512 + h * 128 + 32 * cgp; const float* lnb = p.in[13] + l * 512 + h * 128 + 32 * cgp;
#pragma unroll
        for (int i = 0; i < 32; ++i) { const float y = (g[i] - mu) * rstd * lng[i] + lnb[i]; Vt[(32 * cgp + i) * SG_ST + q] = to_bf1(y); }
    }
    __syncthreads();
    {
        const int prow = 16 * w + l15;
        const bf16_t* wsp = (const bf16_t*)(p.ws + WS_WSP) + ((size_t)(l * 4 + h) * 128 + prow) * 128 + 8 * q4;
        bf16x8 wf[4];
#pragma unroll
        for (int kb = 0; kb < 4; ++kb) wf[kb] = *(const bf16x8*)(wsp + 32 * kb);
        const float bs = p.in[15][(l * 4 + h) * 128 + prow];
        const bf16_t* up = P + PIX(rowbase + prow, 2560 + 128 * h + 4 * q4);
        bf16_t* op = O + (size_t)(rowbase + prow) * D + 512 + 128 * h + 4 * q4;
        u32x2 uall[8];
#pragma unroll
        for (int mt = 0; mt < 8; ++mt) uall[mt] = *(const u32x2*)(up + 16 * mt);
#pragma unroll
        for (int mt = 0; mt < 8; ++mt) {
            f32x4 acc = (f32x4){0.f, 0.f, 0.f, 0.f};
#pragma unroll
            for (int kb = 0; kb < 4; ++kb) { const bf16x8 af = *(const LAS bf16x8*)(Vt + (16 * mt + l15) * SG_ST + 32 * kb + 8 * q4);
                acc = __builtin_amdgcn_mfma_f32_16x16x32_bf16(af, wf[kb], acc, 0, 0, 0); }
            const u32x2 uu = uall[mt];
            const float u0 = gelu_f(bf_lo(uu.x)), u1 = gelu_f(bf_hi(uu.x)), u2 = gelu_f(bf_lo(uu.y)), u3 = gelu_f(bf_hi(uu.y));
            u32x2 wv; wv.x = pk_bf16(u0 * (acc[0] + bs), u1 * (acc[1] + bs)); wv.y = pk_bf16(u2 * (acc[2] + bs), u3 * (acc[3] + bs));
            *(u32x2*)(op + 16 * mt) = wv;
        }
    }
    __syncthreads();
}

constexpr int SGU_IN_M2 = 1088;
__device__ void phase_mixer(const Params& p, int l, LAS unsigned char* lds) {
    const int G = gridDim.x, bid = blockIdx.x;
    const int ntile = (l == 0) ? (NROW / 128) * 4 : (NLAT / 128) * 4;
    if (G > 128) {
        if (bid < 128) scan_chain(p, l, (bid >> 4) * 8 + (bid & 7), (bid >> 3) & 1, lds);
        else for (int t = bid - 128; t < (ntile < SGU_IN_M2 ? ntile : SGU_IN_M2); t += G - 128) sgu_tile(p, l, t, lds);
    } else {
        for (int c = bid; c < 128; c += G) { scan_chain(p, l, c >> 1, c & 1, lds); __syncthreads(); }
        for (int t = bid; t < ntile; t += G) sgu_tile(p, l, t, lds);
    }
}

__device__ void phase_combine(const Params& p, int l, int nrows) {
    const int tid_ = opaque_tid(); const int wave = tid_ >> 6, lane = tid_ & 63, hd = lane >> 4, v0 = (lane & 15) * 8;
    const bf16_t* P = (const bf16_t*)(p.ws + WS_BIG);
    const bf16_t* OF = (const bf16_t*)(p.ws + WS_OFB); const bf16_t* OB = OF + (size_t)NROW * 512;
    bf16_t* O = (bf16_t*)(p.ws + WS_H);
    const float* gn = p.in[11] + l * 512 + hd * 128 + v0;
    const f32x4 g0 = *(const f32x4*)gn, g1 = *(const f32x4*)(gn + 4);
    for (int row0 = (blockIdx.x * 8 + wave) * 4; row0 < nrows; row0 += gridDim.x * 32) {
        u32x4 a[4], bq[4], gg[4];
#pragma unroll
        for (int u = 0; u < 4; ++u) { const size_t row = row0 + u;
            a[u] = *(const u32x4*)(OF + (size_t)hd * PSLOT + row * 128 + v0); bq[u] = *(const u32x4*)(OB + (size_t)hd * PSLOT + row * 128 + v0);
            gg[u] = *(const u32x4*)(P + PIX((int)row, 2048 + hd * 128 + v0)); }
#pragma unroll
        for (int u = 0; u < 4; ++u) {
            float s[8]; float ss = 0.f;
#pragma unroll
            for (int j = 0; j < 4; ++j) { s[2 * j] = bf_lo(a[u][j]) + bf_lo(bq[u][j]); s[2 * j + 1] = bf_hi(a[u][j]) + bf_hi(bq[u][j]); ss += s[2 * j] * s[2 * j] + s[2 * j + 1] * s[2 * j + 1]; }
#pragma unroll
            for (int o = 8; o > 0; o >>= 1) ss += __shfl_xor(ss, o);
            const float rs = rsqrtf(ss * (1.0f / 128.f) + EPS);
            float y[8];
#pragma unroll
            for (int j = 0; j < 4; ++j) { y[2 * j] = s[2 * j] * rs * (j < 2 ? g0[2 * j] : g1[2 * j - 4]) * silu_f(bf_lo(gg[u][j])); y[2 * j + 1] = s[2 * j + 1] * rs * (j < 2 ? g0[2 * j + 1] : g1[2 * j - 3]) * silu_f(bf_hi(gg[u][j])); }
            u32x4 wv; wv.x = pk_bf16(y[0], y[1]); wv.y = pk_bf16(y[2], y[3]); wv.z = pk_bf16(y[4], y[5]); wv.w = pk_bf16(y[6], y[7]);
            *(u32x4*)(O + (size_t)(row0 + u) * D + hd * 128 + v0) = wv;
        }
    }
}

__device__ void phase_conv(const Params& p, int l, int nrows) {
    bf16_t* Aup = (bf16_t*)(p.ws + WS_BIG); const bf16_t* Gup = Aup + (size_t)NROW * FF;
    const float* cw = p.in[18] + (size_t)l * 9 * FF; const float* cb = p.in[19] + (size_t)l * FF;
    const int tid_ = opaque_tid();
    const long total = (long)(nrows / 16) * 352;
    for (long id0 = (long)blockIdx.x * 512 + tid_; id0 < total; id0 += (long)gridDim.x * 512) {
        const int seg = (int)((total - 1 - id0) / 352), f0 = (int)(id0 % 352) * 8;
        const int tok0 = seg * 16;
        int c0, W; bool up, dn;
        if (tok0 < NLAT) { const int t = tok0 & 4095, r = t >> 6; c0 = t & 63; W = 64; up = r > 0; dn = r < 63; }
        else { c0 = (tok0 - NLAT) & 255; W = 256; up = false; dn = false; }
        float tp[9][8]; float bias[8];
#pragma unroll
        for (int k = 0; k < 9; ++k) { const f32x4 t0 = *(const f32x4*)(cw + k * FF + f0), t1 = *(const f32x4*)(cw + k * FF + f0 + 4);
            tp[k][0] = t0[0]; tp[k][1] = t0[1]; tp[k][2] = t0[2]; tp[k][3] = t0[3]; tp[k][4] = t1[0]; tp[k][5] = t1[1]; tp[k][6] = t1[2]; tp[k][7] = t1[3]; }
        { const f32x4 b0 = *(const f32x4*)(cb + f0), b1 = *(const f32x4*)(cb + f0 + 4); bias[0] = b0[0]; bias[1] = b0[1]; bias[2] = b0[2]; bias[3] = b0[3]; bias[4] = b1[0]; bias[5] = b1[1]; bias[6] = b1[2]; bias[7] = b1[3]; }
        const u32x4 zero = (u32x4){0u, 0u, 0u, 0u};
        const bf16_t* gp = Gup + (size_t)tok0 * FF + f0;
        u32x4 L[3], M[3], R[3];
        { const bool v = c0 > 0;
          L[0] = (v && up) ? *(const u32x4*)(gp - (size_t)65 * FF) : zero; L[1] = v ? *(const u32x4*)(gp - (size_t)FF) : zero; L[2] = (v && dn) ? *(const u32x4*)(gp + (size_t)63 * FF) : zero; }
        M[0] = up ? *(const u32x4*)(gp - (size_t)64 * FF) : zero; M[1] = *(const u32x4*)gp; M[2] = dn ? *(const u32x4*)(gp + (size_t)64 * FF) : zero;
#pragma unroll 8
        for (int i = 0; i < 16; ++i) {
            const bf16_t* np = gp + (size_t)(i + 1) * FF;
            const bool v = (c0 + i + 1) < W;
            R[0] = (v && up) ? *(const u32x4*)(np - (size_t)64 * FF) : zero; R[1] = v ? *(const u32x4*)np : zero; R[2] = (v && dn) ? *(const u32x4*)(np + (size_t)64 * FF) : zero;
            float acc[8];
#pragma unroll
            for (int j = 0; j < 8; ++j) acc[j] = bias[j];
#pragma unroll
            for (int rr = 0; rr < 3; ++rr) {
#pragma unroll
                for (int j = 0; j < 4; ++j) {
                    acc[2 * j] += bf_lo(L[rr][j]) * tp[rr * 3 + 0][2 * j] + bf_lo(M[rr][j]) * tp[rr * 3 + 1][2 * j] + bf_lo(R[rr][j]) * tp[rr * 3 + 2][2 * j];
                    acc[2 * j + 1] += bf_hi(L[rr][j]) * tp[rr * 3 + 0][2 * j + 1] + bf_hi(M[rr][j]) * tp[rr * 3 + 1][2 * j + 1] + bf_hi(R[rr][j]) * tp[rr * 3 + 2][2 * j + 1];
                }
            }
            bf16_t* ap = Aup + (size_t)(tok0 + i) * FF + f0;
            const u32x4 av = *(const u32x4*)ap;
            u32x4 wv;
#pragma unroll
            for (int j = 0; j < 4; ++j) wv[j] = pk_bf16(bf_lo(av[j]) * gelu_f(acc[2 * j]), bf_hi(av[j]) * gelu_f(acc[2 * j + 1]));
            *(u32x4*)ap = wv;
#pragma unroll
            for (int rr = 0; rr < 3; ++rr) { L[rr] = M[rr]; M[rr] = R[rr]; }
        }
    }
}

#define XB_TMO      128
#define XB_XCNT(j)  (256  + 64 * (j))
#define XB_XSUB(j)  (1280 + 64 * (j))
#define XB_XGEN(j)  (2304 + 64 * (j))
#define XB_TOP      3328
#define XB_TOPGEN   3392
#define XCD_BAR_WORDS 3456
#define XB_SPIN_CAP (1u << 20)
__device__ __forceinline__ unsigned xb_ld(unsigned* p)              { return __hip_atomic_load(p, __ATOMIC_RELAXED, __HIP_MEMORY_SCOPE_AGENT); }
__device__ __forceinline__ unsigned xb_add(unsigned* p, unsigned v) { return __hip_atomic_fetch_add(p, v, __ATOMIC_RELAXED, __HIP_MEMORY_SCOPE_AGENT); }
__device__ __forceinline__ unsigned xb_xcc_id() { return (unsigned)__builtin_amdgcn_s_getreg((3 << 11) | 20) & 0xFu; }
#define XB_SPIN(cond, bar) do { unsigned _sp = 0; while (cond) { __builtin_amdgcn_s_sleep(1); \
    if ((++_sp & 255u) == 0u) { if (xb_ld(&(bar)[XB_TMO])) break; if (_sp > XB_SPIN_CAP) { atomicAdd(&(bar)[XB_TMO], 1u); break; } } } } while (0)
struct XcdBarrier { unsigned* bar; unsigned x; volatile LAS unsigned* st; };
__device__ __forceinline__ XcdBarrier xcd_barrier_post(unsigned* bar, volatile LAS unsigned* st) {
    XcdBarrier b; b.bar = bar; b.x = xb_xcc_id(); b.st = st;
    if (threadIdx.x == 0) (void)xb_add(&bar[XB_XCNT(b.x)], 1u);
    return b;
}
__device__ __forceinline__ void xcd_barrier_complete(unsigned* bar, unsigned x, unsigned& nloc, unsigned& nx) {
    const unsigned G = gridDim.x * gridDim.y * gridDim.z;
    unsigned sum, cnt, mine, sp = 0u;
    for (;;) {
        sum = 0u; cnt = 0u; mine = 0u;
#pragma unroll
        for (unsigned j = 0; j < 16; ++j) { const unsigned c = xb_ld(&bar[XB_XCNT(j)]); sum += c; cnt += (c > 0u) ? 1u : 0u; mine = (j == x) ? c : mine; }
        if (sum == G) break;
        __builtin_amdgcn_s_sleep(1);
        if ((++sp & 255u) == 0u) { if (xb_ld(&bar[XB_TMO])) break; if (sp > XB_SPIN_CAP) { atomicAdd(&bar[XB_TMO], 1u); break; } }
    }
    nloc = mine > 0u ? mine : 1u; nx = cnt > 0u ? cnt : 1u;
}
__device__ __forceinline__ void xcd_barrier(const XcdBarrier& b) {
    asm volatile("s_waitcnt vmcnt(0)" ::: "memory");
    __syncthreads();
    if (threadIdx.x == 0) {
        unsigned* bar = b.bar;
        __builtin_amdgcn_s_waitcnt(0);
        unsigned nloc = b.st[0], nx = b.st[1];
        if (nloc == 0u) { xcd_barrier_complete(bar, b.x, nloc, nx); b.st[0] = nloc; b.st[1] = nx; }
        const unsigned old = xb_add(&bar[XB_XSUB(b.x)], 1u);
        const unsigned gen = old / nloc;
        if (old + 1u == (gen + 1u) * nloc) {
            __builtin_amdgcn_fence(__ATOMIC_RELEASE, "agent");
            asm volatile("s_waitcnt vmcnt(0)" ::: "memory");
            const unsigned og = xb_add(&bar[XB_TOP], 1u);
            const unsigned tg = og / nx;
            if (og + 1u == (tg + 1u) * nx) xb_add(&bar[XB_TOPGEN], 1u);
            else XB_SPIN(xb_ld(&bar[XB_TOPGEN]) == tg, bar);
            __builtin_amdgcn_fence(__ATOMIC_ACQUIRE, "agent");
            xb_add(&bar[XB_XGEN(b.x)], 1u);
            asm volatile("s_waitcnt vmcnt(0)" ::: "memory");
        } else {
            XB_SPIN(xb_ld(&bar[XB_XGEN(b.x)]) == gen, bar);
            __builtin_amdgcn_fence(__ATOMIC_ACQUIRE, "agent");
            asm volatile("s_waitcnt vmcnt(0)" ::: "memory");
        }
    }
    __syncthreads();
}

__global__ void __launch_bounds__(512, 2) fwd_megakernel(Params p) {
    extern __shared__ __attribute__((aligned(16))) unsigned char shm[];
    LAS unsigned char* lds = (LAS unsigned char*)shm;
    cg::grid_group grid = cg::this_grid();
    __shared__ uint4 xb_words;
    if (threadIdx.x == 0) xb_words = make_uint4(0u, 0u, 0u, 0u);
    __syncthreads();
    const XcdBarrier xb = xcd_barrier_post((unsigned*)(p.ws + WS_BAR), (volatile LAS unsigned*)&xb_words);
    const int G = gridDim.x, bid = blockIdx.x;
    float* XC = (float*)(p.ws + WS_XC);
    bf16_t* H = (bf16_t*)(p.ws + WS_H);
    bf16_t* BIG = (bf16_t*)(p.ws + WS_BIG);
    const float* ADA = (const float*)(p.ws + WS_ADA);
    bf16_t* Y2 = BIG + (size_t)NROW * FF;

    phase_prep(p, lds);
    if (p.ws == nullptr) grid.sync();
    xcd_barrier(xb);
    for (int l = 0; l < DEPTH; ++l) {
        const bool last = (l == DEPTH - 1);
        const float* ada_l = ADA + (size_t)l * 9 * 6144;
        const float* xl = (l == 0) ? p.in[0] : p.out;
        const float* xc = (l == 0) ? p.in[2] : XC;
        const int Mfull = last ? NLAT : NROW;
        if (l == 0) phase_norm(xl, xc, nullptr, nullptr, nullptr, nullptr, p.in[6] + l * D, ada_l, 0, NROW, H);
        else phase_norm(p.out, XC, Y2, ADA + (size_t)(l - 1) * 9 * 6144 + 5 * 1024, p.out, nullptr, p.in[6] + l * D, ada_l, 0, NROW, H);
        xcd_barrier(xb);
        { pg8::StaticOrder S; S.init(NROW, PW, G, bid);
          pg8::EpiBf16 E{BIG, PW, 0, 0, PSLOT};
          pg8::gemm_phase(lds, pg8::Gemm{H, (const bf16_t*)(p.ws + WS_WIN) + (size_t)l * PW * D, NROW, PW, D}, S, E); }
        xcd_barrier(xb);
        { const int ntile = (l == 0) ? (NROW / 128) * 4 : (NLAT / 128) * 4;
          const int nextra = (G > 128 && ntile > SGU_IN_M2) ? ntile - SGU_IN_M2 : 0;
          for (int it = bid; it < 32 * NCH + nextra; it += G) { if (it < 32 * NCH) prep_item(p, l, 32 * NCH - 1 - it, lds); else sgu_tile(p, l, SGU_IN_M2 + it - 32 * NCH, lds); } }
        xcd_barrier(xb);
        phase_mixer(p, l, lds);
        xcd_barrier(xb);
        phase_combine(p, l, Mfull);
        xcd_barrier(xb);
        { pg8::StaticOrder S; S.init(Mfull, D, G, bid);
          pg8::EpiBf16 E{BIG, D, 0, 0, 0};
          pg8::gemm_phase(lds, pg8::Gemm{H, (const bf16_t*)(p.ws + WS_WOUT) + (size_t)l * D * D, Mfull, D, D}, S, E); }
        xcd_barrier(xb);
        phase_norm(xl, xc, BIG, ada_l + 2 * 1024, p.out, XC, p.in[7] + l * D, ada_l, 3, Mfull, H);
        xcd_barrier(xb);
        { pg8::StaticOrder S; S.init(Mfull, UPW, G, bid);
          pg8::EpiBf16 E{BIG, FF, FF, (size_t)NROW * FF, 0};
          pg8::gemm_phase(lds, pg8::Gemm{H, (const bf16_t*)(p.ws + WS_WUP) + (size_t)l * UPW * D, Mfull, UPW, D}, S, E); }
        xcd_barrier(xb);
        phase_conv(p, l, Mfull);
        xcd_barrier(xb);
        { pg8::StaticOrder S; S.init(Mfull, D, G, bid);
          pg8::EpiBf16 E{Y2, D, 0, 0, 0};
          pg8::gemm_phase(lds, pg8::Gemm{BIG, (const bf16_t*)(p.ws + WS_WDOWN) + (size_t)l * D * FF, Mfull, D, FF}, S, E); }
        xcd_barrier(xb);
    }
    phase_final(p.out, Y2, ADA + (size_t)(DEPTH - 1) * 9 * 6144 + 5 * 1024, p.in[21]);
}

extern "C" void kernel_launch(void* const* d_in, const int* in_sizes, int n_in, void* d_out, int out_size, void* d_ws, size_t ws_size, hipStream_t stream) {
    constexpr int LDS_BYTES = 155648;
    static int grid_blocks = 0;
    if (!grid_blocks) {
        int dev = 0, cus = 0, per_cu = 0;
        (void)hipGetDevice(&dev);
        (void)hipDeviceGetAttribute(&cus, hipDeviceAttributeMultiprocessorCount, dev);
        (void)hipFuncSetAttribute((const void*)fwd_megakernel, hipFuncAttributeMaxDynamicSharedMemorySize, LDS_BYTES);
        (void)hipOccupancyMaxActiveBlocksPerMultiprocessor(&per_cu, (const void*)fwd_megakernel, 512, LDS_BYTES);
        if (per_cu < 1) per_cu = 1;
        grid_blocks = cus * per_cu;
        if (ws_size < WS_END) fprintf(stderr, "workspace too small: %zu < %zu\n", ws_size, (size_t)WS_END);
    }
    Params p{};
    for (int i = 0; i < 22; ++i) p.in[i] = (const float*)d_in[i];
    p.out = (float*)d_out; p.ws = (unsigned char*)d_ws;
    (void)hipMemsetAsync((unsigned char*)d_ws + WS_BAR, 0, XCD_BAR_WORDS * 4, stream);
    void* args[] = {&p};
    hipError_t e = hipLaunchCooperativeKernel((const void*)fwd_megakernel, dim3(grid_blocks), dim3(512), args, LDS_BYTES, stream);
    if (e != hipSuccess) fprintf(stderr, "cooperative launch failed: %s (grid %d)\n", hipGetErrorString(e), grid_blocks);
}
```

```cpp
#include <hip/hip_runtime.h>
#include <hip/hip_cooperative_groups.h>
#include <cstdio>
namespace cg = cooperative_groups;

#define LAS __attribute__((address_space(3)))
typedef unsigned short bf16_t;
typedef short bf16x8 __attribute__((ext_vector_type(8)));
typedef float f32x4 __attribute__((ext_vector_type(4)));
typedef float f32x2 __attribute__((ext_vector_type(2)));
typedef unsigned u32x4 __attribute__((ext_vector_type(4)));
typedef unsigned u32x2 __attribute__((ext_vector_type(2)));
typedef __bf16 bf2_t __attribute__((ext_vector_type(2)));

constexpr int D = 1024, NB = 8, SEQ = 4096, DEPTH = 2, CTXL = 256;
constexpr int NLAT = NB * SEQ;
constexpr int NCTX = NB * CTXL;
constexpr int NROW = NLAT + NCTX;
constexpr int PW = 3584, FF = 2816, UPW = 2 * FF;
constexpr float EPS = 1e-6f;

constexpr size_t WS_WIN = 0;
constexpr size_t WS_WOUT = WS_WIN + (size_t)DEPTH * PW * D * 2;
constexpr size_t WS_WUP = WS_WOUT + (size_t)DEPTH * D * D * 2;
constexpr size_t WS_WDOWN = WS_WUP + (size_t)DEPTH * UPW * D * 2;
constexpr size_t WS_WSP = WS_WDOWN + (size_t)DEPTH * D * FF * 2;
constexpr size_t WS_ADA = WS_WSP + (size_t)DEPTH * 4 * 128 * 128 * 2;
constexpr size_t WS_LB = WS_ADA + (size_t)DEPTH * 9 * 6144 * 4;
constexpr size_t WS_XC = WS_LB + 2 * 512 * 4;
constexpr size_t WS_H = WS_XC + (size_t)NCTX * D * 4;
constexpr size_t WS_BIG = WS_H + (size_t)NROW * D * 2;
constexpr size_t WS_OFB = WS_BIG + (size_t)NROW * PW * 2;
constexpr size_t WS_QB = WS_OFB + 2 * (size_t)NROW * 512 * 2;
constexpr size_t WS_DS = WS_BIG + (size_t)NROW * UPW * 2;
constexpr size_t WS_BAR = WS_DS + (size_t)64 * 136 * 128 * 4;
constexpr size_t WS_END = WS_BAR + 16384;

constexpr size_t PSLOT = (size_t)NROW * 128;
__device__ __forceinline__ size_t PIX(int row, int col) { return (size_t)(col >> 7) * PSLOT + (size_t)row * 128 + (col & 127); }
struct Params {
    const float* in[22];
    float* out;
    unsigned char* ws;
};

__device__ __forceinline__ unsigned pk_bf16(float a, float b) { f32x2 v = {a, b}; bf2_t r = __builtin_convertvector(v, bf2_t); return __builtin_bit_cast(unsigned, r); }
__device__ __forceinline__ float bf_lo(unsigned u) { return __uint_as_float(u << 16); }
__device__ __forceinline__ float bf_hi(unsigned u) { return __uint_as_float(u & 0xffff0000u); }
__device__ __forceinline__ float bf1(bf16_t u) { return __uint_as_float(((unsigned)u) << 16); }
__device__ __forceinline__ bf16_t to_bf1(float a) { return (bf16_t)(pk_bf16(a, 0.f) & 0xffffu); }
__device__ __forceinline__ float fast_rcp(float x) { return __builtin_amdgcn_rcpf(x); }
__device__ __forceinline__ float gelu_f(float v) {
    const float av = fabsf(v), t = fast_rcp(av * 0.2316418882f + 1.0f);
    float q = t * 0.5307027145f + (-0.7265760135f); q = q * t + 0.7107068705f; q = q * t + (-0.142248368f); q = q * t + 0.127414796f; q = q * t;
    const float e = __builtin_amdgcn_exp2f((v * v) * (-0.72134752044f));
    const float m = v * (q * e);
    return v < 0.f ? m : v - m;
}
__device__ __forceinline__ int opaque_tid() { int t = threadIdx.x; asm volatile("" : "+v"(t)); return t; }
__device__ __forceinline__ float silu_f(float x) { return x * fast_rcp(1.0f + __expf(-x)); }

namespace pg8 {
constexpr int BM = 256, BK = 64, HALF = 128, HTB = HALF * BK * 2, STAGE_BYTES = 8 * HTB, NXCD = 8, WGM = 8;
__host__ __device__ __forceinline__ int lds_byte(int r, int c) { const int st = (r >> 4) * 2 + (c >> 5), rr = r & 15, cc = c & 31, ob = rr * 64 + cc * 2; return st * 1024 + (ob ^ (((ob >> 9) & 1) << 5)); }
__host__ __device__ __forceinline__ void stage_rc(int b, int& R, int& C) { const int st = b / 1024, sb = b % 1024, swz = sb ^ (((sb >> 9) & 1) << 5); R = (st >> 1) * 16 + swz / 64; C = (st & 1) * 32 + (swz % 64) / 2; }
__host__ __device__ __forceinline__ int perm32(int rho) { const int n = rho >> 4, i = rho & 15; return 8 * (i >> 2) + 4 * n + (i & 3); }
struct Unit { int pm, pn; };
struct Gemm { const bf16_t* A; const bf16_t* Bt; int M, N, K; };
struct StaticOrder {
    int nM, nN, nwg, G, c;
    __device__ void init(int M, int N, int G_, int c_) { nM = M / BM; nN = N / BM; nwg = nM * nN; G = G_; c = c_; }
    __device__ bool next(int i, Unit& u) const {
        const long L = (long)i * G + c; if (L >= nwg) return false;
        int wgid = (int)L; { const int q = nwg / NXCD, r = nwg % NXCD, xcd = wgid % NXCD, off = wgid / NXCD; wgid = (xcd < r ? xcd * (q + 1) : r * (q + 1) + (xcd - r) * q) + off; }
        const int nig = WGM * nN, gid = wgid / nig, fm = gid * WGM, gsz = (nM - fm) < WGM ? (nM - fm) : WGM;
        u.pm = fm + ((wgid % nig) % gsz); u.pn = (wgid % nig) / gsz; return true;
    }
    __device__ __forceinline__ void a_ready(const Unit&) const {}
    __device__ __forceinline__ void done(const Unit&) const {}
};
struct EpiBf16 {
    static constexpr bool PERM = true;
    bf16_t* O; int ldc; int split_cols; size_t split_stride; size_t slot_stride;
    __device__ __forceinline__ void operator()(const f32x4 (&acc)[2][2][4][2], const Unit& u, int wr, int wc, int fr, int fq) const {
        const int row0 = u.pm * BM + wr * 64 + fr; int colt = u.pn * BM; bf16_t* base = O;
        if (split_cols) { const int t = colt / split_cols; base += (size_t)t * split_stride; colt -= t * split_cols; }
        const int col0 = colt + wc * 32 + 8 * fq;
#pragma unroll
        for (int ai = 0; ai < 2; ++ai)
#pragma unroll
            for (int m = 0; m < 4; ++m) { const int row = row0 + ai * HALF + m * 16;
                bf16_t* rowp = slot_stride ? base + (size_t)(colt >> 7) * slot_stride + (size_t)row * 128 + wc * 32 + 8 * fq : base + (size_t)row * ldc + col0;
#pragma unroll
                for (int bj = 0; bj < 2; ++bj) { const f32x4 v0 = acc[ai][bj][m][0], v1 = acc[ai][bj][m][1];
                    u32x4 w; w.x = pk_bf16(v0[0], v0[1]); w.y = pk_bf16(v0[2], v0[3]); w.z = pk_bf16(v1[0], v1[1]); w.w = pk_bf16(v1[2], v1[3]);
                    *(u32x4*)(rowp + (slot_stride ? (size_t)bj * slot_stride : (size_t)bj * HALF)) = w; } }
    }
};
struct EpiRes {
    static constexpr bool PERM = false;
    const float* resL; float* outL; const float* resC; float* outC; const float* gate;
    __device__ __forceinline__ void operator()(const f32x4 (&acc)[2][2][4][2], const Unit& u, int wr, int wc, int fr, int fq) const {
        const float* res; float* out; const float* g; int rowb;
        if (u.pm < NLAT / BM) { res = resL; out = outL; g = gate + (size_t)(u.pm >> 4) * 6144; rowb = u.pm * BM; }
        else { res = resC; out = outC; g = gate + (size_t)8 * 6144; rowb = u.pm * BM - NLAT; }
        const int row0 = rowb + wr * 64 + fr, col0 = u.pn * BM + wc * 32 + 4 * fq;
        f32x4 gv[2][2];
#pragma unroll
        for (int bj = 0; bj < 2; ++bj)
#pragma unroll
            for (int n = 0; n < 2; ++n) gv[bj][n] = *(const f32x4*)(g + col0 + bj * HALF + n * 16);
#pragma unroll
        for (int ai = 0; ai < 2; ++ai)
#pragma unroll
            for (int m = 0; m < 4; ++m) { const size_t ro = (size_t)(row0 + ai * HALF + m * 16) * D + col0;
#pragma unroll
                for (int bj = 0; bj < 2; ++bj)
#pragma unroll
                    for (int n = 0; n < 2; ++n) { const f32x4 r = *(const f32x4*)(res + ro + bj * HALF + n * 16);
                        *(f32x4*)(out + ro + bj * HALF + n * 16) = r + gv[bj][n] * acc[ai][bj][m][n]; } }
    }
};

template <class Epi, class Sched>
__device__ __forceinline__ void gemm_phase(LAS unsigned char* lds, const Gemm g, const Sched& S, const Epi& E) {
    const int tid = opaque_tid(), wid = __builtin_amdgcn_readfirstlane(tid >> 6), lane = tid & 63, wr = wid >> 2, wc = wid & 3, fr = lane & 15, fq = lane >> 4;
    const int K = g.K, nt = K / BK;
    unsigned voffA[2], voffB[2];
#pragma unroll
    for (int i = 0; i < 2; ++i) { int R, C; stage_rc(tid * 16 + i * 8192, R, C); const int Rb = Epi::PERM ? ((R & ~31) + perm32(R & 31)) : R;
        voffA[i] = (unsigned)(R * K + C) * 2u; voffB[i] = (unsigned)(Rb * K + C) * 2u; }
    const size_t kstep = (size_t)(BK * 2);
    const size_t hstep = (size_t)HALF * K * 2;
    const size_t tstep = 2 * hstep;
    const unsigned ldsw = (unsigned)wid * 1024u;
    const int aoff = lds_byte(wr * 64 + fr, fq * 8), boff = lds_byte(wc * 32 + fr, fq * 8);
#define PG8_SA(b, h) (((b) * 2 + (h)) * HTB)
#define PG8_SB(b, h) ((4 + (b) * 2 + (h)) * HTB)
#define PG8_STAGE(bufoff, gbase, voff) do { _Pragma("unroll") for (int _i = 0; _i < 2; ++_i) \
        __builtin_amdgcn_global_load_lds((const unsigned*)((const char*)(gbase) + (voff)[_i]), (LAS unsigned*)(lds + (bufoff) + ldsw + _i * 8192), 16, 0, 0); } while (0)
#define PG8_LDA(dst, b, h) do { _Pragma("unroll") for (int m = 0; m < 4; ++m) _Pragma("unroll") for (int k = 0; k < 2; ++k) dst[m][k] = *(const LAS bf16x8*)(lds + PG8_SA(b, h) + aoff + m * 2048 + k * 1024); } while (0)
#define PG8_LDB(dst, b, h) do { _Pragma("unroll") for (int n = 0; n < 2; ++n) _Pragma("unroll") for (int k = 0; k < 2; ++k) dst[n][k] = *(const LAS bf16x8*)(lds + PG8_SB(b, h) + boff + n * 2048 + k * 1024); } while (0)
#define PG8_MMA(ai, bj, At, Bt) do { __builtin_amdgcn_s_setprio(1); _Pragma("unroll") for (int m = 0; m < 4; ++m) _Pragma("unroll") for (int n = 0; n < 2; ++n) _Pragma("unroll") for (int k = 0; k < 2; ++k) \
        acc[ai][bj][m][n] = __builtin_amdgcn_mfma_f32_16x16x32_bf16(Bt[n][k], At[m][k], acc[ai][bj][m][n], 0, 0, 0); __builtin_amdgcn_s_setprio(0); } while (0)
#define PG8_WAIT_V(n) asm volatile("s_waitcnt vmcnt(" #n ")" ::: "memory")
#define PG8_WAIT_L(n) asm volatile("s_waitcnt lgkmcnt(" #n ")" ::: "memory")
#define PG8_BAR __builtin_amdgcn_s_barrier()
#define PG8_SCHED __builtin_amdgcn_sched_barrier(0)
    Unit cur, nxt; int ui = 0;
    if (!S.next(0, cur)) return;
    f32x4 acc[2][2][4][2];
#pragma unroll
    for (int a = 0; a < 2; ++a)
#pragma unroll
        for (int b = 0; b < 2; ++b)
#pragma unroll
            for (int m = 0; m < 4; ++m)
#pragma unroll
                for (int n = 0; n < 2; ++n) acc[a][b][m][n] = (f32x4){0.f, 0.f, 0.f, 0.f};
    bf16x8 At[4][2], B0[2][2], B1[2][2];
    const char* cA = (const char*)g.A + (size_t)cur.pm * tstep; const char* cB = (const char*)g.Bt + (size_t)cur.pn * tstep;
    S.a_ready(cur);
    PG8_STAGE(PG8_SB(0, 0), cB, voffB); PG8_STAGE(PG8_SA(0, 0), cA, voffA); PG8_STAGE(PG8_SB(0, 1), cB + hstep, voffB); PG8_STAGE(PG8_SA(0, 1), cA + hstep, voffA);
    if (wr == 1) PG8_BAR;
    PG8_WAIT_V(4); PG8_BAR;
    PG8_STAGE(PG8_SB(1, 0), cB + kstep, voffB); PG8_STAGE(PG8_SA(1, 0), cA + kstep, voffA); PG8_STAGE(PG8_SB(1, 1), cB + hstep + kstep, voffB);
    PG8_WAIT_V(6); PG8_BAR;
    for (;;) {
        const bool has_next = S.next(ui + 1, nxt);
        const char* nA = has_next ? (const char*)g.A + (size_t)nxt.pm * tstep : cA; const char* nB = has_next ? (const char*)g.Bt + (size_t)nxt.pn * tstep : cB;
        for (int t = 0; t < nt; t += 2) {
            const bool last = (t == nt - 2);
            const char* a1 = cA + (size_t)(t + 1) * kstep;
            const char* a2 = last ? nA : cA + (size_t)(t + 2) * kstep; const char* b2 = last ? nB : cB + (size_t)(t + 2) * kstep;
            const char* a3 = a2 + kstep; const char* b3 = b2 + kstep;
            if (last && has_next) S.a_ready(nxt);
            PG8_LDB(B0, 0, 0); PG8_SCHED; PG8_LDA(At, 0, 0); PG8_STAGE(PG8_SA(1, 1), a1 + hstep, voffA);
            PG8_WAIT_L(8); PG8_BAR; PG8_WAIT_L(0); PG8_MMA(0, 0, At, B0); PG8_BAR; PG8_SCHED;
            PG8_LDB(B1, 0, 1); PG8_STAGE(PG8_SB(0, 0), b2, voffB);
            PG8_BAR; PG8_WAIT_L(0); PG8_MMA(0, 1, At, B1); PG8_BAR;
            PG8_LDA(At, 0, 1); PG8_STAGE(PG8_SA(0, 0), a2, voffA);
            PG8_BAR; PG8_WAIT_L(0); PG8_MMA(1, 0, At, B0); PG8_BAR; PG8_SCHED;
            PG8_STAGE(PG8_SB(0, 1), b2 + hstep, voffB);
            PG8_WAIT_V(6); PG8_BAR; PG8_MMA(1, 1, At, B1); PG8_BAR;
            PG8_LDB(B0, 1, 0); PG8_SCHED; PG8_LDA(At, 1, 0); PG8_STAGE(PG8_SA(0, 1), a2 + hstep, voffA);
            PG8_WAIT_L(8); PG8_BAR; PG8_WAIT_L(0); PG8_MMA(0, 0, At, B0); PG8_BAR; PG8_SCHED;
            PG8_LDB(B1, 1, 1); PG8_STAGE(PG8_SB(1, 0), b3, voffB);
            PG8_BAR; PG8_WAIT_L(0); PG8_MMA(0, 1, At, B1); PG8_BAR;
            PG8_LDA(At, 1, 1); PG8_STAGE(PG8_SA(1, 0), a3, voffA);
            PG8_BAR; PG8_WAIT_L(0); PG8_MMA(1, 0, At, B0); PG8_BAR; PG8_SCHED;
            PG8_STAGE(PG8_SB(1, 1), b3 + hstep, voffB);
            PG8_WAIT_V(6); PG8_BAR; PG8_MMA(1, 1, At, B1); PG8_BAR;
        }
        E(acc, cur, wr, wc, fr, fq); S.done(cur);
        if (!has_next) break;
#pragma unroll
        for (int a = 0; a < 2; ++a)
#pragma unroll
            for (int b = 0; b < 2; ++b)
#pragma unroll
                for (int m = 0; m < 4; ++m)
#pragma unroll
                    for (int n = 0; n < 2; ++n) acc[a][b][m][n] = (f32x4){0.f, 0.f, 0.f, 0.f};
        cur = nxt; cA = nA; cB = nB; ++ui;
    }
    PG8_WAIT_V(0);
    if (wr == 0) PG8_BAR;
    PG8_BAR;
#undef PG8_SA
#undef PG8_SB
#undef PG8_STAGE
#undef PG8_LDA
#undef PG8_LDB
#undef PG8_MMA
#undef PG8_WAIT_V
#undef PG8_WAIT_L
#undef PG8_BAR
#undef PG8_SCHED
}
}

__device__ void phase_prep(const Params& p, LAS unsigned char* lds) {
    const int tid = opaque_tid();
    constexpr int NT_L = 896 + 256 + 1408 + 704;
    constexpr int J_ADA = 192, J_TR = J_ADA + 2 * NT_L, J_WSP = J_TR + 32, J_LB = J_WSP + 1;
    for (int job = blockIdx.x; job < J_LB; job += gridDim.x) {
        if (job < J_ADA) {
            LAS float* s = (LAS float*)lds;
            LAS float* red = (LAS float*)(lds + 9 * 1024 * 4);
            { float vv[18];
#pragma unroll
              for (int u = 0; u < 18; ++u) { const int i = tid + 512 * u, r = i >> 10, d = i & 1023; vv[u] = r < 8 ? p.in[1][r * 1024 + d] : p.in[3][d]; }
#pragma unroll
              for (int u = 0; u < 18; ++u) s[tid + 512 * u] = silu_f(vv[u]); }
            __syncthreads();
            const int l = job / 96, e0 = (job % 96) * 64, col = tid & 63, dg = tid >> 6;
            const float* w = p.in[4] + ((size_t)l * 1024 + dg * 128) * 6144 + e0 + col;
            float acc[9];
#pragma unroll
            for (int r = 0; r < 9; ++r) acc[r] = 0.f;
            for (int dd = 0; dd < 128; ++dd) { const float wv = w[(size_t)dd * 6144];
#pragma unroll
                for (int r = 0; r < 9; ++r) acc[r] += s[r * 1024 + dg * 128 + dd] * wv; }
#pragma unroll
            for (int r = 0; r < 9; ++r) red[(dg * 9 + r) * 64 + col] = acc[r];
            __syncthreads();
            for (int i = tid; i < 9 * 64; i += 512) { const int r = i >> 6, c = i & 63; float a = 0.f;
#pragma unroll
                for (int g = 0; g < 8; ++g) a += red[(g * 9 + r) * 64 + c];
                ((float*)(p.ws + WS_ADA))[((size_t)l * 9 + r) * 6144 + e0 + c] = a + p.in[5][l * 6144 + e0 + c]; }
            __syncthreads();
        } else if (job < J_TR) {
            const int j = job - J_ADA, l = j / NT_L; int r = j % NT_L;
            const float* src; bf16_t* dst; int K, N;
            if (r < 896) { src = p.in[8] + (size_t)l * D * PW; dst = (bf16_t*)(p.ws + WS_WIN) + (size_t)l * PW * D; K = D; N = PW; }
            else if (r < 1152) { r -= 896; src = p.in[16] + (size_t)l * D * D; dst = (bf16_t*)(p.ws + WS_WOUT) + (size_t)l * D * D; K = D; N = D; }
            else if (r < 2560) { r -= 1152; src = p.in[17] + (size_t)l * D * UPW; dst = (bf16_t*)(p.ws + WS_WUP) + (size_t)l * UPW * D; K = D; N = UPW; }
            else { r -= 2560; src = p.in[20] + (size_t)l * FF * D; dst = (bf16_t*)(p.ws + WS_WDOWN) + (size_t)l * D * FF; K = FF; N = D; }
            const int ntn = N >> 6, kt = r / ntn, nt = r % ntn;
            LAS float* tile = (LAS float*)lds;
            { const int kk = tid >> 3, n8 = (tid & 7) * 8; const float* sp = src + (size_t)(kt * 64 + kk) * N + nt * 64 + n8;
              const f32x4 a = *(const f32x4*)sp, b = *(const f32x4*)(sp + 4);
              LAS float* tp = tile + kk * 65 + n8; tp[0] = a[0]; tp[1] = a[1]; tp[2] = a[2]; tp[3] = a[3]; tp[4] = b[0]; tp[5] = b[1]; tp[6] = b[2]; tp[7] = b[3]; }
            __syncthreads();
            { const int nn = tid >> 3, k8 = (tid & 7) * 8; float v[8];
#pragma unroll
              for (int i = 0; i < 8; ++i) v[i] = tile[(k8 + i) * 65 + nn];
              u32x4 w; w.x = pk_bf16(v[0], v[1]); w.y = pk_bf16(v[2], v[3]); w.z = pk_bf16(v[4], v[5]); w.w = pk_bf16(v[6], v[7]);
              *(u32x4*)(dst + (size_t)(nt * 64 + nn) * K + kt * 64 + k8) = w; }
            __syncthreads();
        } else if (job < J_WSP) {
            const int j = job - J_TR; const size_t i0 = (size_t)j * 4096 + tid * 8;
            const f32x4 a = *(const f32x4*)(p.in[14] + i0), b = *(const f32x4*)(p.in[14] + i0 + 4);
            u32x4 w; w.x = pk_bf16(a[0], a[1]); w.y = pk_bf16(a[2], a[3]); w.z = pk_bf16(b[0], b[1]); w.w = pk_bf16(b[2], b[3]);
            *(u32x4*)((bf16_t*)(p.ws + WS_WSP) + i0) = w;
        } else {
            for (int i = tid; i < 1024; i += 512) { const int dir = i >> 9, c = i & 511; const float* lg = dir ? p.in[10] : p.in[9];
                const float l0 = lg[c], l1 = lg[512 + c]; ((float*)(p.ws + WS_LB))[i] = 1.0f / (1.0f + expf(l0 - l1)); }
        }
    }
}

__device__ void phase_norm(const float* xl, const float* xc, const bf16_t* Y, const float* gate  , float* xl_dst, float* xc_dst,
                           const float* gain, const float* ada_l, int shift_idx, int nrows, bf16_t* H) {
    const int tid_ = opaque_tid(); const int wave = tid_ >> 6, lane = tid_ & 63;
    f32x4 gn[4];
#pragma unroll
    for (int j = 0; j < 4; ++j) gn[j] = *(const f32x4*)(gain + j * 256 + lane * 4);
    for (int rr = (blockIdx.x * 8 + wave) * 2; rr < nrows; rr += gridDim.x * 16) {
        const int row = nrows - 2 - rr;
        const float* src; const float* mod; float* dst; const float* gt;
        if (row < NLAT) { src = xl + (size_t)row * D; mod = ada_l + (size_t)(row >> 12) * 6144; dst = xl_dst ? xl_dst + (size_t)row * D : nullptr; gt = gate + (size_t)(row >> 12) * 6144; }
        else { src = xc + (size_t)(row - NLAT) * D; mod = ada_l + (size_t)8 * 6144; dst = xc_dst ? xc_dst + (size_t)(row - NLAT) * D : nullptr; gt = gate + (size_t)8 * 6144; }
        f32x4 v[2][4], sh[4], sc[4], gg[4]; u32x2 yv[2][4];
#pragma unroll
        for (int u = 0; u < 2; ++u)
#pragma unroll
            for (int j = 0; j < 4; ++j) { v[u][j] = __builtin_nontemporal_load((const f32x4*)(src + (size_t)u * D + j * 256 + lane * 4)); if (Y) yv[u][j] = __builtin_nontemporal_load((const u32x2*)(Y + (size_t)(row + u) * D + j * 256 + lane * 4)); }
#pragma unroll
        for (int j = 0; j < 4; ++j) { const int d = j * 256 + lane * 4; sh[j] = *(const f32x4*)(mod + shift_idx * 1024 + d); sc[j] = *(const f32x4*)(mod + (shift_idx + 1) * 1024 + d); if (Y) gg[j] = *(const f32x4*)(gt + d); }
#pragma unroll
        for (int u = 0; u < 2; ++u) {
            if (Y) {
#pragma unroll
                for (int j = 0; j < 4; ++j) {
                    v[u][j][0] += gg[j][0] * bf_lo(yv[u][j].x); v[u][j][1] += gg[j][1] * bf_hi(yv[u][j].x); v[u][j][2] += gg[j][2] * bf_lo(yv[u][j].y); v[u][j][3] += gg[j][3] * bf_hi(yv[u][j].y);
                    if (dst) __builtin_nontemporal_store(v[u][j], (f32x4*)(dst + (size_t)u * D + j * 256 + lane * 4)); }
            }
            float ss = 0.f;
#pragma unroll
            for (int j = 0; j < 4; ++j) ss += v[u][j][0] * v[u][j][0] + v[u][j][1] * v[u][j][1] + v[u][j][2] * v[u][j][2] + v[u][j][3] * v[u][j][3];
#pragma unroll
            for (int o = 32; o > 0; o >>= 1) ss += __shfl_xor(ss, o);
            const float rs = rsqrtf(ss * (1.0f / D) + EPS);
#pragma unroll
            for (int j = 0; j < 4; ++j) { const int d = j * 256 + lane * 4;
                f32x4 y = v[u][j] * rs * gn[j]; y = y * (sc[j] + 1.0f) + sh[j];
                u32x2 wv; wv.x = pk_bf16(y[0], y[1]); wv.y = pk_bf16(y[2], y[3]);
                *(u32x2*)(H + (size_t)(row + u) * D + d) = wv; }
        }
    }
}
__device__ void phase_final(float* x, const bf16_t* Y, const float* gate, const float* gain) {
    const int tid_ = opaque_tid(); const int wave = tid_ >> 6, lane = tid_ & 63;
    f32x4 gn[4];
#pragma unroll
    for (int j = 0; j < 4; ++j) gn[j] = *(const f32x4*)(gain + j * 256 + lane * 4);
    for (int row = (blockIdx.x * 8 + wave) * 2; row < NLAT; row += gridDim.x * 16) {
        const float* gt = gate + (size_t)(row >> 12) * 6144;
        f32x4 v[2][4], gg[4]; u32x2 yv[2][4];
#pragma unroll
        for (int u = 0; u < 2; ++u)
#pragma unroll
            for (int j = 0; j < 4; ++j) { v[u][j] = __builtin_nontemporal_load((const f32x4*)(x + (size_t)(row + u) * D + j * 256 + lane * 4)); yv[u][j] = __builtin_nontemporal_load((const u32x2*)(Y + (size_t)(row + u) * D + j * 256 + lane * 4)); }
#pragma unroll
        for (int j = 0; j < 4; ++j) gg[j] = *(const f32x4*)(gt + j * 256 + lane * 4);
#pragma unroll
        for (int u = 0; u < 2; ++u) {
            float ss = 0.f;
#pragma unroll
            for (int j = 0; j < 4; ++j) {
                v[u][j][0] += gg[j][0] * bf_lo(yv[u][j].x); v[u][j][1] += gg[j][1] * bf_hi(yv[u][j].x); v[u][j][2] += gg[j][2] * bf_lo(yv[u][j].y); v[u][j][3] += gg[j][3] * bf_hi(yv[u][j].y);
                ss += v[u][j][0] * v[u][j][0] + v[u][j][1] * v[u][j][1] + v[u][j][2] * v[u][j][2] + v[u][j][3] * v[u][j][3]; }
#pragma unroll
            for (int o = 32; o > 0; o >>= 1) ss += __shfl_xor(ss, o);
            const float rs = rsqrtf(ss * (1.0f / D) + EPS);
#pragma unroll
            for (int j = 0; j < 4; ++j) { const int d = j * 256 + lane * 4; __builtin_nontemporal_store(v[u][j] * rs * gn[j], (f32x4*)(x + (size_t)(row + u) * D + d)); }
        }
    }
}

constexpr int QS_ST = 136, KT_ST = 40;
constexpr int P1_QS = 0, P1_KH = P1_QS + 32 * QS_ST * 2, P1_VT = P1_KH + 32 * QS_ST * 2, P1_KT = P1_VT + 128 * KT_ST * 2, P1_AW = P1_KT + 128 * KT_ST * 2;
constexpr int P1_DIRSZ = P1_AW + 8 * 32 * KT_ST * 2;
constexpr int NCH = 8 + 128;

template <int CTRL, int RMASK> __device__ __forceinline__ float dpp_mul(float x) {
    const int t = __builtin_amdgcn_update_dpp(0x3f800000, __builtin_bit_cast(int, x), CTRL, RMASK, 0xf, false);
    return x * __builtin_bit_cast(float, t);
}
__device__ __forceinline__ float cumprod32(float x) {
    x = dpp_mul<0x111, 0xf>(x); x = dpp_mul<0x112, 0xf>(x); x = dpp_mul<0x114, 0xf>(x); x = dpp_mul<0x118, 0xf>(x);
    x = dpp_mul<0x142, 0xa>(x);
    return x;
}

#define DPP8_STEP(CTRL) asm volatile("s_nop 1\n\t" \
    "v_mul_f32_dpp %0, %0, %0 " CTRL "\n\tv_mul_f32_dpp %1, %1, %1 " CTRL "\n\tv_mul_f32_dpp %2, %2, %2 " CTRL "\n\tv_mul_f32_dpp %3, %3, %3 " CTRL "\n\t" \
    "v_mul_f32_dpp %4, %4, %4 " CTRL "\n\tv_mul_f32_dpp %5, %5, %5 " CTRL "\n\tv_mul_f32_dpp %6, %6, %6 " CTRL "\n\tv_mul_f32_dpp %7, %7, %7 " CTRL "\n\ts_nop 1" \
    : "+v"(e[0]), "+v"(e[1]), "+v"(e[2]), "+v"(e[3]), "+v"(e[4]), "+v"(e[5]), "+v"(e[6]), "+v"(e[7]))
__device__ __forceinline__ void cumprod32x8(float (&e)[8]) {
    asm volatile("s_nop 4" ::: );
    DPP8_STEP("row_shr:1 row_mask:0xf bank_mask:0xf");
    DPP8_STEP("row_shr:2 row_mask:0xf bank_mask:0xf");
    DPP8_STEP("row_shr:4 row_mask:0xf bank_mask:0xf");
    DPP8_STEP("row_shr:8 row_mask:0xf bank_mask:0xf");
    DPP8_STEP("row_bcast:15 row_mask:0xa bank_mask:0xf");
}
__device__ void prep_item(const Params& p, int l, int item, LAS unsigned char* lds) {
    const int tid = opaque_tid(), w = tid >> 6, lane = tid & 63;
    const int tau = lane & 31, kh = lane >> 5, k0 = 16 * w + 8 * kh, l15 = lane & 15, q4 = lane >> 4;
    const int ci = item % NCH, bh = item / NCH, h = bh & 3, b = bh >> 2;
    const int R0 = ci < 8 ? NLAT + b * 256 + 32 * ci : b * 4096 + 32 * (ci - 8);
    bf16_t* P = (bf16_t*)(p.ws + WS_BIG);
    const bool first = (l == 0);
    const bool want_out = first || ci >= 8;
    for (int dd = 0; dd < 2; ++dd) { LAS unsigned* az = (LAS unsigned*)(lds + dd * P1_DIRSZ + P1_AW) + w * (32 * KT_ST / 2); for (int i = lane; i < 32 * KT_ST / 2; i += 64) az[i] = 0u; }
    u32x4 rf0, rq0, rv0, rf1, rq1, rv1;
    { const int r_ = R0 + tau; rf0 = *(const u32x4*)(P + PIX(r_, h * 128 + k0)); rq0 = *(const u32x4*)(P + PIX(r_, 1536 + h * 128 + k0)); rv0 = *(const u32x4*)(P + PIX(r_, 1024 + h * 128 + k0)); }
    { const int r_ = R0 + 31 - tau; rf1 = *(const u32x4*)(P + PIX(r_, 512 + h * 128 + k0)); rq1 = *(const u32x4*)(P + PIX(r_, 1536 + h * 128 + k0)); rv1 = *(const u32x4*)(P + PIX(r_, 1024 + h * 128 + k0)); }
    asm volatile("s_waitcnt vmcnt(0)" ::: "memory");
    __syncthreads();
    auto valu_part = [&](const int dir, const u32x4& f, const u32x4& q, const u32x4& v) {
        LAS unsigned char* db = lds + dir * P1_DIRSZ;
        LAS bf16_t* Qs = (LAS bf16_t*)(db + P1_QS); LAS bf16_t* Kh = (LAS bf16_t*)(db + P1_KH);
        LAS bf16_t* Vt = (LAS bf16_t*)(db + P1_VT); LAS bf16_t* Kt = (LAS bf16_t*)(db + P1_KT);
        LAS bf16_t* Aw = (LAS bf16_t*)(db + P1_AW) + w * 32 * KT_ST;
        const int tokl = dir ? 31 - tau : tau;
        const float* lbp = (const float*)(p.ws + WS_LB) + dir * 512 + h * 128 + k0;
        float E[8], kk[8];
#pragma unroll
        for (int j = 0; j < 8; ++j) {
            const unsigned fw = f[j >> 1]; const float x = (j & 1) ? bf_hi(fw) : bf_lo(fw);
            const float e = __expf(-fabsf(x)), r = fast_rcp(1.0f + e);
            const float sp = x >= 0.f ? r : e * r, sn = x >= 0.f ? e * r : r;
            if (first) { E[j] = sp; kk[j] = sn; }
            else { const float lb = lbp[j]; const float gate = lb + (1.0f - lb) * sp; E[j] = gate; kk[j] = 1.0f - gate; }
        }
        float qt[8], kh_[8], kt_[8], Tj[8];
        cumprod32x8(E);
#pragma unroll
        for (int j = 0; j < 8; ++j) {
            const float Ej = fmaxf(E[j], 1e-35f);
            const float T0 = __builtin_bit_cast(float, __builtin_amdgcn_readlane(__builtin_bit_cast(int, Ej), 31)), T1 = __builtin_bit_cast(float, __builtin_amdgcn_readlane(__builtin_bit_cast(int, Ej), 63));
            const float T = kh ? T1 : T0;
            const unsigned qw = q[j >> 1]; const float qx = (j & 1) ? bf_hi(qw) : bf_lo(qw);
            qt[j] = silu_f(qx) * 0.08838834764831845f * Ej;
            kh_[j] = kk[j] * fast_rcp(Ej); kt_[j] = kh_[j] * T;
            Tj[j] = T;
        }
        if (tau == 31) { float* dp = (float*)(p.ws + WS_DS) + ((size_t)((b * 4 + h) * 2 + dir) * NCH + ci) * 128 + k0;
            *(f32x4*)dp = (f32x4){Tj[0], Tj[1], Tj[2], Tj[3]}; *(f32x4*)(dp + 4) = (f32x4){Tj[4], Tj[5], Tj[6], Tj[7]}; }
        u32x4 wq, wk; wq.x = pk_bf16(qt[0], qt[1]); wq.y = pk_bf16(qt[2], qt[3]); wq.z = pk_bf16(qt[4], qt[5]); wq.w = pk_bf16(qt[6], qt[7]);
        wk.x = pk_bf16(kh_[0], kh_[1]); wk.y = pk_bf16(kh_[2], kh_[3]); wk.z = pk_bf16(kh_[4], kh_[5]); wk.w = pk_bf16(kh_[6], kh_[7]);
        *(LAS u32x4*)(Qs + tau * QS_ST + k0) = wq; *(LAS u32x4*)(Kh + tau * QS_ST + k0) = wk;
        {
          bf16_t* qd = (dir == 0) ? P + PIX(R0 + tokl, 1536 + h * 128) : (bf16_t*)(p.ws + WS_QB) + (size_t)h * PSLOT + (size_t)(R0 + tokl) * 128;
          const int a32 = k0 & ~31, kkA = k0 & 31, kkB = kkA + 4;
          u32x2 pa, pb; pa.x = wq.x; pa.y = wq.y; pb.x = wq.z; pb.y = wq.w;
          *(u32x2*)(qd + a32 + 8 * ((kkA & 15) >> 2) + 4 * (kkA >> 4)) = pa;
          *(u32x2*)(qd + a32 + 8 * ((kkB & 15) >> 2) + 4 * (kkB >> 4)) = pb; }
#pragma unroll
        for (int j = 0; j < 8; ++j) { Kt[(k0 + j) * KT_ST + tokl] = to_bf1(kt_[j]); const unsigned vw = v[j >> 1]; Vt[(k0 + j) * KT_ST + tau] = (bf16_t)((j & 1) ? (vw >> 16) : (vw & 0xffffu)); }
    };
    auto mfma_part = [&](const int dir) {
        LAS unsigned char* db = lds + dir * P1_DIRSZ;
        LAS bf16_t* Qs = (LAS bf16_t*)(db + P1_QS); LAS bf16_t* Kh = (LAS bf16_t*)(db + P1_KH);
        LAS bf16_t* Vt = (LAS bf16_t*)(db + P1_VT); LAS bf16_t* Kt = (LAS bf16_t*)(db + P1_KT);
        LAS bf16_t* Aw = (LAS bf16_t*)(db + P1_AW) + w * 32 * KT_ST;
        const int tokl = dir ? 31 - tau : tau; (void)tokl;
        if (want_out) {
            f32x4 a00 = (f32x4){0.f, 0.f, 0.f, 0.f}, a10 = a00, a11 = a00;
#pragma unroll
            for (int kb = 0; kb < 4; ++kb) {
                const bf16x8 qn0 = *(const LAS bf16x8*)(Qs + l15 * QS_ST + 32 * kb + 8 * q4), qn1 = *(const LAS bf16x8*)(Qs + (16 + l15) * QS_ST + 32 * kb + 8 * q4);
                const bf16x8 kh0 = *(const LAS bf16x8*)(Kh + l15 * QS_ST + 32 * kb + 8 * q4), kh1 = *(const LAS bf16x8*)(Kh + (16 + l15) * QS_ST + 32 * kb + 8 * q4);
                a00 = __builtin_amdgcn_mfma_f32_16x16x32_bf16(qn0, kh0, a00, 0, 0, 0);
                a10 = __builtin_amdgcn_mfma_f32_16x16x32_bf16(qn1, kh0, a10, 0, 0, 0);
                a11 = __builtin_amdgcn_mfma_f32_16x16x32_bf16(qn1, kh1, a11, 0, 0, 0);
            }
#pragma unroll
            for (int i = 0; i < 4; ++i) { const int t = 4 * q4 + i; const bool keep = l15 <= t;
                Aw[t * KT_ST + l15] = to_bf1(keep ? a00[i] : 0.f);
                Aw[(16 + t) * KT_ST + l15] = to_bf1(a10[i]);
                Aw[(16 + t) * KT_ST + 16 + l15] = to_bf1(keep ? a11[i] : 0.f); }
            asm volatile("s_waitcnt lgkmcnt(0)" ::: "memory");
            const bf16x8 vf = *(const LAS bf16x8*)(Vt + (16 * w + l15) * KT_ST + 8 * q4);
            bf16_t* OFB = (bf16_t*)(p.ws + WS_OFB) + (size_t)dir * NROW * 512;
#pragma unroll
            for (int mt = 0; mt < 2; ++mt) {
                const bf16x8 af = *(const LAS bf16x8*)(Aw + (16 * mt + l15) * KT_ST + 8 * q4);
                const f32x4 o = __builtin_amdgcn_mfma_f32_16x16x32_bf16(vf, af, (f32x4){0.f, 0.f, 0.f, 0.f}, 0, 0, 0);
                const int tl = 16 * mt + l15, tok = dir ? 31 - tl : tl;
                u32x2 wv; wv.x = pk_bf16(o[0], o[1]); wv.y = pk_bf16(o[2], o[3]);
                *(u32x2*)(OFB + (size_t)h * PSLOT + (size_t)(R0 + tok) * 128 + 16 * w + 4 * q4) = wv;
            }
        }
        { const int k = tid >> 2, part = tid & 3;
          const u32x4 kv = *(const LAS u32x4*)(Kt + k * KT_ST + 8 * part);
          const int pc = h * 128 + (k & 3) * 32 + (part ^ ((k >> 2) & 3)) * 8;
          *(u32x4*)(P + PIX(R0 + (k >> 2), dir * 512 + pc)) = kv;
          if (dir == 0) { const u32x4 vv = *(const LAS u32x4*)(Vt + k * KT_ST + 8 * part); *(u32x4*)(P + PIX(R0 + (k >> 2), 1024 + pc)) = vv; } }
    };
    valu_part(0, rf0, rq0, rv0);
    valu_part(1, rf1, rq1, rv1);
    __syncthreads();
    mfma_part(0);
    mfma_part(1);
    __syncthreads();
}

constexpr int ST_Q = 0, ST_K = 8192, ST_V = 16384, ST_O = 20480, ST_D = 24576, ST_BYTES = 25088, NSTAGE = 6;
__device__ void scan_chain(const Params& p, int l, int chain, int vhalf, LAS unsigned char* lds) {
    const int tid = opaque_tid(), w = __builtin_amdgcn_readfirstlane(tid >> 6), lane = tid & 63, l15 = lane & 15, q4 = lane >> 4;
    const int dir = chain & 1, h = (chain >> 1) & 3, b = chain >> 3;
    bf16_t* P = (bf16_t*)(p.ws + WS_BIG);
    auto chunk_of = [&](int s) -> int { return dir ? (s < 8 ? 7 - s : 143 - s) : s; };
    auto row0_of = [&](int c) -> int { return c < 8 ? NLAT + b * 256 + 32 * c : b * 4096 + 32 * (c - 8); };
    bf16_t* qb = dir ? (bf16_t*)(p.ws + WS_QB) + (size_t)h * PSLOT : P + PIX(0, 1536 + h * 128);
    const int qpitch = 128;
    if (w >= 4) {
        const int lw = w - 4;
        const int r16 = lane >> 4, s16 = lane & 15;
        size_t qoff[2], koff[2];
#pragma unroll
        for (int i = 0; i < 2; ++i) { const int row = 8 * lw + 4 * i + r16; qoff[i] = (size_t)row * qpitch + ((s16 ^ (row & 15)) * 8);
            koff[i] = PIX(4 * (2 * lw + i) + r16, dir * 512 + h * 128) + s16 * 8; }
        const size_t voff = PIX(16 * vhalf + 4 * lw + r16, 1024 + h * 128) + s16 * 8;
        const float* dsrc = (const float*)(p.ws + WS_DS) + (size_t)chain * NCH * 128 + (lw & 1) * 64 + lane;
        const int orow = 8 * lw + (lane >> 3);
        const size_t ooff = (size_t)h * PSLOT + (size_t)orow * 128 + 64 * vhalf + (((lane & 7) ^ (orow & 7)) * 8);
        const bf16_t* OFBc = (const bf16_t*)(p.ws + WS_OFB) + (size_t)dir * NROW * 512;
        auto issue = [&](int s) {
            const int sc = s < NCH ? s : NCH - 1;
            const int c = chunk_of(sc), R0 = row0_of(c);
            LAS unsigned char* st = lds + (s % NSTAGE) * ST_BYTES;
            const bf16_t* qrow = qb + (size_t)R0 * qpitch; const bf16_t* krow = P + (size_t)R0 * 128;
#pragma unroll
            for (int i = 0; i < 2; ++i) {
                __builtin_amdgcn_global_load_lds((const unsigned*)(qrow + qoff[i]), (LAS unsigned*)(st + ST_Q + (2 * lw + i) * 1024), 16, 0, 0);
                __builtin_amdgcn_global_load_lds((const unsigned*)(krow + koff[i]), (LAS unsigned*)(st + ST_K + (2 * lw + i) * 1024), 16, 0, 0);
            }
            __builtin_amdgcn_global_load_lds((const unsigned*)(krow + voff), (LAS unsigned*)(st + ST_V + lw * 1024), 16, 0, 0);
            __builtin_amdgcn_global_load_lds((const unsigned*)(dsrc + (size_t)c * 128), (LAS unsigned*)(st + ST_D + (lw & 1) * 256), 4, 0, 0);
            __builtin_amdgcn_global_load_lds((const unsigned*)(OFBc + (size_t)R0 * 128 + ooff), (LAS unsigned*)(st + ST_O + lw * 1024), 16, 0, 0);
        };
        issue(0); issue(1); issue(2); issue(3); issue(4);
        asm volatile("s_waitcnt vmcnt(28)" ::: "memory");
        __builtin_amdgcn_s_barrier();
        for (int s = 0; s < NCH; ++s) {
            issue(s + 5);
            asm volatile("s_waitcnt vmcnt(28)" ::: "memory");
            __builtin_amdgcn_s_barrier();
        }
        asm volatile("s_waitcnt vmcnt(0)" ::: "memory");
    } else {
        f32x4 S[8];
#pragma unroll
        for (int j = 0; j < 8; ++j) S[j] = (f32x4){0.f, 0.f, 0.f, 0.f};
        const int swz = (l15 >> 2) & 3, vcol = 64 * vhalf + 16 * w;
        bf16_t* OFBw = (bf16_t*)(p.ws + WS_OFB) + (size_t)dir * NROW * 512;
        __builtin_amdgcn_s_barrier();
        for (int s = 0; s < NCH; ++s) {
            LAS unsigned char* st = lds + (s % NSTAGE) * ST_BYTES;
            bf16x8 qf[4][2], kf[8]; f32x4 dv[8];
#pragma unroll
            for (int kb = 0; kb < 4; ++kb)
#pragma unroll
                for (int mt = 0; mt < 2; ++mt) {
                    qf[kb][mt] = *(const LAS bf16x8*)(st + ST_Q + (16 * mt + l15) * 256 + (((4 * kb + q4) ^ l15) * 16));
                }
            const bf16x8 vf = *(const LAS bf16x8*)(st + ST_V + (16 * w + l15) * 64 + ((q4 ^ swz) * 16));
            u32x2 oi[2];
#pragma unroll
            for (int mt = 0; mt < 2; ++mt) { const int tr = 16 * mt + l15; oi[mt] = *(const LAS u32x2*)(st + ST_O + tr * 128 + (((2 * w + (q4 >> 1)) ^ (tr & 7)) * 16) + (q4 & 1) * 8); }
#pragma unroll
            for (int j = 0; j < 8; ++j) { dv[j] = *(const LAS f32x4*)(st + ST_D + (16 * j + 4 * q4) * 4); kf[j] = *(const LAS bf16x8*)(st + ST_K + (16 * j + l15) * 64 + ((q4 ^ swz) * 16)); }
            __builtin_amdgcn_sched_barrier(0);
            f32x4 o[2]; o[0] = (f32x4){0.f, 0.f, 0.f, 0.f}; o[1] = o[0];
#pragma unroll
            for (int kb = 0; kb < 4; ++kb) {
                u32x4 sb; sb.x = pk_bf16(S[2 * kb][0], S[2 * kb][1]); sb.y = pk_bf16(S[2 * kb][2], S[2 * kb][3]); sb.z = pk_bf16(S[2 * kb + 1][0], S[2 * kb + 1][1]); sb.w = pk_bf16(S[2 * kb + 1][2], S[2 * kb + 1][3]);
                const bf16x8 sfr = __builtin_bit_cast(bf16x8, sb);
                o[0] = __builtin_amdgcn_mfma_f32_16x16x32_bf16(sfr, qf[kb][0], o[0], 0, 0, 0);
                o[1] = __builtin_amdgcn_mfma_f32_16x16x32_bf16(sfr, qf[kb][1], o[1], 0, 0, 0);
            }
#pragma unroll
            for (int j = 0; j < 8; ++j) S[j] = __builtin_amdgcn_mfma_f32_16x16x32_bf16(kf[j], vf, S[j] * dv[j], 0, 0, 0);
            const int R0 = row0_of(chunk_of(s));
#pragma unroll
            for (int mt = 0; mt < 2; ++mt) { const int tr = 16 * mt + l15;
                u32x2 wv; wv.x = pk_bf16(o[mt][0] + bf_lo(oi[mt].x), o[mt][1] + bf_hi(oi[mt].x)); wv.y = pk_bf16(o[mt][2] + bf_lo(oi[mt].y), o[mt][3] + bf_hi(oi[mt].y));
                *(u32x2*)(OFBw + (size_t)h * PSLOT + (size_t)(R0 + tr) * 128 + vcol + 4 * q4) = wv; }
            asm volatile("s_waitcnt lgkmcnt(0)" ::: "memory");
            __builtin_amdgcn_s_barrier();
        }
    }
}

constexpr int SG_ST = 136;
__device__ void sgu_tile(const Params& p, int l, int tile, LAS unsigned char* lds) {
    const int tid = opaque_tid(), w = tid >> 6, lane = tid & 63, l15 = lane & 15, q4 = lane >> 4;
    const int h = tile & 3, rowbase = (tile >> 2) * 128;
    const bf16_t* P = (const bf16_t*)(p.ws + WS_BIG);
    bf16_t* O = (bf16_t*)(p.ws + WS_H);
    LAS bf16_t* Vt = (LAS bf16_t*)lds;
    {
        const int q = tid >> 2, cgp = tid & 3;
        const bf16_t* vp = P + PIX(rowbase + q, 3072 + 128 * h + 32 * cgp);
        float g[32];
#pragma unroll
        for (int i = 0; i < 4; ++i) { const u32x4 r = *(const u32x4*)(vp + 8 * i);
#pragma unroll
            for (int j = 0; j < 4; ++j) { g[8 * i + 2 * j] = gelu_f(bf_lo(r[j])); g[8 * i + 2 * j + 1] = gelu_f(bf_hi(r[j])); } }
        float s = 0.f;
#pragma unroll
        for (int i = 0; i < 32; ++i) s += g[i];
        s += __shfl_xor(s, 1); s += __shfl_xor(s, 2);
        const float mu = s * (1.0f / 128.f);
        float vs = 0.f;
#pragma unroll
        for (int i = 0; i < 32; ++i) { const float d = g[i] - mu; vs += d * d; }
        vs += __shfl_xor(vs, 1); vs += __shfl_xor(vs, 2);
        const float rstd = rsqrtf(vs * (1.0f / 128.f) + EPS);
        const float* lng = p.in[12] + l * 512 + h * 128 + 32 * cgp; const float* lnb = p.in[13] + l * 512 + h * 128 + 32 * cgp;
#pragma unroll
        for (int i = 0; i < 32; ++i) { const float y = (g[i] - mu) * rstd * lng[i] + lnb[i]; Vt[(32 * cgp + i) * SG_ST + q] = to_bf1(y); }
    }
    __syncthreads();
    {
        const int prow = 16 * w + l15;
        const bf16_t* wsp = (const bf16_t*)(p.ws + WS_WSP) + ((size_t)(l * 4 + h) * 128 + prow) * 128 + 8 * q4;
        bf16x8 wf[4];
#pragma unroll
        for (int kb = 0; kb < 4; ++kb) wf[kb] = *(const bf16x8*)(wsp + 32 * kb);
        const float bs = p.in[15][(l * 4 + h) * 128 + prow];
        const bf16_t* up = P + PIX(rowbase + prow, 2560 + 128 * h + 4 * q4);
        bf16_t* op = O + (size_t)(rowbase + prow) * D + 512 + 128 * h + 4 * q4;
        u32x2 uall[8];
#pragma unroll
        for (int mt = 0; mt < 8; ++mt) uall[mt] = *(const u32x2*)(up + 16 * mt);
#pragma unroll
        for (int mt = 0; mt < 8; ++mt) {
            f32x4 acc = (f32x4){0.f, 0.f, 0.f, 0.f};
#pragma unroll
            for (int kb = 0; kb < 4; ++kb) { const bf16x8 af = *(const LAS bf16x8*)(Vt + (16 * mt + l15) * SG_ST + 32 * kb + 8 * q4);
                acc = __builtin_amdgcn_mfma_f32_16x16x32_bf16(af, wf[kb], acc, 0, 0, 0); }
            const u32x2 uu = uall[mt];
            const float u0 = gelu_f(bf_lo(uu.x)), u1 = gelu_f(bf_hi(uu.x)), u2 = gelu_f(bf_lo(uu.y)), u3 = gelu_f(bf_hi(uu.y));
            u32x2 wv; wv.x = pk_bf16(u0 * (acc[0] + bs), u1 * (acc[1] + bs)); wv.y = pk_bf16(u2 * (acc[2] + bs), u3 * (acc[3] + bs));
            *(u32x2*)(op + 16 * mt) = wv;
        }
    }
    __syncthreads();
}

constexpr int SGU_IN_M2 = 1088;
__device__ void phase_mixer(const Params& p, int l, LAS unsigned char* lds) {
    const int G = gridDim.x, bid = blockIdx.x;
    const int ntile = (l == 0) ? (NROW / 128) * 4 : (NLAT / 128) * 4;
    if (G > 128) {
        if (bid < 128) scan_chain(p, l, (bid >> 4) * 8 + (bid & 7), (bid >> 3) & 1, lds);
        else for (int t = bid - 128; t < (ntile < SGU_IN_M2 ? ntile : SGU_IN_M2); t += G - 128) sgu_tile(p, l, t, lds);
    } else {
        for (int c = bid; c < 128; c += G) { scan_chain(p, l, c >> 1, c & 1, lds); __syncthreads(); }
        for (int t = bid; t < ntile; t += G) sgu_tile(p, l, t, lds);
    }
}

__device__ void phase_combine(const Params& p, int l, int nrows) {
    const int tid_ = opaque_tid(); const int wave = tid_ >> 6, lane = tid_ & 63, hd = lane >> 4, v0 = (lane & 15) * 8;
    const bf16_t* P = (const bf16_t*)(p.ws + WS_BIG);
    const bf16_t* OF = (const bf16_t*)(p.ws + WS_OFB); const bf16_t* OB = OF + (size_t)NROW * 512;
    bf16_t* O = (bf16_t*)(p.ws + WS_H);
    const float* gn = p.in[11] + l * 512 + hd * 128 + v0;
    const f32x4 g0 = *(const f32x4*)gn, g1 = *(const f32x4*)(gn + 4);
    for (int row0 = (blockIdx.x * 8 + wave) * 4; row0 < nrows; row0 += gridDim.x * 32) {
        u32x4 a[4], bq[4], gg[4];
#pragma unroll
        for (int u = 0; u < 4; ++u) { const size_t row = row0 + u;
            a[u] = __builtin_nontemporal_load((const u32x4*)(OF + (size_t)hd * PSLOT + row * 128 + v0)); bq[u] = __builtin_nontemporal_load((const u32x4*)(OB + (size_t)hd * PSLOT + row * 128 + v0));
            gg[u] = __builtin_nontemporal_load((const u32x4*)(P + PIX((int)row, 2048 + hd * 128 + v0))); }
#pragma unroll
        for (int u = 0; u < 4; ++u) {
            float s[8]; float ss = 0.f;
#pragma unroll
            for (int j = 0; j < 4; ++j) { s[2 * j] = bf_lo(a[u][j]) + bf_lo(bq[u][j]); s[2 * j + 1] = bf_hi(a[u][j]) + bf_hi(bq[u][j]); ss += s[2 * j] * s[2 * j] + s[2 * j + 1] * s[2 * j + 1]; }
#pragma unroll
            for (int o = 8; o > 0; o >>= 1) ss += __shfl_xor(ss, o);
            const float rs = rsqrtf(ss * (1.0f / 128.f) + EPS);
            float y[8];
#pragma unroll
            for (int j = 0; j < 4; ++j) { y[2 * j] = s[2 * j] * rs * (j < 2 ? g0[2 * j] : g1[2 * j - 4]) * silu_f(bf_lo(gg[u][j])); y[2 * j + 1] = s[2 * j + 1] * rs * (j < 2 ? g0[2 * j + 1] : g1[2 * j - 3]) * silu_f(bf_hi(gg[u][j])); }
            u32x4 wv; wv.x = pk_bf16(y[0], y[1]); wv.y = pk_bf16(y[2], y[3]); wv.z = pk_bf16(y[4], y[5]); wv.w = pk_bf16(y[6], y[7]);
            *(u32x4*)(O + (size_t)(row0 + u) * D + hd * 128 + v0) = wv;
        }
    }
}

__device__ void phase_conv(const Params& p, int l, int nrows) {
    bf16_t* Aup = (bf16_t*)(p.ws + WS_BIG); const bf16_t* Gup = Aup + (size_t)NROW * FF;
    const float* cw = p.in[18] + (size_t)l * 9 * FF; const float* cb = p.in[19] + (size_t)l * FF;
    const int tid_ = opaque_tid();
    const long total = (long)(nrows / 16) * 352;
    for (long id0 = (long)blockIdx.x * 512 + tid_; id0 < total; id0 += (long)gridDim.x * 512) {
        const int seg = (int)((total - 1 - id0) / 352), f0 = (int)(id0 % 352) * 8;
        const int tok0 = seg * 16;
        int c0, W; bool up, dn;
        if (tok0 < NLAT) { const int t = tok0 & 4095, r = t >> 6; c0 = t & 63; W = 64; up = r > 0; dn = r < 63; }
        else { c0 = (tok0 - NLAT) & 255; W = 256; up = false; dn = false; }
        float tp[9][8]; float bias[8];
#pragma unroll
        for (int k = 0; k < 9; ++k) { const f32x4 t0 = *(const f32x4*)(cw + k * FF + f0), t1 = *(const f32x4*)(cw + k * FF + f0 + 4);
            tp[k][0] = t0[0]; tp[k][1] = t0[1]; tp[k][2] = t0[2]; tp[k][3] = t0[3]; tp[k][4] = t1[0]; tp[k][5] = t1[1]; tp[k][6] = t1[2]; tp[k][7] = t1[3]; }
        { const f32x4 b0 = *(const f32x4*)(cb + f0), b1 = *(const f32x4*)(cb + f0 + 4); bias[0] = b0[0]; bias[1] = b0[1]; bias[2] = b0[2]; bias[3] = b0[3]; bias[4] = b1[0]; bias[5] = b1[1]; bias[6] = b1[2]; bias[7] = b1[3]; }
        const u32x4 zero = (u32x4){0u, 0u, 0u, 0u};
        const bf16_t* gp = Gup + (size_t)tok0 * FF + f0;
        u32x4 L[3], M[3], R[3];
        { const bool v = c0 > 0;
          L[0] = (v && up) ? *(const u32x4*)(gp - (size_t)65 * FF) : zero; L[1] = v ? *(const u32x4*)(gp - (size_t)FF) : zero; L[2] = (v && dn) ? *(const u32x4*)(gp + (size_t)63 * FF) : zero; }
        M[0] = up ? *(const u32x4*)(gp - (size_t)64 * FF) : zero; M[1] = *(const u32x4*)gp; M[2] = dn ? *(const u32x4*)(gp + (size_t)64 * FF) : zero;
#pragma unroll 8
        for (int i = 0; i < 16; ++i) {
            const bf16_t* np = gp + (size_t)(i + 1) * FF;
            const bool v = (c0 + i + 1) < W;
            R[0] = (v && up) ? *(const u32x4*)(np - (size_t)64 * FF) : zero; R[1] = v ? *(const u32x4*)np : zero; R[2] = (v && dn) ? *(const u32x4*)(np + (size_t)64 * FF) : zero;
            float acc[8];
#pragma unroll
            for (int j = 0; j < 8; ++j) acc[j] = bias[j];
#pragma unroll
            for (int rr = 0; rr < 3; ++rr) {
#pragma unroll
                for (int j = 0; j < 4; ++j) {
                    acc[2 * j] += bf_lo(L[rr][j]) * tp[rr * 3 + 0][2 * j] + bf_lo(M[rr][j]) * tp[rr * 3 + 1][2 * j] + bf_lo(R[rr][j]) * tp[rr * 3 + 2][2 * j];
                    acc[2 * j + 1] += bf_hi(L[rr][j]) * tp[rr * 3 + 0][2 * j + 1] + bf_hi(M[rr][j]) * tp[rr * 3 + 1][2 * j + 1] + bf_hi(R[rr][j]) * tp[rr * 3 + 2][2 * j + 1];
                }
            }
            bf16_t* ap = Aup + (size_t)(tok0 + i) * FF + f0;
            const u32x4 av = __builtin_nontemporal_load((const u32x4*)ap);
            u32x4 wv;
#pragma unroll
            for (int j = 0; j < 4; ++j) wv[j] = pk_bf16(bf_lo(av[j]) * gelu_f(acc[2 * j]), bf_hi(av[j]) * gelu_f(acc[2 * j + 1]));
            *(u32x4*)ap = wv;
#pragma unroll
            for (int rr = 0; rr < 3; ++rr) { L[rr] = M[rr]; M[rr] = R[rr]; }
        }
    }
}

#define XB_TMO      128
#define XB_XCNT(j)  (256  + 64 * (j))
#define XB_XSUB(j)  (1280 + 64 * (j))
#define XB_XGEN(j)  (2304 + 64 * (j))
#define XB_TOP      3328
#define XB_TOPGEN   3392
#define XCD_BAR_WORDS 3456
#define XB_SPIN_CAP (1u << 20)
__device__ __forceinline__ unsigned xb_ld(unsigned* p)              { return __hip_atomic_load(p, __ATOMIC_RELAXED, __HIP_MEMORY_SCOPE_AGENT); }
__device__ __forceinline__ unsigned xb_add(unsigned* p, unsigned v) { return __hip_atomic_fetch_add(p, v, __ATOMIC_RELAXED, __HIP_MEMORY_SCOPE_AGENT); }
__device__ __forceinline__ unsigned xb_xcc_id() { return (unsigned)__builtin_amdgcn_s_getreg((3 << 11) | 20) & 0xFu; }
#define XB_SPIN(cond, bar) do { unsigned _sp = 0; while (cond) { __builtin_amdgcn_s_sleep(1); \
    if ((++_sp & 255u) == 0u) { if (xb_ld(&(bar)[XB_TMO])) break; if (_sp > XB_SPIN_CAP) { atomicAdd(&(bar)[XB_TMO], 1u); break; } } } } while (0)
struct XcdBarrier { unsigned* bar; unsigned x; volatile LAS unsigned* st; };
__device__ __forceinline__ XcdBarrier xcd_barrier_post(unsigned* bar, volatile LAS unsigned* st) {
    XcdBarrier b; b.bar = bar; b.x = xb_xcc_id(); b.st = st;
    if (threadIdx.x == 0) (void)xb_add(&bar[XB_XCNT(b.x)], 1u);
    return b;
}
__device__ __forceinline__ void xcd_barrier_complete(unsigned* bar, unsigned x, unsigned& nloc, unsigned& nx) {
    const unsigned G = gridDim.x * gridDim.y * gridDim.z;
    unsigned sum, cnt, mine, sp = 0u;
    for (;;) {
        sum = 0u; cnt = 0u; mine = 0u;
#pragma unroll
        for (unsigned j = 0; j < 16; ++j) { const unsigned c = xb_ld(&bar[XB_XCNT(j)]); sum += c; cnt += (c > 0u) ? 1u : 0u; mine = (j == x) ? c : mine; }
        if (sum == G) break;
        __builtin_amdgcn_s_sleep(1);
        if ((++sp & 255u) == 0u) { if (xb_ld(&bar[XB_TMO])) break; if (sp > XB_SPIN_CAP) { atomicAdd(&bar[XB_TMO], 1u); break; } }
    }
    nloc = mine > 0u ? mine : 1u; nx = cnt > 0u ? cnt : 1u;
}
__device__ __forceinline__ void xcd_barrier(const XcdBarrier& b) {
    asm volatile("s_waitcnt vmcnt(0)" ::: "memory");
    __syncthreads();
    if (threadIdx.x == 0) {
        unsigned* bar = b.bar;
        __builtin_amdgcn_s_waitcnt(0);
        unsigned nloc = b.st[0], nx = b.st[1];
        if (nloc == 0u) { xcd_barrier_complete(bar, b.x, nloc, nx); b.st[0] = nloc; b.st[1] = nx; }
        const unsigned old = xb_add(&bar[XB_XSUB(b.x)], 1u);
        const unsigned gen = old / nloc;
        if (old + 1u == (gen + 1u) * nloc) {
            __builtin_amdgcn_fence(__ATOMIC_RELEASE, "agent");
            asm volatile("s_waitcnt vmcnt(0)" ::: "memory");
            const unsigned og = xb_add(&bar[XB_TOP], 1u);
            const unsigned tg = og / nx;
            if (og + 1u == (tg + 1u) * nx) xb_add(&bar[XB_TOPGEN], 1u);
            else XB_SPIN(xb_ld(&bar[XB_TOPGEN]) == tg, bar);
            __builtin_amdgcn_fence(__ATOMIC_ACQUIRE, "agent");
            xb_add(&bar[XB_XGEN(b.x)], 1u);
            asm volatile("s_waitcnt vmcnt(0)" ::: "memory");
        } else {
            XB_SPIN(xb_ld(&bar[XB_XGEN(b.x)]) == gen, bar);
            __builtin_amdgcn_fence(__ATOMIC_ACQUIRE, "agent");
            asm volatile("s_waitcnt vmcnt(0)" ::: "memory");
        }
    }
    __syncthreads();
}

__global__ void __launch_bounds__(512, 2) fwd_megakernel(Params p) {
    extern __shared__ __attribute__((aligned(16))) unsigned char shm[];
    LAS unsigned char* lds = (LAS unsigned char*)shm;
    cg::grid_group grid = cg::this_grid();
    __shared__ uint4 xb_words;
    if (threadIdx.x == 0) xb_words = make_uint4(0u, 0u, 0u, 0u);
    __syncthreads();
    const XcdBarrier xb = xcd_barrier_post((unsigned*)(p.ws + WS_BAR), (volatile LAS unsigned*)&xb_words);
    const int G = gridDim.x, bid = blockIdx.x;
    float* XC = (float*)(p.ws + WS_XC);
    bf16_t* H = (bf16_t*)(p.ws + WS_H);
    bf16_t* BIG = (bf16_t*)(p.ws + WS_BIG);
    const float* ADA = (const float*)(p.ws + WS_ADA);
    bf16_t* Y2 = BIG + (size_t)NROW * FF;

    phase_prep(p, lds);
    if (p.ws == nullptr) grid.sync();
    xcd_barrier(xb);
    for (int l = 0; l < DEPTH; ++l) {
        const bool last = (l == DEPTH - 1);
        const float* ada_l = ADA + (size_t)l * 9 * 6144;
        const float* xl = (l == 0) ? p.in[0] : p.out;
        const float* xc = (l == 0) ? p.in[2] : XC;
        const int Mfull = last ? NLAT : NROW;
        if (l == 0) phase_norm(xl, xc, nullptr, nullptr, nullptr, nullptr, p.in[6] + l * D, ada_l, 0, NROW, H);
        else phase_norm(p.out, XC, Y2, ADA + (size_t)(l - 1) * 9 * 6144 + 5 * 1024, p.out, nullptr, p.in[6] + l * D, ada_l, 0, NROW, H);
        xcd_barrier(xb);
        { pg8::StaticOrder S; S.init(NROW, PW, G, bid);
          pg8::EpiBf16 E{BIG, PW, 0, 0, PSLOT};
          pg8::gemm_phase(lds, pg8::Gemm{H, (const bf16_t*)(p.ws + WS_WIN) + (size_t)l * PW * D, NROW, PW, D}, S, E); }
        xcd_barrier(xb);
        { const int ntile = (l == 0) ? (NROW / 128) * 4 : (NLAT / 128) * 4;
          const int nextra = (G > 128 && ntile > SGU_IN_M2) ? ntile - SGU_IN_M2 : 0;
          for (int it = bid; it < 32 * NCH + nextra; it += G) { if (it < 32 * NCH) prep_item(p, l, 32 * NCH - 1 - it, lds); else sgu_tile(p, l, SGU_IN_M2 + it - 32 * NCH, lds); } }
        xcd_barrier(xb);
        phase_mixer(p, l, lds);
        xcd_barrier(xb);
        phase_combine(p, l, Mfull);
        xcd_barrier(xb);
        { pg8::StaticOrder S; S.init(Mfull, D, G, bid);
          pg8::EpiBf16 E{BIG, D, 0, 0, 0};
          pg8::gemm_phase(lds, pg8::Gemm{H, (const bf16_t*)(p.ws + WS_WOUT) + (size_t)l * D * D, Mfull, D, D}, S, E); }
        xcd_barrier(xb);
        phase_norm(xl, xc, BIG, ada_l + 2 * 1024, p.out, XC, p.in[7] + l * D, ada_l, 3, Mfull, H);
        xcd_barrier(xb);
        { pg8::StaticOrder S; S.init(Mfull, UPW, G, bid);
          pg8::EpiBf16 E{BIG, FF, FF, (size_t)NROW * FF, 0};
          pg8::gemm_phase(lds, pg8::Gemm{H, (const bf16_t*)(p.ws + WS_WUP) + (size_t)l * UPW * D, Mfull, UPW, D}, S, E); }
        xcd_barrier(xb);
        phase_conv(p, l, Mfull);
        xcd_barrier(xb);
        { pg8::StaticOrder S; S.init(Mfull, D, G, bid);
          pg8::EpiBf16 E{Y2, D, 0, 0, 0};
          pg8::gemm_phase(lds, pg8::Gemm{BIG, (const bf16_t*)(p.ws + WS_WDOWN) + (size_t)l * D * FF, Mfull, D, FF}, S, E); }
        xcd_barrier(xb);
    }
    phase_final(p.out, Y2, ADA + (size_t)(DEPTH - 1) * 9 * 6144 + 5 * 1024, p.in[21]);
}

extern "C" void kernel_launch(void* const* d_in, const int* in_sizes, int n_in, void* d_out, int out_size, void* d_ws, size_t ws_size, hipStream_t stream) {
    constexpr int LDS_BYTES = 155648;
    static int grid_blocks = 0;
    if (!grid_blocks) {
        int dev = 0, cus = 0, per_cu = 0;
        (void)hipGetDevice(&dev);
        (void)hipDeviceGetAttribute(&cus, hipDeviceAttributeMultiprocessorCount, dev);
        (void)hipFuncSetAttribute((const void*)fwd_megakernel, hipFuncAttributeMaxDynamicSharedMemorySize, LDS_BYTES);
        (void)hipOccupancyMaxActiveBlocksPerMultiprocessor(&per_cu, (const void*)fwd_megakernel, 512, LDS_BYTES);
        if (per_cu < 1) per_cu = 1;
        grid_blocks = cus * per_cu;
        if (ws_size < WS_END) fprintf(stderr, "workspace too small: %zu < %zu\n", ws_size, (size_t)WS_END);
    }
    Params p{};
    for (int i = 0; i < 22; ++i) p.in[i] = (const float*)d_in[i];
    p.out = (float*)d_out; p.ws = (unsigned char*)d_ws;
    (void)hipMemsetAsync((unsigned char*)d_ws + WS_BAR, 0, XCD_BAR_WORDS * 4, stream);
    void* args[] = {&p};
    hipError_t e = hipLaunchCooperativeKernel((const void*)fwd_megakernel, dim3(grid_blocks), dim3(512), args, LDS_BYTES, stream);
    if (e != hipSuccess) fprintf(stderr, "cooperative launch failed: %s (grid %d)\n", hipGetErrorString(e), grid_blocks);
}
```

```cpp
#include <hip/hip_runtime.h>
#include <hip/hip_cooperative_groups.h>
#include <cstdio>
namespace cg = cooperative_groups;

#define LAS __attribute__((address_space(3)))
typedef unsigned short bf16_t;
typedef short bf16x8 __attribute__((ext_vector_type(8)));
typedef float f32x4 __attribute__((ext_vector_type(4)));
typedef float f32x2 __attribute__((ext_vector_type(2)));
typedef unsigned u32x4 __attribute__((ext_vector_type(4)));
typedef unsigned u32x2 __attribute__((ext_vector_type(2)));
typedef __bf16 bf2_t __attribute__((ext_vector_type(2)));

constexpr int D = 1024, NB = 8, SEQ = 4096, DEPTH = 2, CTXL = 256;
constexpr int NLAT = NB * SEQ;
constexpr int NCTX = NB * CTXL;
constexpr int NROW = NLAT + NCTX;
constexpr int PW = 3584, FF = 2816, UPW = 2 * FF;
constexpr float EPS = 1e-6f;

constexpr size_t WS_WIN = 0;
constexpr size_t WS_WOUT = WS_WIN + (size_t)DEPTH * PW * D * 2;
constexpr size_t WS_WUP = WS_WOUT + (size_t)DEPTH * D * D * 2;
constexpr size_t WS_WDOWN = WS_WUP + (size_t)DEPTH * UPW * D * 2;
constexpr size_t WS_WSP = WS_WDOWN + (size_t)DEPTH * D * FF * 2;
constexpr size_t WS_ADA = WS_WSP + (size_t)DEPTH * 4 * 128 * 128 * 2;
constexpr size_t WS_LB = WS_ADA + (size_t)DEPTH * 9 * 6144 * 4;
constexpr size_t WS_XC = WS_LB + 2 * 512 * 4;
constexpr size_t WS_H = WS_XC + (size_t)NCTX * D * 4;
constexpr size_t WS_BIG = WS_H + (size_t)NROW * D * 2;
constexpr size_t WS_OFB = WS_BIG + (size_t)NROW * PW * 2;
constexpr size_t WS_QB = WS_OFB + 2 * (size_t)NROW * 512 * 2;
constexpr size_t WS_DS = WS_BIG + (size_t)NROW * UPW * 2;
constexpr size_t WS_BAR = WS_DS + (size_t)64 * 136 * 128 * 4;
constexpr size_t WS_END = WS_BAR + 16384;

constexpr size_t PSLOT = (size_t)NROW * 128;
__device__ __forceinline__ size_t PIX(int row, int col) { return (size_t)(col >> 7) * PSLOT + (size_t)row * 128 + (col & 127); }
struct Params {
    const float* in[22];
    float* out;
    unsigned char* ws;
};

__device__ __forceinline__ unsigned pk_bf16(float a, float b) { f32x2 v = {a, b}; bf2_t r = __builtin_convertvector(v, bf2_t); return __builtin_bit_cast(unsigned, r); }
__device__ __forceinline__ float bf_lo(unsigned u) { return __uint_as_float(u << 16); }
__device__ __forceinline__ float bf_hi(unsigned u) { return __uint_as_float(u & 0xffff0000u); }
__device__ __forceinline__ float bf1(bf16_t u) { return __uint_as_float(((unsigned)u) << 16); }
__device__ __forceinline__ bf16_t to_bf1(float a) { return (bf16_t)(pk_bf16(a, 0.f) & 0xffffu); }
__device__ __forceinline__ float fast_rcp(float x) { return __builtin_amdgcn_rcpf(x); }
__device__ __forceinline__ float gelu_f(float v) {
    const float av = fabsf(v), t = fast_rcp(av * 0.2316418882f + 1.0f);
    float q = t * 0.5307027145f + (-0.7265760135f); q = q * t + 0.7107068705f; q = q * t + (-0.142248368f); q = q * t + 0.127414796f; q = q * t;
    const float e = __builtin_amdgcn_exp2f((v * v) * (-0.72134752044f));
    const float m = v * (q * e);
    return v < 0.f ? m : v - m;
}
__device__ __forceinline__ int opaque_tid() { int t = threadIdx.x; asm volatile("" : "+v"(t)); return t; }
__device__ __forceinline__ float silu_f(float x) { return x * fast_rcp(1.0f + __expf(-x)); }

namespace pg8 {
constexpr int BM = 256, BK = 64, HALF = 128, HTB = HALF * BK * 2, STAGE_BYTES = 8 * HTB, NXCD = 8, WGM = 8;
__host__ __device__ __forceinline__ int lds_byte(int r, int c) { const int st = (r >> 4) * 2 + (c >> 5), rr = r & 15, cc = c & 31, ob = rr * 64 + cc * 2; return st * 1024 + (ob ^ (((ob >> 9) & 1) << 5)); }
__host__ __device__ __forceinline__ void stage_rc(int b, int& R, int& C) { const int st = b / 1024, sb = b % 1024, swz = sb ^ (((sb >> 9) & 1) << 5); R = (st >> 1) * 16 + swz / 64; C = (st & 1) * 32 + (swz % 64) / 2; }
__host__ __device__ __forceinline__ int perm32(int rho) { const int n = rho >> 4, i = rho & 15; return 8 * (i >> 2) + 4 * n + (i & 3); }
struct Unit { int pm, pn; };
struct Gemm { const bf16_t* A; const bf16_t* Bt; int M, N, K; };
struct StaticOrder {
    int nM, nN, nwg, G, c;
    __device__ void init(int M, int N, int G_, int c_) { nM = M / BM; nN = N / BM; nwg = nM * nN; G = G_; c = c_; }
    __device__ bool next(int i, Unit& u) const {
        const long L = (long)i * G + c; if (L >= nwg) return false;
        int wgid = (int)L; { const int q = nwg / NXCD, r = nwg % NXCD, xcd = wgid % NXCD, off = wgid / NXCD; wgid = (xcd < r ? xcd * (q + 1) : r * (q + 1) + (xcd - r) * q) + off; }
        const int nig = WGM * nN, gid = wgid / nig, fm = gid * WGM, gsz = (nM - fm) < WGM ? (nM - fm) : WGM;
        u.pm = fm + ((wgid % nig) % gsz); u.pn = (wgid % nig) / gsz; return true;
    }
    __device__ __forceinline__ void a_ready(const Unit&) const {}
    __device__ __forceinline__ void done(const Unit&) const {}
};
struct EpiBf16 {
    static constexpr bool PERM = true;
    bf16_t* O; int ldc; int split_cols; size_t split_stride; size_t slot_stride;
    __device__ __forceinline__ void operator()(const f32x4 (&acc)[2][2][4][2], const Unit& u, int wr, int wc, int fr, int fq) const {
        const int row0 = u.pm * BM + wr * 64 + fr; int colt = u.pn * BM; bf16_t* base = O;
        if (split_cols) { const int t = colt / split_cols; base += (size_t)t * split_stride; colt -= t * split_cols; }
        const int col0 = colt + wc * 32 + 8 * fq;
#pragma unroll
        for (int ai = 0; ai < 2; ++ai)
#pragma unroll
            for (int m = 0; m < 4; ++m) { const int row = row0 + ai * HALF + m * 16;
                bf16_t* rowp = slot_stride ? base + (size_t)(colt >> 7) * slot_stride + (size_t)row * 128 + wc * 32 + 8 * fq : base + (size_t)row * ldc + col0;
#pragma unroll
                for (int bj = 0; bj < 2; ++bj) { const f32x4 v0 = acc[ai][bj][m][0], v1 = acc[ai][bj][m][1];
                    u32x4 w; w.x = pk_bf16(v0[0], v0[1]); w.y = pk_bf16(v0[2], v0[3]); w.z = pk_bf16(v1[0], v1[1]); w.w = pk_bf16(v1[2], v1[3]);
                    *(u32x4*)(rowp + (slot_stride ? (size_t)bj * slot_stride : (size_t)bj * HALF)) = w; } }
    }
};
struct EpiRes {
    static constexpr bool PERM = false;
    const float* resL; float* outL; const float* resC; float* outC; const float* gate;
    __device__ __forceinline__ void operator()(const f32x4 (&acc)[2][2][4][2], const Unit& u, int wr, int wc, int fr, int fq) const {
        const float* res; float* out; const float* g; int rowb;
        if (u.pm < NLAT / BM) { res = resL; out = outL; g = gate + (size_t)(u.pm >> 4) * 6144; rowb = u.pm * BM; }
        else { res = resC; out = outC; g = gate + (size_t)8 * 6144; rowb = u.pm * BM - NLAT; }
        const int row0 = rowb + wr * 64 + fr, col0 = u.pn * BM + wc * 32 + 4 * fq;
        f32x4 gv[2][2];
#pragma unroll
        for (int bj = 0; bj < 2; ++bj)
#pragma unroll
            for (int n = 0; n < 2; ++n) gv[bj][n] = *(const f32x4*)(g + col0 + bj * HALF + n * 16);
#pragma unroll
        for (int ai = 0; ai < 2; ++ai)
#pragma unroll
            for (int m = 0; m < 4; ++m) { const size_t ro = (size_t)(row0 + ai * HALF + m * 16) * D + col0;
#pragma unroll
                for (int bj = 0; bj < 2; ++bj)
#pragma unroll
                    for (int n = 0; n < 2; ++n) { const f32x4 r = *(const f32x4*)(res + ro + bj * HALF + n * 16);
                        *(f32x4*)(out + ro + bj * HALF + n * 16) = r + gv[bj][n] * acc[ai][bj][m][n]; } }
    }
};

template <class Epi, class Sched>
__device__ __forceinline__ void gemm_phase(LAS unsigned char* lds, const Gemm g, const Sched& S, const Epi& E) {
    const int tid = opaque_tid(), wid = __builtin_amdgcn_readfirstlane(tid >> 6), lane = tid & 63, wr = wid >> 2, wc = wid & 3, fr = lane & 15, fq = lane >> 4;
    const int K = g.K, nt = K / BK;
    unsigned voffA[2], voffB[2];
#pragma unroll
    for (int i = 0; i < 2; ++i) { int R, C; stage_rc(tid * 16 + i * 8192, R, C); const int Rb = Epi::PERM ? ((R & ~31) + perm32(R & 31)) : R;
        voffA[i] = (unsigned)(R * K + C) * 2u; voffB[i] = (unsigned)(Rb * K + C) * 2u; }
    const size_t kstep = (size_t)(BK * 2);
    const size_t hstep = (size_t)HALF * K * 2;
    const size_t tstep = 2 * hstep;
    const unsigned ldsw = (unsigned)wid * 1024u;
    const int aoff = lds_byte(wr * 64 + fr, fq * 8), boff = lds_byte(wc * 32 + fr, fq * 8);
#define PG8_SA(b, h) (((b) * 2 + (h)) * HTB)
#define PG8_SB(b, h) ((4 + (b) * 2 + (h)) * HTB)
#define PG8_STAGE(bufoff, gbase, voff) do { _Pragma("unroll") for (int _i = 0; _i < 2; ++_i) \
        __builtin_amdgcn_global_load_lds((const unsigned*)((const char*)(gbase) + (voff)[_i]), (LAS unsigned*)(lds + (bufoff) + ldsw + _i * 8192), 16, 0, 0); } while (0)
#define PG8_LDA(dst, b, h) do { _Pragma("unroll") for (int m = 0; m < 4; ++m) _Pragma("unroll") for (int k = 0; k < 2; ++k) dst[m][k] = *(const LAS bf16x8*)(lds + PG8_SA(b, h) + aoff + m * 2048 + k * 1024); } while (0)
#define PG8_LDB(dst, b, h) do { _Pragma("unroll") for (int n = 0; n < 2; ++n) _Pragma("unroll") for (int k = 0; k < 2; ++k) dst[n][k] = *(const LAS bf16x8*)(lds + PG8_SB(b, h) + boff + n * 2048 + k * 1024); } while (0)
#define PG8_MMA(ai, bj, At, Bt) do { __builtin_amdgcn_s_setprio(1); _Pragma("unroll") for (int m = 0; m < 4; ++m) _Pragma("unroll") for (int n = 0; n < 2; ++n) _Pragma("unroll") for (int k = 0; k < 2; ++k) \
        acc[ai][bj][m][n] = __builtin_amdgcn_mfma_f32_16x16x32_bf16(Bt[n][k], At[m][k], acc[ai][bj][m][n], 0, 0, 0); __builtin_amdgcn_s_setprio(0); } while (0)
#define PG8_WAIT_V(n) asm volatile("s_waitcnt vmcnt(" #n ")" ::: "memory")
#define PG8_WAIT_L(n) asm volatile("s_waitcnt lgkmcnt(" #n ")" ::: "memory")
#define PG8_BAR __builtin_amdgcn_s_barrier()
#define PG8_SCHED __builtin_amdgcn_sched_barrier(0)
    Unit cur, nxt; int ui = 0;
    if (!S.next(0, cur)) return;
    f32x4 acc[2][2][4][2];
#pragma unroll
    for (int a = 0; a < 2; ++a)
#pragma unroll
        for (int b = 0; b < 2; ++b)
#pragma unroll
            for (int m = 0; m < 4; ++m)
#pragma unroll
                for (int n = 0; n < 2; ++n) acc[a][b][m][n] = (f32x4){0.f, 0.f, 0.f, 0.f};
    bf16x8 At[4][2], B0[2][2], B1[2][2];
    const char* cA = (const char*)g.A + (size_t)cur.pm * tstep; const char* cB = (const char*)g.Bt + (size_t)cur.pn * tstep;
    S.a_ready(cur);
    PG8_STAGE(PG8_SB(0, 0), cB, voffB); PG8_STAGE(PG8_SA(0, 0), cA, voffA); PG8_STAGE(PG8_SB(0, 1), cB + hstep, voffB); PG8_STAGE(PG8_SA(0, 1), cA + hstep, voffA);
    if (wr == 1) PG8_BAR;
    PG8_WAIT_V(4); PG8_BAR;
    PG8_STAGE(PG8_SB(1, 0), cB + kstep, voffB); PG8_STAGE(PG8_SA(1, 0), cA + kstep, voffA); PG8_STAGE(PG8_SB(1, 1), cB + hstep + kstep, voffB);
    PG8_WAIT_V(6); PG8_BAR;
    for (;;) {
        const bool has_next = S.next(ui + 1, nxt);
        const char* nA = has_next ? (const char*)g.A + (size_t)nxt.pm * tstep : cA; const char* nB = has_next ? (const char*)g.Bt + (size_t)nxt.pn * tstep : cB;
        for (int t = 0; t < nt; t += 2) {
            const bool last = (t == nt - 2);
            const char* a1 = cA + (size_t)(t + 1) * kstep;
            const char* a2 = last ? nA : cA + (size_t)(t + 2) * kstep; const char* b2 = last ? nB : cB + (size_t)(t + 2) * kstep;
            const char* a3 = a2 + kstep; const char* b3 = b2 + kstep;
            if (last && has_next) S.a_ready(nxt);
            PG8_LDB(B0, 0, 0); PG8_SCHED; PG8_LDA(At, 0, 0); PG8_STAGE(PG8_SA(1, 1), a1 + hstep, voffA);
            PG8_WAIT_L(8); PG8_BAR; PG8_WAIT_L(0); PG8_MMA(0, 0, At, B0); PG8_BAR; PG8_SCHED;
            PG8_LDB(B1, 0, 1); PG8_STAGE(PG8_SB(0, 0), b2, voffB);
            PG8_BAR; PG8_WAIT_L(0); PG8_MMA(0, 1, At, B1); PG8_BAR;
            PG8_LDA(At, 0, 1); PG8_STAGE(PG8_SA(0, 0), a2, voffA);
            PG8_BAR; PG8_WAIT_L(0); PG8_MMA(1, 0, At, B0); PG8_BAR; PG8_SCHED;
            PG8_STAGE(PG8_SB(0, 1), b2 + hstep, voffB);
            PG8_WAIT_V(6); PG8_BAR; PG8_MMA(1, 1, At, B1); PG8_BAR;
            PG8_LDB(B0, 1, 0); PG8_SCHED; PG8_LDA(At, 1, 0); PG8_STAGE(PG8_SA(0, 1), a2 + hstep, voffA);
            PG8_WAIT_L(8); PG8_BAR; PG8_WAIT_L(0); PG8_MMA(0, 0, At, B0); PG8_BAR; PG8_SCHED;
            PG8_LDB(B1, 1, 1); PG8_STAGE(PG8_SB(1, 0), b3, voffB);
            PG8_BAR; PG8_WAIT_L(0); PG8_MMA(0, 1, At, B1); PG8_BAR;
            PG8_LDA(At, 1, 1); PG8_STAGE(PG8_SA(1, 0), a3, voffA);
            PG8_BAR; PG8_WAIT_L(0); PG8_MMA(1, 0, At, B0); PG8_BAR; PG8_SCHED;
            PG8_STAGE(PG8_SB(1, 1), b3 + hstep, voffB);
            PG8_WAIT_V(6); PG8_BAR; PG8_MMA(1, 1, At, B1); PG8_BAR;
        }
        E(acc, cur, wr, wc, fr, fq); S.done(cur);
        if (!has_next) break;
#pragma unroll
        for (int a = 0; a < 2; ++a)
#pragma unroll
            for (int b = 0; b < 2; ++b)
#pragma unroll
                for (int m = 0; m < 4; ++m)
#pragma unroll
                    for (int n = 0; n < 2; ++n) acc[a][b][m][n] = (f32x4){0.f, 0.f, 0.f, 0.f};
        cur = nxt; cA = nA; cB = nB; ++ui;
    }
    PG8_WAIT_V(0);
    if (wr == 0) PG8_BAR;
    PG8_BAR;
#undef PG8_SA
#undef PG8_SB
#undef PG8_STAGE
#undef PG8_LDA
#undef PG8_LDB
#undef PG8_MMA
#undef PG8_WAIT_V
#undef PG8_WAIT_L
#undef PG8_BAR
#undef PG8_SCHED
}
}

__device__ void transpose_tile(const Params& p, LAS unsigned char* lds, int l, int r) {
    const int tid = opaque_tid();
    const float* src; bf16_t* dst; int K, N;
    if (r < 896) { src = p.in[8] + (size_t)l * D * PW; dst = (bf16_t*)(p.ws + WS_WIN) + (size_t)l * PW * D; K = D; N = PW; }
    else if (r < 1152) { r -= 896; src = p.in[16] + (size_t)l * D * D; dst = (bf16_t*)(p.ws + WS_WOUT) + (size_t)l * D * D; K = D; N = D; }
    else if (r < 2560) { r -= 1152; src = p.in[17] + (size_t)l * D * UPW; dst = (bf16_t*)(p.ws + WS_WUP) + (size_t)l * UPW * D; K = D; N = UPW; }
    else { r -= 2560; src = p.in[20] + (size_t)l * FF * D; dst = (bf16_t*)(p.ws + WS_WDOWN) + (size_t)l * D * FF; K = FF; N = D; }
    const int ntn = N >> 6, kt = r / ntn, nt = r % ntn;
    LAS float* tile = (LAS float*)lds;
    { const int kk = tid >> 3, n8 = (tid & 7) * 8; const float* sp = src + (size_t)(kt * 64 + kk) * N + nt * 64 + n8;
      const f32x4 a = *(const f32x4*)sp, b = *(const f32x4*)(sp + 4);
      LAS float* tp = tile + kk * 65 + n8; tp[0] = a[0]; tp[1] = a[1]; tp[2] = a[2]; tp[3] = a[3]; tp[4] = b[0]; tp[5] = b[1]; tp[6] = b[2]; tp[7] = b[3]; }
    __syncthreads();
    { const int nn = tid >> 3, k8 = (tid & 7) * 8; float v[8];
#pragma unroll
      for (int i = 0; i < 8; ++i) v[i] = tile[(k8 + i) * 65 + nn];
      u32x4 w; w.x = pk_bf16(v[0], v[1]); w.y = pk_bf16(v[2], v[3]); w.z = pk_bf16(v[4], v[5]); w.w = pk_bf16(v[6], v[7]);
      *(u32x4*)(dst + (size_t)(nt * 64 + nn) * K + kt * 64 + k8) = w; }
    __syncthreads();
}
constexpr int NT_LAYER = 896 + 256 + 1408 + 704;

__device__ void phase_prep(const Params& p, LAS unsigned char* lds) {
    const int tid = opaque_tid();
    constexpr int NT_L = 896 + 256 + 1408 + 704;
    constexpr int J_ADA = 192, J_TR = J_ADA + NT_LAYER, J_WSP = J_TR + 32, J_LB = J_WSP + 1;
    for (int job = blockIdx.x; job < J_LB; job += gridDim.x) {
        if (job < J_ADA) {
            LAS float* s = (LAS float*)lds;
            LAS float* red = (LAS float*)(lds + 9 * 1024 * 4);
            { float vv[18];
#pragma unroll
              for (int u = 0; u < 18; ++u) { const int i = tid + 512 * u, r = i >> 10, d = i & 1023; vv[u] = r < 8 ? p.in[1][r * 1024 + d] : p.in[3][d]; }
#pragma unroll
              for (int u = 0; u < 18; ++u) s[tid + 512 * u] = silu_f(vv[u]); }
            __syncthreads();
            const int l = job / 96, e0 = (job % 96) * 64, col = tid & 63, dg = tid >> 6;
            const float* w = p.in[4] + ((size_t)l * 1024 + dg * 128) * 6144 + e0 + col;
            float acc[9];
#pragma unroll
            for (int r = 0; r < 9; ++r) acc[r] = 0.f;
            for (int dd = 0; dd < 128; ++dd) { const float wv = w[(size_t)dd * 6144];
#pragma unroll
                for (int r = 0; r < 9; ++r) acc[r] += s[r * 1024 + dg * 128 + dd] * wv; }
#pragma unroll
            for (int r = 0; r < 9; ++r) red[(dg * 9 + r) * 64 + col] = acc[r];
            __syncthreads();
            for (int i = tid; i < 9 * 64; i += 512) { const int r = i >> 6, c = i & 63; float a = 0.f;
#pragma unroll
                for (int g = 0; g < 8; ++g) a += red[(g * 9 + r) * 64 + c];
                ((float*)(p.ws + WS_ADA))[((size_t)l * 9 + r) * 6144 + e0 + c] = a + p.in[5][l * 6144 + e0 + c]; }
            __syncthreads();
        } else if (job < J_TR) {
            transpose_tile(p, lds, 0, job - J_ADA);
        } else if (job < J_WSP) {
            const int j = job - J_TR; const size_t i0 = (size_t)j * 4096 + tid * 8;
            const f32x4 a = *(const f32x4*)(p.in[14] + i0), b = *(const f32x4*)(p.in[14] + i0 + 4);
            u32x4 w; w.x = pk_bf16(a[0], a[1]); w.y = pk_bf16(a[2], a[3]); w.z = pk_bf16(b[0], b[1]); w.w = pk_bf16(b[2], b[3]);
            *(u32x4*)((bf16_t*)(p.ws + WS_WSP) + i0) = w;
        } else {
            for (int i = tid; i < 1024; i += 512) { const int dir = i >> 9, c = i & 511; const float* lg = dir ? p.in[10] : p.in[9];
                const float l0 = lg[c], l1 = lg[512 + c]; ((float*)(p.ws + WS_LB))[i] = 1.0f / (1.0f + expf(l0 - l1)); }
        }
    }
}

__device__ void phase_norm(const float* xl, const float* xc, const bf16_t* Y, const float* gate  , float* xl_dst, float* xc_dst,
                           const float* gain, const float* ada_l, int shift_idx, int nrows, bf16_t* H) {
    const int tid_ = opaque_tid(); const int wave = tid_ >> 6, lane = tid_ & 63;
    f32x4 gn[4];
#pragma unroll
    for (int j = 0; j < 4; ++j) gn[j] = *(const f32x4*)(gain + j * 256 + lane * 4);
    for (int rr = (blockIdx.x * 8 + wave) * 2; rr < nrows; rr += gridDim.x * 16) {
        const int row = nrows - 2 - rr;
        const float* src; const float* mod; float* dst; const float* gt;
        if (row < NLAT) { src = xl + (size_t)row * D; mod = ada_l + (size_t)(row >> 12) * 6144; dst = xl_dst ? xl_dst + (size_t)row * D : nullptr; gt = gate + (size_t)(row >> 12) * 6144; }
        else { src = xc + (size_t)(row - NLAT) * D; mod = ada_l + (size_t)8 * 6144; dst = xc_dst ? xc_dst + (size_t)(row - NLAT) * D : nullptr; gt = gate + (size_t)8 * 6144; }
        f32x4 v[2][4], sh[4], sc[4], gg[4]; u32x2 yv[2][4];
#pragma unroll
        for (int u = 0; u < 2; ++u)
#pragma unroll
            for (int j = 0; j < 4; ++j) { v[u][j] = __builtin_nontemporal_load((const f32x4*)(src + (size_t)u * D + j * 256 + lane * 4)); if (Y) yv[u][j] = __builtin_nontemporal_load((const u32x2*)(Y + (size_t)(row + u) * D + j * 256 + lane * 4)); }
#pragma unroll
        for (int j = 0; j < 4; ++j) { const int d = j * 256 + lane * 4; sh[j] = *(const f32x4*)(mod + shift_idx * 1024 + d); sc[j] = *(const f32x4*)(mod + (shift_idx + 1) * 1024 + d); if (Y) gg[j] = *(const f32x4*)(gt + d); }
#pragma unroll
        for (int u = 0; u < 2; ++u) {
            if (Y) {
#pragma unroll
                for (int j = 0; j < 4; ++j) {
                    v[u][j][0] += gg[j][0] * bf_lo(yv[u][j].x); v[u][j][1] += gg[j][1] * bf_hi(yv[u][j].x); v[u][j][2] += gg[j][2] * bf_lo(yv[u][j].y); v[u][j][3] += gg[j][3] * bf_hi(yv[u][j].y);
                    if (dst) __builtin_nontemporal_store(v[u][j], (f32x4*)(dst + (size_t)u * D + j * 256 + lane * 4)); }
            }
            float ss = 0.f;
#pragma unroll
            for (int j = 0; j < 4; ++j) ss += v[u][j][0] * v[u][j][0] + v[u][j][1] * v[u][j][1] + v[u][j][2] * v[u][j][2] + v[u][j][3] * v[u][j][3];
#pragma unroll
            for (int o = 32; o > 0; o >>= 1) ss += __shfl_xor(ss, o);
            const float rs = rsqrtf(ss * (1.0f / D) + EPS);
#pragma unroll
            for (int j = 0; j < 4; ++j) { const int d = j * 256 + lane * 4;
                f32x4 y = v[u][j] * rs * gn[j]; y = y * (sc[j] + 1.0f) + sh[j];
                u32x2 wv; wv.x = pk_bf16(y[0], y[1]); wv.y = pk_bf16(y[2], y[3]);
                *(u32x2*)(H + (size_t)(row + u) * D + d) = wv; }
        }
    }
}
__device__ void phase_final(float* x, const bf16_t* Y, const float* gate, const float* gain) {
    const int tid_ = opaque_tid(); const int wave = tid_ >> 6, lane = tid_ & 63;
    f32x4 gn[4];
#pragma unroll
    for (int j = 0; j < 4; ++j) gn[j] = *(const f32x4*)(gain + j * 256 + lane * 4);
    for (int row = (blockIdx.x * 8 + wave) * 2; row < NLAT; row += gridDim.x * 16) {
        const float* gt = gate + (size_t)(row >> 12) * 6144;
        f32x4 v[2][4], gg[4]; u32x2 yv[2][4];
#pragma unroll
        for (int u = 0; u < 2; ++u)
#pragma unroll
            for (int j = 0; j < 4; ++j) { v[u][j] = __builtin_nontemporal_load((const f32x4*)(x + (size_t)(row + u) * D + j * 256 + lane * 4)); yv[u][j] = __builtin_nontemporal_load((const u32x2*)(Y + (size_t)(row + u) * D + j * 256 + lane * 4)); }
#pragma unroll
        for (int j = 0; j < 4; ++j) gg[j] = *(const f32x4*)(gt + j * 256 + lane * 4);
#pragma unroll
        for (int u = 0; u < 2; ++u) {
            float ss = 0.f;
#pragma unroll
            for (int j = 0; j < 4; ++j) {
                v[u][j][0] += gg[j][0] * bf_lo(yv[u][j].x); v[u][j][1] += gg[j][1] * bf_hi(yv[u][j].x); v[u][j][2] += gg[j][2] * bf_lo(yv[u][j].y); v[u][j][3] += gg[j][3] * bf_hi(yv[u][j].y);
                ss += v[u][j][0] * v[u][j][0] + v[u][j][1] * v[u][j][1] + v[u][j][2] * v[u][j][2] + v[u][j][3] * v[u][j][3]; }
#pragma unroll
            for (int o = 32; o > 0; o >>= 1) ss += __shfl_xor(ss, o);
            const float rs = rsqrtf(ss * (1.0f / D) + EPS);
#pragma unroll
            for (int j = 0; j < 4; ++j) { const int d = j * 256 + lane * 4; __builtin_nontemporal_store(v[u][j] * rs * gn[j], (f32x4*)(x + (size_t)(row + u) * D + d)); }
        }
    }
}

constexpr int QS_ST = 136, KT_ST = 40;
constexpr int P1_QS = 0, P1_KH = P1_QS + 32 * QS_ST * 2, P1_VT = P1_KH + 32 * QS_ST * 2, P1_KT = P1_VT + 128 * KT_ST * 2, P1_AW = P1_KT + 128 * KT_ST * 2;
constexpr int P1_DIRSZ = P1_AW + 8 * 32 * KT_ST * 2;
constexpr int NCH = 8 + 128;

template <int CTRL, int RMASK> __device__ __forceinline__ float dpp_mul(float x) {
    const int t = __builtin_amdgcn_update_dpp(0x3f800000, __builtin_bit_cast(int, x), CTRL, RMASK, 0xf, false);
    return x * __builtin_bit_cast(float, t);
}
__device__ __forceinline__ float cumprod32(float x) {
    x = dpp_mul<0x111, 0xf>(x); x = dpp_mul<0x112, 0xf>(x); x = dpp_mul<0x114, 0xf>(x); x = dpp_mul<0x118, 0xf>(x);
    x = dpp_mul<0x142, 0xa>(x);
    return x;
}

#define DPP8_STEP(CTRL) asm volatile("s_nop 1\n\t" \
    "v_mul_f32_dpp %0, %0, %0 " CTRL "\n\tv_mul_f32_dpp %1, %1, %1 " CTRL "\n\tv_mul_f32_dpp %2, %2, %2 " CTRL "\n\tv_mul_f32_dpp %3, %3, %3 " CTRL "\n\t" \
    "v_mul_f32_dpp %4, %4, %4 " CTRL "\n\tv_mul_f32_dpp %5, %5, %5 " CTRL "\n\tv_mul_f32_dpp %6, %6, %6 " CTRL "\n\tv_mul_f32_dpp %7, %7, %7 " CTRL "\n\ts_nop 1" \
    : "+v"(e[0]), "+v"(e[1]), "+v"(e[2]), "+v"(e[3]), "+v"(e[4]), "+v"(e[5]), "+v"(e[6]), "+v"(e[7]))
__device__ __forceinline__ void cumprod32x8(float (&e)[8]) {
    asm volatile("s_nop 4" ::: );
    DPP8_STEP("row_shr:1 row_mask:0xf bank_mask:0xf");
    DPP8_STEP("row_shr:2 row_mask:0xf bank_mask:0xf");
    DPP8_STEP("row_shr:4 row_mask:0xf bank_mask:0xf");
    DPP8_STEP("row_shr:8 row_mask:0xf bank_mask:0xf");
    DPP8_STEP("row_bcast:15 row_mask:0xa bank_mask:0xf");
}
__device__ void prep_item(const Params& p, int l, int item, LAS unsigned char* lds) {
    const int tid = opaque_tid(), w = tid >> 6, lane = tid & 63;
    const int tau = lane & 31, kh = lane >> 5, k0 = 16 * w + 8 * kh, l15 = lane & 15, q4 = lane >> 4;
    const int ci = item % NCH, bh = item / NCH, h = bh & 3, b = bh >> 2;
    const int R0 = ci < 8 ? NLAT + b * 256 + 32 * ci : b * 4096 + 32 * (ci - 8);
    bf16_t* P = (bf16_t*)(p.ws + WS_BIG);
    const bool first = (l == 0);
    const bool want_out = first || ci >= 8;
    for (int dd = 0; dd < 2; ++dd) { LAS unsigned* az = (LAS unsigned*)(lds + dd * P1_DIRSZ + P1_AW) + w * (32 * KT_ST / 2); for (int i = lane; i < 32 * KT_ST / 2; i += 64) az[i] = 0u; }
    u32x4 rf0, rq0, rv0, rf1, rq1, rv1;
    { const int r_ = R0 + tau; rf0 = *(const u32x4*)(P + PIX(r_, h * 128 + k0)); rq0 = *(const u32x4*)(P + PIX(r_, 1536 + h * 128 + k0)); rv0 = *(const u32x4*)(P + PIX(r_, 1024 + h * 128 + k0)); }
    { const int r_ = R0 + 31 - tau; rf1 = *(const u32x4*)(P + PIX(r_, 512 + h * 128 + k0)); rq1 = *(const u32x4*)(P + PIX(r_, 1536 + h * 128 + k0)); rv1 = *(const u32x4*)(P + PIX(r_, 1024 + h * 128 + k0)); }
    asm volatile("s_waitcnt vmcnt(0)" ::: "memory");
    __syncthreads();
    auto valu_part = [&](const int dir, const u32x4& f, const u32x4& q, const u32x4& v) {
        LAS unsigned char* db = lds + dir * P1_DIRSZ;
        LAS bf16_t* Qs = (LAS bf16_t*)(db + P1_QS); LAS bf16_t* Kh = (LAS bf16_t*)(db + P1_KH);
        LAS bf16_t* Vt = (LAS bf16_t*)(db + P1_VT); LAS bf16_t* Kt = (LAS bf16_t*)(db + P1_KT);
        LAS bf16_t* Aw = (LAS bf16_t*)(db + P1_AW) + w * 32 * KT_ST;
        const int tokl = dir ? 31 - tau : tau;
        const float* lbp = (const float*)(p.ws + WS_LB) + dir * 512 + h * 128 + k0;
        float E[8], kk[8];
#pragma unroll
        for (int j = 0; j < 8; ++j) {
            const unsigned fw = f[j >> 1]; const float x = (j & 1) ? bf_hi(fw) : bf_lo(fw);
            const float e = __expf(-fabsf(x)), r = fast_rcp(1.0f + e);
            const float sp = x >= 0.f ? r : e * r, sn = x >= 0.f ? e * r : r;
            if (first) { E[j] = sp; kk[j] = sn; }
            else { const float lb = lbp[j]; const float gate = lb + (1.0f - lb) * sp; E[j] = gate; kk[j] = 1.0f - gate; }
        }
        float qt[8], kh_[8], kt_[8], Tj[8];
        cumprod32x8(E);
#pragma unroll
        for (int j = 0; j < 8; ++j) {
            const float Ej = fmaxf(E[j], 1e-35f);
            const float T0 = __builtin_bit_cast(float, __builtin_amdgcn_readlane(__builtin_bit_cast(int, Ej), 31)), T1 = __builtin_bit_cast(float, __builtin_amdgcn_readlane(__builtin_bit_cast(int, Ej), 63));
            const float T = kh ? T1 : T0;
            const unsigned qw = q[j >> 1]; const float qx = (j & 1) ? bf_hi(qw) : bf_lo(qw);
            qt[j] = silu_f(qx) * 0.08838834764831845f * Ej;
            kh_[j] = kk[j] * fast_rcp(Ej); kt_[j] = kh_[j] * T;
            Tj[j] = T;
        }
        if (tau == 31) { float* dp = (float*)(p.ws + WS_DS) + ((size_t)((b * 4 + h) * 2 + dir) * NCH + ci) * 128 + k0;
            *(f32x4*)dp = (f32x4){Tj[0], Tj[1], Tj[2], Tj[3]}; *(f32x4*)(dp + 4) = (f32x4){Tj[4], Tj[5], Tj[6], Tj[7]}; }
        u32x4 wq, wk; wq.x = pk_bf16(qt[0], qt[1]); wq.y = pk_bf16(qt[2], qt[3]); wq.z = pk_bf16(qt[4], qt[5]); wq.w = pk_bf16(qt[6], qt[7]);
        wk.x = pk_bf16(kh_[0], kh_[1]); wk.y = pk_bf16(kh_[2], kh_[3]); wk.z = pk_bf16(kh_[4], kh_[5]); wk.w = pk_bf16(kh_[6], kh_[7]);
        *(LAS u32x4*)(Qs + tau * QS_ST + k0) = wq; *(LAS u32x4*)(Kh + tau * QS_ST + k0) = wk;
        {
          bf16_t* qd = (dir == 0) ? P + PIX(R0 + tokl, 1536 + h * 128) : (bf16_t*)(p.ws + WS_QB) + (size_t)h * PSLOT + (size_t)(R0 + tokl) * 128;
          const int a32 = k0 & ~31, kkA = k0 & 31, kkB = kkA + 4;
          u32x2 pa, pb; pa.x = wq.x; pa.y = wq.y; pb.x = wq.z; pb.y = wq.w;
          *(u32x2*)(qd + a32 + 8 * ((kkA & 15) >> 2) + 4 * (kkA >> 4)) = pa;
          *(u32x2*)(qd + a32 + 8 * ((kkB & 15) >> 2) + 4 * (kkB >> 4)) = pb; }
#pragma unroll
        for (int j = 0; j < 8; ++j) { Kt[(k0 + j) * KT_ST + tokl] = to_bf1(kt_[j]); const unsigned vw = v[j >> 1]; Vt[(k0 + j) * KT_ST + tau] = (bf16_t)((j & 1) ? (vw >> 16) : (vw & 0xffffu)); }
    };
    auto mfma_part = [&](const int dir) {
        LAS unsigned char* db = lds + dir * P1_DIRSZ;
        LAS bf16_t* Qs = (LAS bf16_t*)(db + P1_QS); LAS bf16_t* Kh = (LAS bf16_t*)(db + P1_KH);
        LAS bf16_t* Vt = (LAS bf16_t*)(db + P1_VT); LAS bf16_t* Kt = (LAS bf16_t*)(db + P1_KT);
        LAS bf16_t* Aw = (LAS bf16_t*)(db + P1_AW) + w * 32 * KT_ST;
        const int tokl = dir ? 31 - tau : tau; (void)tokl;
        if (want_out) {
            f32x4 a00 = (f32x4){0.f, 0.f, 0.f, 0.f}, a10 = a00, a11 = a00;
#pragma unroll
            for (int kb = 0; kb < 4; ++kb) {
                const bf16x8 qn0 = *(const LAS bf16x8*)(Qs + l15 * QS_ST + 32 * kb + 8 * q4), qn1 = *(const LAS bf16x8*)(Qs + (16 + l15) * QS_ST + 32 * kb + 8 * q4);
                const bf16x8 kh0 = *(const LAS bf16x8*)(Kh + l15 * QS_ST + 32 * kb + 8 * q4), kh1 = *(const LAS bf16x8*)(Kh + (16 + l15) * QS_ST + 32 * kb + 8 * q4);
                a00 = __builtin_amdgcn_mfma_f32_16x16x32_bf16(qn0, kh0, a00, 0, 0, 0);
                a10 = __builtin_amdgcn_mfma_f32_16x16x32_bf16(qn1, kh0, a10, 0, 0, 0);
                a11 = __builtin_amdgcn_mfma_f32_16x16x32_bf16(qn1, kh1, a11, 0, 0, 0);
            }
#pragma unroll
            for (int i = 0; i < 4; ++i) { const int t = 4 * q4 + i; const bool keep = l15 <= t;
                Aw[t * KT_ST + l15] = to_bf1(keep ? a00[i] : 0.f);
                Aw[(16 + t) * KT_ST + l15] = to_bf1(a10[i]);
                Aw[(16 + t) * KT_ST + 16 + l15] = to_bf1(keep ? a11[i] : 0.f); }
            asm volatile("s_waitcnt lgkmcnt(0)" ::: "memory");
            const bf16x8 vf = *(const LAS bf16x8*)(Vt + (16 * w + l15) * KT_ST + 8 * q4);
            bf16_t* OFB = (bf16_t*)(p.ws + WS_OFB) + (size_t)dir * NROW * 512;
#pragma unroll
            for (int mt = 0; mt < 2; ++mt) {
                const bf16x8 af = *(const LAS bf16x8*)(Aw + (16 * mt + l15) * KT_ST + 8 * q4);
                const f32x4 o = __builtin_amdgcn_mfma_f32_16x16x32_bf16(vf, af, (f32x4){0.f, 0.f, 0.f, 0.f}, 0, 0, 0);
                const int tl = 16 * mt + l15, tok = dir ? 31 - tl : tl;
                u32x2 wv; wv.x = pk_bf16(o[0], o[1]); wv.y = pk_bf16(o[2], o[3]);
                *(u32x2*)(OFB + (size_t)h * PSLOT + (size_t)(R0 + tok) * 128 + 16 * w + 4 * q4) = wv;
            }
        }
        { const int k = tid >> 2, part = tid & 3;
          const u32x4 kv = *(const LAS u32x4*)(Kt + k * KT_ST + 8 * part);
          const int pc = h * 128 + (k & 3) * 32 + (part ^ ((k >> 2) & 3)) * 8;
          *(u32x4*)(P + PIX(R0 + (k >> 2), dir * 512 + pc)) = kv;
          if (dir == 0) { const u32x4 vv = *(const LAS u32x4*)(Vt + k * KT_ST + 8 * part); *(u32x4*)(P + PIX(R0 + (k >> 2), 1024 + pc)) = vv; } }
    };
    valu_part(0, rf0, rq0, rv0);
    valu_part(1, rf1, rq1, rv1);
    __syncthreads();
    mfma_part(0);
    mfma_part(1);
    __syncthreads();
}

constexpr int ST_Q = 0, ST_K = 8192, ST_V = 16384, ST_O = 20480, ST_D = 24576, ST_BYTES = 25088, NSTAGE = 6;
__device__ void scan_chain(const Params& p, int l, int chain, int vhalf, LAS unsigned char* lds) {
    const int tid = opaque_tid(), w = __builtin_amdgcn_readfirstlane(tid >> 6), lane = tid & 63, l15 = lane & 15, q4 = lane >> 4;
    const int dir = chain & 1, h = (chain >> 1) & 3, b = chain >> 3;
    bf16_t* P = (bf16_t*)(p.ws + WS_BIG);
    auto chunk_of = [&](int s) -> int { return dir ? (s < 8 ? 7 - s : 143 - s) : s; };
    auto row0_of = [&](int c) -> int { return c < 8 ? NLAT + b * 256 + 32 * c : b * 4096 + 32 * (c - 8); };
    bf16_t* qb = dir ? (bf16_t*)(p.ws + WS_QB) + (size_t)h * PSLOT : P + PIX(0, 1536 + h * 128);
    const int qpitch = 128;
    if (w >= 4) {
        const int lw = w - 4;
        const int r16 = lane >> 4, s16 = lane & 15;
        size_t qoff[2], koff[2];
#pragma unroll
        for (int i = 0; i < 2; ++i) { const int row = 8 * lw + 4 * i + r16; qoff[i] = (size_t)row * qpitch + ((s16 ^ (row & 15)) * 8);
            koff[i] = PIX(4 * (2 * lw + i) + r16, dir * 512 + h * 128) + s16 * 8; }
        const size_t voff = PIX(16 * vhalf + 4 * lw + r16, 1024 + h * 128) + s16 * 8;
        const float* dsrc = (const float*)(p.ws + WS_DS) + (size_t)chain * NCH * 128 + (lw & 1) * 64 + lane;
        const int orow = 8 * lw + (lane >> 3);
        const size_t ooff = (size_t)h * PSLOT + (size_t)orow * 128 + 64 * vhalf + (((lane & 7) ^ (orow & 7)) * 8);
        const bf16_t* OFBc = (const bf16_t*)(p.ws + WS_OFB) + (size_t)dir * NROW * 512;
        auto issue = [&](int s) {
            const int sc = s < NCH ? s : NCH - 1;
            const int c = chunk_of(sc), R0 = row0_of(c);
            LAS unsigned char* st = lds + (s % NSTAGE) * ST_BYTES;
            const bf16_t* qrow = qb + (size_t)R0 * qpitch; const bf16_t* krow = P + (size_t)R0 * 128;
#pragma unroll
            for (int i = 0; i < 2; ++i) {
                __builtin_amdgcn_global_load_lds((const unsigned*)(qrow + qoff[i]), (LAS unsigned*)(st + ST_Q + (2 * lw + i) * 1024), 16, 0, 0);
                __builtin_amdgcn_global_load_lds((const unsigned*)(krow + koff[i]), (LAS unsigned*)(st + ST_K + (2 * lw + i) * 1024), 16, 0, 0);
            }
            __builtin_amdgcn_global_load_lds((const unsigned*)(krow + voff), (LAS unsigned*)(st + ST_V + lw * 1024), 16, 0, 0);
            __builtin_amdgcn_global_load_lds((const unsigned*)(dsrc + (size_t)c * 128), (LAS unsigned*)(st + ST_D + (lw & 1) * 256), 4, 0, 0);
            __builtin_amdgcn_global_load_lds((const unsigned*)(OFBc + (size_t)R0 * 128 + ooff), (LAS unsigned*)(st + ST_O + lw * 1024), 16, 0, 0);
        };
        issue(0); issue(1); issue(2); issue(3); issue(4);
        asm volatile("s_waitcnt vmcnt(28)" ::: "memory");
        __builtin_amdgcn_s_barrier();
        for (int s = 0; s < NCH; ++s) {
            issue(s + 5);
            asm volatile("s_waitcnt vmcnt(28)" ::: "memory");
            __builtin_amdgcn_s_barrier();
        }
        asm volatile("s_waitcnt vmcnt(0)" ::: "memory");
    } else {
        f32x4 S[8];
#pragma unroll
        for (int j = 0; j < 8; ++j) S[j] = (f32x4){0.f, 0.f, 0.f, 0.f};
        const int swz = (l15 >> 2) & 3, vcol = 64 * vhalf + 16 * w;
        bf16_t* OFBw = (bf16_t*)(p.ws + WS_OFB) + (size_t)dir * NROW * 512;
        __builtin_amdgcn_s_barrier();
        for (int s = 0; s < NCH; ++s) {
            LAS unsigned char* st = lds + (s % NSTAGE) * ST_BYTES;
            bf16x8 qf[4][2], kf[8]; f32x4 dv[8];
#pragma unroll
            for (int kb = 0; kb < 4; ++kb)
#pragma unroll
                for (int mt = 0; mt < 2; ++mt) {
                    qf[kb][mt] = *(const LAS bf16x8*)(st + ST_Q + (16 * mt + l15) * 256 + (((4 * kb + q4) ^ l15) * 16));
                }
            const bf16x8 vf = *(const LAS bf16x8*)(st + ST_V + (16 * w + l15) * 64 + ((q4 ^ swz) * 16));
            u32x2 oi[2];
#pragma unroll
            for (int mt = 0; mt < 2; ++mt) { const int tr = 16 * mt + l15; oi[mt] = *(const LAS u32x2*)(st + ST_O + tr * 128 + (((2 * w + (q4 >> 1)) ^ (tr & 7)) * 16) + (q4 & 1) * 8); }
#pragma unroll
            for (int j = 0; j < 8; ++j) { dv[j] = *(const LAS f32x4*)(st + ST_D + (16 * j + 4 * q4) * 4); kf[j] = *(const LAS bf16x8*)(st + ST_K + (16 * j + l15) * 64 + ((q4 ^ swz) * 16)); }
            __builtin_amdgcn_sched_barrier(0);
            f32x4 o[2]; o[0] = (f32x4){0.f, 0.f, 0.f, 0.f}; o[1] = o[0];
#pragma unroll
            for (int kb = 0; kb < 4; ++kb) {
                u32x4 sb; sb.x = pk_bf16(S[2 * kb][0], S[2 * kb][1]); sb.y = pk_bf16(S[2 * kb][2], S[2 * kb][3]); sb.z = pk_bf16(S[2 * kb + 1][0], S[2 * kb + 1][1]); sb.w = pk_bf16(S[2 * kb + 1][2], S[2 * kb + 1][3]);
                const bf16x8 sfr = __builtin_bit_cast(bf16x8, sb);
                o[0] = __builtin_amdgcn_mfma_f32_16x16x32_bf16(sfr, qf[kb][0], o[0], 0, 0, 0);
                o[1] = __builtin_amdgcn_mfma_f32_16x16x32_bf16(sfr, qf[kb][1], o[1], 0, 0, 0);
            }
#pragma unroll
            for (int j = 0; j < 8; ++j) S[j] = __builtin_amdgcn_mfma_f32_16x16x32_bf16(kf[j], vf, S[j] * dv[j], 0, 0, 0);
            const int R0 = row0_of(chunk_of(s));
#pragma unroll
            for (int mt = 0; mt < 2; ++mt) { const int tr = 16 * mt + l15;
                u32x2 wv; wv.x = pk_bf16(o[mt][0] + bf_lo(oi[mt].x), o[mt][1] + bf_hi(oi[mt].x)); wv.y = pk_bf16(o[mt][2] + bf_lo(oi[mt].y), o[mt][3] + bf_hi(oi[mt].y));
                *(u32x2*)(OFBw + (size_t)h * PSLOT + (size_t)(R0 + tr) * 128 + vcol + 4 * q4) = wv; }
            asm volatile("s_waitcnt lgkmcnt(0)" ::: "memory");
            __builtin_amdgcn_s_barrier();
        }
    }
}

constexpr int SG_ST = 136;
__device__ void sgu_tile(const Params& p, int l, int tile, LAS unsigned char* lds) {
    const int tid = opaque_tid(), w = tid >> 6, lane = tid & 63, l15 = lane & 15, q4 = lane >> 4;
    const int h = tile & 3, rowbase = (tile >> 2) * 128;
    const bf16_t* P = (const bf16_t*)(p.ws + WS_BIG);
    bf16_t* O = (bf16_t*)(p.ws + WS_H);
    LAS bf16_t* Vt = (LAS bf16_t*)lds;
    {
        const int q = tid >> 2, cgp = tid & 3;
        const bf16_t* vp = P + PIX(rowbase + q, 3072 + 128 * h + 32 * cgp);
        float g[32];
#pragma unroll
        for (int i = 0; i < 4; ++i) { const u32x4 r = *(const u32x4*)(vp + 8 * i);
#pragma unroll
            for (int j = 0; j < 4; ++j) { g[8 * i + 2 * j] = gelu_f(bf_lo(r[j])); g[8 * i + 2 * j + 1] = gelu_f(bf_hi(r[j])); } }
        float s = 0.f;
#pragma unroll
        for (int i = 0; i < 32; ++i) s += g[i];
        s += __shfl_xor(s, 1); s += __shfl_xor(s, 2);
        const float mu = s * (1.0f / 128.f);
        float vs = 0.f;
#pragma unroll
        for (int i = 0; i < 32; ++i) { const float d = g[i] - mu; vs += d * d; }
        vs += __shfl_xor(vs, 1); vs += __shfl_xor(vs, 2);
        const float rstd = rsqrtf(vs * (1.0f / 128.f) + EPS);
        const float* lng = p.in[12] + l * 512 + h * 128 + 32 * cgp; const float* lnb = p.in[13] + l * 512 + h * 128 + 32 * cgp;
#pragma unroll
        for (int i = 0; i < 32; ++i) { const float y = (g[i] - mu) * rstd * lng[i] + lnb[i]; Vt[(32 * cgp + i) * SG_ST + q] = to_bf1(y); }
    }
    __syncthreads();
    {
        const int prow = 16 * w + l15;
        const bf16_t* wsp = (const bf16_t*)(p.ws + WS_WSP) + ((size_t)(l * 4 + h) * 128 + prow) * 128 + 8 * q4;
        bf16x8 wf[4];
#pragma unroll
        for (int kb = 0; kb < 4; ++kb) wf[kb] = *(const bf16x8*)(wsp + 32 * kb);
        const float bs = p.in[15][(l * 4 + h) * 128 + prow];
        const bf16_t* up = P + PIX(rowbase + prow, 2560 + 128 * h + 4 * q4);
        bf16_t* op = O + (size_t)(rowbase + prow) * D + 512 + 128 * h + 4 * q4;
        u32x2 uall[8];
#pragma unroll
        for (int mt = 0; mt < 8; ++mt) uall[mt] = *(const u32x2*)(up + 16 * mt);
#pragma unroll
        for (int mt = 0; mt < 8; ++mt) {
            f32x4 acc = (f32x4){0.f, 0.f, 0.f, 0.f};
#pragma unroll
            for (int kb = 0; kb < 4; ++kb) { const bf16x8 af = *(const LAS bf16x8*)(Vt + (16 * mt + l15) * SG_ST + 32 * kb + 8 * q4);
                acc = __builtin_amdgcn_mfma_f32_16x16x32_bf16(af, wf[kb], acc, 0, 0, 0); }
            const u32x2 uu = uall[mt];
            const float u0 = gelu_f(bf_lo(uu.x)), u1 = gelu_f(bf_hi(uu.x)), u2 = gelu_f(bf_lo(uu.y)), u3 = gelu_f(bf_hi(uu.y));
            u32x2 wv; wv.x = pk_bf16(u0 * (acc[0] + bs), u1 * (acc[1] + bs)); wv.y = pk_bf16(u2 * (acc[2] + bs), u3 * (acc[3] + bs));
            *(u32x2*)(op + 16 * mt) = wv;
        }
    }
    __syncthreads();
}

constexpr int SGU_IN_M2 = 1088;
__device__ void phase_mixer(const Params& p, int l, LAS unsigned char* lds) {
    const int G = gridDim.x, bid = blockIdx.x;
    const int ntile = (l == 0) ? (NROW / 128) * 4 : (NLAT / 128) * 4;
    if (G > 128) {
        if (bid < 128) scan_chain(p, l, (bid >> 4) * 8 + (bid & 7), (bid >> 3) & 1, lds);
        else { for (int t = bid - 128; t < (ntile < SGU_IN_M2 ? ntile : SGU_IN_M2); t += G - 128) sgu_tile(p, l, t, lds);
               if (l + 1 < DEPTH) for (int t = bid - 128; t < NT_LAYER; t += G - 128) transpose_tile(p, lds, l + 1, t); }
    } else {
        for (int c = bid; c < 128; c += G) { scan_chain(p, l, c >> 1, c & 1, lds); __syncthreads(); }
        for (int t = bid; t < ntile; t += G) sgu_tile(p, l, t, lds);
        if (l + 1 < DEPTH) for (int t = bid; t < NT_LAYER; t += G) transpose_tile(p, lds, l + 1, t);
    }
}

__device__ void phase_combine(const Params& p, int l, int nrows) {
    const int tid_ = opaque_tid(); const int wave = tid_ >> 6, lane = tid_ & 63, hd = lane >> 4, v0 = (lane & 15) * 8;
    const bf16_t* P = (const bf16_t*)(p.ws + WS_BIG);
    const bf16_t* OF = (const bf16_t*)(p.ws + WS_OFB); const bf16_t* OB = OF + (size_t)NROW * 512;
    bf16_t* O = (bf16_t*)(p.ws + WS_H);
    const float* gn = p.in[11] + l * 512 + hd * 128 + v0;
    const f32x4 g0 = *(const f32x4*)gn, g1 = *(const f32x4*)(gn + 4);
    for (int row0 = (blockIdx.x * 8 + wave) * 4; row0 < nrows; row0 += gridDim.x * 32) {
        u32x4 a[4], bq[4], gg[4];
#pragma unroll
        for (int u = 0; u < 4; ++u) { const size_t row = row0 + u;
            a[u] = __builtin_nontemporal_load((const u32x4*)(OF + (size_t)hd * PSLOT + row * 128 + v0)); bq[u] = __builtin_nontemporal_load((const u32x4*)(OB + (size_t)hd * PSLOT + row * 128 + v0));
            gg[u] = __builtin_nontemporal_load((const u32x4*)(P + PIX((int)row, 2048 + hd * 128 + v0))); }
#pragma unroll
        for (int u = 0; u < 4; ++u) {
            float s[8]; float ss = 0.f;
#pragma unroll
            for (int j = 0; j < 4; ++j) { s[2 * j] = bf_lo(a[u][j]) + bf_lo(bq[u][j]); s[2 * j + 1] = bf_hi(a[u][j]) + bf_hi(bq[u][j]); ss += s[2 * j] * s[2 * j] + s[2 * j + 1] * s[2 * j + 1]; }
#pragma unroll
            for (int o = 8; o > 0; o >>= 1) ss += __shfl_xor(ss, o);
            const float rs = rsqrtf(ss * (1.0f / 128.f) + EPS);
            float y[8];
#pragma unroll
            for (int j = 0; j < 4; ++j) { y[2 * j] = s[2 * j] * rs * (j < 2 ? g0[2 * j] : g1[2 * j - 4]) * silu_f(bf_lo(gg[u][j])); y[2 * j + 1] = s[2 * j + 1] * rs * (j < 2 ? g0[2 * j + 1] : g1[2 * j - 3]) * silu_f(bf_hi(gg[u][j])); }
            u32x4 wv; wv.x = pk_bf16(y[0], y[1]); wv.y = pk_bf16(y[2], y[3]); wv.z = pk_bf16(y[4], y[5]); wv.w = pk_bf16(y[6], y[7]);
            *(u32x4*)(O + (size_t)(row0 + u) * D + hd * 128 + v0) = wv;
        }
    }
}

__device__ void phase_conv(const Params& p, int l, int nrows) {
    bf16_t* Aup = (bf16_t*)(p.ws + WS_BIG); const bf16_t* Gup = Aup + (size_t)NROW * FF;
    const float* cw = p.in[18] + (size_t)l * 9 * FF; const float* cb = p.in[19] + (size_t)l * FF;
    const int tid_ = opaque_tid();
    const long total = (long)(nrows / 16) * 352;
    for (long id0 = (long)blockIdx.x * 512 + tid_; id0 < total; id0 += (long)gridDim.x * 512) {
        const int seg = (int)((total - 1 - id0) / 352), f0 = (int)(id0 % 352) * 8;
        const int tok0 = seg * 16;
        int c0, W; bool up, dn;
        if (tok0 < NLAT) { const int t = tok0 & 4095, r = t >> 6; c0 = t & 63; W = 64; up = r > 0; dn = r < 63; }
        else { c0 = (tok0 - NLAT) & 255; W = 256; up = false; dn = false; }
        float tp[9][8]; float bias[8];
#pragma unroll
        for (int k = 0; k < 9; ++k) { const f32x4 t0 = *(const f32x4*)(cw + k * FF + f0), t1 = *(const f32x4*)(cw + k * FF + f0 + 4);
            tp[k][0] = t0[0]; tp[k][1] = t0[1]; tp[k][2] = t0[2]; tp[k][3] = t0[3]; tp[k][4] = t1[0]; tp[k][5] = t1[1]; tp[k][6] = t1[2]; tp[k][7] = t1[3]; }
        { const f32x4 b0 = *(const f32x4*)(cb + f0), b1 = *(const f32x4*)(cb + f0 + 4); bias[0] = b0[0]; bias[1] = b0[1]; bias[2] = b0[2]; bias[3] = b0[3]; bias[4] = b1[0]; bias[5] = b1[1]; bias[6] = b1[2]; bias[7] = b1[3]; }
        const u32x4 zero = (u32x4){0u, 0u, 0u, 0u};
        const bf16_t* gp = Gup + (size_t)tok0 * FF + f0;
        u32x4 L[3], M[3], R[3];
        { const bool v = c0 > 0;
          L[0] = (v && up) ? *(const u32x4*)(gp - (size_t)65 * FF) : zero; L[1] = v ? *(const u32x4*)(gp - (size_t)FF) : zero; L[2] = (v && dn) ? *(const u32x4*)(gp + (size_t)63 * FF) : zero; }
        M[0] = up ? *(const u32x4*)(gp - (size_t)64 * FF) : zero; M[1] = *(const u32x4*)gp; M[2] = dn ? *(const u32x4*)(gp + (size_t)64 * FF) : zero;
#pragma unroll 8
        for (int i = 0; i < 16; ++i) {
            const bf16_t* np = gp + (size_t)(i + 1) * FF;
            const bool v = (c0 + i + 1) < W;
            R[0] = (v && up) ? *(const u32x4*)(np - (size_t)64 * FF) : zero; R[1] = v ? *(const u32x4*)np : zero; R[2] = (v && dn) ? *(const u32x4*)(np + (size_t)64 * FF) : zero;
            float acc[8];
#pragma unroll
            for (int j = 0; j < 8; ++j) acc[j] = bias[j];
#pragma unroll
            for (int rr = 0; rr < 3; ++rr) {
#pragma unroll
                for (int j = 0; j < 4; ++j) {
                    acc[2 * j] += bf_lo(L[rr][j]) * tp[rr * 3 + 0][2 * j] + bf_lo(M[rr][j]) * tp[rr * 3 + 1][2 * j] + bf_lo(R[rr][j]) * tp[rr * 3 + 2][2 * j];
                    acc[2 * j + 1] += bf_hi(L[rr][j]) * tp[rr * 3 + 0][2 * j + 1] + bf_hi(M[rr][j]) * tp[rr * 3 + 1][2 * j + 1] + bf_hi(R[rr][j]) * tp[rr * 3 + 2][2 * j + 1];
                }
            }
            bf16_t* ap = Aup + (size_t)(tok0 + i) * FF + f0;
            const u32x4 av = __builtin_nontemporal_load((const u32x4*)ap);
            u32x4 wv;
#pragma unroll
            for (int j = 0; j < 4; ++j) wv[j] = pk_bf16(bf_lo(av[j]) * gelu_f(acc[2 * j]), bf_hi(av[j]) * gelu_f(acc[2 * j + 1]));
            *(u32x4*)ap = wv;
#pragma unroll
            for (int rr = 0; rr < 3; ++rr) { L[rr] = M[rr]; M[rr] = R[rr]; }
        }
    }
}

#define XB_TMO      128
#define XB_XCNT(j)  (256  + 64 * (j))
#define XB_XSUB(j)  (1280 + 64 * (j))
#define XB_XGEN(j)  (2304 + 64 * (j))
#define XB_TOP      3328
#define XB_TOPGEN   3392
#define XCD_BAR_WORDS 3456
#define XB_SPIN_CAP (1u << 20)
__device__ __forceinline__ unsigned xb_ld(unsigned* p)              { return __hip_atomic_load(p, __ATOMIC_RELAXED, __HIP_MEMORY_SCOPE_AGENT); }
__device__ __forceinline__ unsigned xb_add(unsigned* p, unsigned v) { return __hip_atomic_fetch_add(p, v, __ATOMIC_RELAXED, __HIP_MEMORY_SCOPE_AGENT); }
__device__ __forceinline__ unsigned xb_xcc_id() { return (unsigned)__builtin_amdgcn_s_getreg((3 << 11) | 20) & 0xFu; }
#define XB_SPIN(cond, bar) do { unsigned _sp = 0; while (cond) { __builtin_amdgcn_s_sleep(1); \
    if ((++_sp & 255u) == 0u) { if (xb_ld(&(bar)[XB_TMO])) break; if (_sp > XB_SPIN_CAP) { atomicAdd(&(bar)[XB_TMO], 1u); break; } } } } while (0)
struct XcdBarrier { unsigned* bar; unsigned x; volatile LAS unsigned* st; };
__device__ __forceinline__ XcdBarrier xcd_barrier_post(unsigned* bar, volatile LAS unsigned* st) {
    XcdBarrier b; b.bar = bar; b.x = xb_xcc_id(); b.st = st;
    if (threadIdx.x == 0) (void)xb_add(&bar[XB_XCNT(b.x)], 1u);
    return b;
}
__device__ __forceinline__ void xcd_barrier_complete(unsigned* bar, unsigned x, unsigned& nloc, unsigned& nx) {
    const unsigned G = gridDim.x * gridDim.y * gridDim.z;
    unsigned sum, cnt, mine, sp = 0u;
    for (;;) {
        sum = 0u; cnt = 0u; mine = 0u;
#pragma unroll
        for (unsigned j = 0; j < 16; ++j) { const unsigned c = xb_ld(&bar[XB_XCNT(j)]); sum += c; cnt += (c > 0u) ? 1u : 0u; mine = (j == x) ? c : mine; }
        if (sum == G) break;
        __builtin_amdgcn_s_sleep(1);
        if ((++sp & 255u) == 0u) { if (xb_ld(&bar[XB_TMO])) break; if (sp > XB_SPIN_CAP) { atomicAdd(&bar[XB_TMO], 1u); break; } }
    }
    nloc = mine > 0u ? mine : 1u; nx = cnt > 0u ? cnt : 1u;
}
__device__ __forceinline__ void xcd_barrier(const XcdBarrier& b) {
    asm volatile("s_waitcnt vmcnt(0)" ::: "memory");
    __syncthreads();
    if (threadIdx.x == 0) {
        unsigned* bar = b.bar;
        __builtin_amdgcn_s_waitcnt(0);
        unsigned nloc = b.st[0], nx = b.st[1];
        if (nloc == 0u) { xcd_barrier_complete(bar, b.x, nloc, nx); b.st[0] = nloc; b.st[1] = nx; }
        const unsigned old = xb_add(&bar[XB_XSUB(b.x)], 1u);
        const unsigned gen = old / nloc;
        if (old + 1u == (gen + 1u) * nloc) {
            __builtin_amdgcn_fence(__ATOMIC_RELEASE, "agent");
            asm volatile("s_waitcnt vmcnt(0)" ::: "memory");
            const unsigned og = xb_add(&bar[XB_TOP], 1u);
            const unsigned tg = og / nx;
            if (og + 1u == (tg + 1u) * nx) xb_add(&bar[XB_TOPGEN], 1u);
            else XB_SPIN(xb_ld(&bar[XB_TOPGEN]) == tg, bar);
            __builtin_amdgcn_fence(__ATOMIC_ACQUIRE, "agent");
            xb_add(&bar[XB_XGEN(b.x)], 1u);
            asm volatile("s_waitcnt vmcnt(0)" ::: "memory");
        } else {
            XB_SPIN(xb_ld(&bar[XB_XGEN(b.x)]) == gen, bar);
            __builtin_amdgcn_fence(__ATOMIC_ACQUIRE, "agent");
            asm volatile("s_waitcnt vmcnt(0)" ::: "memory");
        }
    }
    __syncthreads();
}

__global__ void __launch_bounds__(512, 2) fwd_megakernel(Params p) {
    extern __shared__ __attribute__((aligned(16))) unsigned char shm[];
    LAS unsigned char* lds = (LAS unsigned char*)shm;
    cg::grid_group grid = cg::this_grid();
    __shared__ uint4 xb_words;
    if (threadIdx.x == 0) xb_words = make_uint4(0u, 0u, 0u, 0u);
    __syncthreads();
    const XcdBarrier xb = xcd_barrier_post((unsigned*)(p.ws + WS_BAR), (volatile LAS unsigned*)&xb_words);
    const int G = gridDim.x, bid = blockIdx.x;
    float* XC = (float*)(p.ws + WS_XC);
    bf16_t* H = (bf16_t*)(p.ws + WS_H);
    bf16_t* BIG = (bf16_t*)(p.ws + WS_BIG);
    const float* ADA = (const float*)(p.ws + WS_ADA);
    bf16_t* Y2 = BIG + (size_t)NROW * FF;

    phase_prep(p, lds);
    if (p.ws == nullptr) grid.sync();
    xcd_barrier(xb);
    for (int l = 0; l < DEPTH; ++l) {
        const bool last = (l == DEPTH - 1);
        const float* ada_l = ADA + (size_t)l * 9 * 6144;
        const float* xl = (l == 0) ? p.in[0] : p.out;
        const float* xc = (l == 0) ? p.in[2] : XC;
        const int Mfull = last ? NLAT : NROW;
        if (l == 0) phase_norm(xl, xc, nullptr, nullptr, nullptr, nullptr, p.in[6] + l * D, ada_l, 0, NROW, H);
        else phase_norm(p.out, XC, Y2, ADA + (size_t)(l - 1) * 9 * 6144 + 5 * 1024, p.out, nullptr, p.in[6] + l * D, ada_l, 0, NROW, H);
        xcd_barrier(xb);
        { pg8::StaticOrder S; S.init(NROW, PW, G, bid);
          pg8::EpiBf16 E{BIG, PW, 0, 0, PSLOT};
          pg8::gemm_phase(lds, pg8::Gemm{H, (const bf16_t*)(p.ws + WS_WIN) + (size_t)l * PW * D, NROW, PW, D}, S, E); }
        xcd_barrier(xb);
        { const int ntile = (l == 0) ? (NROW / 128) * 4 : (NLAT / 128) * 4;
          const int nextra = (G > 128 && ntile > SGU_IN_M2) ? ntile - SGU_IN_M2 : 0;
          for (int it = bid; it < 32 * NCH + nextra; it += G) { if (it < 32 * NCH) prep_item(p, l, 32 * NCH - 1 - it, lds); else sgu_tile(p, l, SGU_IN_M2 + it - 32 * NCH, lds); } }
        xcd_barrier(xb);
        phase_mixer(p, l, lds);
        xcd_barrier(xb);
        phase_combine(p, l, Mfull);
        xcd_barrier(xb);
        { pg8::StaticOrder S; S.init(Mfull, D, G, bid);
          pg8::EpiBf16 E{BIG, D, 0, 0, 0};
          pg8::gemm_phase(lds, pg8::Gemm{H, (const bf16_t*)(p.ws + WS_WOUT) + (size_t)l * D * D, Mfull, D, D}, S, E); }
        xcd_barrier(xb);
        phase_norm(xl, xc, BIG, ada_l + 2 * 1024, p.out, XC, p.in[7] + l * D, ada_l, 3, Mfull, H);
        xcd_barrier(xb);
        { pg8::StaticOrder S; S.init(Mfull, UPW, G, bid);
          pg8::EpiBf16 E{BIG, FF, FF, (size_t)NROW * FF, 0};
          pg8::gemm_phase(lds, pg8::Gemm{H, (const bf16_t*)(p.ws + WS_WUP) + (size_t)l * UPW * D, Mfull, UPW, D}, S, E); }
        xcd_barrier(xb);
        phase_conv(p, l, Mfull);
        xcd_barrier(xb);
        { pg8::StaticOrder S; S.init(Mfull, D, G, bid);
          pg8::EpiBf16 E{Y2, D, 0, 0, 0};
          pg8::gemm_phase(lds, pg8::Gemm{BIG, (const bf16_t*)(p.ws + WS_WDOWN) + (size_t)l * D * FF, Mfull, D, FF}, S, E); }
        xcd_barrier(xb);
    }
    phase_final(p.out, Y2, ADA + (size_t)(DEPTH - 1) * 9 * 6144 + 5 * 1024, p.in[21]);
}

extern "C" void kernel_launch(void* const* d_in, const int* in_sizes, int n_in, void* d_out, int out_size, void* d_ws, size_t ws_size, hipStream_t stream) {
    constexpr int LDS_BYTES = 155648;
    static int grid_blocks = 0;
    if (!grid_blocks) {
        int dev = 0, cus = 0, per_cu = 0;
        (void)hipGetDevice(&dev);
        (void)hipDeviceGetAttribute(&cus, hipDeviceAttributeMultiprocessorCount, dev);
        (void)hipFuncSetAttribute((const void*)fwd_megakernel, hipFuncAttributeMaxDynamicSharedMemorySize, LDS_BYTES);
        (void)hipOccupancyMaxActiveBlocksPerMultiprocessor(&per_cu, (const void*)fwd_megakernel, 512, LDS_BYTES);
        if (per_cu < 1) per_cu = 1;
        grid_blocks = cus * per_cu;
        if (ws_size < WS_END) fprintf(stderr, "workspace too small: %zu < %zu\n", ws_size, (size_t)WS_END);
    }
    Params p{};
    for (int i = 0; i < 22; ++i) p.in[i] = (const float*)d_in[i];
    p.out = (float*)d_out; p.ws = (unsigned char*)d_ws;
    (void)hipMemsetAsync((unsigned char*)d_ws + WS_BAR, 0, XCD_BAR_WORDS * 4, stream);
    void* args[] = {&p};
    hipError_t e = hipLaunchCooperativeKernel((const void*)fwd_megakernel, dim3(grid_blocks), dim3(512), args, LDS_BYTES, stream);
    if (e != hipSuccess) fprintf(stderr, "cooperative launch failed: %s (grid %d)\n", hipGetErrorString(e), grid_blocks);
}
```
